# Optimizing an MI355X kernel written in HIP

```python
import math, functools
import jax, jax.numpy as jnp
from jax import lax
import numpy as np


D_MODEL = 1024
BATCH = 8
SEQ = 2048
DEPTH = 2
DEC_BATCH = 128
DEC_SEQ = 4
PAST_LEN = 16384
PAGE_SIZE = 128

N_META = 16
N_EVEN = (DEPTH + 1) // 2
N_ODD = DEPTH // 2
H_A = 4
DK_A = 128
DV_A = 128
H_B = 4
DK_B = 64
DV_B = 128
GLA_RANK = 16
GLA_TAU = 16.0
LA_CHUNK = 32
D_INNER = 2 * D_MODEL
HEAD_P = 64
H_C = D_INNER // HEAD_P
D_STATE = 128
N_GROUPS = 4
D_CONV = 4
CONV_DIM = D_INNER + 2 * N_GROUPS * D_STATE
SSD_CHUNK = 64
D_FF = -(-8 * D_MODEL // (3 * 256)) * 256
EPS = 1e-6

IN_EVEN = 2 * H_A * DK_A + 2 * H_A * DV_A + 2 * H_B * DK_B + 2 * H_B * DV_B + GLA_RANK
OUT_EVEN = H_A * DV_A + H_B * DV_B
IN_ODD = D_INNER + CONV_DIM + H_C

kernel_name = 'hybrid_hgrn2_gla_mamba2_step'


def rmsnorm(x, w):
    xf = x.astype(jnp.float32)
    y = xf * lax.rsqrt(jnp.mean(xf * xf, axis=-1, keepdims=True) + EPS)
    return (y * w.astype(jnp.float32)).astype(x.dtype)


def run_segments(scan_fn, arrays, state, seg_lens):
    outs = []
    start = 0
    for length in seg_lens:
        o, state = scan_fn(*[a[:, start:start + length] for a in arrays], state)
        outs.append(o)
        start += length
    return jnp.concatenate(outs, axis=1), state


def gated_linear_scan(q, k, v, log_f, s0):
    f32 = jnp.float32
    b, t, h, dk = q.shape
    dv = v.shape[-1]
    c = math.gcd(t, LA_CHUNK)
    n = t // c
    qc = q.astype(f32).reshape(b, n, c, h, dk)
    kc = k.astype(f32).reshape(b, n, c, h, dk)
    vc = v.astype(f32).reshape(b, n, c, h, dv)
    cum = jnp.cumsum(log_f.astype(f32).reshape(b, n, c, h, dk), axis=2)
    last = cum[:, :, -1:]
    q_e = qc * jnp.exp(cum)
    k_e = kc * jnp.exp(-cum)
    k_end = kc * jnp.exp(last - cum)
    causal = jnp.tril(jnp.ones((c, c), dtype=bool))
    scores = jnp.where(causal, jnp.einsum('bnihk,bnjhk->bnhij', q_e, k_e), 0.0)
    o_intra = jnp.einsum('bnhij,bnjhv->bnihv', scores, vc)
    u = jnp.einsum('bnjhk,bnjhv->bnhkv', k_end, vc)
    decay = jnp.exp(last[:, :, 0])

    def step(s, inp):
        d_n, u_n = inp
        return d_n[..., None] * s + u_n, s

    s_last, s_start = lax.scan(step, s0.astype(f32), (jnp.moveaxis(decay, 1, 0), jnp.moveaxis(u, 1, 0)))
    s_start = jnp.moveaxis(s_start, 0, 1)
    o_inter = jnp.einsum('bnihk,bnhkv->bnihv', q_e, s_start)
    return (o_intra + o_inter).reshape(b, t, h, dv), s_last


def ssd_scan(x, dt, bm, cm, s0, a_neg):
    f32 = jnp.float32
    b, t, h, p = x.shape
    g, ds = bm.shape[2], bm.shape[3]
    r = h // g
    c = math.gcd(t, SSD_CHUNK)
    n = t // c
    xc = x.astype(f32).reshape(b, n, c, g, r, p)
    dtc = dt.astype(f32).reshape(b, n, c, g, r)
    bc = bm.astype(f32).reshape(b, n, c, g, ds)
    cc = cm.astype(f32).reshape(b, n, c, g, ds)
    cum = jnp.cumsum(dtc * a_neg.reshape(g, r), axis=2)
    cum_t = jnp.moveaxis(cum, 2, -1)
    diff = cum_t[..., :, None] - cum_t[..., None, :]
    causal = jnp.tril(jnp.ones((c, c), dtype=bool))
    decay_ij = jnp.exp(jnp.where(causal, diff, -jnp.inf))
    xdt = xc * dtc[..., None]
    cb = jnp.einsum('bnigs,bnjgs->bngij', cc, bc)
    y_intra = jnp.einsum('bngrij,bnjgrp->bnigrp', cb[:, :, :, None] * decay_ij, xdt)
    decay_end = jnp.exp(cum[:, :, -1:] - cum)
    u = jnp.einsum('bnjgrp,bnjgs->bngrps', xdt * decay_end[..., None], bc)
    chunk_decay = jnp.exp(cum[:, :, -1])

    def step(s, inp):
        d_n, u_n = inp
        return d_n[..., None, None] * s + u_n, s

    s_init = s0.astype(f32).reshape(b, g, r, p, ds)
    s_last, s_start = lax.scan(step, s_init, (jnp.moveaxis(chunk_decay, 1, 0), jnp.moveaxis(u, 1, 0)))
    s_start = jnp.moveaxis(s_start, 0, 1)
    y_inter = jnp.einsum('bnigs,bngrps->bnigrp', cc, s_start) * jnp.exp(cum)[..., None]
    return (y_intra + y_inter).reshape(b, t, h, p), s_last.reshape(b, h, p, ds)


def even_mixer(h, s_hgrn, s_gla, seg, lb, w_in, w_alpha_up, b_alpha, norm_a, norm_b, w_out):
    f32 = jnp.float32
    b, t, _ = h.shape
    wa_k, wa_v, wb_k, wb_v = H_A * DK_A, H_A * DV_A, H_B * DK_B, H_B * DV_B
    sizes = [wa_k, wa_k, wa_v, wa_v, wb_k, wb_k, wb_v, wb_v, GLA_RANK]
    idx = [int(v) for v in np.cumsum(sizes)[:-1]]
    qa, fa, ia, ga, qb, kb, vb, gb, alow = jnp.split(h @ w_in, idx, axis=-1)
    lbh = lb.reshape(H_A, DK_A)
    f_a = lbh + (1.0 - lbh) * jax.nn.sigmoid(fa.astype(f32).reshape(b, t, H_A, DK_A))
    o_a, s_a = run_segments(gated_linear_scan,
                            [qa.reshape(b, t, H_A, DK_A), 1.0 - f_a, ia.reshape(b, t, H_A, DV_A), jnp.log(f_a)],
                            s_hgrn, seg)
    o_a = rmsnorm(o_a, norm_a) * jax.nn.silu(ga.astype(f32).reshape(b, t, H_A, DV_A))
    log_alpha = jax.nn.log_sigmoid((alow @ w_alpha_up + b_alpha).astype(f32)) / GLA_TAU
    o_b, s_b = run_segments(gated_linear_scan,
                            [qb.reshape(b, t, H_B, DK_B) * (DK_B ** -0.5), kb.reshape(b, t, H_B, DK_B),
                             vb.reshape(b, t, H_B, DV_B), log_alpha.reshape(b, t, H_B, DK_B)],
                            s_gla, seg)
    o_b = rmsnorm(o_b, norm_b) * jax.nn.silu(gb.astype(f32).reshape(b, t, H_B, DV_B))
    o = jnp.concatenate([o_a.reshape(b, t, wa_v), o_b.reshape(b, t, wb_v)], axis=-1).astype(h.dtype)
    return o @ w_out, s_a, s_b


def odd_mixer(h, s_ssm, s_conv, seg, w_in, conv_w, conv_b, dt_bias, a_log, d_skip, norm_w, w_out):
    f32 = jnp.float32
    b, t, _ = h.shape
    z, xbc, dt = jnp.split(h @ w_in, [D_INNER, D_INNER + CONV_DIM], axis=-1)
    xpad = jnp.concatenate([s_conv.astype(xbc.dtype), xbc], axis=1)
    new_conv = xpad[:, t:]
    conv = conv_b.astype(f32) + sum(xpad[:, k:k + t].astype(f32) * conv_w[k].astype(f32) for k in range(D_CONV))
    xbc = jax.nn.silu(conv)
    xs, bm, cm = jnp.split(xbc, [D_INNER, D_INNER + N_GROUPS * D_STATE], axis=-1)
    xs = xs.reshape(b, t, H_C, HEAD_P)
    bm = bm.reshape(b, t, N_GROUPS, D_STATE)
    cm = cm.reshape(b, t, N_GROUPS, D_STATE)
    dt = jax.nn.softplus(dt.astype(f32) + dt_bias.astype(f32))
    a_neg = -jnp.exp(a_log.astype(f32))
    y, s_new = run_segments(functools.partial(ssd_scan, a_neg=a_neg), [xs, dt, bm, cm], s_ssm, seg)
    y = y + d_skip.astype(f32)[:, None] * xs
    y = y.reshape(b, t, D_INNER) * jax.nn.silu(z.astype(f32))
    y = rmsnorm(y.reshape(b, t, N_GROUPS, D_INNER // N_GROUPS), norm_w.reshape(N_GROUPS, D_INNER // N_GROUPS))
    return y.reshape(b, t, D_INNER).astype(h.dtype) @ w_out, s_new, new_conv


def swiglu(x, w_gate, w_up, w_down):
    return (jax.nn.silu(x @ w_gate) * (x @ w_up)) @ w_down


def trunk(x, seg, st_hgrn, st_gla, st_ssm, st_conv, lb_all,
          norm_mix_pre, norm_mix_post, norm_ffn_pre, norm_ffn_post,
          ev_w_in, ev_w_alpha_up, ev_b_alpha, ev_norm_a, ev_norm_b, ev_w_out,
          od_w_in, od_conv_w, od_conv_b, od_dt_bias, od_a_log, od_d_skip, od_norm, od_w_out,
          ffn_w_gate, ffn_w_up, ffn_w_down):
    new_hgrn, new_gla, new_ssm, new_conv = [], [], [], []
    for l in range(DEPTH):
        hn = rmsnorm(x, norm_mix_pre[l])
        if l % 2 == 0:
            e = l // 2
            mix, s_a, s_b = even_mixer(hn, st_hgrn[e], st_gla[e], seg, lb_all[l],
                                       ev_w_in[e], ev_w_alpha_up[e], ev_b_alpha[e],
                                       ev_norm_a[e], ev_norm_b[e], ev_w_out[e])
            new_hgrn.append(s_a)
            new_gla.append(s_b)
        else:
            o = l // 2
            mix, s_c, c_c = odd_mixer(hn, st_ssm[o], st_conv[o], seg, od_w_in[o], od_conv_w[o], od_conv_b[o],
                                      od_dt_bias[o], od_a_log[o], od_d_skip[o], od_norm[o], od_w_out[o])
            new_ssm.append(s_c)
            new_conv.append(c_c)
        x = x + rmsnorm(mix.astype(x.dtype), norm_mix_post[l])
        ff = swiglu(rmsnorm(x, norm_ffn_pre[l]), ffn_w_gate[l], ffn_w_up[l], ffn_w_down[l])
        x = x + rmsnorm(ff.astype(x.dtype), norm_ffn_post[l])
    return x, jnp.stack(new_hgrn), jnp.stack(new_gla), jnp.stack(new_ssm), jnp.stack(new_conv)


def setup_inputs(seed: int = 0) -> dict:
    key = jax.random.key(seed)
    ks = jax.random.split(key, 32)
    f32 = jnp.float32

    def nrm(k, shape, scale):
        return jax.random.normal(k, shape, f32) * scale

    def gain(k, shape):
        return 1.0 + 0.05 * jax.random.normal(k, shape, f32)

    dt0 = jnp.exp(jax.random.uniform(ks[21], (N_ODD, H_C), f32, math.log(1e-3), math.log(1e-1)))
    return {
        'x_prompt': nrm(ks[0], (BATCH, SEQ, D_MODEL), 1.0),
        'x_sample': nrm(ks[1], (DEC_BATCH, DEC_SEQ, D_MODEL), 1.0),
        'state_hgrn': nrm(ks[2], (N_EVEN, DEC_BATCH, H_A, DK_A, DV_A), 0.5),
        'state_gla': nrm(ks[3], (N_EVEN, DEC_BATCH, H_B, DK_B, DV_B), 0.5),
        'state_ssm': nrm(ks[4], (N_ODD, DEC_BATCH, H_C, HEAD_P, D_STATE), 0.5),
        'state_conv': nrm(ks[5], (N_ODD, DEC_BATCH, D_CONV - 1, CONV_DIM), 1.0),
        'meta_tokens': nrm(ks[6], (N_META, D_MODEL), 1.0),
        'hgrn_gamma': nrm(ks[7], (DEPTH + 1, H_A * DK_A), 0.5),
        'norm_mix_pre': gain(ks[8], (DEPTH, D_MODEL)),
        'norm_mix_post': gain(ks[9], (DEPTH, D_MODEL)),
        'norm_ffn_pre': gain(ks[10], (DEPTH, D_MODEL)),
        'norm_ffn_post': gain(ks[11], (DEPTH, D_MODEL)),
        'ev_w_in': nrm(ks[12], (N_EVEN, D_MODEL, IN_EVEN), D_MODEL ** -0.5),
        'ev_w_alpha_up': nrm(ks[13], (N_EVEN, GLA_RANK, H_B * DK_B), GLA_RANK ** -0.5),
        'ev_b_alpha': nrm(ks[14], (N_EVEN, H_B * DK_B), 0.1),
        'ev_norm_a': gain(ks[15], (N_EVEN, DV_A)),
        'ev_norm_b': gain(ks[16], (N_EVEN, DV_B)),
        'ev_w_out': nrm(ks[17], (N_EVEN, OUT_EVEN, D_MODEL), OUT_EVEN ** -0.5),
        'od_w_in': nrm(ks[18], (N_ODD, D_MODEL, IN_ODD), D_MODEL ** -0.5),
        'od_conv_w': nrm(ks[19], (N_ODD, D_CONV, CONV_DIM), D_CONV ** -0.5),
        'od_conv_b': nrm(ks[20], (N_ODD, CONV_DIM), 0.02),
        'od_dt_bias': dt0 + jnp.log(-jnp.expm1(-dt0)),
        'od_a_log': jnp.log(jax.random.uniform(ks[22], (N_ODD, H_C), f32, 1.0, 16.0)),
        'od_d_skip': gain(ks[23], (N_ODD, H_C)),
        'od_norm': gain(ks[24], (N_ODD, D_INNER)),
        'od_w_out': nrm(ks[25], (N_ODD, D_INNER, D_MODEL), D_INNER ** -0.5),
        'ffn_w_gate': nrm(ks[26], (DEPTH, D_MODEL, D_FF), D_MODEL ** -0.5),
        'ffn_w_up': nrm(ks[27], (DEPTH, D_MODEL, D_FF), D_MODEL ** -0.5),
        'ffn_w_down': nrm(ks[28], (DEPTH, D_FF, D_MODEL), D_FF ** -0.5),
    }


def reference(x_prompt, x_sample, state_hgrn, state_gla, state_ssm, state_conv, meta_tokens, hgrn_gamma,
              norm_mix_pre, norm_mix_post, norm_ffn_pre, norm_ffn_post,
              ev_w_in, ev_w_alpha_up, ev_b_alpha, ev_norm_a, ev_norm_b, ev_w_out,
              od_w_in, od_conv_w, od_conv_b, od_dt_bias, od_a_log, od_d_skip, od_norm, od_w_out,
              ffn_w_gate, ffn_w_up, ffn_w_down):
    f32 = jnp.float32
    lb_all = jnp.cumsum(jax.nn.softmax(hgrn_gamma.astype(f32), axis=0), axis=0)
    w = (norm_mix_pre, norm_mix_post, norm_ffn_pre, norm_ffn_post,
         ev_w_in, ev_w_alpha_up, ev_b_alpha, ev_norm_a, ev_norm_b, ev_w_out,
         od_w_in, od_conv_w, od_conv_b, od_dt_bias, od_a_log, od_d_skip, od_norm, od_w_out,
         ffn_w_gate, ffn_w_up, ffn_w_down)
    bp, sp = x_prompt.shape[0], x_prompt.shape[1]
    meta = jnp.broadcast_to(meta_tokens.astype(x_prompt.dtype)[None], (bp, N_META, D_MODEL))
    xp = jnp.concatenate([meta, x_prompt], axis=1)
    z_hgrn = jnp.zeros((N_EVEN, bp, H_A, DK_A, DV_A), f32)
    z_gla = jnp.zeros((N_EVEN, bp, H_B, DK_B, DV_B), f32)
    z_ssm = jnp.zeros((N_ODD, bp, H_C, HEAD_P, D_STATE), f32)
    z_conv = jnp.zeros((N_ODD, bp, D_CONV - 1, CONV_DIM), x_prompt.dtype)
    yp, hgrn_p, gla_p, ssm_p, conv_p = trunk(xp, (N_META, sp), z_hgrn, z_gla, z_ssm, z_conv, lb_all, *w)
    ys, hgrn_s, gla_s, ssm_s, conv_s = trunk(x_sample, (x_sample.shape[1],), state_hgrn, state_gla,
                                             state_ssm, state_conv, lb_all, *w)
    return (yp[:, N_META:], ys, hgrn_p, gla_p, ssm_p, conv_p, hgrn_s, gla_s, ssm_s, conv_s)
```

```cpp
#include <hip/hip_runtime.h>
#include <hip/hip_cooperative_groups.h>
#include <cstdio>
#include <cstdint>
namespace cg = cooperative_groups;

#ifndef ONE_LAUNCH
#define ONE_LAUNCH 1
#endif

#define DI __device__ __forceinline__
typedef unsigned short bf16_t;
typedef short bf16x8 __attribute__((ext_vector_type(8)));
typedef short s16x4 __attribute__((ext_vector_type(4)));
typedef float f32x16 __attribute__((ext_vector_type(16)));
typedef float f32x4 __attribute__((ext_vector_type(4)));
typedef float f32x2 __attribute__((ext_vector_type(2)));
typedef unsigned u32x4 __attribute__((ext_vector_type(4)));
typedef unsigned u32x2 __attribute__((ext_vector_type(2)));
typedef __bf16 bf16v2 __attribute__((ext_vector_type(2)));
#define MFMA32(a, b, c) __builtin_amdgcn_mfma_f32_32x32x16_bf16((a), (b), (c), 0, 0, 0)

constexpr int T_ALL = 17024, T_PAD = 17152, T_PROMPT = 16512, SEQP = 2064, NTHREADS = 512, HB = 256  ;
constexpr int LD_EV = 3840, LD_OD = 5376;
constexpr int HALF_LDS = 75776;
constexpr int LDS_BYTES = 2 * HALF_LDS + 32;

constexpr size_t OFF_WT_EVIN = 0;
constexpr size_t OFF_WT_EVOUT = OFF_WT_EVIN + (size_t)3840 * 1024 * 2;
constexpr size_t OFF_WT_GU = OFF_WT_EVOUT + (size_t)1024 * 1024 * 2;
constexpr size_t SZ_WT_GU1 = (size_t)5632 * 1024 * 2;
constexpr size_t OFF_WT_DN = OFF_WT_GU + 2 * SZ_WT_GU1;
constexpr size_t SZ_WT_DN1 = (size_t)1024 * 2816 * 2;
constexpr size_t OFF_WT_ODIN = OFF_WT_DN + 2 * SZ_WT_DN1;
constexpr size_t OFF_WT_ODOUT = OFF_WT_ODIN + (size_t)5376 * 1024 * 2;
constexpr size_t OFF_X = OFF_WT_ODOUT + (size_t)1024 * 2048 * 2;
constexpr size_t OFF_HN = OFF_X + (size_t)T_PAD * 1024 * 4;
constexpr size_t OFF_P = OFF_HN + (size_t)T_PAD * 1024 * 2;
constexpr size_t OFF_O = OFF_P + (size_t)T_PAD * 5376 * 2;
constexpr size_t OFF_MIX = OFF_O + (size_t)T_PAD * 2048 * 2;
constexpr size_t OFF_SSQ = OFF_MIX + (size_t)T_PAD * 1024 * 4;
constexpr size_t OFF_BAR = OFF_SSQ + (size_t)T_PAD * 16 * 4;
constexpr size_t WS_END = OFF_BAR + 16384;

constexpr size_t OUT_YP = 0;
constexpr size_t OUT_YS = 16777216;
constexpr size_t OUT_HGP = OUT_YS + 524288;
constexpr size_t OUT_GLP = OUT_HGP + 524288;
constexpr size_t OUT_SSP = OUT_GLP + 262144;
constexpr size_t OUT_CVP = OUT_SSP + 2097152;
constexpr size_t OUT_HGS = OUT_CVP + 73728;
constexpr size_t OUT_GLS = OUT_HGS + 8388608;
constexpr size_t OUT_SSS = OUT_GLS + 4194304;
constexpr size_t OUT_CVS = OUT_SSS + 33554432;

struct Params { const float* in[29]; float* out; char* ws; };

DI unsigned pk2(float lo, float hi) { f32x2 v = {lo, hi}; bf16v2 b = __builtin_convertvector(v, bf16v2); return __builtin_bit_cast(unsigned, b); }
DI float bflo(unsigned u) { return __uint_as_float(u << 16); }
DI float bfhi(unsigned u) { return __uint_as_float(u & 0xffff0000u); }
DI f32x4 ld_bf4(const bf16_t* p) { const u32x2 u = *(const u32x2*)p; return (f32x4){bflo(u[0]), bfhi(u[0]), bflo(u[1]), bfhi(u[1])}; }
DI void st_bf4(bf16_t* p, f32x4 v) { u32x2 u; u[0] = pk2(v.x, v.y); u[1] = pk2(v.z, v.w); *(u32x2*)p = u; }
DI float sigmoidf_(float x) { return __builtin_amdgcn_rcpf(1.f + __expf(-x)); }
DI float siluf_(float x) { return x * sigmoidf_(x); }
DI int crow(int r, int h) { return (r & 3) + 8 * (r >> 2) + 4 * h; }
DI bf16x8 cat8(s16x4 lo, s16x4 hi) { return __builtin_shufflevector(lo, hi, 0, 1, 2, 3, 4, 5, 6, 7); }
template <int S> DI bf16x8 pack8(const f32x16& x) {
  u32x4 p;
  p[0] = pk2(x[8 * S + 0], x[8 * S + 1]); p[1] = pk2(x[8 * S + 2], x[8 * S + 3]);
  p[2] = pk2(x[8 * S + 4], x[8 * S + 5]); p[3] = pk2(x[8 * S + 6], x[8 * S + 7]);
  return __builtin_bit_cast(bf16x8, p);
}
DI float wave_sum(float v) {
#pragma unroll
  for (int o = 1; o < 64; o <<= 1) v += __shfl_xor(v, o);
  return v;
}
DI void zero16(f32x16& a) {
#pragma unroll
  for (int i = 0; i < 16; ++i) a[i] = 0.f;
}

DI void transpose_tile(const float* __restrict__ W, int K, int N, bf16_t* Wt, int mode, int kt, int nt, float* tile, bool active) {
  const int tid = threadIdx.x & (HB - 1), k0 = kt * 64, n0 = nt * 64;
  if (active) {
    const int c = tid & 63, r0 = tid >> 6, n = n0 + c;
#pragma unroll
    for (int i = 0; i < 16; ++i) { const int k = r0 + 4 * i; tile[k * 65 + c] = (n < N) ? W[(size_t)(k0 + k) * N + n] : 0.f; }
  }
  __syncthreads();
  if (active) {
    const int nl = tid >> 2, kc = (tid & 3) * 16, n = n0 + nl;
    int drow = n;
    if (mode == 1) drow = (n >> 7) * 256 + (n & 127);
    if (mode == 2) drow = (n >> 7) * 256 + 128 + (n & 127);
    u32x4 o0, o1;
#pragma unroll
    for (int j = 0; j < 4; ++j) {
      o0[j] = pk2(tile[(kc + 2 * j) * 65 + nl], tile[(kc + 2 * j + 1) * 65 + nl]);
      o1[j] = pk2(tile[(kc + 8 + 2 * j) * 65 + nl], tile[(kc + 8 + 2 * j + 1) * 65 + nl]);
    }
    u32x4* d = (u32x4*)(Wt + (size_t)drow * K + k0 + kc);
    d[0] = o0; d[1] = o1;
  }
  __syncthreads();
}

DI void rms_row_to_bf16(const f32x4 (&v)[4], const float* __restrict__ wn, bf16_t* dst, int lane) {
  float s = 0.f;
#pragma unroll
  for (int j = 0; j < 4; ++j) s += v[j].x * v[j].x + v[j].y * v[j].y + v[j].z * v[j].z + v[j].w * v[j].w;
  const float rstd = rsqrtf(wave_sum(s) * (1.f / 1024.f) + 1e-6f);
#pragma unroll
  for (int j = 0; j < 4; ++j) {
    const f32x4 g = *(const f32x4*)(wn + 256 * j + 4 * lane);
    u32x2 o; o[0] = pk2(v[j].x * rstd * g.x, v[j].y * rstd * g.y); o[1] = pk2(v[j].z * rstd * g.z, v[j].w * rstd * g.w);
    *(u32x2*)(dst + 256 * j + 4 * lane) = o;
  }
}

DI void phase_prep(const Params& p, char* lds, int bid, int G) {
  const int half = threadIdx.x >> 8;
  float* tile = (float*)(lds + half * HALF_LDS);
  constexpr int NT_TILES = 960 + 256 + 1408 + 1408 + 1408 + 1344 + 512;
  for (int tb = bid * 2; tb < NT_TILES; tb += G * 2) {
    const int t = tb + half;
    const bool active = t < NT_TILES;
    const float* W = p.in[12]; int K = 1024, N = 3600, nnt = 60, mode = 0; bf16_t* dst = (bf16_t*)(p.ws + OFF_WT_EVIN); int r = active ? t : 0;
    if (r < 960) { }
    else if ((r -= 960) < 256) { W = p.in[17]; K = 1024; N = 1024; nnt = 16; dst = (bf16_t*)(p.ws + OFF_WT_EVOUT); }
    else if ((r -= 256) < 1408) { const int l = r / 704; r -= l * 704; W = p.in[26] + (size_t)l * 1024 * 2816; K = 1024; N = 2816; nnt = 44; mode = 1; dst = (bf16_t*)(p.ws + OFF_WT_GU + l * SZ_WT_GU1); }
    else if ((r -= 1408) < 1408) { const int l = r / 704; r -= l * 704; W = p.in[27] + (size_t)l * 1024 * 2816; K = 1024; N = 2816; nnt = 44; mode = 2; dst = (bf16_t*)(p.ws + OFF_WT_GU + l * SZ_WT_GU1); }
    else if ((r -= 1408) < 1408) { const int l = r / 704; r -= l * 704; W = p.in[28] + (size_t)l * 2816 * 1024; K = 2816; N = 1024; nnt = 16; dst = (bf16_t*)(p.ws + OFF_WT_DN + l * SZ_WT_DN1); }
    else if ((r -= 1408) < 1344) { W = p.in[18]; K = 1024; N = 5152; nnt = 84; dst = (bf16_t*)(p.ws + OFF_WT_ODIN); }
    else { r -= 1344; W = p.in[25]; K = 2048; N = 1024; nnt = 16; dst = (bf16_t*)(p.ws + OFF_WT_ODOUT); }
    const int kt = r / nnt, nt = r - kt * nnt;
    transpose_tile(W, K, N, dst, mode, kt, nt, tile, active);
  }
  const int lane = threadIdx.x & 63, w = threadIdx.x >> 6;
  bf16_t* X = (bf16_t*)(p.ws + OFF_X);
  bf16_t* HN = (bf16_t*)(p.ws + OFF_HN);
  for (int row = bid * 8 + w; row < T_ALL; row += G * 8) {
    const float* src;
    if (row < T_PROMPT) { const int b = row / SEQP, t = row - b * SEQP; src = (t < 16) ? p.in[6] + (size_t)t * 1024 : p.in[0] + ((size_t)b * 2048 + (t - 16)) * 1024; }
    else src = p.in[1] + (size_t)(row - T_PROMPT) * 1024;
    f32x4 v[4];
#pragma unroll
    for (int j = 0; j < 4; ++j) { v[j] = *(const f32x4*)(src + 256 * j + 4 * lane); st_bf4(X + (size_t)row * 1024 + 256 * j + 4 * lane, v[j]); }
    rms_row_to_bf16(v, p.in[8], HN + (size_t)row * 1024, lane);
  }
}

DI void phase_rowwise(const Params& p, const float* __restrict__ wpost, const float* __restrict__ wpre, bool final_, const float* PART, int nsplit, int bid, int G) {
  const int lane = threadIdx.x & 63, w = threadIdx.x >> 6;
  bf16_t* X = (bf16_t*)(p.ws + OFF_X);
  const bf16_t* MIX = (const bf16_t*)(p.ws + OFF_MIX);
  bf16_t* HN = (bf16_t*)(p.ws + OFF_HN);
  for (int rowa = bid * 8 + w; rowa < T_ALL; rowa += G * 16) {
    const int rowb = rowa + G * 8;
    const bool hasb = rowb < T_ALL;
    f32x4 m[2][4], x[2][4];
#pragma unroll
    for (int q = 0; q < 2; ++q) {
      const int row = q ? (hasb ? rowb : rowa) : rowa;
#pragma unroll
      for (int j = 0; j < 4; ++j) {
        if (row < 16384) m[q][j] = ld_bf4(MIX + (size_t)row * 1024 + 256 * j + 4 * lane);
        else {
          f32x4 a = {0.f, 0.f, 0.f, 0.f};
          for (int ks = 0; ks < nsplit; ++ks) a = a + *(const f32x4*)(PART + ((size_t)ks * 768 + (row - 16384)) * 1024 + 256 * j + 4 * lane);
          m[q][j] = a;
        }
        x[q][j] = ld_bf4(X + (size_t)row * 1024 + 256 * j + 4 * lane);
      }
    }
#pragma unroll
    for (int q = 0; q < 2; ++q) {
      if (q == 1 && !hasb) break;
      const int row = q ? rowb : rowa;
      float s = 0.f;
#pragma unroll
      for (int j = 0; j < 4; ++j) s += m[q][j].x * m[q][j].x + m[q][j].y * m[q][j].y + m[q][j].z * m[q][j].z + m[q][j].w * m[q][j].w;
      const float rstd = rsqrtf(wave_sum(s) * (1.f / 1024.f) + 1e-6f);
#pragma unroll
      for (int j = 0; j < 4; ++j) { const f32x4 g = *(const f32x4*)(wpost + 256 * j + 4 * lane); x[q][j] = x[q][j] + m[q][j] * rstd * g; }
      if (!final_) {
#pragma unroll
        for (int j = 0; j < 4; ++j) st_bf4(X + (size_t)row * 1024 + 256 * j + 4 * lane, x[q][j]);
        rms_row_to_bf16(x[q], wpre, HN + (size_t)row * 1024, lane);
      } else {
        float* dst = nullptr;
        if (row < T_PROMPT) { const int b = row / SEQP, t = row - b * SEQP; if (t >= 16) dst = p.out + OUT_YP + ((size_t)b * 2048 + (t - 16)) * 1024; }
        else dst = p.out + OUT_YS + (size_t)(row - T_PROMPT) * 1024;
        if (dst) {
#pragma unroll
          for (int j = 0; j < 4; ++j) *(f32x4*)(dst + 256 * j + 4 * lane) = x[q][j];
        }
      }
    }
  }
}

DI void phase_groupnorm(const Params& p, int bid, int G) {
  const int lane = threadIdx.x & 63, w = threadIdx.x >> 6;
  bf16_t* O = (bf16_t*)(p.ws + OFF_O);
  const float* SSQ = (const float*)(p.ws + OFF_SSQ);
  const float* __restrict__ nw = p.in[24];
  const int g = lane >> 4;
  for (int row = bid * 8 + w; row < T_ALL; row += G * 8) {
    const f32x4 q = *(const f32x4*)(SSQ + (size_t)row * 16 + 4 * g);
    const float rstd = rsqrtf((q.x + q.y + q.z + q.w) * (1.f / 512.f) + 1e-6f);
    bf16_t* o = O + (size_t)row * 2048 + lane * 32;
#pragma unroll
    for (int j = 0; j < 4; ++j) {
      u32x4 v = *(u32x4*)(o + 8 * j);
      const f32x4 w0 = *(const f32x4*)(nw + lane * 32 + 8 * j), w1 = *(const f32x4*)(nw + lane * 32 + 8 * j + 4);
      v[0] = pk2(bflo(v[0]) * rstd * w0.x, bfhi(v[0]) * rstd * w0.y); v[1] = pk2(bflo(v[1]) * rstd * w0.z, bfhi(v[1]) * rstd * w0.w);
      v[2] = pk2(bflo(v[2]) * rstd * w1.x, bfhi(v[2]) * rstd * w1.y); v[3] = pk2(bflo(v[3]) * rstd * w1.z, bfhi(v[3]) * rstd * w1.w);
      *(u32x4*)(o + 8 * j) = v;
    }
  }
}

namespace pg8 {
#define PG8_LAS __attribute__((address_space(3)))
typedef unsigned short bf16_t;
typedef short bf16x8 __attribute__((ext_vector_type(8)));
typedef float f32x4 __attribute__((ext_vector_type(4)));
typedef unsigned u32x4 __attribute__((ext_vector_type(4)));
constexpr int BM = 256, BK = 64, HALF = 128, HTB = HALF * BK * 2  , STAGE_BYTES = 8 * HTB, NXCD = 8, WGM = 8;

__host__ __device__ __forceinline__ int lds_byte(int r, int c) { const int st = (r >> 4) * 2 + (c >> 5), rr = r & 15, cc = c & 31, ob = rr * 64 + cc * 2; return st * 1024 + (ob ^ (((ob >> 9) & 1) << 5)); }
__host__ __device__ __forceinline__ void stage_rc(int b, int& R, int& C) { const int st = b / 1024, sb = b % 1024, swz = sb ^ (((sb >> 9) & 1) << 5); R = (st >> 1) * 16 + swz / 64; C = (st & 1) * 32 + (swz % 64) / 2; }
__host__ __device__ __forceinline__ int perm32(int rho) { const int n = rho >> 4, i = rho & 15; return 8 * (i >> 2) + 4 * n + (i & 3); }

struct Unit { int pm, pn, ks; };
struct Gemm { const bf16_t* A; const bf16_t* Bt; int M, N, K, ld; };

struct StaticOrder {
    int nM, nN, nwg, G, c;
    __host__ __device__ void init(int M, int N, int G_, int c_) { nM = M / BM; nN = N / BM; nwg = nM * nN; G = G_; c = c_; }
    __host__ __device__ bool next(int i, Unit& u) const {
        const long L = (long)i * G + c; if (L >= nwg) return false;
        int wgid = (int)L; { const int q = nwg / NXCD, r = nwg % NXCD, xcd = wgid % NXCD, off = wgid / NXCD; wgid = (xcd < r ? xcd * (q + 1) : r * (q + 1) + (xcd - r) * q) + off; }
        const int nig = WGM * nN, gid = wgid / nig, fm = gid * WGM, gsz = (nM - fm) < WGM ? (nM - fm) : WGM;
        u.pm = fm + ((wgid % nig) % gsz); u.pn = (wgid % nig) / gsz; u.ks = 0; return true;
    }
    __device__ __forceinline__ void a_ready(const Unit&) const {}
    __device__ __forceinline__ void done(const Unit&) const {}
};
__device__ __forceinline__ unsigned cvt_pk_bf16(float lo, float hi) { unsigned r; asm volatile("v_cvt_pk_bf16_f32 %0, %1, %2" : "=v"(r) : "v"(lo), "v"(hi)); return r; }
typedef float f32x2 __attribute__((ext_vector_type(2)));
template <class Epi, class Sched, bool ALIGN_EPI = false, bool SP2 = false>
__device__ __forceinline__ void gemm_phase(PG8_LAS unsigned char* lds, const Gemm g, const Sched& S, const Epi& E) {
    int tid_ = threadIdx.x; asm volatile("" : "+v"(tid_));
    const int tid = tid_, wid = __builtin_amdgcn_readfirstlane(tid >> 6), lane = tid & 63, wr = wid >> 2, wc = wid & 3, fr = lane & 15, fq = lane >> 4;
    const int K = g.ld, nt = g.K / BK;
    unsigned voffA[2], voffB[2];
#pragma unroll
    for (int i = 0; i < 2; ++i) { int R, C; stage_rc(tid * 16 + i * 8192, R, C); const int Rb = Epi::PERM ? ((R & ~31) + perm32(R & 31)) : R;
        voffA[i] = (unsigned)(R * K + C) * 2u; voffB[i] = (unsigned)(Rb * K + C) * 2u; }
    const size_t kstep = (size_t)(BK * 2);
    const size_t hstep = (size_t)HALF * K * 2;
    const size_t tstep = 2 * hstep;
    const unsigned ldsw = (unsigned)wid * 1024u;
    const int aoff = lds_byte(wr * 64 + fr, fq * 8), boff = lds_byte(wc * 32 + fr, fq * 8);
#define PG8_SA(b, h) (((b) * 2 + (h)) * HTB)
#define PG8_SB(b, h) ((4 + (b) * 2 + (h)) * HTB)
#define PG8_STAGE(bufoff, gbase, voff) do { _Pragma("unroll") for (int _i = 0; _i < 2; ++_i) \
        __builtin_amdgcn_global_load_lds((const unsigned*)((const char*)(gbase) + (voff)[_i]), (PG8_LAS unsigned*)(lds + (bufoff) + ldsw + _i * 8192), 16, 0, 0); } while (0)
#define PG8_LDA(dst, b, h) do { _Pragma("unroll") for (int m = 0; m < 4; ++m) _Pragma("unroll") for (int k = 0; k < 2; ++k) dst[m][k] = *(const PG8_LAS bf16x8*)(lds + PG8_SA(b, h) + aoff + m * 2048 + k * 1024); } while (0)
#define PG8_LDB(dst, b, h) do { _Pragma("unroll") for (int n = 0; n < 2; ++n) _Pragma("unroll") for (int k = 0; k < 2; ++k) dst[n][k] = *(const PG8_LAS bf16x8*)(lds + PG8_SB(b, h) + boff + n * 2048 + k * 1024); } while (0)
#define PG8_MMA(ai, bj, At, Bt) do { __builtin_amdgcn_s_setprio(1); _Pragma("unroll") for (int m = 0; m < 4; ++m) _Pragma("unroll") for (int n = 0; n < 2; ++n) _Pragma("unroll") for (int k = 0; k < 2; ++k) \
        acc[ai][bj][m][n] = __builtin_amdgcn_mfma_f32_16x16x32_bf16(Bt[n][k], At[m][k], acc[ai][bj][m][n], 0, 0, 0); __builtin_amdgcn_s_setprio(0); } while (0)
#define PG8_WAIT_V(n) asm volatile("s_waitcnt vmcnt(" #n ")" ::: "memory")
#define PG8_WAIT_L(n) asm volatile("s_waitcnt lgkmcnt(" #n ")" ::: "memory")
#define PG8_BAR __builtin_amdgcn_s_barrier()
#define PG8_SCHED __builtin_amdgcn_sched_barrier(0)
    Unit cur, nxt; int ui = 0;
    if (!S.next(0, cur)) return;
    f32x4 acc[2][2][4][2];
#pragma unroll
    for (int a = 0; a < 2; ++a)
#pragma unroll
        for (int b = 0; b < 2; ++b)
#pragma unroll
            for (int m = 0; m < 4; ++m)
#pragma unroll
                for (int n = 0; n < 2; ++n) acc[a][b][m][n] = (f32x4){0.f, 0.f, 0.f, 0.f};
    bf16x8 At[4][2], B0[2][2], B1[2][2];
    const char* cA = (const char*)g.A + (size_t)cur.pm * tstep + (size_t)cur.ks * g.K * 2; const char* cB = (const char*)g.Bt + (size_t)cur.pn * tstep + (size_t)cur.ks * g.K * 2;
    S.a_ready(cur);
    if constexpr (SP2) {
        PG8_STAGE(PG8_SB(0, 0), cB, voffB); PG8_STAGE(PG8_SB(0, 1), cB + hstep, voffB); PG8_STAGE(PG8_SA(0, 0), cA, voffA); PG8_STAGE(PG8_SA(0, 1), cA + hstep, voffA);
        if (wr == 1) PG8_BAR;
        PG8_WAIT_V(2); PG8_BAR;
        PG8_STAGE(PG8_SB(1, 0), cB + kstep, voffB); PG8_STAGE(PG8_SA(1, 0), cA + kstep, voffA); PG8_STAGE(PG8_SB(1, 1), cB + hstep + kstep, voffB);
        PG8_WAIT_V(6); PG8_BAR;
    } else {
        PG8_STAGE(PG8_SB(0, 0), cB, voffB); PG8_STAGE(PG8_SA(0, 0), cA, voffA); PG8_STAGE(PG8_SB(0, 1), cB + hstep, voffB); PG8_STAGE(PG8_SA(0, 1), cA + hstep, voffA);
        if (wr == 1) PG8_BAR;
        PG8_WAIT_V(4); PG8_BAR;
        PG8_STAGE(PG8_SB(1, 0), cB + kstep, voffB); PG8_STAGE(PG8_SA(1, 0), cA + kstep, voffA); PG8_STAGE(PG8_SB(1, 1), cB + hstep + kstep, voffB);
        PG8_WAIT_V(6); PG8_BAR;
    }
    for (;;) {
        const bool has_next = S.next(ui + 1, nxt);
        const char* nA = has_next ? (const char*)g.A + (size_t)nxt.pm * tstep + (size_t)nxt.ks * g.K * 2 : cA; const char* nB = has_next ? (const char*)g.Bt + (size_t)nxt.pn * tstep + (size_t)nxt.ks * g.K * 2 : cB;
        for (int t = 0; t < nt; t += 2) {
            const bool last = (t == nt - 2);
            const char* a1 = cA + (size_t)(t + 1) * kstep;
            const char* a2 = last ? nA : cA + (size_t)(t + 2) * kstep; const char* b2 = last ? nB : cB + (size_t)(t + 2) * kstep;
            const char* a3 = a2 + kstep; const char* b3 = b2 + kstep;
            if (last && has_next) S.a_ready(nxt);
            if constexpr (SP2) {
            PG8_LDB(B0, 0, 0); PG8_LDB(B1, 0, 1); PG8_SCHED; PG8_LDA(At, 0, 0); PG8_STAGE(PG8_SA(1, 1), a1 + hstep, voffA);
            PG8_WAIT_V(8); PG8_WAIT_L(0); PG8_BAR; PG8_MMA(0, 0, At, B0); PG8_MMA(0, 1, At, B1); PG8_BAR; PG8_SCHED;
            PG8_LDA(At, 0, 1); PG8_STAGE(PG8_SB(0, 0), b2, voffB); PG8_STAGE(PG8_SB(0, 1), b2 + hstep, voffB); PG8_STAGE(PG8_SA(0, 0), a2, voffA);
            PG8_WAIT_V(8); PG8_WAIT_L(0); PG8_BAR; PG8_MMA(1, 0, At, B0); PG8_MMA(1, 1, At, B1); PG8_BAR; PG8_SCHED;
            PG8_LDB(B0, 1, 0); PG8_LDB(B1, 1, 1); PG8_SCHED; PG8_LDA(At, 1, 0); PG8_STAGE(PG8_SA(0, 1), a2 + hstep, voffA);
            PG8_WAIT_V(8); PG8_WAIT_L(0); PG8_BAR; PG8_MMA(0, 0, At, B0); PG8_MMA(0, 1, At, B1); PG8_BAR; PG8_SCHED;
            PG8_LDA(At, 1, 1); PG8_STAGE(PG8_SB(1, 0), b3, voffB); PG8_STAGE(PG8_SB(1, 1), b3 + hstep, voffB); PG8_STAGE(PG8_SA(1, 0), a3, voffA);
            PG8_WAIT_V(8); PG8_WAIT_L(0); PG8_BAR; PG8_MMA(1, 0, At, B0); PG8_MMA(1, 1, At, B1); PG8_BAR; PG8_SCHED;
            } else {
            PG8_LDB(B0, 0, 0); PG8_SCHED; PG8_LDA(At, 0, 0); PG8_STAGE(PG8_SA(1, 1), a1 + hstep, voffA);
            PG8_WAIT_L(8); PG8_BAR; PG8_WAIT_L(0); PG8_MMA(0, 0, At, B0); PG8_BAR; PG8_SCHED;
            PG8_LDB(B1, 0, 1); PG8_STAGE(PG8_SB(0, 0), b2, voffB);
            PG8_BAR; PG8_WAIT_L(0); PG8_MMA(0, 1, At, B1); PG8_BAR;
            PG8_LDA(At, 0, 1); PG8_STAGE(PG8_SA(0, 0), a2, voffA);
            PG8_BAR; PG8_WAIT_L(0); PG8_MMA(1, 0, At, B0); PG8_BAR; PG8_SCHED;
            PG8_STAGE(PG8_SB(0, 1), b2 + hstep, voffB);
            PG8_WAIT_V(6); PG8_BAR; PG8_MMA(1, 1, At, B1); PG8_BAR;
            PG8_LDB(B0, 1, 0); PG8_SCHED; PG8_LDA(At, 1, 0); PG8_STAGE(PG8_SA(0, 1), a2 + hstep, voffA);
            PG8_WAIT_L(8); PG8_BAR; PG8_WAIT_L(0); PG8_MMA(0, 0, At, B0); PG8_BAR; PG8_SCHED;
            PG8_LDB(B1, 1, 1); PG8_STAGE(PG8_SB(1, 0), b3, voffB);
            PG8_BAR; PG8_WAIT_L(0); PG8_MMA(0, 1, At, B1); PG8_BAR;
            PG8_LDA(At, 1, 1); PG8_STAGE(PG8_SA(1, 0), a3, voffA);
            PG8_BAR; PG8_WAIT_L(0); PG8_MMA(1, 0, At, B0); PG8_BAR; PG8_SCHED;
            PG8_STAGE(PG8_SB(1, 1), b3 + hstep, voffB);
            PG8_WAIT_V(6); PG8_BAR; PG8_MMA(1, 1, At, B1); PG8_BAR;
            }
        }
        if constexpr (ALIGN_EPI) { if (wr == 0) PG8_BAR; }
        if constexpr (!Epi::AFTER_DRAIN) { E(acc, cur, wr, wc, fr, fq); S.done(cur); }
        if (!has_next) break;
#pragma unroll
        for (int a = 0; a < 2; ++a)
#pragma unroll
            for (int b = 0; b < 2; ++b)
#pragma unroll
                for (int m = 0; m < 4; ++m)
#pragma unroll
                    for (int n = 0; n < 2; ++n) acc[a][b][m][n] = (f32x4){0.f, 0.f, 0.f, 0.f};
        cur = nxt; cA = nA; cB = nB; ++ui;
        if constexpr (ALIGN_EPI) { if (wr == 1) PG8_BAR; }
    }
    PG8_WAIT_V(0);
    if constexpr (!ALIGN_EPI) { if (wr == 0) PG8_BAR; }
    PG8_BAR;
    if constexpr (Epi::AFTER_DRAIN) { E.fused(acc, cur, wr, wc, fr, fq, lds, wid, lane); S.done(cur); }
#undef PG8_SA
#undef PG8_SB
#undef PG8_STAGE
#undef PG8_LDA
#undef PG8_LDB
#undef PG8_MMA
#undef PG8_WAIT_V
#undef PG8_WAIT_L
#undef PG8_BAR
#undef PG8_SCHED
}
}

struct EpiStoreBf16 {
  static constexpr bool PERM = true, AFTER_DRAIN = false;
  bf16_t* C; int ldc;
  DI void operator()(const pg8::f32x4 (&acc)[2][2][4][2], const pg8::Unit& u, int wr, int wc, int fr, int fq) const {
    const int row0 = u.pm * 256 + wr * 64 + fr, col0 = u.pn * 256 + wc * 32 + 8 * fq;
#pragma unroll
    for (int ai = 0; ai < 2; ++ai)
#pragma unroll
      for (int m = 0; m < 4; ++m) {
        bf16_t* rowp = C + (size_t)(row0 + ai * 128 + m * 16) * ldc + col0;
#pragma unroll
        for (int bj = 0; bj < 2; ++bj) {
          const pg8::f32x4 v0 = acc[ai][bj][m][0], v1 = acc[ai][bj][m][1];
          u32x4 w_; w_[0] = pk2(v0[0], v0[1]); w_[1] = pk2(v0[2], v0[3]); w_[2] = pk2(v1[0], v1[1]); w_[3] = pk2(v1[2], v1[3]);
          *(u32x4*)(rowp + bj * 128) = w_;
        }
      }
  }
};
struct EpiStoreF32 {
  static constexpr bool PERM = false, AFTER_DRAIN = false;
  float* C0; int ldc; size_t ks_stride;
  DI void operator()(const pg8::f32x4 (&acc)[2][2][4][2], const pg8::Unit& u, int wr, int wc, int fr, int fq) const {
    float* C = C0 + (size_t)u.ks * ks_stride;
    const int row0 = u.pm * 256 + wr * 64 + fr, col0 = u.pn * 256 + wc * 32 + 4 * fq;
#pragma unroll
    for (int ai = 0; ai < 2; ++ai)
#pragma unroll
      for (int m = 0; m < 4; ++m) {
        float* rowp = C + (size_t)(row0 + ai * 128 + m * 16) * ldc + col0;
#pragma unroll
        for (int bj = 0; bj < 2; ++bj)
#pragma unroll
          for (int n = 0; n < 2; ++n) *(pg8::f32x4*)(rowp + bj * 128 + n * 16) = acc[ai][bj][m][n];
      }
  }
};
struct EpiSwiglu {
  static constexpr bool PERM = true, AFTER_DRAIN = false;
  bf16_t* C; int ldc;
  DI void operator()(const pg8::f32x4 (&acc)[2][2][4][2], const pg8::Unit& u, int wr, int wc, int fr, int fq) const {
    const int row0 = u.pm * 256 + wr * 64 + fr, col0 = u.pn * 128 + wc * 32 + 8 * fq;
#pragma unroll
    for (int ai = 0; ai < 2; ++ai)
#pragma unroll
      for (int m = 0; m < 4; ++m) {
        float y[8];
#pragma unroll
        for (int n = 0; n < 2; ++n)
#pragma unroll
          for (int e = 0; e < 4; ++e) y[4 * n + e] = siluf_(acc[ai][0][m][n][e]) * acc[ai][1][m][n][e];
        u32x4 w_; w_[0] = pk2(y[0], y[1]); w_[1] = pk2(y[2], y[3]); w_[2] = pk2(y[4], y[5]); w_[3] = pk2(y[6], y[7]);
        *(u32x4*)(C + (size_t)(row0 + ai * 128 + m * 16) * ldc + col0) = w_;
      }
  }
};
template <class Epi>
DI void gemm_run(char* lds, const bf16_t* A, const bf16_t* Bt, int N, int K, const Epi& E, int vcu, int G) {
  pg8::Gemm g{A, Bt, T_PAD, N, K, K};
  pg8::StaticOrder S; S.init(T_PAD, N, G, vcu);
  pg8::gemm_phase<Epi, pg8::StaticOrder, true, true>((PG8_LAS unsigned char*)lds, g, S, E);
}
constexpr int M_MAIN = 16384;
struct SplitOrder {
  int nsplit, nitems, G, c;
  DI bool next(int i, pg8::Unit& u) const {
    const int L = i * G + c; if (L >= nitems) return false;
    const int q = L / nsplit; u.ks = L - q * nsplit; u.pm = q >> 2; u.pn = q & 3; return true;
  }
  DI void a_ready(const pg8::Unit&) const {}
  DI void done(const pg8::Unit&) const {}
};
DI void gemm_n1024(char* lds, const bf16_t* A, const bf16_t* Bt, int K, float* MIXp, float* PART, int vcu, int G) {
  {
    pg8::Gemm g{A, Bt, M_MAIN, 1024, K, K};
    pg8::StaticOrder S; S.init(M_MAIN, 1024, G, vcu);
    pg8::gemm_phase<EpiStoreBf16, pg8::StaticOrder, true, true>((PG8_LAS unsigned char*)lds, g, S, EpiStoreBf16{(bf16_t*)MIXp, 1024});
  }
  {
    const int nsplit = K >> 8;
    pg8::Gemm g{A + (size_t)M_MAIN * K, Bt, 768, 1024, 256, K};
    SplitOrder S{nsplit, 12 * nsplit, G, (vcu + 128) % G};
    pg8::gemm_phase<EpiStoreF32, SplitOrder, true, true>((PG8_LAS unsigned char*)lds, g, S, EpiStoreF32{PART, 1024, (size_t)768 * 1024});
  }
}

constexpr int L_QE = 0, L_KE = 8704, L_QI = 17408, L_G = 26112, L_KENDT = 34816, L_VT = 45056, L_DEC = 55296, L_TOT = 55808, L_SSQ = 57856;
constexpr int RS = 272, TS = 80;

template <int DK>
DI void pc_core(char* lds, f32x16 (&S)[DK / 32], f32x16& o, const int w, const int r32, const int h) {
  const char* QE = lds + L_QE + r32 * RS;
  const char* KE = lds + L_KE + r32 * RS;
  const char* QI = lds + L_QI + r32 * RS;
  f32x16 sc; zero16(sc);
#pragma unroll
  for (int s = 0; s < DK / 16; ++s) {
    const bf16x8 a = *(const bf16x8*)(KE + s * 32 + h * 16);
    const bf16x8 b = *(const bf16x8*)(QE + s * 32 + h * 16);
    sc = MFMA32(a, b, sc);
  }
#pragma unroll
  for (int r = 0; r < 16; ++r) if (crow(r, h) > r32) sc[r] = 0.f;
  const bf16x8 scb0 = pack8<0>(sc), scb1 = pack8<1>(sc);
  zero16(o);
#pragma unroll
  for (int kt = 0; kt < DK / 32; ++kt) {
    {
      const bf16x8 a = pack8<0>(S[kt]);
      const s16x4 lo = *(const s16x4*)(QI + (32 * kt + 4 * h) * 2), hi = *(const s16x4*)(QI + (32 * kt + 8 + 4 * h) * 2);
      o = MFMA32(a, cat8(lo, hi), o);
    }
    {
      const bf16x8 a = pack8<1>(S[kt]);
      const s16x4 lo = *(const s16x4*)(QI + (32 * kt + 16 + 4 * h) * 2), hi = *(const s16x4*)(QI + (32 * kt + 24 + 4 * h) * 2);
      o = MFMA32(a, cat8(lo, hi), o);
    }
  }
  const char* VTr = lds + L_VT + (32 * w + r32) * TS;
  {
    const s16x4 lo = *(const s16x4*)(VTr + (4 * h) * 2), hi = *(const s16x4*)(VTr + (8 + 4 * h) * 2);
    o = MFMA32(cat8(lo, hi), scb0, o);
  }
  {
    const s16x4 lo = *(const s16x4*)(VTr + (16 + 4 * h) * 2), hi = *(const s16x4*)(VTr + (24 + 4 * h) * 2);
    o = MFMA32(cat8(lo, hi), scb1, o);
  }
  const float* DEC = (const float*)(lds + L_DEC);
#pragma unroll
  for (int kt = 0; kt < DK / 32; ++kt)
#pragma unroll
    for (int g = 0; g < 4; ++g) {
      const f32x4 d = *(const f32x4*)(DEC + 32 * kt + 8 * g + 4 * h);
      S[kt][4 * g] *= d.x; S[kt][4 * g + 1] *= d.y; S[kt][4 * g + 2] *= d.z; S[kt][4 * g + 3] *= d.w;
    }
#pragma unroll
  for (int s = 0; s < 2; ++s) {
    const bf16x8 b = *(const bf16x8*)(VTr + s * 32 + h * 16);
#pragma unroll
    for (int kt = 0; kt < DK / 32; ++kt) {
      const bf16x8 a = *(const bf16x8*)(lds + L_KENDT + (32 * kt + r32) * TS + s * 32 + h * 16);
      S[kt] = MFMA32(a, b, S[kt]);
    }
  }
}

constexpr int NSC = 8;
DI int sc_beg(int sc) { return sc == 0 ? 0 : 16 + 256 * sc; }
DI int sc_end(int sc) { return 16 + 256 * (sc + 1); }
constexpr size_t SCR_HG_U = 0;
constexpr size_t SCR_GL_U = SCR_HG_U + (size_t)8 * 4 * 7 * 16384;
constexpr size_t SCR_HG_D = SCR_GL_U + (size_t)8 * 4 * 7 * 8192;
constexpr size_t SCR_GL_D = SCR_HG_D + (size_t)8 * 4 * 7 * 128;
constexpr size_t SCR_SS_U = 0;
constexpr size_t SCR_SS_D = SCR_SS_U + (size_t)8 * 32 * 7 * 8192;

template <int TYPE, bool SO>
DI void scan_even_job(const Params& p, char* lds, const int head, const int row0, const int ntok, const float* s_in, float* s_out, float* d_out) {
  constexpr int DK = TYPE == 0 ? 128 : 64;
  constexpr int KC = DK / 64;
  const int tid = threadIdx.x & (HB - 1), c = tid & 63, w = tid >> 6, r32 = c & 31, h = c >> 5;
  const bf16_t* P = (const bf16_t*)(p.ws + OFF_P);
  bf16_t* O = (bf16_t*)(p.ws + OFF_O);
  float* TOT = (float*)(lds + L_TOT);
  float* SSQ = (float*)(lds + L_SSQ);
  float* DEC = (float*)(lds + L_DEC);
  const int qcol = TYPE == 0 ? head * 128 : 2048 + head * 64;
  const int kcol = TYPE == 0 ? 512 + head * 128 : 2304 + head * 64;
  const int vcol = TYPE == 0 ? 1024 + head * 128 : 2560 + head * 128;
  const int gcol = TYPE == 0 ? 1536 + head * 128 : 3072 + head * 128;
  const int ocol = TYPE == 0 ? head * 128 : 512 + head * 128;
  float lb[2] = {0.f, 0.f}, wup[16], bal = 0.f;
  if (TYPE == 0) {
#pragma unroll
    for (int e = 0; e < 2; ++e) {
      const float g0 = p.in[7][head * 128 + 2 * c + e], g1 = p.in[7][512 + head * 128 + 2 * c + e], g2 = p.in[7][1024 + head * 128 + 2 * c + e];
      const float m = fmaxf(g0, fmaxf(g1, g2));
      const float e0 = __expf(g0 - m), e1 = __expf(g1 - m), e2 = __expf(g2 - m);
      lb[e] = e0 / (e0 + e1 + e2);
    }
  } else {
#pragma unroll
    for (int r = 0; r < 16; ++r) wup[r] = p.in[13][r * 256 + head * 64 + c];
    bal = p.in[14][head * 64 + c];
  }
  const float* __restrict__ nwp = TYPE == 0 ? p.in[15] : p.in[16];
  f32x16 S[DK / 32];
#pragma unroll
  for (int kt = 0; kt < DK / 32; ++kt)
#pragma unroll
    for (int r = 0; r < 16; ++r) S[kt][r] = (!SO && s_in) ? s_in[(size_t)(32 * kt + crow(r, h)) * 128 + 32 * w + r32] : 0.f;
  float dsum[KC];
#pragma unroll
  for (int e = 0; e < KC; ++e) dsum[e] = 0.f;

  unsigned rq[8], rk[8], rv[8], rg[8]; float ral[8];
  auto load_raw = [&](int ch) {
#pragma unroll
    for (int i = 0; i < 8; ++i) {
      const int t = min(ch * 32 + 8 * w + i, ntok - 1);
      const bf16_t* pr = P + (size_t)(row0 + t) * LD_EV;
      if (TYPE == 0) {
        if (!SO) rq[i] = *(const unsigned*)(pr + qcol + 2 * c);
        rk[i] = *(const unsigned*)(pr + kcol + 2 * c);
      } else {
        if (!SO) rq[i] = (unsigned)pr[qcol + c];
        rk[i] = (unsigned)pr[kcol + c];
        ral[i] = bflo((unsigned)pr[3584 + (c & 15)]);
      }
      rv[i] = *(const unsigned*)(pr + vcol + 2 * c);
      if (!SO) rg[i] = *(const unsigned*)(pr + gcol + 2 * c);
    }
  };
  const int nch = __builtin_amdgcn_readfirstlane((ntok + 31) >> 5);
  load_raw(0);
  for (int ch = 0; ch < nch; ++ch) {
    const int t0 = ch * 32;
    float kk[8][KC], cum[8][KC], run[KC];
#pragma unroll
    for (int e = 0; e < KC; ++e) run[e] = 0.f;
#pragma unroll
    for (int i = 0; i < 8; ++i) {
      const float vm = (t0 + 8 * w + i) < ntok ? 1.f : 0.f;
      if (TYPE == 0) {
#pragma unroll
        for (int e = 0; e < 2; ++e) {
          const float fa = e ? bfhi(rk[i]) : bflo(rk[i]);
          const float f = lb[e] + (1.f - lb[e]) * sigmoidf_(fa);
          kk[i][e] = vm - vm * f;
          run[e] += vm * __logf(f); cum[i][e] = run[e];
        }
      } else {
        float x = bal;
#pragma unroll
        for (int r = 0; r < 16; ++r) x += __int_as_float(__builtin_amdgcn_readlane(__float_as_int(ral[i]), r)) * wup[r];
        const float ls = fminf(x, 0.f) - __logf(1.f + __expf(-fabsf(x)));
        kk[i][0] = vm * bflo(rk[i]);
        run[0] += vm * ls * (1.f / 16.f); cum[i][0] = run[0];
      }
    }
#pragma unroll
    for (int e = 0; e < KC; ++e) TOT[w * 128 + KC * c + e] = run[e];
    __syncthreads();
    float off[KC], mid[KC], tot[KC];
#pragma unroll
    for (int e = 0; e < KC; ++e) {
      const float t0_ = TOT[KC * c + e], t1_ = TOT[128 + KC * c + e], t2_ = TOT[256 + KC * c + e], t3_ = TOT[384 + KC * c + e];
      mid[e] = t0_ + t1_; tot[e] = (t0_ + t1_) + (t2_ + t3_);
      off[e] = w == 0 ? 0.f : (w == 1 ? t0_ : (w == 2 ? t0_ + t1_ : t0_ + t1_ + t2_));
      dsum[e] += tot[e];
    }
    {
      u32x4 kp[KC];
#pragma unroll
      for (int m = 0; m < 4; ++m) {
        float kend[2][KC];
#pragma unroll
        for (int i2 = 0; i2 < 2; ++i2) {
          const int i = 2 * m + i2;
          const int ti = 8 * w + i;
          float qe[KC], ke[KC], qi[KC];
#pragma unroll
          for (int e = 0; e < KC; ++e) {
            const float cv = off[e] + cum[i][e];
            kend[i2][e] = kk[i][e] * __expf(tot[e] - cv);
            if (!SO) {
              const float qv = TYPE == 0 ? (e ? bfhi(rq[i]) : bflo(rq[i])) : bflo(rq[i]) * 0.125f;
              qe[e] = qv * __expf(cv - mid[e]);
              ke[e] = kk[i][e] * __expf(mid[e] - cv);
              qi[e] = qv * __expf(cv);
            }
          }
          if (!SO) {
            if (KC == 2) {
              *(unsigned*)(lds + L_QE + ti * RS + 4 * c) = pk2(qe[0], qe[KC - 1]);
              *(unsigned*)(lds + L_KE + ti * RS + 4 * c) = pk2(ke[0], ke[KC - 1]);
              *(unsigned*)(lds + L_QI + ti * RS + 4 * c) = pk2(qi[0], qi[KC - 1]);
            } else {
              *(bf16_t*)(lds + L_QE + ti * RS + 2 * c) = (bf16_t)pk2(qe[0], 0.f);
              *(bf16_t*)(lds + L_KE + ti * RS + 2 * c) = (bf16_t)pk2(ke[0], 0.f);
              *(bf16_t*)(lds + L_QI + ti * RS + 2 * c) = (bf16_t)pk2(qi[0], 0.f);
            }
            *(unsigned*)(lds + L_G + ti * RS + 4 * c) = rg[i];
          }
        }
#pragma unroll
        for (int e = 0; e < KC; ++e) kp[e][m] = pk2(kend[0][e], kend[1][e]);
      }
#pragma unroll
      for (int e = 0; e < KC; ++e) *(u32x4*)(lds + L_KENDT + (KC * c + e) * TS + 16 * w) = kp[e];
      u32x4 v0, v1;
#pragma unroll
      for (int m = 0; m < 4; ++m) {
        v0[m] = (rv[2 * m] & 0xffffu) | (rv[2 * m + 1] << 16);
        v1[m] = (rv[2 * m] >> 16) | (rv[2 * m + 1] & 0xffff0000u);
      }
      *(u32x4*)(lds + L_VT + (2 * c) * TS + 16 * w) = v0;
      *(u32x4*)(lds + L_VT + (2 * c + 1) * TS + 16 * w) = v1;
      if (w == 0) {
#pragma unroll
        for (int e = 0; e < KC; ++e) DEC[KC * c + e] = __expf(tot[e]);
      }
    }
    __syncthreads();
    load_raw(min(ch + 1, nch - 1));
    if (SO) {
      const char* VTr = lds + L_VT + (32 * w + r32) * TS;
#pragma unroll
      for (int kt = 0; kt < DK / 32; ++kt)
#pragma unroll
        for (int g = 0; g < 4; ++g) {
          const f32x4 d = *(const f32x4*)(DEC + 32 * kt + 8 * g + 4 * h);
          S[kt][4 * g] *= d.x; S[kt][4 * g + 1] *= d.y; S[kt][4 * g + 2] *= d.z; S[kt][4 * g + 3] *= d.w;
        }
#pragma unroll
      for (int s = 0; s < 2; ++s) {
        const bf16x8 bq = *(const bf16x8*)(VTr + s * 32 + h * 16);
#pragma unroll
        for (int kt = 0; kt < DK / 32; ++kt) {
          const bf16x8 a = *(const bf16x8*)(lds + L_KENDT + (32 * kt + r32) * TS + s * 32 + h * 16);
          S[kt] = MFMA32(a, bq, S[kt]);
        }
      }
      __syncthreads();
    } else {
      f32x16 o;
      pc_core<DK>(lds, S, o, w, r32, h);
      {
        float ss = 0.f;
#pragma unroll
        for (int r = 0; r < 16; ++r) ss += o[r] * o[r];
        ss += __shfl_xor(ss, 32);
        if (h == 0) SSQ[w * 32 + r32] = ss;
      }
      __syncthreads();
      {
        const float tot2 = (SSQ[r32] + SSQ[32 + r32]) + (SSQ[64 + r32] + SSQ[96 + r32]);
        const float rstd = rsqrtf(tot2 * (1.f / 128.f) + 1e-6f);
        if (t0 + r32 < ntok) {
          bf16_t* orow = O + (size_t)(row0 + t0 + r32) * 1024 + ocol + 32 * w + 4 * h;
#pragma unroll
          for (int g = 0; g < 4; ++g) {
            const u32x2 gp = *(const u32x2*)(lds + L_G + r32 * RS + (32 * w + 8 * g + 4 * h) * 2);
            const f32x4 nw = *(const f32x4*)(nwp + 32 * w + 8 * g + 4 * h);
            const float y0 = o[4 * g] * rstd * nw.x * siluf_(bflo(gp[0]));
            const float y1 = o[4 * g + 1] * rstd * nw.y * siluf_(bfhi(gp[0]));
            const float y2 = o[4 * g + 2] * rstd * nw.z * siluf_(bflo(gp[1]));
            const float y3 = o[4 * g + 3] * rstd * nw.w * siluf_(bfhi(gp[1]));
            u32x2 v; v[0] = pk2(y0, y1); v[1] = pk2(y2, y3);
            *(u32x2*)(orow + 8 * g) = v;
          }
        }
      }
    }
  }
  if (s_out) {
#pragma unroll
    for (int kt = 0; kt < DK / 32; ++kt)
#pragma unroll
      for (int r = 0; r < 16; ++r) s_out[(size_t)(32 * kt + crow(r, h)) * 128 + 32 * w + r32] = S[kt][r];
  }
  if (SO && w == 0) {
#pragma unroll
    for (int e = 0; e < KC; ++e) d_out[KC * c + e] = dsum[e];
  }
  __syncthreads();
}

DI void phase_scan_even_a(const Params& p, char* lds, int bid, int G) {
  float* scr = (float*)(p.ws + OFF_MIX);
  const int half = threadIdx.x >> 8; lds += half * HALF_LDS;
  for (int jb = bid * 2; jb < 448 + 1024; jb += G * 2) {
    const int j = jb + half;
    if (j < 448) {
      const int type = j & 1, head = (j >> 1) & 3, b = (j >> 3) & 7, sc = j >> 6;
      const int row0 = b * SEQP + sc_beg(sc), ntok = sc_end(sc) - sc_beg(sc);
      const size_t slot = ((size_t)b * 4 + head) * 7 + sc;
      if (type == 0) scan_even_job<0, true>(p, lds, head, row0, ntok, nullptr, scr + SCR_HG_U + slot * 16384, scr + SCR_HG_D + slot * 128);
      else scan_even_job<1, true>(p, lds, head, row0, ntok, nullptr, scr + SCR_GL_U + slot * 8192, scr + SCR_GL_D + slot * 64);
    } else {
      const int jj = j - 448, type = jj & 1, head = (jj >> 1) & 3, b = jj >> 3;
      const int row0 = T_PROMPT + 4 * b;
      if (type == 0) scan_even_job<0, false>(p, lds, head, row0, 4, p.in[2] + ((size_t)b * 4 + head) * 16384, p.out + OUT_HGS + ((size_t)b * 4 + head) * 16384, nullptr);
      else scan_even_job<1, false>(p, lds, head, row0, 4, p.in[3] + ((size_t)b * 4 + head) * 8192, p.out + OUT_GLS + ((size_t)b * 4 + head) * 8192, nullptr);
    }
  }
}
DI void phase_scan_even_c(const Params& p, int bid, int G) {
  float* scr = (float*)(p.ws + OFF_MIX);
  for (int i = bid * NTHREADS + threadIdx.x; i < 32 * 4096 + 32 * 2048; i += G * NTHREADS) {
    const bool gl = i >= 32 * 4096;
    const int ii = gl ? i - 32 * 4096 : i;
    const int per = gl ? 2048 : 4096, bh = ii / per, e4 = ii - bh * per, k = e4 >> 5;
    float* U = scr + (gl ? SCR_GL_U + (size_t)bh * 7 * 8192 : SCR_HG_U + (size_t)bh * 7 * 16384) + 4 * e4;
    const float* D = scr + (gl ? SCR_GL_D + (size_t)bh * 7 * 64 : SCR_HG_D + (size_t)bh * 7 * 128) + k;
    const int ustride = gl ? 8192 : 16384, dstride = gl ? 64 : 128;
    f32x4 run = {0.f, 0.f, 0.f, 0.f};
#pragma unroll
    for (int sc = 0; sc < 7; ++sc) {
      const float d = __expf(D[sc * dstride]);
      const f32x4 u = *(const f32x4*)(U + (size_t)sc * ustride);
      run = run * d + u;
      *(f32x4*)(U + (size_t)sc * ustride) = run;
    }
  }
}
DI void phase_scan_even_b(const Params& p, char* lds, int bid, int G) {
  float* scr = (float*)(p.ws + OFF_MIX);
  const int half = threadIdx.x >> 8; lds += half * HALF_LDS;
  for (int jb = bid * 2; jb < 512; jb += G * 2) {
    const int j = jb + half;
    {
      const int type = j & 1, head = (j >> 1) & 3, b = (j >> 3) & 7, sc = j >> 6;
      const int row0 = b * SEQP + sc_beg(sc), ntok = sc_end(sc) - sc_beg(sc);
      const size_t slot = ((size_t)b * 4 + head) * 7 + sc - 1;
      if (type == 0) scan_even_job<0, false>(p, lds, head, row0, ntok, sc ? scr + SCR_HG_U + slot * 16384 : nullptr,
                                             sc == NSC - 1 ? p.out + OUT_HGP + ((size_t)b * 4 + head) * 16384 : nullptr, nullptr);
      else scan_even_job<1, false>(p, lds, head, row0, ntok, sc ? scr + SCR_GL_U + slot * 8192 : nullptr,
                                   sc == NSC - 1 ? p.out + OUT_GLP + ((size_t)b * 4 + head) * 8192 : nullptr, nullptr);
    }
  }
}

constexpr int M_BM = 0, M_CM = 8704, M_XS = 17408, M_Z = 26112, M_BT = 34816, M_VT = 45056, M_VENDT = 55296, M_CUM = 65536, M_DT = 65792, M_SSQ = 66048, M_CW = 66560;

DI void phase_conv(const Params& p, int bid, int G) {
  const bf16_t* P = (const bf16_t*)(p.ws + OFF_P);
  bf16_t* O = (bf16_t*)(p.ws + OFF_O);
  bf16_t* HN = (bf16_t*)(p.ws + OFF_HN);
  const float* __restrict__ cwp = p.in[19];
  const float* __restrict__ cbp = p.in[20];
  const int gt = bid * NTHREADS + threadIdx.x, NPAR = (G * NTHREADS) / 384;
  const int cg = gt % 384, r0 = gt / 384, ch = 8 * cg;
  if (r0 >= NPAR) return;
  float w[4][8], bs[8];
#pragma unroll
  for (int k = 0; k < 4; ++k) {
    const f32x4 a = *(const f32x4*)(cwp + k * 3072 + ch), b_ = *(const f32x4*)(cwp + k * 3072 + ch + 4);
    w[k][0] = a.x; w[k][1] = a.y; w[k][2] = a.z; w[k][3] = a.w; w[k][4] = b_.x; w[k][5] = b_.y; w[k][6] = b_.z; w[k][7] = b_.w;
  }
  {
    const f32x4 a = *(const f32x4*)(cbp + ch), b_ = *(const f32x4*)(cbp + ch + 4);
    bs[0] = a.x; bs[1] = a.y; bs[2] = a.z; bs[3] = a.w; bs[4] = b_.x; bs[5] = b_.y; bs[6] = b_.z; bs[7] = b_.w;
  }
  bf16_t* dbase = ch < 2048 ? O + ch : HN + (ch - 2048);
  const int dld = ch < 2048 ? 2048 : 1024;
  for (int run = r0; run < 8 * 258; run += NPAR) {
    const int b = run / 258, t0 = (run - b * 258) * 8, row0 = b * SEQP + t0;
    u32x4 pre[11];
#pragma unroll
    for (int i = 0; i < 11; ++i) {
      const int r = row0 + i - 3;
      pre[i] = (i >= 3 || t0 > 0) ? *(const u32x4*)(P + (size_t)r * LD_OD + 2048 + ch) : (u32x4){0u, 0u, 0u, 0u};
    }
#pragma unroll
    for (int i = 0; i < 8; ++i) {
      u32x4 o;
#pragma unroll
      for (int q = 0; q < 4; ++q) {
        float a0 = bs[2 * q], a1 = bs[2 * q + 1];
#pragma unroll
        for (int k = 0; k < 4; ++k) { a0 += bflo(pre[i + k][q]) * w[k][2 * q]; a1 += bfhi(pre[i + k][q]) * w[k][2 * q + 1]; }
        o[q] = pk2(siluf_(a0), siluf_(a1));
      }
      *(u32x4*)(dbase + (size_t)(row0 + i) * dld) = o;
    }
  }
  for (int sq = r0; sq < 128; sq += NPAR) {
    const int row0 = T_PROMPT + 4 * sq;
    float pf[7][8];
#pragma unroll
    for (int i = 0; i < 3; ++i) {
      const f32x4 a = *(const f32x4*)(p.in[5] + ((size_t)sq * 3 + i) * 3072 + ch), b_ = *(const f32x4*)(p.in[5] + ((size_t)sq * 3 + i) * 3072 + ch + 4);
      pf[i][0] = a.x; pf[i][1] = a.y; pf[i][2] = a.z; pf[i][3] = a.w; pf[i][4] = b_.x; pf[i][5] = b_.y; pf[i][6] = b_.z; pf[i][7] = b_.w;
    }
#pragma unroll
    for (int i = 0; i < 4; ++i) {
      const u32x4 u = *(const u32x4*)(P + (size_t)(row0 + i) * LD_OD + 2048 + ch);
#pragma unroll
      for (int q = 0; q < 4; ++q) { pf[3 + i][2 * q] = bflo(u[q]); pf[3 + i][2 * q + 1] = bfhi(u[q]); }
    }
#pragma unroll
    for (int i = 0; i < 4; ++i) {
      u32x4 o;
#pragma unroll
      for (int q = 0; q < 4; ++q) {
        float a0 = bs[2 * q], a1 = bs[2 * q + 1];
#pragma unroll
        for (int k = 0; k < 4; ++k) { a0 += pf[i + k][2 * q] * w[k][2 * q]; a1 += pf[i + k][2 * q + 1] * w[k][2 * q + 1]; }
        o[q] = pk2(siluf_(a0), siluf_(a1));
      }
      *(u32x4*)(dbase + (size_t)(row0 + i) * dld) = o;
    }
  }
}

template <bool SO>
DI void scan_odd_job(const Params& p, char* lds, const int b, const int hp, const bool smp, const int tbeg, const int tend, const float* s_in, float* s_out, float* d_out) {
  const int tid = threadIdx.x & (HB - 1), c = tid & 63, w = tid >> 6, r32 = c & 31, h = c >> 5;
  const int grp = hp >> 2, hl = w >> 1, headw = 2 * hp + hl;
  const int row0 = (smp ? T_PROMPT + 4 * b : b * SEQP) + tbeg, ntok = tend - tbeg;
  const bf16_t* P = (const bf16_t*)(p.ws + OFF_P);
  bf16_t* O = (bf16_t*)(p.ws + OFF_O);
  const bf16_t* BC = (const bf16_t*)(p.ws + OFF_HN);
  float* CUM = (float*)(lds + M_CUM);
  float* DTL = (float*)(lds + M_DT);
  float* SSQ = (float*)(lds + M_SSQ);
  const int hd_l = 2 * hp + h;
  const float dtb = p.in[21][hd_l], aneg = -__expf(p.in[22][hd_l]);
  const float dsk = p.in[23][headw];
  f32x16 S[4];
  {
    const float* sin = s_in + ((size_t)hl * 64 + 32 * (w & 1) + r32) * 128;
#pragma unroll
    for (int kt = 0; kt < 4; ++kt)
#pragma unroll
      for (int g = 0; g < 4; ++g) {
        f32x4 v = {0.f, 0.f, 0.f, 0.f};
        if (!SO && s_in) v = *(const f32x4*)(sin + 32 * kt + 8 * g + 4 * h);
        S[kt][4 * g] = v.x; S[kt][4 * g + 1] = v.y; S[kt][4 * g + 2] = v.z; S[kt][4 * g + 3] = v.w;
      }
  }
  float dsum = 0.f;
  unsigned rx[8], rb[8], rc[8], rz[8]; float rdt;
  auto load_raw = [&](int ch) {
#pragma unroll
    for (int i = 0; i < 8; ++i) {
      const int t = min(ch * 32 + 8 * w + i, ntok - 1);
      rx[i] = *(const unsigned*)(O + (size_t)(row0 + t) * 2048 + hp * 128 + 2 * c);
      rb[i] = *(const unsigned*)(BC + (size_t)(row0 + t) * 1024 + grp * 128 + 2 * c);
      if (!SO) {
        rc[i] = *(const unsigned*)(BC + (size_t)(row0 + t) * 1024 + 512 + grp * 128 + 2 * c);
        rz[i] = *(const unsigned*)(P + (size_t)(row0 + t) * LD_OD + hp * 128 + 2 * c);
      }
    }
    {
      const int t = min(ch * 32 + r32, ntok - 1);
      rdt = bflo((unsigned)P[(size_t)(row0 + t) * LD_OD + 5120 + hd_l]);
    }
  };
  const int nch = __builtin_amdgcn_readfirstlane((ntok + 31) >> 5);
  load_raw(0);
  for (int ch = 0; ch < nch; ++ch) {
    const int t0 = ch * 32;
    {
      const float xdt = rdt + dtb;
      float dt = xdt > 20.f ? xdt : __logf(1.f + __expf(xdt));
      dt = (t0 + r32 < ntok) ? dt : 0.f;
      float cs = dt * aneg;
#pragma unroll
      for (int d = 1; d < 32; d <<= 1) { const float o_ = __shfl_up(cs, d, 32); if (r32 >= d) cs += o_; }
      if (w == 0) { CUM[h * 32 + r32] = cs; DTL[h * 32 + r32] = dt; }
    }
    {
#pragma unroll
      for (int i = 0; i < 8; ++i) {
        if (!SO) {
          *(unsigned*)(lds + M_BM + (8 * w + i) * RS + 4 * c) = rb[i];
          *(unsigned*)(lds + M_CM + (8 * w + i) * RS + 4 * c) = rc[i];
          *(unsigned*)(lds + M_XS + (8 * w + i) * RS + 4 * c) = rx[i];
          *(unsigned*)(lds + M_Z + (8 * w + i) * RS + 4 * c) = rz[i];
        }
      }
      u32x4 b0, b1;
#pragma unroll
      for (int m = 0; m < 4; ++m) {
        b0[m] = (rb[2 * m] & 0xffffu) | (rb[2 * m + 1] << 16);
        b1[m] = (rb[2 * m] >> 16) | (rb[2 * m + 1] & 0xffff0000u);
      }
      *(u32x4*)(lds + M_BT + (2 * c) * TS + 16 * w) = b0;
      *(u32x4*)(lds + M_BT + (2 * c + 1) * TS + 16 * w) = b1;
    }
    __syncthreads();
    {
      const int hx = c >> 5;
      const float last = CUM[hx * 32 + 31];
      float vt[8][2], ve[8][2];
#pragma unroll
      for (int i = 0; i < 8; ++i) {
        const int ti = 8 * w + i;
        const float dt = DTL[hx * 32 + ti], cm = CUM[hx * 32 + ti];
        const float ee = __expf(last - cm);
        vt[i][0] = bflo(rx[i]) * dt; vt[i][1] = bfhi(rx[i]) * dt;
        ve[i][0] = vt[i][0] * ee; ve[i][1] = vt[i][1] * ee;
      }
#pragma unroll
      for (int e = 0; e < 2; ++e) {
        u32x4 pv, pe;
#pragma unroll
        for (int m = 0; m < 4; ++m) { pv[m] = pk2(vt[2 * m][e], vt[2 * m + 1][e]); pe[m] = pk2(ve[2 * m][e], ve[2 * m + 1][e]); }
        if (!SO) *(u32x4*)(lds + M_VT + (2 * c + e) * TS + 16 * w) = pv;
        *(u32x4*)(lds + M_VENDT + (2 * c + e) * TS + 16 * w) = pe;
      }
    }
    __syncthreads();
    load_raw(min(ch + 1, nch - 1));
    f32x16 o;
    const float lastw = CUM[hl * 32 + 31];
    dsum += lastw;
    if (!SO) {
      const char* BMr = lds + M_BM + r32 * RS;
      const char* CMr = lds + M_CM + r32 * RS;
      f32x16 sc; zero16(sc);
#pragma unroll
      for (int s = 0; s < 8; ++s) {
        const bf16x8 a = *(const bf16x8*)(BMr + s * 32 + h * 16);
        const bf16x8 bq = *(const bf16x8*)(CMr + s * 32 + h * 16);
        sc = MFMA32(a, bq, sc);
      }
      const float ci = CUM[hl * 32 + r32];
#pragma unroll
      for (int g = 0; g < 4; ++g) {
        const f32x4 cj = *(const f32x4*)(CUM + hl * 32 + 8 * g + 4 * h);
#pragma unroll
        for (int e = 0; e < 4; ++e) {
          const int j = 8 * g + 4 * h + e;
          const float cje = e == 0 ? cj.x : (e == 1 ? cj.y : (e == 2 ? cj.z : cj.w));
          sc[4 * g + e] = (j <= r32) ? sc[4 * g + e] * __expf(ci - cje) : 0.f;
        }
      }
      const bf16x8 scb0 = pack8<0>(sc), scb1 = pack8<1>(sc);
      zero16(o);
#pragma unroll
      for (int kt = 0; kt < 4; ++kt) {
        {
          const bf16x8 a = pack8<0>(S[kt]);
          const s16x4 lo = *(const s16x4*)(CMr + (32 * kt + 4 * h) * 2), hi = *(const s16x4*)(CMr + (32 * kt + 8 + 4 * h) * 2);
          o = MFMA32(a, cat8(lo, hi), o);
        }
        {
          const bf16x8 a = pack8<1>(S[kt]);
          const s16x4 lo = *(const s16x4*)(CMr + (32 * kt + 16 + 4 * h) * 2), hi = *(const s16x4*)(CMr + (32 * kt + 24 + 4 * h) * 2);
          o = MFMA32(a, cat8(lo, hi), o);
        }
      }
      const float ei = __expf(ci);
#pragma unroll
      for (int r = 0; r < 16; ++r) o[r] *= ei;
      const char* VTr = lds + M_VT + (32 * w + r32) * TS;
      {
        const s16x4 lo = *(const s16x4*)(VTr + (4 * h) * 2), hi = *(const s16x4*)(VTr + (8 + 4 * h) * 2);
        o = MFMA32(cat8(lo, hi), scb0, o);
      }
      {
        const s16x4 lo = *(const s16x4*)(VTr + (16 + 4 * h) * 2), hi = *(const s16x4*)(VTr + (24 + 4 * h) * 2);
        o = MFMA32(cat8(lo, hi), scb1, o);
      }
    }
    {
      const float el = __expf(lastw);
#pragma unroll
      for (int kt = 0; kt < 4; ++kt)
#pragma unroll
        for (int r = 0; r < 16; ++r) S[kt][r] *= el;
      const char* VEr = lds + M_VENDT + (32 * w + r32) * TS;
#pragma unroll
      for (int s = 0; s < 2; ++s) {
        const bf16x8 bq = *(const bf16x8*)(VEr + s * 32 + h * 16);
#pragma unroll
        for (int kt = 0; kt < 4; ++kt) {
          const bf16x8 a = *(const bf16x8*)(lds + M_BT + (32 * kt + r32) * TS + s * 32 + h * 16);
          S[kt] = MFMA32(a, bq, S[kt]);
        }
      }
    }
    if (!SO) {
      float y[16]; float ss = 0.f;
#pragma unroll
      for (int g = 0; g < 4; ++g) {
        const u32x2 xp = *(const u32x2*)(lds + M_XS + r32 * RS + (32 * w + 8 * g + 4 * h) * 2);
        const u32x2 zp = *(const u32x2*)(lds + M_Z + r32 * RS + (32 * w + 8 * g + 4 * h) * 2);
        y[4 * g] = (o[4 * g] + dsk * bflo(xp[0])) * siluf_(bflo(zp[0]));
        y[4 * g + 1] = (o[4 * g + 1] + dsk * bfhi(xp[0])) * siluf_(bfhi(zp[0]));
        y[4 * g + 2] = (o[4 * g + 2] + dsk * bflo(xp[1])) * siluf_(bflo(zp[1]));
        y[4 * g + 3] = (o[4 * g + 3] + dsk * bfhi(xp[1])) * siluf_(bfhi(zp[1]));
      }
#pragma unroll
      for (int r = 0; r < 16; ++r) ss += y[r] * y[r];
      ss += __shfl_xor(ss, 32);
      if (h == 0) SSQ[w * 32 + r32] = ss;
      if (t0 + r32 < ntok) {
        bf16_t* orow = O + (size_t)(row0 + t0 + r32) * 2048 + hp * 128 + 32 * w + 4 * h;
#pragma unroll
        for (int g = 0; g < 4; ++g) { u32x2 v; v[0] = pk2(y[4 * g], y[4 * g + 1]); v[1] = pk2(y[4 * g + 2], y[4 * g + 3]); *(u32x2*)(orow + 8 * g) = v; }
      }
    }
    __syncthreads();
    if (!SO && tid < 32 && t0 + tid < ntok) {
      float* q = (float*)(p.ws + OFF_SSQ);
      q[(size_t)(row0 + t0 + tid) * 16 + hp] = (SSQ[tid] + SSQ[32 + tid]) + (SSQ[64 + tid] + SSQ[96 + tid]);
    }
  }
  if (s_out) {
    float* so = s_out + ((size_t)hl * 64 + 32 * (w & 1) + r32) * 128;
#pragma unroll
    for (int kt = 0; kt < 4; ++kt)
#pragma unroll
      for (int g = 0; g < 4; ++g) {
        f32x4 v = {S[kt][4 * g], S[kt][4 * g + 1], S[kt][4 * g + 2], S[kt][4 * g + 3]};
        *(f32x4*)(so + 32 * kt + 8 * g + 4 * h) = v;
      }
  }
  if (SO && (w & 1) == 0 && c == 0) d_out[hl * 7] = dsum;
  __syncthreads();
}

DI void phase_scan_odd_a(const Params& p, char* lds, int bid, int G) {
  float* scr = (float*)(p.ws + OFF_MIX);
  const int half = threadIdx.x >> 8; lds += half * HALF_LDS;
  for (int jb = bid * 2; jb < 896 + 2048; jb += G * 2) {
    const int j = jb + half;
    if (j >= 896) {
      const int jj = j - 896, hp = jj & 15, b = jj >> 4;
      scan_odd_job<false>(p, lds, b, hp, true, 0, 4, p.in[4] + ((size_t)b * 32 + 2 * hp) * 8192, p.out + OUT_SSS + ((size_t)b * 32 + 2 * hp) * 8192, nullptr);
      continue;
    }
    const int hp = j & 15, b = (j >> 4) & 7, sc = j >> 7;
    float* U = scr + SCR_SS_U + ((((size_t)b * 16 + hp) * 7 + sc) * 2) * 8192;
    float* D = scr + SCR_SS_D + ((size_t)b * 32 + 2 * hp) * 7 + sc;
    scan_odd_job<true>(p, lds, b, hp, false, sc_beg(sc), sc_end(sc), nullptr, U, D);
  }
}
DI void phase_scan_odd_c(const Params& p, int bid, int G) {
  float* scr = (float*)(p.ws + OFF_MIX);
  for (int i = bid * NTHREADS + threadIdx.x; i < 128 * 2 * 2048; i += G * NTHREADS) {
    const int e4 = i & 2047, hd = (i >> 11) & 1, bhp = i >> 12;
    float* U = scr + SCR_SS_U + ((size_t)bhp * 7 * 2 + hd) * 8192 + 4 * e4;
    const float* D = scr + SCR_SS_D + ((size_t)(bhp >> 4) * 32 + 2 * (bhp & 15) + hd) * 7;
    f32x4 run = {0.f, 0.f, 0.f, 0.f};
#pragma unroll
    for (int sc = 0; sc < 7; ++sc) {
      const float d = __expf(D[sc]);
      const f32x4 u = *(const f32x4*)(U + (size_t)sc * 16384);
      run = run * d + u;
      *(f32x4*)(U + (size_t)sc * 16384) = run;
    }
  }
}
DI void phase_scan_odd_b(const Params& p, char* lds, int bid, int G) {
  float* scr = (float*)(p.ws + OFF_MIX);
  const int half = threadIdx.x >> 8; lds += half * HALF_LDS;
  for (int jb = bid * 2; jb < 1024; jb += G * 2) {
    const int j = jb + half;
    {
      const int hp = j & 15, b = (j >> 4) & 7, sc = j >> 7;
      const float* s_in = sc ? scr + SCR_SS_U + ((((size_t)b * 16 + hp) * 7 + sc - 1) * 2) * 8192 : nullptr;
      float* s_out = sc == NSC - 1 ? p.out + OUT_SSP + ((size_t)b * 32 + 2 * hp) * 8192 : nullptr;
      scan_odd_job<false>(p, lds, b, hp, false, sc_beg(sc), sc_end(sc), s_in, s_out, nullptr);
    }
  }
  const bf16_t* P = (const bf16_t*)(p.ws + OFF_P);
  for (int i = bid * NTHREADS + threadIdx.x; i < 136 * 3 * 3072; i += G * NTHREADS) {
    const int ch = i % 3072, r = i / 3072, j = r % 3, b = r / 3;
    if (b < 8) p.out[OUT_CVP + ((size_t)b * 3 + j) * 3072 + ch] = bflo((unsigned)P[(size_t)(b * SEQP + 2061 + j) * LD_OD + 2048 + ch]);
    else { const int bs = b - 8; p.out[OUT_CVS + ((size_t)bs * 3 + j) * 3072 + ch] = bflo((unsigned)P[(size_t)(T_PROMPT + 4 * bs + 1 + j) * LD_OD + 2048 + ch]); }
  }
}

#define XB_TMO      128
#define XB_XCNT(j)  (256  + 64 * (j))
#define XB_XSUB(j)  (1280 + 64 * (j))
#define XB_XGEN(j)  (2304 + 64 * (j))
#define XB_TOP      3328
#define XB_TOPGEN   3392
#define XCD_BAR_WORDS 3456
#define XB_SPIN_CAP (1u << 20)
#define LAS __attribute__((address_space(3)))
DI unsigned xb_ld(unsigned* p) { return __hip_atomic_load(p, __ATOMIC_RELAXED, __HIP_MEMORY_SCOPE_AGENT); }
DI unsigned xb_add(unsigned* p, unsigned v) { return __hip_atomic_fetch_add(p, v, __ATOMIC_RELAXED, __HIP_MEMORY_SCOPE_AGENT); }
DI unsigned xb_xcc_id() { return (unsigned)__builtin_amdgcn_s_getreg((3 << 11) | 20) & 0xFu; }
#define XB_SPIN(cond, bar) do { unsigned _sp = 0; while (cond) { __builtin_amdgcn_s_sleep(1); \
    if ((++_sp & 255u) == 0u) { if (xb_ld(&(bar)[XB_TMO])) break; if (_sp > XB_SPIN_CAP) { atomicAdd(&(bar)[XB_TMO], 1u); break; } } } } while (0)
struct XcdBarrier { unsigned* bar; unsigned x; volatile LAS unsigned* st; };
DI XcdBarrier xcd_barrier_post(unsigned* bar, volatile LAS unsigned* st) {
  XcdBarrier b; b.bar = bar; b.x = xb_xcc_id(); b.st = st;
  if (threadIdx.x == 0) (void)xb_add(&bar[XB_XCNT(b.x)], 1u);
  return b;
}
DI void xcd_barrier_complete(unsigned* bar, unsigned x, unsigned& nloc, unsigned& nx) {
  const unsigned G = gridDim.x * gridDim.y * gridDim.z;
  unsigned sum, cnt, mine, sp = 0u;
  for (;;) {
    sum = 0u; cnt = 0u; mine = 0u;
#pragma unroll
    for (unsigned j = 0; j < 16; ++j) { const unsigned c = xb_ld(&bar[XB_XCNT(j)]); sum += c; cnt += (c > 0u) ? 1u : 0u; mine = (j == x) ? c : mine; }
    if (sum == G) break;
    __builtin_amdgcn_s_sleep(1);
    if ((++sp & 255u) == 0u) { if (xb_ld(&bar[XB_TMO])) break; if (sp > XB_SPIN_CAP) { atomicAdd(&bar[XB_TMO], 1u); break; } }
  }
  nloc = mine > 0u ? mine : 1u; nx = cnt > 0u ? cnt : 1u;
}
DI void xcd_barrier(const XcdBarrier& b) {
  asm volatile("s_waitcnt vmcnt(0)" ::: "memory");
  __syncthreads();
  if (threadIdx.x == 0) {
    unsigned* bar = b.bar;
    __builtin_amdgcn_s_waitcnt(0);
    unsigned nloc = b.st[0], nx = b.st[1];
    if (nloc == 0u) { xcd_barrier_complete(bar, b.x, nloc, nx); b.st[0] = nloc; b.st[1] = nx; }
    const unsigned old = xb_add(&bar[XB_XSUB(b.x)], 1u);
    const unsigned gen = old / nloc;
    if (old + 1u == (gen + 1u) * nloc) {
      __builtin_amdgcn_fence(__ATOMIC_RELEASE, "agent");
      asm volatile("s_waitcnt vmcnt(0)" ::: "memory");
      const unsigned og = xb_add(&bar[XB_TOP], 1u);
      const unsigned tg = og / nx;
      if (og + 1u == (tg + 1u) * nx) xb_add(&bar[XB_TOPGEN], 1u);
      else XB_SPIN(xb_ld(&bar[XB_TOPGEN]) == tg, bar);
      __builtin_amdgcn_fence(__ATOMIC_ACQUIRE, "agent");
      xb_add(&bar[XB_XGEN(b.x)], 1u);
      asm volatile("s_waitcnt vmcnt(0)" ::: "memory");
    } else {
      XB_SPIN(xb_ld(&bar[XB_XGEN(b.x)]) == gen, bar);
      __builtin_amdgcn_fence(__ATOMIC_ACQUIRE, "agent");
      asm volatile("s_waitcnt vmcnt(0)" ::: "memory");
    }
  }
  __syncthreads();
}

constexpr int N_PHASES = 21;
#ifndef ONLY_PHASE
#define ONLY_PHASE -1
#endif
#define PHASE(k, body) do { if ((ONLY_PHASE < 0 || ONLY_PHASE == (k)) && ph_lo <= (k) && (k) <= ph_hi) { body; } if (ph_lo <= (k) && (k) < ph_hi) xcd_barrier(xb); } while (0)

__global__ void __launch_bounds__(NTHREADS, 2) fwd_mega(Params p, int ph_lo, int ph_hi) {
  extern __shared__ __attribute__((aligned(16))) char lds[];
  cg::grid_group grid = cg::this_grid();
  const int G = gridDim.x, bid = blockIdx.x;
  if (ph_lo > 1000) grid.sync();
  volatile LAS unsigned* xst = (volatile LAS unsigned*)(lds + 2 * HALF_LDS);
  if (threadIdx.x == 0) { xst[0] = 0u; xst[1] = 0u; }
  __syncthreads();
  XcdBarrier xb = xcd_barrier_post((unsigned*)(p.ws + OFF_BAR), xst);
  bf16_t* HN = (bf16_t*)(p.ws + OFF_HN);
  bf16_t* Pb = (bf16_t*)(p.ws + OFF_P);
  bf16_t* Ob = (bf16_t*)(p.ws + OFF_O);
  float* MIX = (float*)(p.ws + OFF_MIX);
  PHASE(0, phase_prep(p, lds, bid, G));
  PHASE(1, gemm_run(lds, HN, (const bf16_t*)(p.ws + OFF_WT_EVIN), LD_EV, 1024, EpiStoreBf16{Pb, LD_EV}, bid, G));
  PHASE(2, phase_scan_even_a(p, lds, bid, G));
  PHASE(3, phase_scan_even_c(p, bid, G));
  PHASE(4, phase_scan_even_b(p, lds, bid, G));
  PHASE(5, gemm_n1024(lds, Ob, (const bf16_t*)(p.ws + OFF_WT_EVOUT), 1024, MIX, (float*)Pb, bid, G));
  PHASE(6, phase_rowwise(p, p.in[9], p.in[10], false, (const float*)Pb, 4, bid, G));
  PHASE(7, gemm_run(lds, HN, (const bf16_t*)(p.ws + OFF_WT_GU), 5632, 1024, EpiSwiglu{Pb, 2816}, bid, G));
  PHASE(8, gemm_n1024(lds, Pb, (const bf16_t*)(p.ws + OFF_WT_DN), 2816, MIX, (float*)Ob, bid, G));
  PHASE(9, phase_rowwise(p, p.in[11], p.in[8] + 1024, false, (const float*)Ob, 11, bid, G));
  PHASE(10, gemm_run(lds, HN, (const bf16_t*)(p.ws + OFF_WT_ODIN), LD_OD, 1024, EpiStoreBf16{Pb, LD_OD}, bid, G));
  PHASE(11, phase_conv(p, bid, G));
  PHASE(12, phase_scan_odd_a(p, lds, bid, G));
  PHASE(13, phase_scan_odd_c(p, bid, G));
  PHASE(14, phase_scan_odd_b(p, lds, bid, G));
  PHASE(15, phase_groupnorm(p, bid, G));
  PHASE(16, gemm_n1024(lds, Ob, (const bf16_t*)(p.ws + OFF_WT_ODOUT), 2048, MIX, (float*)Pb, bid, G));
  PHASE(17, phase_rowwise(p, p.in[9] + 1024, p.in[10] + 1024, false, (const float*)Pb, 8, bid, G));
  PHASE(18, gemm_run(lds, HN, (const bf16_t*)(p.ws + OFF_WT_GU + SZ_WT_GU1), 5632, 1024, EpiSwiglu{Pb, 2816}, bid, G));
  PHASE(19, gemm_n1024(lds, Pb, (const bf16_t*)(p.ws + OFF_WT_DN + SZ_WT_DN1), 2816, MIX, (float*)Ob, bid, G));
  PHASE(20, phase_rowwise(p, p.in[11] + 1024, nullptr, true, (const float*)Ob, 11, bid, G));
}

extern "C" void kernel_launch(void* const* d_in, const int* in_sizes, int n_in, void* d_out, int out_size, void* d_ws, size_t ws_size, hipStream_t stream) {
  static int grid_blocks = 0;
  if (!grid_blocks) {
    int dev = 0, cus = 0, per_cu = 0;
    hipGetDevice(&dev);
    hipDeviceGetAttribute(&cus, hipDeviceAttributeMultiprocessorCount, dev);
    hipFuncSetAttribute((const void*)fwd_mega, hipFuncAttributeMaxDynamicSharedMemorySize, LDS_BYTES);
    hipOccupancyMaxActiveBlocksPerMultiprocessor(&per_cu, (const void*)fwd_mega, NTHREADS, LDS_BYTES);
    if (per_cu < 1) per_cu = 1;
    if (per_cu > 1) per_cu = 1;
    grid_blocks = cus * per_cu;
    if (ws_size < WS_END) fprintf(stderr, "kernel_launch: workspace too small: %zu < %zu\n", ws_size, (size_t)WS_END);
  }
  Params p{};
  for (int i = 0; i < 29; ++i) p.in[i] = (const float*)d_in[i];
  p.out = (float*)d_out;
  p.ws = (char*)d_ws;
  (void)hipMemsetAsync((char*)d_ws + OFF_BAR, 0, XCD_BAR_WORDS * 4, stream);
#if ONE_LAUNCH
  int lo = 0, hi = N_PHASES - 1;
  void* args[] = {&p, &lo, &hi};
  hipError_t e = hipLaunchCooperativeKernel((const void*)fwd_mega, dim3(grid_blocks), dim3(NTHREADS), args, LDS_BYTES, stream);
  if (e != hipSuccess) fprintf(stderr, "cooperative launch failed: %s (grid %d)\n", hipGetErrorString(e), grid_blocks);
#else
  for (int ph = 0; ph < N_PHASES; ++ph) {
    int lo = ph, hi = ph;
    void* args[] = {&p, &lo, &hi};
    hipError_t e = hipLaunchCooperativeKernel((const void*)fwd_mega, dim3(grid_blocks), dim3(NTHREADS), args, LDS_BYTES, stream);
    if (e != hipSuccess) fprintf(stderr, "launch failed: %s (grid %d)\n", hipGetErrorString(e), grid_blocks);
  }
#endif
}
```

```cpp
#include <hip/hip_runtime.h>
#include <hip/hip_cooperative_groups.h>
#include <cstdio>
#include <cstdint>
namespace cg = cooperative_groups;

#ifndef ONE_LAUNCH
#define ONE_LAUNCH 1
#endif

#define DI __device__ __forceinline__
typedef unsigned short bf16_t;
typedef short bf16x8 __attribute__((ext_vector_type(8)));
typedef short s16x4 __attribute__((ext_vector_type(4)));
typedef float f32x16 __attribute__((ext_vector_type(16)));
typedef float f32x4 __attribute__((ext_vector_type(4)));
typedef float f32x2 __attribute__((ext_vector_type(2)));
typedef unsigned u32x4 __attribute__((ext_vector_type(4)));
typedef unsigned u32x2 __attribute__((ext_vector_type(2)));
typedef __bf16 bf16v2 __attribute__((ext_vector_type(2)));
#define MFMA32(a, b, c) __builtin_amdgcn_mfma_f32_32x32x16_bf16((a), (b), (c), 0, 0, 0)

constexpr int T_ALL = 17024, T_PAD = 17152, T_PROMPT = 16512, SEQP = 2064, NTHREADS = 512, HB = 256  ;
constexpr int LD_EV = 3840, LD_OD = 5376;
constexpr int HALF_LDS = 75776;
constexpr int LDS_BYTES = 2 * HALF_LDS + 32;
constexpr int M_MAIN = 16384;

constexpr size_t OFF_WT_EVIN = 0;
constexpr size_t OFF_WT_EVOUT = OFF_WT_EVIN + (size_t)3840 * 1024 * 2;
constexpr size_t OFF_WT_GU = OFF_WT_EVOUT + (size_t)1024 * 1024 * 2;
constexpr size_t SZ_WT_GU1 = (size_t)5632 * 1024 * 2;
constexpr size_t OFF_WT_DN = OFF_WT_GU + 2 * SZ_WT_GU1;
constexpr size_t SZ_WT_DN1 = (size_t)1024 * 2816 * 2;
constexpr size_t OFF_WT_ODIN = OFF_WT_DN + 2 * SZ_WT_DN1;
constexpr size_t OFF_WT_ODOUT = OFF_WT_ODIN + (size_t)5376 * 1024 * 2;
constexpr size_t OFF_X = OFF_WT_ODOUT + (size_t)1024 * 2048 * 2;
constexpr size_t OFF_HN = OFF_X + (size_t)T_PAD * 1024 * 4;
constexpr size_t OFF_P = OFF_HN + (size_t)T_PAD * 1024 * 2;
constexpr size_t OFF_O = OFF_P + (size_t)T_PAD * 5376 * 2;
constexpr size_t OFF_MIX = OFF_O + (size_t)T_PAD * 2048 * 2;
constexpr size_t OFF_SSQ = OFF_MIX + (size_t)T_PAD * 1024 * 4;
constexpr size_t OFF_BAR = OFF_SSQ + (size_t)T_PAD * 16 * 4;
constexpr size_t OFF_CNT = OFF_BAR + 16384;
constexpr size_t SZ_CNT_SET = 64 * 256;
constexpr size_t OFF_XB = OFF_CNT + 8 * SZ_CNT_SET;
constexpr size_t SZ_XB_SET = (size_t)64 * 256 * 4 * 4;
constexpr size_t WS_END = OFF_XB + 8 * SZ_XB_SET;

constexpr size_t OUT_YP = 0;
constexpr size_t OUT_YS = 16777216;
constexpr size_t OUT_HGP = OUT_YS + 524288;
constexpr size_t OUT_GLP = OUT_HGP + 524288;
constexpr size_t OUT_SSP = OUT_GLP + 262144;
constexpr size_t OUT_CVP = OUT_SSP + 2097152;
constexpr size_t OUT_HGS = OUT_CVP + 73728;
constexpr size_t OUT_GLS = OUT_HGS + 8388608;
constexpr size_t OUT_SSS = OUT_GLS + 4194304;
constexpr size_t OUT_CVS = OUT_SSS + 33554432;

struct Params { const float* in[29]; float* out; char* ws; };

DI unsigned pk2(float lo, float hi) { f32x2 v = {lo, hi}; bf16v2 b = __builtin_convertvector(v, bf16v2); return __builtin_bit_cast(unsigned, b); }
DI float bflo(unsigned u) { return __uint_as_float(u << 16); }
DI float bfhi(unsigned u) { return __uint_as_float(u & 0xffff0000u); }
DI f32x4 ld_bf4(const bf16_t* p) { const u32x2 u = *(const u32x2*)p; return (f32x4){bflo(u[0]), bfhi(u[0]), bflo(u[1]), bfhi(u[1])}; }
DI void st_bf4(bf16_t* p, f32x4 v) { u32x2 u; u[0] = pk2(v.x, v.y); u[1] = pk2(v.z, v.w); *(u32x2*)p = u; }
DI float sigmoidf_(float x) { return __builtin_amdgcn_rcpf(1.f + __expf(-x)); }
DI float siluf_(float x) { return x * sigmoidf_(x); }
DI int crow(int r, int h) { return (r & 3) + 8 * (r >> 2) + 4 * h; }
DI bf16x8 cat8(s16x4 lo, s16x4 hi) { return __builtin_shufflevector(lo, hi, 0, 1, 2, 3, 4, 5, 6, 7); }
template <int S> DI bf16x8 pack8(const f32x16& x) {
  u32x4 p;
  p[0] = pk2(x[8 * S + 0], x[8 * S + 1]); p[1] = pk2(x[8 * S + 2], x[8 * S + 3]);
  p[2] = pk2(x[8 * S + 4], x[8 * S + 5]); p[3] = pk2(x[8 * S + 6], x[8 * S + 7]);
  return __builtin_bit_cast(bf16x8, p);
}
DI float wave_sum(float v) {
#pragma unroll
  for (int o = 1; o < 64; o <<= 1) v += __shfl_xor(v, o);
  return v;
}
DI void zero16(f32x16& a) {
#pragma unroll
  for (int i = 0; i < 16; ++i) a[i] = 0.f;
}

DI void transpose_tile(const float* __restrict__ W, int K, int N, bf16_t* Wt, int mode, int kt, int nt, float* tile, bool active) {
  const int tid = threadIdx.x & (HB - 1), k0 = kt * 64, n0 = nt * 64;
  if (active) {
    const int c = tid & 63, r0 = tid >> 6, n = n0 + c;
#pragma unroll
    for (int i = 0; i < 16; ++i) { const int k = r0 + 4 * i; tile[k * 65 + c] = (n < N) ? W[(size_t)(k0 + k) * N + n] : 0.f; }
  }
  __syncthreads();
  if (active) {
    const int nl = tid >> 2, kc = (tid & 3) * 16, n = n0 + nl;
    int drow = n;
    if (mode == 1) drow = (n >> 7) * 256 + (n & 127);
    if (mode == 2) drow = (n >> 7) * 256 + 128 + (n & 127);
    u32x4 o0, o1;
#pragma unroll
    for (int j = 0; j < 4; ++j) {
      o0[j] = pk2(tile[(kc + 2 * j) * 65 + nl], tile[(kc + 2 * j + 1) * 65 + nl]);
      o1[j] = pk2(tile[(kc + 8 + 2 * j) * 65 + nl], tile[(kc + 8 + 2 * j + 1) * 65 + nl]);
    }
    u32x4* d = (u32x4*)(Wt + (size_t)drow * K + k0 + kc);
    d[0] = o0; d[1] = o1;
  }
  __syncthreads();
}

DI void rms_row_to_bf16(const f32x4 (&v)[4], const float* __restrict__ wn, bf16_t* dst, int lane) {
  float s = 0.f;
#pragma unroll
  for (int j = 0; j < 4; ++j) s += v[j].x * v[j].x + v[j].y * v[j].y + v[j].z * v[j].z + v[j].w * v[j].w;
  const float rstd = rsqrtf(wave_sum(s) * (1.f / 1024.f) + 1e-6f);
#pragma unroll
  for (int j = 0; j < 4; ++j) {
    const f32x4 g = *(const f32x4*)(wn + 256 * j + 4 * lane);
    u32x2 o; o[0] = pk2(v[j].x * rstd * g.x, v[j].y * rstd * g.y); o[1] = pk2(v[j].z * rstd * g.z, v[j].w * rstd * g.w);
    *(u32x2*)(dst + 256 * j + 4 * lane) = o;
  }
}

DI void phase_prep(const Params& p, char* lds, int bid, int G) {
  const int half = threadIdx.x >> 8;
  float* tile = (float*)(lds + half * HALF_LDS);
  constexpr int NT_TILES = 960 + 256 + 1408 + 1408 + 1408 + 1344 + 512;
  for (int tb = bid * 2; tb < NT_TILES; tb += G * 2) {
    const int t = tb + half;
    const bool active = t < NT_TILES;
    const float* W = p.in[12]; int K = 1024, N = 3600, nnt = 60, mode = 0; bf16_t* dst = (bf16_t*)(p.ws + OFF_WT_EVIN); int r = active ? t : 0;
    if (r < 960) { }
    else if ((r -= 960) < 256) { W = p.in[17]; K = 1024; N = 1024; nnt = 16; dst = (bf16_t*)(p.ws + OFF_WT_EVOUT); }
    else if ((r -= 256) < 1408) { const int l = r / 704; r -= l * 704; W = p.in[26] + (size_t)l * 1024 * 2816; K = 1024; N = 2816; nnt = 44; mode = 1; dst = (bf16_t*)(p.ws + OFF_WT_GU + l * SZ_WT_GU1); }
    else if ((r -= 1408) < 1408) { const int l = r / 704; r -= l * 704; W = p.in[27] + (size_t)l * 1024 * 2816; K = 1024; N = 2816; nnt = 44; mode = 2; dst = (bf16_t*)(p.ws + OFF_WT_GU + l * SZ_WT_GU1); }
    else if ((r -= 1408) < 1408) { const int l = r / 704; r -= l * 704; W = p.in[28] + (size_t)l * 2816 * 1024; K = 2816; N = 1024; nnt = 16; dst = (bf16_t*)(p.ws + OFF_WT_DN + l * SZ_WT_DN1); }
    else if ((r -= 1408) < 1344) { W = p.in[18]; K = 1024; N = 5152; nnt = 84; dst = (bf16_t*)(p.ws + OFF_WT_ODIN); }
    else { r -= 1344; W = p.in[25]; K = 2048; N = 1024; nnt = 16; dst = (bf16_t*)(p.ws + OFF_WT_ODOUT); }
    const int kt = r / nnt, nt = r - kt * nnt;
    transpose_tile(W, K, N, dst, mode, kt, nt, tile, active);
  }
  const int lane = threadIdx.x & 63, w = threadIdx.x >> 6;
  bf16_t* X = (bf16_t*)(p.ws + OFF_X);
  bf16_t* HN = (bf16_t*)(p.ws + OFF_HN);
  for (int row = bid * 8 + w; row < T_ALL; row += G * 8) {
    const float* src;
    if (row < T_PROMPT) { const int b = row / SEQP, t = row - b * SEQP; src = (t < 16) ? p.in[6] + (size_t)t * 1024 : p.in[0] + ((size_t)b * 2048 + (t - 16)) * 1024; }
    else src = p.in[1] + (size_t)(row - T_PROMPT) * 1024;
    f32x4 v[4];
#pragma unroll
    for (int j = 0; j < 4; ++j) { v[j] = *(const f32x4*)(src + 256 * j + 4 * lane); st_bf4(X + (size_t)row * 1024 + 256 * j + 4 * lane, v[j]); }
    rms_row_to_bf16(v, p.in[8], HN + (size_t)row * 1024, lane);
  }
}

DI void phase_rowwise(const Params& p, const float* __restrict__ wpost, const float* __restrict__ wpre, bool final_, const float* PART, int nsplit, int row_begin, int bid, int G) {
  const int lane = threadIdx.x & 63, w = threadIdx.x >> 6;
  bf16_t* X = (bf16_t*)(p.ws + OFF_X);
  const bf16_t* MIX = (const bf16_t*)(p.ws + OFF_MIX);
  bf16_t* HN = (bf16_t*)(p.ws + OFF_HN);
  for (int rowa = row_begin + bid * 8 + w; rowa < T_ALL; rowa += G * 16) {
    const int rowb = rowa + G * 8;
    const bool hasb = rowb < T_ALL;
    f32x4 m[2][4], x[2][4];
#pragma unroll
    for (int q = 0; q < 2; ++q) {
      const int row = q ? (hasb ? rowb : rowa) : rowa;
#pragma unroll
      for (int j = 0; j < 4; ++j) {
        if (row < 16384) m[q][j] = ld_bf4(MIX + (size_t)row * 1024 + 256 * j + 4 * lane);
        else {
          f32x4 a = {0.f, 0.f, 0.f, 0.f};
          for (int ks = 0; ks < nsplit; ++ks) a = a + *(const f32x4*)(PART + ((size_t)ks * 768 + (row - 16384)) * 1024 + 256 * j + 4 * lane);
          m[q][j] = a;
        }
        x[q][j] = ld_bf4(X + (size_t)row * 1024 + 256 * j + 4 * lane);
      }
    }
#pragma unroll
    for (int q = 0; q < 2; ++q) {
      if (q == 1 && !hasb) break;
      const int row = q ? rowb : rowa;
      float s = 0.f;
#pragma unroll
      for (int j = 0; j < 4; ++j) s += m[q][j].x * m[q][j].x + m[q][j].y * m[q][j].y + m[q][j].z * m[q][j].z + m[q][j].w * m[q][j].w;
      const float rstd = rsqrtf(wave_sum(s) * (1.f / 1024.f) + 1e-6f);
#pragma unroll
      for (int j = 0; j < 4; ++j) { const f32x4 g = *(const f32x4*)(wpost + 256 * j + 4 * lane); x[q][j] = x[q][j] + m[q][j] * rstd * g; }
      if (!final_) {
#pragma unroll
        for (int j = 0; j < 4; ++j) st_bf4(X + (size_t)row * 1024 + 256 * j + 4 * lane, x[q][j]);
        rms_row_to_bf16(x[q], wpre, HN + (size_t)row * 1024, lane);
      } else {
        float* dst = nullptr;
        if (row < T_PROMPT) { const int b = row / SEQP, t = row - b * SEQP; if (t >= 16) dst = p.out + OUT_YP + ((size_t)b * 2048 + (t - 16)) * 1024; }
        else dst = p.out + OUT_YS + (size_t)(row - T_PROMPT) * 1024;
        if (dst) {
#pragma unroll
          for (int j = 0; j < 4; ++j) *(f32x4*)(dst + 256 * j + 4 * lane) = x[q][j];
        }
      }
    }
  }
}

DI void phase_groupnorm(const Params& p, int bid, int G) {
  const int lane = threadIdx.x & 63, w = threadIdx.x >> 6;
  bf16_t* O = (bf16_t*)(p.ws + OFF_O);
  const float* SSQ = (const float*)(p.ws + OFF_SSQ);
  const float* __restrict__ nw = p.in[24];
  const int g = lane >> 4;
  for (int row = bid * 8 + w; row < T_ALL; row += G * 8) {
    const f32x4 q = *(const f32x4*)(SSQ + (size_t)row * 16 + 4 * g);
    const float rstd = rsqrtf((q.x + q.y + q.z + q.w) * (1.f / 512.f) + 1e-6f);
    bf16_t* o = O + (size_t)row * 2048 + lane * 32;
#pragma unroll
    for (int j = 0; j < 4; ++j) {
      u32x4 v = *(u32x4*)(o + 8 * j);
      const f32x4 w0 = *(const f32x4*)(nw + lane * 32 + 8 * j), w1 = *(const f32x4*)(nw + lane * 32 + 8 * j + 4);
      v[0] = pk2(bflo(v[0]) * rstd * w0.x, bfhi(v[0]) * rstd * w0.y); v[1] = pk2(bflo(v[1]) * rstd * w0.z, bfhi(v[1]) * rstd * w0.w);
      v[2] = pk2(bflo(v[2]) * rstd * w1.x, bfhi(v[2]) * rstd * w1.y); v[3] = pk2(bflo(v[3]) * rstd * w1.z, bfhi(v[3]) * rstd * w1.w);
      *(u32x4*)(o + 8 * j) = v;
    }
  }
}

namespace pg8 {
#define PG8_LAS __attribute__((address_space(3)))
typedef unsigned short bf16_t;
typedef short bf16x8 __attribute__((ext_vector_type(8)));
typedef float f32x4 __attribute__((ext_vector_type(4)));
typedef unsigned u32x4 __attribute__((ext_vector_type(4)));
constexpr int BM = 256, BK = 64, HALF = 128, HTB = HALF * BK * 2  , STAGE_BYTES = 8 * HTB, NXCD = 8, WGM = 8;

__host__ __device__ __forceinline__ int lds_byte(int r, int c) { const int st = (r >> 4) * 2 + (c >> 5), rr = r & 15, cc = c & 31, ob = rr * 64 + cc * 2; return st * 1024 + (ob ^ (((ob >> 9) & 1) << 5)); }
__host__ __device__ __forceinline__ void stage_rc(int b, int& R, int& C) { const int st = b / 1024, sb = b % 1024, swz = sb ^ (((sb >> 9) & 1) << 5); R = (st >> 1) * 16 + swz / 64; C = (st & 1) * 32 + (swz % 64) / 2; }
__host__ __device__ __forceinline__ int perm32(int rho) { const int n = rho >> 4, i = rho & 15; return 8 * (i >> 2) + 4 * n + (i & 3); }

struct Unit { int pm, pn, ks; };
struct Gemm { const bf16_t* A; const bf16_t* Bt; int M, N, K, ld; };

struct StaticOrder {
    int nM, nN, nwg, G, c;
    __host__ __device__ void init(int M, int N, int G_, int c_) { nM = M / BM; nN = N / BM; nwg = nM * nN; G = G_; c = c_; }
    __host__ __device__ bool next(int i, Unit& u) const {
        const long L = (long)i * G + c; if (L >= nwg) return false;
        int wgid = (int)L; { const int q = nwg / NXCD, r = nwg % NXCD, xcd = wgid % NXCD, off = wgid / NXCD; wgid = (xcd < r ? xcd * (q + 1) : r * (q + 1) + (xcd - r) * q) + off; }
        const int nig = WGM * nN, gid = wgid / nig, fm = gid * WGM, gsz = (nM - fm) < WGM ? (nM - fm) : WGM;
        u.pm = fm + ((wgid % nig) % gsz); u.pn = (wgid % nig) / gsz; u.ks = 0; return true;
    }
    __device__ __forceinline__ void a_ready(const Unit&) const {}
    __device__ __forceinline__ void done(const Unit&) const {}
};
__device__ __forceinline__ unsigned cvt_pk_bf16(float lo, float hi) { unsigned r; asm volatile("v_cvt_pk_bf16_f32 %0, %1, %2" : "=v"(r) : "v"(lo), "v"(hi)); return r; }
typedef float f32x2 __attribute__((ext_vector_type(2)));
template <class Epi, class Sched, bool ALIGN_EPI = false, bool SP2 = false>
__device__ __forceinline__ void gemm_phase(PG8_LAS unsigned char* lds, const Gemm g, const Sched& S, const Epi& E) {
    int tid_ = threadIdx.x; asm volatile("" : "+v"(tid_));
    const int tid = tid_, wid = __builtin_amdgcn_readfirstlane(tid >> 6), lane = tid & 63, wr = wid >> 2, wc = wid & 3, fr = lane & 15, fq = lane >> 4;
    const int K = g.ld, nt = g.K / BK;
    unsigned voffA[2], voffB[2];
#pragma unroll
    for (int i = 0; i < 2; ++i) { int R, C; stage_rc(tid * 16 + i * 8192, R, C); const int Rb = Epi::PERM ? ((R & ~31) + perm32(R & 31)) : R;
        voffA[i] = (unsigned)(R * K + C) * 2u; voffB[i] = (unsigned)(Rb * K + C) * 2u; }
    const size_t kstep = (size_t)(BK * 2);
    const size_t hstep = (size_t)HALF * K * 2;
    const size_t tstep = 2 * hstep;
    const unsigned ldsw = (unsigned)wid * 1024u;
    const int aoff = lds_byte(wr * 64 + fr, fq * 8), boff = lds_byte(wc * 32 + fr, fq * 8);
#define PG8_SA(b, h) (((b) * 2 + (h)) * HTB)
#define PG8_SB(b, h) ((4 + (b) * 2 + (h)) * HTB)
#define PG8_STAGE(bufoff, gbase, voff) do { _Pragma("unroll") for (int _i = 0; _i < 2; ++_i) \
        __builtin_amdgcn_global_load_lds((const unsigned*)((const char*)(gbase) + (voff)[_i]), (PG8_LAS unsigned*)(lds + (bufoff) + ldsw + _i * 8192), 16, 0, 0); } while (0)
#define PG8_LDA(dst, b, h) do { _Pragma("unroll") for (int m = 0; m < 4; ++m) _Pragma("unroll") for (int k = 0; k < 2; ++k) dst[m][k] = *(const PG8_LAS bf16x8*)(lds + PG8_SA(b, h) + aoff + m * 2048 + k * 1024); } while (0)
#define PG8_LDB(dst, b, h) do { _Pragma("unroll") for (int n = 0; n < 2; ++n) _Pragma("unroll") for (int k = 0; k < 2; ++k) dst[n][k] = *(const PG8_LAS bf16x8*)(lds + PG8_SB(b, h) + boff + n * 2048 + k * 1024); } while (0)
#define PG8_MMA(ai, bj, At, Bt) do { __builtin_amdgcn_s_setprio(1); _Pragma("unroll") for (int m = 0; m < 4; ++m) _Pragma("unroll") for (int n = 0; n < 2; ++n) _Pragma("unroll") for (int k = 0; k < 2; ++k) \
        acc[ai][bj][m][n] = __builtin_amdgcn_mfma_f32_16x16x32_bf16(Bt[n][k], At[m][k], acc[ai][bj][m][n], 0, 0, 0); __builtin_amdgcn_s_setprio(0); } while (0)
#define PG8_WAIT_V(n) asm volatile("s_waitcnt vmcnt(" #n ")" ::: "memory")
#define PG8_WAIT_L(n) asm volatile("s_waitcnt lgkmcnt(" #n ")" ::: "memory")
#define PG8_BAR __builtin_amdgcn_s_barrier()
#define PG8_SCHED __builtin_amdgcn_sched_barrier(0)
    Unit cur, nxt; int ui = 0;
    if (!S.next(0, cur)) return;
    f32x4 acc[2][2][4][2];
#pragma unroll
    for (int a = 0; a < 2; ++a)
#pragma unroll
        for (int b = 0; b < 2; ++b)
#pragma unroll
            for (int m = 0; m < 4; ++m)
#pragma unroll
                for (int n = 0; n < 2; ++n) acc[a][b][m][n] = (f32x4){0.f, 0.f, 0.f, 0.f};
    bf16x8 At[4][2], B0[2][2], B1[2][2];
    const char* cA = (const char*)g.A + (size_t)cur.pm * tstep + (size_t)cur.ks * g.K * 2; const char* cB = (const char*)g.Bt + (size_t)cur.pn * tstep + (size_t)cur.ks * g.K * 2;
    S.a_ready(cur);
    if constexpr (SP2) {
        PG8_STAGE(PG8_SB(0, 0), cB, voffB); PG8_STAGE(PG8_SB(0, 1), cB + hstep, voffB); PG8_STAGE(PG8_SA(0, 0), cA, voffA); PG8_STAGE(PG8_SA(0, 1), cA + hstep, voffA);
        if (wr == 1) PG8_BAR;
        PG8_WAIT_V(2); PG8_BAR;
        PG8_STAGE(PG8_SB(1, 0), cB + kstep, voffB); PG8_STAGE(PG8_SA(1, 0), cA + kstep, voffA); PG8_STAGE(PG8_SB(1, 1), cB + hstep + kstep, voffB);
        PG8_WAIT_V(6); PG8_BAR;
    } else {
        PG8_STAGE(PG8_SB(0, 0), cB, voffB); PG8_STAGE(PG8_SA(0, 0), cA, voffA); PG8_STAGE(PG8_SB(0, 1), cB + hstep, voffB); PG8_STAGE(PG8_SA(0, 1), cA + hstep, voffA);
        if (wr == 1) PG8_BAR;
        PG8_WAIT_V(4); PG8_BAR;
        PG8_STAGE(PG8_SB(1, 0), cB + kstep, voffB); PG8_STAGE(PG8_SA(1, 0), cA + kstep, voffA); PG8_STAGE(PG8_SB(1, 1), cB + hstep + kstep, voffB);
        PG8_WAIT_V(6); PG8_BAR;
    }
    for (;;) {
        const bool has_next = S.next(ui + 1, nxt);
        const char* nA = has_next ? (const char*)g.A + (size_t)nxt.pm * tstep + (size_t)nxt.ks * g.K * 2 : cA; const char* nB = has_next ? (const char*)g.Bt + (size_t)nxt.pn * tstep + (size_t)nxt.ks * g.K * 2 : cB;
        for (int t = 0; t < nt; t += 2) {
            const bool last = (t == nt - 2);
            const char* a1 = cA + (size_t)(t + 1) * kstep;
            const char* a2 = last ? nA : cA + (size_t)(t + 2) * kstep; const char* b2 = last ? nB : cB + (size_t)(t + 2) * kstep;
            const char* a3 = a2 + kstep; const char* b3 = b2 + kstep;
            if (last && has_next) S.a_ready(nxt);
            if constexpr (SP2) {
            PG8_LDB(B0, 0, 0); PG8_LDB(B1, 0, 1); PG8_SCHED; PG8_LDA(At, 0, 0); PG8_STAGE(PG8_SA(1, 1), a1 + hstep, voffA);
            PG8_WAIT_V(8); PG8_WAIT_L(0); PG8_BAR; PG8_MMA(0, 0, At, B0); PG8_MMA(0, 1, At, B1); PG8_BAR; PG8_SCHED;
            PG8_LDA(At, 0, 1); PG8_STAGE(PG8_SB(0, 0), b2, voffB); PG8_STAGE(PG8_SB(0, 1), b2 + hstep, voffB); PG8_STAGE(PG8_SA(0, 0), a2, voffA);
            PG8_WAIT_V(8); PG8_WAIT_L(0); PG8_BAR; PG8_MMA(1, 0, At, B0); PG8_MMA(1, 1, At, B1); PG8_BAR; PG8_SCHED;
            PG8_LDB(B0, 1, 0); PG8_LDB(B1, 1, 1); PG8_SCHED; PG8_LDA(At, 1, 0); PG8_STAGE(PG8_SA(0, 1), a2 + hstep, voffA);
            PG8_WAIT_V(8); PG8_WAIT_L(0); PG8_BAR; PG8_MMA(0, 0, At, B0); PG8_MMA(0, 1, At, B1); PG8_BAR; PG8_SCHED;
            PG8_LDA(At, 1, 1); PG8_STAGE(PG8_SB(1, 0), b3, voffB); PG8_STAGE(PG8_SB(1, 1), b3 + hstep, voffB); PG8_STAGE(PG8_SA(1, 0), a3, voffA);
            PG8_WAIT_V(8); PG8_WAIT_L(0); PG8_BAR; PG8_MMA(1, 0, At, B0); PG8_MMA(1, 1, At, B1); PG8_BAR; PG8_SCHED;
            } else {
            PG8_LDB(B0, 0, 0); PG8_SCHED; PG8_LDA(At, 0, 0); PG8_STAGE(PG8_SA(1, 1), a1 + hstep, voffA);
            PG8_WAIT_L(8); PG8_BAR; PG8_WAIT_L(0); PG8_MMA(0, 0, At, B0); PG8_BAR; PG8_SCHED;
            PG8_LDB(B1, 0, 1); PG8_STAGE(PG8_SB(0, 0), b2, voffB);
            PG8_BAR; PG8_WAIT_L(0); PG8_MMA(0, 1, At, B1); PG8_BAR;
            PG8_LDA(At, 0, 1); PG8_STAGE(PG8_SA(0, 0), a2, voffA);
            PG8_BAR; PG8_WAIT_L(0); PG8_MMA(1, 0, At, B0); PG8_BAR; PG8_SCHED;
            PG8_STAGE(PG8_SB(0, 1), b2 + hstep, voffB);
            PG8_WAIT_V(6); PG8_BAR; PG8_MMA(1, 1, At, B1); PG8_BAR;
            PG8_LDB(B0, 1, 0); PG8_SCHED; PG8_LDA(At, 1, 0); PG8_STAGE(PG8_SA(0, 1), a2 + hstep, voffA);
            PG8_WAIT_L(8); PG8_BAR; PG8_WAIT_L(0); PG8_MMA(0, 0, At, B0); PG8_BAR; PG8_SCHED;
            PG8_LDB(B1, 1, 1); PG8_STAGE(PG8_SB(1, 0), b3, voffB);
            PG8_BAR; PG8_WAIT_L(0); PG8_MMA(0, 1, At, B1); PG8_BAR;
            PG8_LDA(At, 1, 1); PG8_STAGE(PG8_SA(1, 0), a3, voffA);
            PG8_BAR; PG8_WAIT_L(0); PG8_MMA(1, 0, At, B0); PG8_BAR; PG8_SCHED;
            PG8_STAGE(PG8_SB(1, 1), b3 + hstep, voffB);
            PG8_WAIT_V(6); PG8_BAR; PG8_MMA(1, 1, At, B1); PG8_BAR;
            }
        }
        if constexpr (ALIGN_EPI) { if (wr == 0) PG8_BAR; }
        if constexpr (!Epi::AFTER_DRAIN) { E(acc, cur, wr, wc, fr, fq); S.done(cur); }
        if (!has_next) break;
#pragma unroll
        for (int a = 0; a < 2; ++a)
#pragma unroll
            for (int b = 0; b < 2; ++b)
#pragma unroll
                for (int m = 0; m < 4; ++m)
#pragma unroll
                    for (int n = 0; n < 2; ++n) acc[a][b][m][n] = (f32x4){0.f, 0.f, 0.f, 0.f};
        cur = nxt; cA = nA; cB = nB; ++ui;
        if constexpr (ALIGN_EPI) { if (wr == 1) PG8_BAR; }
    }
    PG8_WAIT_V(0);
    if constexpr (!ALIGN_EPI) { if (wr == 0) PG8_BAR; }
    PG8_BAR;
    if constexpr (Epi::AFTER_DRAIN) { E.fused(acc, cur, wr, wc, fr, fq, lds, wid, lane); S.done(cur); }
#undef PG8_SA
#undef PG8_SB
#undef PG8_STAGE
#undef PG8_LDA
#undef PG8_LDB
#undef PG8_MMA
#undef PG8_WAIT_V
#undef PG8_WAIT_L
#undef PG8_BAR
#undef PG8_SCHED
}
}

struct EpiStoreBf16 {
  static constexpr bool PERM = true, AFTER_DRAIN = false;
  bf16_t* C; int ldc;
  DI void operator()(const pg8::f32x4 (&acc)[2][2][4][2], const pg8::Unit& u, int wr, int wc, int fr, int fq) const {
    const int row0 = u.pm * 256 + wr * 64 + fr, col0 = u.pn * 256 + wc * 32 + 8 * fq;
#pragma unroll
    for (int ai = 0; ai < 2; ++ai)
#pragma unroll
      for (int m = 0; m < 4; ++m) {
        bf16_t* rowp = C + (size_t)(row0 + ai * 128 + m * 16) * ldc + col0;
#pragma unroll
        for (int bj = 0; bj < 2; ++bj) {
          const pg8::f32x4 v0 = acc[ai][bj][m][0], v1 = acc[ai][bj][m][1];
          u32x4 w_; w_[0] = pk2(v0[0], v0[1]); w_[1] = pk2(v0[2], v0[3]); w_[2] = pk2(v1[0], v1[1]); w_[3] = pk2(v1[2], v1[3]);
          *(u32x4*)(rowp + bj * 128) = w_;
        }
      }
  }
};
struct EpiStoreF32 {
  static constexpr bool PERM = false, AFTER_DRAIN = false;
  float* C0; int ldc; size_t ks_stride;
  DI void operator()(const pg8::f32x4 (&acc)[2][2][4][2], const pg8::Unit& u, int wr, int wc, int fr, int fq) const {
    float* C = C0 + (size_t)u.ks * ks_stride;
    const int row0 = u.pm * 256 + wr * 64 + fr, col0 = u.pn * 256 + wc * 32 + 4 * fq;
#pragma unroll
    for (int ai = 0; ai < 2; ++ai)
#pragma unroll
      for (int m = 0; m < 4; ++m) {
        float* rowp = C + (size_t)(row0 + ai * 128 + m * 16) * ldc + col0;
#pragma unroll
        for (int bj = 0; bj < 2; ++bj)
#pragma unroll
          for (int n = 0; n < 2; ++n) *(pg8::f32x4*)(rowp + bj * 128 + n * 16) = acc[ai][bj][m][n];
      }
  }
};
struct EpiSwiglu {
  static constexpr bool PERM = true, AFTER_DRAIN = false;
  bf16_t* C; int ldc;
  DI void operator()(const pg8::f32x4 (&acc)[2][2][4][2], const pg8::Unit& u, int wr, int wc, int fr, int fq) const {
    const int row0 = u.pm * 256 + wr * 64 + fr, col0 = u.pn * 128 + wc * 32 + 8 * fq;
#pragma unroll
    for (int ai = 0; ai < 2; ++ai)
#pragma unroll
      for (int m = 0; m < 4; ++m) {
        float y[8];
#pragma unroll
        for (int n = 0; n < 2; ++n)
#pragma unroll
          for (int e = 0; e < 4; ++e) y[4 * n + e] = siluf_(acc[ai][0][m][n][e]) * acc[ai][1][m][n][e];
        u32x4 w_; w_[0] = pk2(y[0], y[1]); w_[1] = pk2(y[2], y[3]); w_[2] = pk2(y[4], y[5]); w_[3] = pk2(y[6], y[7]);
        *(u32x4*)(C + (size_t)(row0 + ai * 128 + m * 16) * ldc + col0) = w_;
      }
  }
};

struct RowSumExchange {
  float* xbuf; unsigned* cnt; unsigned* tmo;
  DI void run(const float (&part)[2][4], const pg8::Unit& u, int wr, int wc, int fr, int fq, char* lds, float* S, int wid, int lane) const {
    float* P = (float*)lds;
    if (fq == 0) {
#pragma unroll
      for (int ai = 0; ai < 2; ++ai)
#pragma unroll
        for (int m = 0; m < 4; ++m) P[(ai * 128 + wr * 64 + m * 16 + fr) * 4 + wc] = part[ai][m];
    }
    __syncthreads();
    const int row = wid * 32 + (lane & 31);
    if (lane < 32) {
      const f32x4 a = *(const f32x4*)(P + row * 4);
      __hip_atomic_store(xbuf + ((size_t)u.pm * 256 + row) * 4 + u.pn, (a.x + a.y) + (a.z + a.w), __ATOMIC_RELAXED, __HIP_MEMORY_SCOPE_AGENT);
    }
    asm volatile("s_waitcnt vmcnt(0)" ::: "memory");
    if (lane == 0) __hip_atomic_fetch_add(cnt + 64 * u.pm, 1u, __ATOMIC_RELAXED, __HIP_MEMORY_SCOPE_AGENT);
    if (wid == 0) {
      unsigned it = 0;
      while ((unsigned)__builtin_amdgcn_readfirstlane(__hip_atomic_load(cnt + 64 * u.pm, __ATOMIC_RELAXED, __HIP_MEMORY_SCOPE_AGENT)) < 32u) {
        __builtin_amdgcn_s_sleep(2);
        if (++it > (1u << 21)) { if (lane == 0) __hip_atomic_store(tmo, 1u, __ATOMIC_RELAXED, __HIP_MEMORY_SCOPE_AGENT); break; }
      }
      __builtin_amdgcn_fence(__ATOMIC_ACQUIRE, "agent");
    }
    asm volatile("s_waitcnt vmcnt(0) lgkmcnt(0)" ::: "memory");
    __syncthreads();
    if (lane < 32) {
      const float* slot = xbuf + ((size_t)u.pm * 256 + row) * 4;
      float t = 0.f;
#pragma unroll
      for (int k = 0; k < 4; ++k) t += __hip_atomic_load(slot + k, __ATOMIC_RELAXED, __HIP_MEMORY_SCOPE_AGENT);
      S[row] = t;
    }
    __syncthreads();
  }
};
template <bool FINAL>
struct EpiResNorm {
  static constexpr bool PERM = true, AFTER_DRAIN = true;
  bf16_t* X; bf16_t* HN; const float* wpost; const float* wpre; float* yout;
  float* xbuf; unsigned* cnt; unsigned* tmo;
  DI void operator()(const pg8::f32x4 (&)[2][2][4][2], const pg8::Unit&, int, int, int, int) const {}
  DI static void ssq_rows(const pg8::f32x4 (&acc)[2][2][4][2], float (&part)[2][4]) {
#pragma unroll
    for (int ai = 0; ai < 2; ++ai)
#pragma unroll
      for (int m = 0; m < 4; ++m) {
        float q = 0.f;
#pragma unroll
        for (int bj = 0; bj < 2; ++bj)
#pragma unroll
          for (int n = 0; n < 2; ++n) { const pg8::f32x4 v = acc[ai][bj][m][n]; q += (v[0] * v[0] + v[1] * v[1]) + (v[2] * v[2] + v[3] * v[3]); }
        q += __shfl_xor(q, 16); q += __shfl_xor(q, 32);
        part[ai][m] = q;
      }
  }
  DI void fused(pg8::f32x4 (&acc)[2][2][4][2], const pg8::Unit& u, int wr, int wc, int fr, int fq, PG8_LAS unsigned char* ldsl, int wid, int lane) const {
    char* lds = (char*)ldsl;
    float* S1 = (float*)(lds + 4096);
    float* S2 = (float*)(lds + 5120);
    float part[2][4];
    ssq_rows(acc, part);
    RowSumExchange{xbuf, cnt, tmo}.run(part, u, wr, wc, fr, fq, lds, S1, wid, lane);
#pragma unroll
    for (int ai = 0; ai < 2; ++ai)
#pragma unroll
      for (int m = 0; m < 4; ++m) {
        if (m == 0) __builtin_amdgcn_sched_barrier(0);
        const int rl = ai * 128 + wr * 64 + m * 16 + fr;
        const float r1 = rsqrtf(S1[rl] * (1.f / 1024.f) + 1e-6f);
        const bf16_t* xrow = X + (size_t)(u.pm * 256 + rl) * 1024;
#pragma unroll
        for (int bj = 0; bj < 2; ++bj) {
          const int c8 = u.pn * 256 + bj * 128 + wc * 32 + 8 * fq;
          const u32x4 xr = *(const u32x4*)(xrow + c8);
          const f32x4 g0 = *(const f32x4*)(wpost + c8), g1 = *(const f32x4*)(wpost + c8 + 4);
          const f32x4 x0 = {bflo(xr[0]), bfhi(xr[0]), bflo(xr[1]), bfhi(xr[1])}, x1 = {bflo(xr[2]), bfhi(xr[2]), bflo(xr[3]), bfhi(xr[3])};
          acc[ai][bj][m][0] = x0 + acc[ai][bj][m][0] * r1 * g0;
          acc[ai][bj][m][1] = x1 + acc[ai][bj][m][1] * r1 * g1;
        }
      }
    if (FINAL) {
#pragma unroll
      for (int ai = 0; ai < 2; ++ai)
#pragma unroll
        for (int m = 0; m < 4; ++m) {
          __builtin_amdgcn_sched_barrier(0);
          const int row = u.pm * 256 + ai * 128 + wr * 64 + m * 16 + fr;
          const int b = row / SEQP, t = row - b * SEQP;
          if (t >= 16) {
            float* dst = yout + ((size_t)b * 2048 + (t - 16)) * 1024;
#pragma unroll
            for (int bj = 0; bj < 2; ++bj)
#pragma unroll
              for (int n = 0; n < 2; ++n) *(f32x4*)(dst + u.pn * 256 + bj * 128 + wc * 32 + 8 * fq + 4 * n) = acc[ai][bj][m][n];
          }
        }
      return;
    }
    ssq_rows(acc, part);
    RowSumExchange{xbuf + SZ_XB_SET / 4, cnt + SZ_CNT_SET / 4, tmo}.run(part, u, wr, wc, fr, fq, lds, S2, wid, lane);
#pragma unroll
    for (int ai = 0; ai < 2; ++ai)
#pragma unroll
      for (int m = 0; m < 4; ++m) {
        if (m == 0) __builtin_amdgcn_sched_barrier(0);
        const int rl = ai * 128 + wr * 64 + m * 16 + fr;
        const float r2 = rsqrtf(S2[rl] * (1.f / 1024.f) + 1e-6f);
        bf16_t* xrow = X + (size_t)(u.pm * 256 + rl) * 1024;
        bf16_t* hrow = HN + (size_t)(u.pm * 256 + rl) * 1024;
#pragma unroll
        for (int bj = 0; bj < 2; ++bj) {
          const int c8 = u.pn * 256 + bj * 128 + wc * 32 + 8 * fq;
          const f32x4 g0 = *(const f32x4*)(wpre + c8), g1 = *(const f32x4*)(wpre + c8 + 4);
          const pg8::f32x4 v0 = acc[ai][bj][m][0], v1 = acc[ai][bj][m][1];
          u32x4 xo, ho;
          xo[0] = pk2(v0[0], v0[1]); xo[1] = pk2(v0[2], v0[3]); xo[2] = pk2(v1[0], v1[1]); xo[3] = pk2(v1[2], v1[3]);
          const pg8::f32x4 h0 = v0 * r2 * g0, h1 = v1 * r2 * g1;
          ho[0] = pk2(h0[0], h0[1]); ho[1] = pk2(h0[2], h0[3]); ho[2] = pk2(h1[0], h1[1]); ho[3] = pk2(h1[2], h1[3]);
          *(u32x4*)(xrow + c8) = xo;
          *(u32x4*)(hrow + c8) = ho;
        }
      }
  }
};
template <class Epi>
DI void gemm_run(char* lds, const bf16_t* A, const bf16_t* Bt, int N, int K, const Epi& E, int vcu, int G) {
  pg8::Gemm g{A, Bt, T_PAD, N, K, K};
  pg8::StaticOrder S; S.init(T_PAD, N, G, vcu);
  pg8::gemm_phase<Epi, pg8::StaticOrder, true, true>((PG8_LAS unsigned char*)lds, g, S, E);
}
struct SplitOrder {
  int nsplit, nitems, G, c;
  DI bool next(int i, pg8::Unit& u) const {
    const int L = i * G + c; if (L >= nitems) return false;
    const int q = L / nsplit; u.ks = L - q * nsplit; u.pm = q >> 2; u.pn = q & 3; return true;
  }
  DI void a_ready(const pg8::Unit&) const {}
  DI void done(const pg8::Unit&) const {}
};
DI void gemm_n1024_plain(char* lds, const bf16_t* A, const bf16_t* Bt, int K, float* MIXp, float* PART, int vcu, int G) {
  {
    pg8::Gemm g{A, Bt, M_MAIN, 1024, K, K};
    pg8::StaticOrder S; S.init(M_MAIN, 1024, G, vcu);
    pg8::gemm_phase<EpiStoreBf16, pg8::StaticOrder, true, true>((PG8_LAS unsigned char*)lds, g, S, EpiStoreBf16{(bf16_t*)MIXp, 1024});
  }
  {
    const int nsplit = K >> 8;
    pg8::Gemm g{A + (size_t)M_MAIN * K, Bt, 768, 1024, 256, K};
    SplitOrder S{nsplit, 12 * nsplit, G, (vcu + 128) % G};
    pg8::gemm_phase<EpiStoreF32, SplitOrder, true, true>((PG8_LAS unsigned char*)lds, g, S, EpiStoreF32{PART, 1024, (size_t)768 * 1024});
  }
}
template <bool FINAL>
DI void gemm_n1024(char* lds, const bf16_t* A, const bf16_t* Bt, int K, const EpiResNorm<FINAL>& E, float* PART, int vcu, int G) {
  {
    pg8::Gemm g{A, Bt, M_MAIN, 1024, K, K};
    pg8::StaticOrder S; S.init(M_MAIN, 1024, G, vcu);
    pg8::gemm_phase<EpiResNorm<FINAL>, pg8::StaticOrder, false, true>((PG8_LAS unsigned char*)lds, g, S, E);
  }
  __syncthreads();
  {
    const int nsplit = K >> 8;
    pg8::Gemm g{A + (size_t)M_MAIN * K, Bt, 768, 1024, 256, K};
    SplitOrder S{nsplit, 12 * nsplit, G, (vcu + 128) % G};
    pg8::gemm_phase<EpiStoreF32, SplitOrder, true, true>((PG8_LAS unsigned char*)lds, g, S, EpiStoreF32{PART, 1024, (size_t)768 * 1024});
  }
}

constexpr int L_QE = 0, L_KE = 8704, L_QI = 17408, L_G = 26112, L_KENDT = 34816, L_VT = 45056, L_DEC = 55296, L_TOT = 55808, L_SSQ = 57856;
constexpr int RS = 272, TS = 80;

template <int DK>
DI void pc_core(char* lds, f32x16 (&S)[DK / 32], f32x16& o, const int w, const int r32, const int h) {
  const char* QE = lds + L_QE + r32 * RS;
  const char* KE = lds + L_KE + r32 * RS;
  const char* QI = lds + L_QI + r32 * RS;
  f32x16 sc; zero16(sc);
#pragma unroll
  for (int s = 0; s < DK / 16; ++s) {
    const bf16x8 a = *(const bf16x8*)(KE + s * 32 + h * 16);
    const bf16x8 b = *(const bf16x8*)(QE + s * 32 + h * 16);
    sc = MFMA32(a, b, sc);
  }
#pragma unroll
  for (int r = 0; r < 16; ++r) if (crow(r, h) > r32) sc[r] = 0.f;
  const bf16x8 scb0 = pack8<0>(sc), scb1 = pack8<1>(sc);
  zero16(o);
#pragma unroll
  for (int kt = 0; kt < DK / 32; ++kt) {
    {
      const bf16x8 a = pack8<0>(S[kt]);
      const s16x4 lo = *(const s16x4*)(QI + (32 * kt + 4 * h) * 2), hi = *(const s16x4*)(QI + (32 * kt + 8 + 4 * h) * 2);
      o = MFMA32(a, cat8(lo, hi), o);
    }
    {
      const bf16x8 a = pack8<1>(S[kt]);
      const s16x4 lo = *(const s16x4*)(QI + (32 * kt + 16 + 4 * h) * 2), hi = *(const s16x4*)(QI + (32 * kt + 24 + 4 * h) * 2);
      o = MFMA32(a, cat8(lo, hi), o);
    }
  }
  const char* VTr = lds + L_VT + (32 * w + r32) * TS;
  {
    const s16x4 lo = *(const s16x4*)(VTr + (4 * h) * 2), hi = *(const s16x4*)(VTr + (8 + 4 * h) * 2);
    o = MFMA32(cat8(lo, hi), scb0, o);
  }
  {
    const s16x4 lo = *(const s16x4*)(VTr + (16 + 4 * h) * 2), hi = *(const s16x4*)(VTr + (24 + 4 * h) * 2);
    o = MFMA32(cat8(lo, hi), scb1, o);
  }
  const float* DEC = (const float*)(lds + L_DEC);
#pragma unroll
  for (int kt = 0; kt < DK / 32; ++kt)
#pragma unroll
    for (int g = 0; g < 4; ++g) {
      const f32x4 d = *(const f32x4*)(DEC + 32 * kt + 8 * g + 4 * h);
      S[kt][4 * g] *= d.x; S[kt][4 * g + 1] *= d.y; S[kt][4 * g + 2] *= d.z; S[kt][4 * g + 3] *= d.w;
    }
#pragma unroll
  for (int s = 0; s < 2; ++s) {
    const bf16x8 b = *(const bf16x8*)(VTr + s * 32 + h * 16);
#pragma unroll
    for (int kt = 0; kt < DK / 32; ++kt) {
      const bf16x8 a = *(const bf16x8*)(lds + L_KENDT + (32 * kt + r32) * TS + s * 32 + h * 16);
      S[kt] = MFMA32(a, b, S[kt]);
    }
  }
}

constexpr int NSC = 8;
DI int sc_beg(int sc) { return sc == 0 ? 0 : 16 + 256 * sc; }
DI int sc_end(int sc) { return 16 + 256 * (sc + 1); }
constexpr size_t SCR_HG_U = 0;
constexpr size_t SCR_GL_U = SCR_HG_U + (size_t)8 * 4 * 7 * 16384;
constexpr size_t SCR_HG_D = SCR_GL_U + (size_t)8 * 4 * 7 * 8192;
constexpr size_t SCR_GL_D = SCR_HG_D + (size_t)8 * 4 * 7 * 128;
constexpr size_t SCR_SS_U = 0;
constexpr size_t SCR_SS_D = SCR_SS_U + (size_t)8 * 32 * 7 * 8192;

template <int TYPE, bool SO>
DI void scan_even_job(const Params& p, char* lds, const int head, const int row0, const int ntok, const float* s_in, float* s_out, float* d_out) {
  constexpr int DK = TYPE == 0 ? 128 : 64;
  constexpr int KC = DK / 64;
  const int tid = threadIdx.x & (HB - 1), c = tid & 63, w = tid >> 6, r32 = c & 31, h = c >> 5;
  const bf16_t* P = (const bf16_t*)(p.ws + OFF_P);
  bf16_t* O = (bf16_t*)(p.ws + OFF_O);
  float* TOT = (float*)(lds + L_TOT);
  float* SSQ = (float*)(lds + L_SSQ);
  float* DEC = (float*)(lds + L_DEC);
  const int qcol = TYPE == 0 ? head * 128 : 2048 + head * 64;
  const int kcol = TYPE == 0 ? 512 + head * 128 : 2304 + head * 64;
  const int vcol = TYPE == 0 ? 1024 + head * 128 : 2560 + head * 128;
  const int gcol = TYPE == 0 ? 1536 + head * 128 : 3072 + head * 128;
  const int ocol = TYPE == 0 ? head * 128 : 512 + head * 128;
  float lb[2] = {0.f, 0.f}, wup[16], bal = 0.f;
  if (TYPE == 0) {
#pragma unroll
    for (int e = 0; e < 2; ++e) {
      const float g0 = p.in[7][head * 128 + 2 * c + e], g1 = p.in[7][512 + head * 128 + 2 * c + e], g2 = p.in[7][1024 + head * 128 + 2 * c + e];
      const float m = fmaxf(g0, fmaxf(g1, g2));
      const float e0 = __expf(g0 - m), e1 = __expf(g1 - m), e2 = __expf(g2 - m);
      lb[e] = e0 / (e0 + e1 + e2);
    }
  } else {
#pragma unroll
    for (int r = 0; r < 16; ++r) wup[r] = p.in[13][r * 256 + head * 64 + c];
    bal = p.in[14][head * 64 + c];
  }
  const float* __restrict__ nwp = TYPE == 0 ? p.in[15] : p.in[16];
  f32x16 S[DK / 32];
#pragma unroll
  for (int kt = 0; kt < DK / 32; ++kt)
#pragma unroll
    for (int r = 0; r < 16; ++r) S[kt][r] = (!SO && s_in) ? s_in[(size_t)(32 * kt + crow(r, h)) * 128 + 32 * w + r32] : 0.f;
  float dsum[KC];
#pragma unroll
  for (int e = 0; e < KC; ++e) dsum[e] = 0.f;

  unsigned rq[8], rk[8], rv[8], rg[8]; float ral[8];
  auto load_raw = [&](int ch) {
#pragma unroll
    for (int i = 0; i < 8; ++i) {
      const int t = min(ch * 32 + 8 * w + i, ntok - 1);
      const bf16_t* pr = P + (size_t)(row0 + t) * LD_EV;
      if (TYPE == 0) {
        if (!SO) rq[i] = *(const unsigned*)(pr + qcol + 2 * c);
        rk[i] = *(const unsigned*)(pr + kcol + 2 * c);
      } else {
        if (!SO) rq[i] = (unsigned)pr[qcol + c];
        rk[i] = (unsigned)pr[kcol + c];
        ral[i] = bflo((unsigned)pr[3584 + (c & 15)]);
      }
      rv[i] = *(const unsigned*)(pr + vcol + 2 * c);
      if (!SO) rg[i] = *(const unsigned*)(pr + gcol + 2 * c);
    }
  };
  const int nch = __builtin_amdgcn_readfirstlane((ntok + 31) >> 5);
  load_raw(0);
  for (int ch = 0; ch < nch; ++ch) {
    const int t0 = ch * 32;
    float kk[8][KC], cum[8][KC], run[KC];
#pragma unroll
    for (int e = 0; e < KC; ++e) run[e] = 0.f;
#pragma unroll
    for (int i = 0; i < 8; ++i) {
      const float vm = (t0 + 8 * w + i) < ntok ? 1.f : 0.f;
      if (TYPE == 0) {
#pragma unroll
        for (int e = 0; e < 2; ++e) {
          const float fa = e ? bfhi(rk[i]) : bflo(rk[i]);
          const float f = lb[e] + (1.f - lb[e]) * sigmoidf_(fa);
          kk[i][e] = vm - vm * f;
          run[e] += vm * __logf(f); cum[i][e] = run[e];
        }
      } else {
        float x = bal;
#pragma unroll
        for (int r = 0; r < 16; ++r) x += __int_as_float(__builtin_amdgcn_readlane(__float_as_int(ral[i]), r)) * wup[r];
        const float ls = fminf(x, 0.f) - __logf(1.f + __expf(-fabsf(x)));
        kk[i][0] = vm * bflo(rk[i]);
        run[0] += vm * ls * (1.f / 16.f); cum[i][0] = run[0];
      }
    }
#pragma unroll
    for (int e = 0; e < KC; ++e) TOT[w * 128 + KC * c + e] = run[e];
    __syncthreads();
    float off[KC], mid[KC], tot[KC];
#pragma unroll
    for (int e = 0; e < KC; ++e) {
      const float t0_ = TOT[KC * c + e], t1_ = TOT[128 + KC * c + e], t2_ = TOT[256 + KC * c + e], t3_ = TOT[384 + KC * c + e];
      mid[e] = t0_ + t1_; tot[e] = (t0_ + t1_) + (t2_ + t3_);
      off[e] = w == 0 ? 0.f : (w == 1 ? t0_ : (w == 2 ? t0_ + t1_ : t0_ + t1_ + t2_));
      dsum[e] += tot[e];
    }
    {
      u32x4 kp[KC];
#pragma unroll
      for (int m = 0; m < 4; ++m) {
        float kend[2][KC];
#pragma unroll
        for (int i2 = 0; i2 < 2; ++i2) {
          const int i = 2 * m + i2;
          const int ti = 8 * w + i;
          float qe[KC], ke[KC], qi[KC];
#pragma unroll
          for (int e = 0; e < KC; ++e) {
            const float cv = off[e] + cum[i][e];
            kend[i2][e] = kk[i][e] * __expf(tot[e] - cv);
            if (!SO) {
              const float qv = TYPE == 0 ? (e ? bfhi(rq[i]) : bflo(rq[i])) : bflo(rq[i]) * 0.125f;
              qe[e] = qv * __expf(cv - mid[e]);
              ke[e] = kk[i][e] * __expf(mid[e] - cv);
              qi[e] = qv * __expf(cv);
            }
          }
          if (!SO) {
            if (KC == 2) {
              *(unsigned*)(lds + L_QE + ti * RS + 4 * c) = pk2(qe[0], qe[KC - 1]);
              *(unsigned*)(lds + L_KE + ti * RS + 4 * c) = pk2(ke[0], ke[KC - 1]);
              *(unsigned*)(lds + L_QI + ti * RS + 4 * c) = pk2(qi[0], qi[KC - 1]);
            } else {
              *(bf16_t*)(lds + L_QE + ti * RS + 2 * c) = (bf16_t)pk2(qe[0], 0.f);
              *(bf16_t*)(lds + L_KE + ti * RS + 2 * c) = (bf16_t)pk2(ke[0], 0.f);
              *(bf16_t*)(lds + L_QI + ti * RS + 2 * c) = (bf16_t)pk2(qi[0], 0.f);
            }
            *(unsigned*)(lds + L_G + ti * RS + 4 * c) = rg[i];
          }
        }
#pragma unroll
        for (int e = 0; e < KC; ++e) kp[e][m] = pk2(kend[0][e], kend[1][e]);
      }
#pragma unroll
      for (int e = 0; e < KC; ++e) *(u32x4*)(lds + L_KENDT + (KC * c + e) * TS + 16 * w) = kp[e];
      u32x4 v0, v1;
#pragma unroll
      for (int m = 0; m < 4; ++m) {
        v0[m] = (rv[2 * m] & 0xffffu) | (rv[2 * m + 1] << 16);
        v1[m] = (rv[2 * m] >> 16) | (rv[2 * m + 1] & 0xffff0000u);
      }
      *(u32x4*)(lds + L_VT + (2 * c) * TS + 16 * w) = v0;
      *(u32x4*)(lds + L_VT + (2 * c + 1) * TS + 16 * w) = v1;
      if (w == 0) {
#pragma unroll
        for (int e = 0; e < KC; ++e) DEC[KC * c + e] = __expf(tot[e]);
      }
    }
    __syncthreads();
    load_raw(min(ch + 1, nch - 1));
    if (SO) {
      const char* VTr = lds + L_VT + (32 * w + r32) * TS;
#pragma unroll
      for (int kt = 0; kt < DK / 32; ++kt)
#pragma unroll
        for (int g = 0; g < 4; ++g) {
          const f32x4 d = *(const f32x4*)(DEC + 32 * kt + 8 * g + 4 * h);
          S[kt][4 * g] *= d.x; S[kt][4 * g + 1] *= d.y; S[kt][4 * g + 2] *= d.z; S[kt][4 * g + 3] *= d.w;
        }
#pragma unroll
      for (int s = 0; s < 2; ++s) {
        const bf16x8 bq = *(const bf16x8*)(VTr + s * 32 + h * 16);
#pragma unroll
        for (int kt = 0; kt < DK / 32; ++kt) {
          const bf16x8 a = *(const bf16x8*)(lds + L_KENDT + (32 * kt + r32) * TS + s * 32 + h * 16);
          S[kt] = MFMA32(a, bq, S[kt]);
        }
      }
      __syncthreads();
    } else {
      f32x16 o;
      pc_core<DK>(lds, S, o, w, r32, h);
      {
        float ss = 0.f;
#pragma unroll
        for (int r = 0; r < 16; ++r) ss += o[r] * o[r];
        ss += __shfl_xor(ss, 32);
        if (h == 0) SSQ[w * 32 + r32] = ss;
      }
      __syncthreads();
      {
        const float tot2 = (SSQ[r32] + SSQ[32 + r32]) + (SSQ[64 + r32] + SSQ[96 + r32]);
        const float rstd = rsqrtf(tot2 * (1.f / 128.f) + 1e-6f);
        if (t0 + r32 < ntok) {
          bf16_t* orow = O + (size_t)(row0 + t0 + r32) * 1024 + ocol + 32 * w + 4 * h;
#pragma unroll
          for (int g = 0; g < 4; ++g) {
            const u32x2 gp = *(const u32x2*)(lds + L_G + r32 * RS + (32 * w + 8 * g + 4 * h) * 2);
            const f32x4 nw = *(const f32x4*)(nwp + 32 * w + 8 * g + 4 * h);
            const float y0 = o[4 * g] * rstd * nw.x * siluf_(bflo(gp[0]));
            const float y1 = o[4 * g + 1] * rstd * nw.y * siluf_(bfhi(gp[0]));
            const float y2 = o[4 * g + 2] * rstd * nw.z * siluf_(bflo(gp[1]));
            const float y3 = o[4 * g + 3] * rstd * nw.w * siluf_(bfhi(gp[1]));
            u32x2 v; v[0] = pk2(y0, y1); v[1] = pk2(y2, y3);
            *(u32x2*)(orow + 8 * g) = v;
          }
        }
      }
    }
  }
  if (s_out) {
#pragma unroll
    for (int kt = 0; kt < DK / 32; ++kt)
#pragma unroll
      for (int r = 0; r < 16; ++r) s_out[(size_t)(32 * kt + crow(r, h)) * 128 + 32 * w + r32] = S[kt][r];
  }
  if (SO && w == 0) {
#pragma unroll
    for (int e = 0; e < KC; ++e) d_out[KC * c + e] = dsum[e];
  }
  __syncthreads();
}

DI void phase_scan_even_a(const Params& p, char* lds, int bid, int G) {
  float* scr = (float*)(p.ws + OFF_MIX);
  const int half = threadIdx.x >> 8; lds += half * HALF_LDS;
  for (int jb = bid * 2; jb < 448 + 1024; jb += G * 2) {
    const int j = jb + half;
    if (j < 448) {
      const int type = j & 1, head = (j >> 1) & 3, b = (j >> 3) & 7, sc = j >> 6;
      const int row0 = b * SEQP + sc_beg(sc), ntok = sc_end(sc) - sc_beg(sc);
      const size_t slot = ((size_t)b * 4 + head) * 7 + sc;
      if (type == 0) scan_even_job<0, true>(p, lds, head, row0, ntok, nullptr, scr + SCR_HG_U + slot * 16384, scr + SCR_HG_D + slot * 128);
      else scan_even_job<1, true>(p, lds, head, row0, ntok, nullptr, scr + SCR_GL_U + slot * 8192, scr + SCR_GL_D + slot * 64);
    } else {
      const int jj = j - 448, type = jj & 1, head = (jj >> 1) & 3, b = jj >> 3;
      const int row0 = T_PROMPT + 4 * b;
      if (type == 0) scan_even_job<0, false>(p, lds, head, row0, 4, p.in[2] + ((size_t)b * 4 + head) * 16384, p.out + OUT_HGS + ((size_t)b * 4 + head) * 16384, nullptr);
      else scan_even_job<1, false>(p, lds, head, row0, 4, p.in[3] + ((size_t)b * 4 + head) * 8192, p.out + OUT_GLS + ((size_t)b * 4 + head) * 8192, nullptr);
    }
  }
}
DI void phase_scan_even_c(const Params& p, int bid, int G) {
  float* scr = (float*)(p.ws + OFF_MIX);
  for (int i = bid * NTHREADS + threadIdx.x; i < 32 * 4096 + 32 * 2048; i += G * NTHREADS) {
    const bool gl = i >= 32 * 4096;
    const int ii = gl ? i - 32 * 4096 : i;
    const int per = gl ? 2048 : 4096, bh = ii / per, e4 = ii - bh * per, k = e4 >> 5;
    float* U = scr + (gl ? SCR_GL_U + (size_t)bh * 7 * 8192 : SCR_HG_U + (size_t)bh * 7 * 16384) + 4 * e4;
    const float* D = scr + (gl ? SCR_GL_D + (size_t)bh * 7 * 64 : SCR_HG_D + (size_t)bh * 7 * 128) + k;
    const int ustride = gl ? 8192 : 16384, dstride = gl ? 64 : 128;
    f32x4 run = {0.f, 0.f, 0.f, 0.f};
#pragma unroll
    for (int sc = 0; sc < 7; ++sc) {
      const float d = __expf(D[sc * dstride]);
      const f32x4 u = *(const f32x4*)(U + (size_t)sc * ustride);
      run = run * d + u;
      *(f32x4*)(U + (size_t)sc * ustride) = run;
    }
  }
}
DI void phase_scan_even_b(const Params& p, char* lds, int bid, int G) {
  float* scr = (float*)(p.ws + OFF_MIX);
  const int half = threadIdx.x >> 8; lds += half * HALF_LDS;
  for (int jb = bid * 2; jb < 512; jb += G * 2) {
    const int j = jb + half;
    {
      const int type = j & 1, head = (j >> 1) & 3, b = (j >> 3) & 7, sc = j >> 6;
      const int row0 = b * SEQP + sc_beg(sc), ntok = sc_end(sc) - sc_beg(sc);
      const size_t slot = ((size_t)b * 4 + head) * 7 + sc - 1;
      if (type == 0) scan_even_job<0, false>(p, lds, head, row0, ntok, sc ? scr + SCR_HG_U + slot * 16384 : nullptr,
                                             sc == NSC - 1 ? p.out + OUT_HGP + ((size_t)b * 4 + head) * 16384 : nullptr, nullptr);
      else scan_even_job<1, false>(p, lds, head, row0, ntok, sc ? scr + SCR_GL_U + slot * 8192 : nullptr,
                                   sc == NSC - 1 ? p.out + OUT_GLP + ((size_t)b * 4 + head) * 8192 : nullptr, nullptr);
    }
  }
}

constexpr int M_BM = 0, M_CM = 8704, M_XS = 17408, M_Z = 26112, M_BT = 34816, M_VT = 45056, M_VENDT = 55296, M_CUM = 65536, M_DT = 65792, M_SSQ = 66048, M_CW = 66560;

DI void phase_conv(const Params& p, int bid, int G) {
  const bf16_t* P = (const bf16_t*)(p.ws + OFF_P);
  bf16_t* O = (bf16_t*)(p.ws + OFF_O);
  bf16_t* HN = (bf16_t*)(p.ws + OFF_HN);
  const float* __restrict__ cwp = p.in[19];
  const float* __restrict__ cbp = p.in[20];
  const int gt = bid * NTHREADS + threadIdx.x, NPAR = (G * NTHREADS) / 384;
  const int cg = gt % 384, r0 = gt / 384, ch = 8 * cg;
  if (r0 >= NPAR) return;
  float w[4][8], bs[8];
#pragma unroll
  for (int k = 0; k < 4; ++k) {
    const f32x4 a = *(const f32x4*)(cwp + k * 3072 + ch), b_ = *(const f32x4*)(cwp + k * 3072 + ch + 4);
    w[k][0] = a.x; w[k][1] = a.y; w[k][2] = a.z; w[k][3] = a.w; w[k][4] = b_.x; w[k][5] = b_.y; w[k][6] = b_.z; w[k][7] = b_.w;
  }
  {
    const f32x4 a = *(const f32x4*)(cbp + ch), b_ = *(const f32x4*)(cbp + ch + 4);
    bs[0] = a.x; bs[1] = a.y; bs[2] = a.z; bs[3] = a.w; bs[4] = b_.x; bs[5] = b_.y; bs[6] = b_.z; bs[7] = b_.w;
  }
  bf16_t* dbase = ch < 2048 ? O + ch : HN + (ch - 2048);
  const int dld = ch < 2048 ? 2048 : 1024;
  for (int run = r0; run < 8 * 258; run += NPAR) {
    const int b = run / 258, t0 = (run - b * 258) * 8, row0 = b * SEQP + t0;
    u32x4 pre[11];
#pragma unroll
    for (int i = 0; i < 11; ++i) {
      const int r = row0 + i - 3;
      pre[i] = (i >= 3 || t0 > 0) ? *(const u32x4*)(P + (size_t)r * LD_OD + 2048 + ch) : (u32x4){0u, 0u, 0u, 0u};
    }
#pragma unroll
    for (int i = 0; i < 8; ++i) {
      u32x4 o;
#pragma unroll
      for (int q = 0; q < 4; ++q) {
        float a0 = bs[2 * q], a1 = bs[2 * q + 1];
#pragma unroll
        for (int k = 0; k < 4; ++k) { a0 += bflo(pre[i + k][q]) * w[k][2 * q]; a1 += bfhi(pre[i + k][q]) * w[k][2 * q + 1]; }
        o[q] = pk2(siluf_(a0), siluf_(a1));
      }
      *(u32x4*)(dbase + (size_t)(row0 + i) * dld) = o;
    }
  }
  for (int sq = r0; sq < 128; sq += NPAR) {
    const int row0 = T_PROMPT + 4 * sq;
    float pf[7][8];
#pragma unroll
    for (int i = 0; i < 3; ++i) {
      const f32x4 a = *(const f32x4*)(p.in[5] + ((size_t)sq * 3 + i) * 3072 + ch), b_ = *(const f32x4*)(p.in[5] + ((size_t)sq * 3 + i) * 3072 + ch + 4);
      pf[i][0] = a.x; pf[i][1] = a.y; pf[i][2] = a.z; pf[i][3] = a.w; pf[i][4] = b_.x; pf[i][5] = b_.y; pf[i][6] = b_.z; pf[i][7] = b_.w;
    }
#pragma unroll
    for (int i = 0; i < 4; ++i) {
      const u32x4 u = *(const u32x4*)(P + (size_t)(row0 + i) * LD_OD + 2048 + ch);
#pragma unroll
      for (int q = 0; q < 4; ++q) { pf[3 + i][2 * q] = bflo(u[q]); pf[3 + i][2 * q + 1] = bfhi(u[q]); }
    }
#pragma unroll
    for (int i = 0; i < 4; ++i) {
      u32x4 o;
#pragma unroll
      for (int q = 0; q < 4; ++q) {
        float a0 = bs[2 * q], a1 = bs[2 * q + 1];
#pragma unroll
        for (int k = 0; k < 4; ++k) { a0 += pf[i + k][2 * q] * w[k][2 * q]; a1 += pf[i + k][2 * q + 1] * w[k][2 * q + 1]; }
        o[q] = pk2(siluf_(a0), siluf_(a1));
      }
      *(u32x4*)(dbase + (size_t)(row0 + i) * dld) = o;
    }
  }
}

template <bool SO>
DI void scan_odd_job(const Params& p, char* lds, const int b, const int hp, const bool smp, const int tbeg, const int tend, const float* s_in, float* s_out, float* d_out) {
  const int tid = threadIdx.x & (HB - 1), c = tid & 63, w = tid >> 6, r32 = c & 31, h = c >> 5;
  const int grp = hp >> 2, hl = w >> 1, headw = 2 * hp + hl;
  const int row0 = (smp ? T_PROMPT + 4 * b : b * SEQP) + tbeg, ntok = tend - tbeg;
  const bf16_t* P = (const bf16_t*)(p.ws + OFF_P);
  bf16_t* O = (bf16_t*)(p.ws + OFF_O);
  const bf16_t* BC = (const bf16_t*)(p.ws + OFF_HN);
  float* CUM = (float*)(lds + M_CUM);
  float* DTL = (float*)(lds + M_DT);
  float* SSQ = (float*)(lds + M_SSQ);
  const int hd_l = 2 * hp + h;
  const float dtb = p.in[21][hd_l], aneg = -__expf(p.in[22][hd_l]);
  const float dsk = p.in[23][headw];
  f32x16 S[4];
  {
    const float* sin = s_in + ((size_t)hl * 64 + 32 * (w & 1) + r32) * 128;
#pragma unroll
    for (int kt = 0; kt < 4; ++kt)
#pragma unroll
      for (int g = 0; g < 4; ++g) {
        f32x4 v = {0.f, 0.f, 0.f, 0.f};
        if (!SO && s_in) v = *(const f32x4*)(sin + 32 * kt + 8 * g + 4 * h);
        S[kt][4 * g] = v.x; S[kt][4 * g + 1] = v.y; S[kt][4 * g + 2] = v.z; S[kt][4 * g + 3] = v.w;
      }
  }
  float dsum = 0.f;
  unsigned rx[8], rb[8], rc[8], rz[8]; float rdt;
  auto load_raw = [&](int ch) {
#pragma unroll
    for (int i = 0; i < 8; ++i) {
      const int t = min(ch * 32 + 8 * w + i, ntok - 1);
      rx[i] = *(const unsigned*)(O + (size_t)(row0 + t) * 2048 + hp * 128 + 2 * c);
      rb[i] = *(const unsigned*)(BC + (size_t)(row0 + t) * 1024 + grp * 128 + 2 * c);
      if (!SO) {
        rc[i] = *(const unsigned*)(BC + (size_t)(row0 + t) * 1024 + 512 + grp * 128 + 2 * c);
        rz[i] = *(const unsigned*)(P + (size_t)(row0 + t) * LD_OD + hp * 128 + 2 * c);
      }
    }
    {
      const int t = min(ch * 32 + r32, ntok - 1);
      rdt = bflo((unsigned)P[(size_t)(row0 + t) * LD_OD + 5120 + hd_l]);
    }
  };
  const int nch = __builtin_amdgcn_readfirstlane((ntok + 31) >> 5);
  load_raw(0);
  for (int ch = 0; ch < nch; ++ch) {
    const int t0 = ch * 32;
    {
      const float xdt = rdt + dtb;
      float dt = xdt > 20.f ? xdt : __logf(1.f + __expf(xdt));
      dt = (t0 + r32 < ntok) ? dt : 0.f;
      float cs = dt * aneg;
#pragma unroll
      for (int d = 1; d < 32; d <<= 1) { const float o_ = __shfl_up(cs, d, 32); if (r32 >= d) cs += o_; }
      if (w == 0) { CUM[h * 32 + r32] = cs; DTL[h * 32 + r32] = dt; }
    }
    {
#pragma unroll
      for (int i = 0; i < 8; ++i) {
        if (!SO) {
          *(unsigned*)(lds + M_BM + (8 * w + i) * RS + 4 * c) = rb[i];
          *(unsigned*)(lds + M_CM + (8 * w + i) * RS + 4 * c) = rc[i];
          *(unsigned*)(lds + M_XS + (8 * w + i) * RS + 4 * c) = rx[i];
          *(unsigned*)(lds + M_Z + (8 * w + i) * RS + 4 * c) = rz[i];
        }
      }
      u32x4 b0, b1;
#pragma unroll
      for (int m = 0; m < 4; ++m) {
        b0[m] = (rb[2 * m] & 0xffffu) | (rb[2 * m + 1] << 16);
        b1[m] = (rb[2 * m] >> 16) | (rb[2 * m + 1] & 0xffff0000u);
      }
      *(u32x4*)(lds + M_BT + (2 * c) * TS + 16 * w) = b0;
      *(u32x4*)(lds + M_BT + (2 * c + 1) * TS + 16 * w) = b1;
    }
    __syncthreads();
    {
      const int hx = c >> 5;
      const float last = CUM[hx * 32 + 31];
      float vt[8][2], ve[8][2];
#pragma unroll
      for (int i = 0; i < 8; ++i) {
        const int ti = 8 * w + i;
        const float dt = DTL[hx * 32 + ti], cm = CUM[hx * 32 + ti];
        const float ee = __expf(last - cm);
        vt[i][0] = bflo(rx[i]) * dt; vt[i][1] = bfhi(rx[i]) * dt;
        ve[i][0] = vt[i][0] * ee; ve[i][1] = vt[i][1] * ee;
      }
#pragma unroll
      for (int e = 0; e < 2; ++e) {
        u32x4 pv, pe;
#pragma unroll
        for (int m = 0; m < 4; ++m) { pv[m] = pk2(vt[2 * m][e], vt[2 * m + 1][e]); pe[m] = pk2(ve[2 * m][e], ve[2 * m + 1][e]); }
        if (!SO) *(u32x4*)(lds + M_VT + (2 * c + e) * TS + 16 * w) = pv;
        *(u32x4*)(lds + M_VENDT + (2 * c + e) * TS + 16 * w) = pe;
      }
    }
    __syncthreads();
    load_raw(min(ch + 1, nch - 1));
    f32x16 o;
    const float lastw = CUM[hl * 32 + 31];
    dsum += lastw;
    if (!SO) {
      const char* BMr = lds + M_BM + r32 * RS;
      const char* CMr = lds + M_CM + r32 * RS;
      f32x16 sc; zero16(sc);
#pragma unroll
      for (int s = 0; s < 8; ++s) {
        const bf16x8 a = *(const bf16x8*)(BMr + s * 32 + h * 16);
        const bf16x8 bq = *(const bf16x8*)(CMr + s * 32 + h * 16);
        sc = MFMA32(a, bq, sc);
      }
      const float ci = CUM[hl * 32 + r32];
#pragma unroll
      for (int g = 0; g < 4; ++g) {
        const f32x4 cj = *(const f32x4*)(CUM + hl * 32 + 8 * g + 4 * h);
#pragma unroll
        for (int e = 0; e < 4; ++e) {
          const int j = 8 * g + 4 * h + e;
          const float cje = e == 0 ? cj.x : (e == 1 ? cj.y : (e == 2 ? cj.z : cj.w));
          sc[4 * g + e] = (j <= r32) ? sc[4 * g + e] * __expf(ci - cje) : 0.f;
        }
      }
      const bf16x8 scb0 = pack8<0>(sc), scb1 = pack8<1>(sc);
      zero16(o);
#pragma unroll
      for (int kt = 0; kt < 4; ++kt) {
        {
          const bf16x8 a = pack8<0>(S[kt]);
          const s16x4 lo = *(const s16x4*)(CMr + (32 * kt + 4 * h) * 2), hi = *(const s16x4*)(CMr + (32 * kt + 8 + 4 * h) * 2);
          o = MFMA32(a, cat8(lo, hi), o);
        }
        {
          const bf16x8 a = pack8<1>(S[kt]);
          const s16x4 lo = *(const s16x4*)(CMr + (32 * kt + 16 + 4 * h) * 2), hi = *(const s16x4*)(CMr + (32 * kt + 24 + 4 * h) * 2);
          o = MFMA32(a, cat8(lo, hi), o);
        }
      }
      const float ei = __expf(ci);
#pragma unroll
      for (int r = 0; r < 16; ++r) o[r] *= ei;
      const char* VTr = lds + M_VT + (32 * w + r32) * TS;
      {
        const s16x4 lo = *(const s16x4*)(VTr + (4 * h) * 2), hi = *(const s16x4*)(VTr + (8 + 4 * h) * 2);
        o = MFMA32(cat8(lo, hi), scb0, o);
      }
      {
        const s16x4 lo = *(const s16x4*)(VTr + (16 + 4 * h) * 2), hi = *(const s16x4*)(VTr + (24 + 4 * h) * 2);
        o = MFMA32(cat8(lo, hi), scb1, o);
      }
    }
    {
      const float el = __expf(lastw);
#pragma unroll
      for (int kt = 0; kt < 4; ++kt)
#pragma unroll
        for (int r = 0; r < 16; ++r) S[kt][r] *= el;
      const char* VEr = lds + M_VENDT + (32 * w + r32) * TS;
#pragma unroll
      for (int s = 0; s < 2; ++s) {
        const bf16x8 bq = *(const bf16x8*)(VEr + s * 32 + h * 16);
#pragma unroll
        for (int kt = 0; kt < 4; ++kt) {
          const bf16x8 a = *(const bf16x8*)(lds + M_BT + (32 * kt + r32) * TS + s * 32 + h * 16);
          S[kt] = MFMA32(a, bq, S[kt]);
        }
      }
    }
    if (!SO) {
      float y[16]; float ss = 0.f;
#pragma unroll
      for (int g = 0; g < 4; ++g) {
        const u32x2 xp = *(const u32x2*)(lds + M_XS + r32 * RS + (32 * w + 8 * g + 4 * h) * 2);
        const u32x2 zp = *(const u32x2*)(lds + M_Z + r32 * RS + (32 * w + 8 * g + 4 * h) * 2);
        y[4 * g] = (o[4 * g] + dsk * bflo(xp[0])) * siluf_(bflo(zp[0]));
        y[4 * g + 1] = (o[4 * g + 1] + dsk * bfhi(xp[0])) * siluf_(bfhi(zp[0]));
        y[4 * g + 2] = (o[4 * g + 2] + dsk * bflo(xp[1])) * siluf_(bflo(zp[1]));
        y[4 * g + 3] = (o[4 * g + 3] + dsk * bfhi(xp[1])) * siluf_(bfhi(zp[1]));
      }
#pragma unroll
      for (int r = 0; r < 16; ++r) ss += y[r] * y[r];
      ss += __shfl_xor(ss, 32);
      if (h == 0) SSQ[w * 32 + r32] = ss;
      if (t0 + r32 < ntok) {
        bf16_t* orow = O + (size_t)(row0 + t0 + r32) * 2048 + hp * 128 + 32 * w + 4 * h;
#pragma unroll
        for (int g = 0; g < 4; ++g) { u32x2 v; v[0] = pk2(y[4 * g], y[4 * g + 1]); v[1] = pk2(y[4 * g + 2], y[4 * g + 3]); *(u32x2*)(orow + 8 * g) = v; }
      }
    }
    __syncthreads();
    if (!SO && tid < 32 && t0 + tid < ntok) {
      float* q = (float*)(p.ws + OFF_SSQ);
      q[(size_t)(row0 + t0 + tid) * 16 + hp] = (SSQ[tid] + SSQ[32 + tid]) + (SSQ[64 + tid] + SSQ[96 + tid]);
    }
  }
  if (s_out) {
    float* so = s_out + ((size_t)hl * 64 + 32 * (w & 1) + r32) * 128;
#pragma unroll
    for (int kt = 0; kt < 4; ++kt)
#pragma unroll
      for (int g = 0; g < 4; ++g) {
        f32x4 v = {S[kt][4 * g], S[kt][4 * g + 1], S[kt][4 * g + 2], S[kt][4 * g + 3]};
        *(f32x4*)(so + 32 * kt + 8 * g + 4 * h) = v;
      }
  }
  if (SO && (w & 1) == 0 && c == 0) d_out[hl * 7] = dsum;
  __syncthreads();
}

DI void phase_scan_odd_a(const Params& p, char* lds, int bid, int G) {
  float* scr = (float*)(p.ws + OFF_MIX);
  const int half = threadIdx.x >> 8; lds += half * HALF_LDS;
  for (int jb = bid * 2; jb < 896 + 2048; jb += G * 2) {
    const int j = jb + half;
    if (j >= 896) {
      const int jj = j - 896, hp = jj & 15, b = jj >> 4;
      scan_odd_job<false>(p, lds, b, hp, true, 0, 4, p.in[4] + ((size_t)b * 32 + 2 * hp) * 8192, p.out + OUT_SSS + ((size_t)b * 32 + 2 * hp) * 8192, nullptr);
      continue;
    }
    const int hp = j & 15, b = (j >> 4) & 7, sc = j >> 7;
    float* U = scr + SCR_SS_U + ((((size_t)b * 16 + hp) * 7 + sc) * 2) * 8192;
    float* D = scr + SCR_SS_D + ((size_t)b * 32 + 2 * hp) * 7 + sc;
    scan_odd_job<true>(p, lds, b, hp, false, sc_beg(sc), sc_end(sc), nullptr, U, D);
  }
}
DI void phase_scan_odd_c(const Params& p, int bid, int G) {
  float* scr = (float*)(p.ws + OFF_MIX);
  for (int i = bid * NTHREADS + threadIdx.x; i < 128 * 2 * 2048; i += G * NTHREADS) {
    const int e4 = i & 2047, hd = (i >> 11) & 1, bhp = i >> 12;
    float* U = scr + SCR_SS_U + ((size_t)bhp * 7 * 2 + hd) * 8192 + 4 * e4;
    const float* D = scr + SCR_SS_D + ((size_t)(bhp >> 4) * 32 + 2 * (bhp & 15) + hd) * 7;
    f32x4 run = {0.f, 0.f, 0.f, 0.f};
#pragma unroll
    for (int sc = 0; sc < 7; ++sc) {
      const float d = __expf(D[sc]);
      const f32x4 u = *(const f32x4*)(U + (size_t)sc * 16384);
      run = run * d + u;
      *(f32x4*)(U + (size_t)sc * 16384) = run;
    }
  }
}
DI void phase_scan_odd_b(const Params& p, char* lds, int bid, int G) {
  float* scr = (float*)(p.ws + OFF_MIX);
  const int half = threadIdx.x >> 8; lds += half * HALF_LDS;
  for (int jb = bid * 2; jb < 1024; jb += G * 2) {
    const int j = jb + half;
    {
      const int hp = j & 15, b = (j >> 4) & 7, sc = j >> 7;
      const float* s_in = sc ? scr + SCR_SS_U + ((((size_t)b * 16 + hp) * 7 + sc - 1) * 2) * 8192 : nullptr;
      float* s_out = sc == NSC - 1 ? p.out + OUT_SSP + ((size_t)b * 32 + 2 * hp) * 8192 : nullptr;
      scan_odd_job<false>(p, lds, b, hp, false, sc_beg(sc), sc_end(sc), s_in, s_out, nullptr);
    }
  }
  const bf16_t* P = (const bf16_t*)(p.ws + OFF_P);
  for (int i = bid * NTHREADS + threadIdx.x; i < 136 * 3 * 3072; i += G * NTHREADS) {
    const int ch = i % 3072, r = i / 3072, j = r % 3, b = r / 3;
    if (b < 8) p.out[OUT_CVP + ((size_t)b * 3 + j) * 3072 + ch] = bflo((unsigned)P[(size_t)(b * SEQP + 2061 + j) * LD_OD + 2048 + ch]);
    else { const int bs = b - 8; p.out[OUT_CVS + ((size_t)bs * 3 + j) * 3072 + ch] = bflo((unsigned)P[(size_t)(T_PROMPT + 4 * bs + 1 + j) * LD_OD + 2048 + ch]); }
  }
}

#define XB_TMO      128
#define XB_XCNT(j)  (256  + 64 * (j))
#define XB_XSUB(j)  (1280 + 64 * (j))
#define XB_XGEN(j)  (2304 + 64 * (j))
#define XB_TOP      3328
#define XB_TOPGEN   3392
#define XCD_BAR_WORDS 3456
#define XB_SPIN_CAP (1u << 20)
#define LAS __attribute__((address_space(3)))
DI unsigned xb_ld(unsigned* p) { return __hip_atomic_load(p, __ATOMIC_RELAXED, __HIP_MEMORY_SCOPE_AGENT); }
DI unsigned xb_add(unsigned* p, unsigned v) { return __hip_atomic_fetch_add(p, v, __ATOMIC_RELAXED, __HIP_MEMORY_SCOPE_AGENT); }
DI unsigned xb_xcc_id() { return (unsigned)__builtin_amdgcn_s_getreg((3 << 11) | 20) & 0xFu; }
#define XB_SPIN(cond, bar) do { unsigned _sp = 0; while (cond) { __builtin_amdgcn_s_sleep(1); \
    if ((++_sp & 255u) == 0u) { if (xb_ld(&(bar)[XB_TMO])) break; if (_sp > XB_SPIN_CAP) { atomicAdd(&(bar)[XB_TMO], 1u); break; } } } } while (0)
struct XcdBarrier { unsigned* bar; unsigned x; volatile LAS unsigned* st; };
DI XcdBarrier xcd_barrier_post(unsigned* bar, volatile LAS unsigned* st) {
  XcdBarrier b; b.bar = bar; b.x = xb_xcc_id(); b.st = st;
  if (threadIdx.x == 0) (void)xb_add(&bar[XB_XCNT(b.x)], 1u);
  return b;
}
DI void xcd_barrier_complete(unsigned* bar, unsigned x, unsigned& nloc, unsigned& nx) {
  const unsigned G = gridDim.x * gridDim.y * gridDim.z;
  unsigned sum, cnt, mine, sp = 0u;
  for (;;) {
    sum = 0u; cnt = 0u; mine = 0u;
#pragma unroll
    for (unsigned j = 0; j < 16; ++j) { const unsigned c = xb_ld(&bar[XB_XCNT(j)]); sum += c; cnt += (c > 0u) ? 1u : 0u; mine = (j == x) ? c : mine; }
    if (sum == G) break;
    __builtin_amdgcn_s_sleep(1);
    if ((++sp & 255u) == 0u) { if (xb_ld(&bar[XB_TMO])) break; if (sp > XB_SPIN_CAP) { atomicAdd(&bar[XB_TMO], 1u); break; } }
  }
  nloc = mine > 0u ? mine : 1u; nx = cnt > 0u ? cnt : 1u;
}
DI void xcd_barrier(const XcdBarrier& b) {
  asm volatile("s_waitcnt vmcnt(0)" ::: "memory");
  __syncthreads();
  if (threadIdx.x == 0) {
    unsigned* bar = b.bar;
    __builtin_amdgcn_s_waitcnt(0);
    unsigned nloc = b.st[0], nx = b.st[1];
    if (nloc == 0u) { xcd_barrier_complete(bar, b.x, nloc, nx); b.st[0] = nloc; b.st[1] = nx; }
    const unsigned old = xb_add(&bar[XB_XSUB(b.x)], 1u);
    const unsigned gen = old / nloc;
    if (old + 1u == (gen + 1u) * nloc) {
      __builtin_amdgcn_fence(__ATOMIC_RELEASE, "agent");
      asm volatile("s_waitcnt vmcnt(0)" ::: "memory");
      const unsigned og = xb_add(&bar[XB_TOP], 1u);
      const unsigned tg = og / nx;
      if (og + 1u == (tg + 1u) * nx) xb_add(&bar[XB_TOPGEN], 1u);
      else XB_SPIN(xb_ld(&bar[XB_TOPGEN]) == tg, bar);
      __builtin_amdgcn_fence(__ATOMIC_ACQUIRE, "agent");
      xb_add(&bar[XB_XGEN(b.x)], 1u);
      asm volatile("s_waitcnt vmcnt(0)" ::: "memory");
    } else {
      XB_SPIN(xb_ld(&bar[XB_XGEN(b.x)]) == gen, bar);
      __builtin_amdgcn_fence(__ATOMIC_ACQUIRE, "agent");
      asm volatile("s_waitcnt vmcnt(0)" ::: "memory");
    }
  }
  __syncthreads();
}

constexpr int N_PHASES = 21;
#ifndef ONLY_PHASE
#define ONLY_PHASE -1
#endif
#define PHASE(k, body) do { if ((ONLY_PHASE < 0 || ONLY_PHASE == (k)) && ph_lo <= (k) && (k) <= ph_hi) { body; } if (ph_lo <= (k) && (k) < ph_hi) xcd_barrier(xb); } while (0)

__global__ void __launch_bounds__(NTHREADS, 2) fwd_mega(Params p, int ph_lo, int ph_hi) {
  extern __shared__ __attribute__((aligned(16))) char lds[];
  cg::grid_group grid = cg::this_grid();
  const int G = gridDim.x, bid = blockIdx.x;
  if (ph_lo > 1000) grid.sync();
  volatile LAS unsigned* xst = (volatile LAS unsigned*)(lds + 2 * HALF_LDS);
  if (threadIdx.x == 0) { xst[0] = 0u; xst[1] = 0u; }
  __syncthreads();
  XcdBarrier xb = xcd_barrier_post((unsigned*)(p.ws + OFF_BAR), xst);
  bf16_t* HN = (bf16_t*)(p.ws + OFF_HN);
  bf16_t* Pb = (bf16_t*)(p.ws + OFF_P);
  bf16_t* Ob = (bf16_t*)(p.ws + OFF_O);
  float* MIX = (float*)(p.ws + OFF_MIX);
  PHASE(0, phase_prep(p, lds, bid, G));
  PHASE(1, gemm_run(lds, HN, (const bf16_t*)(p.ws + OFF_WT_EVIN), LD_EV, 1024, EpiStoreBf16{Pb, LD_EV}, bid, G));
  PHASE(2, phase_scan_even_a(p, lds, bid, G));
  PHASE(3, phase_scan_even_c(p, bid, G));
  PHASE(4, phase_scan_even_b(p, lds, bid, G));
  PHASE(5, gemm_n1024<false>(lds, Ob, (const bf16_t*)(p.ws + OFF_WT_EVOUT), 1024, EpiResNorm<false>{(bf16_t*)(p.ws + OFF_X), (bf16_t*)(p.ws + OFF_HN), p.in[9], p.in[10], nullptr, (float*)(p.ws + OFF_XB) + 0 * (SZ_XB_SET / 4), (unsigned*)(p.ws + OFF_CNT) + 0 * (SZ_CNT_SET / 4), (unsigned*)(p.ws + OFF_BAR) + 64}, (float*)Pb, bid, G));
  PHASE(6, phase_rowwise(p, p.in[9], p.in[10], false, (const float*)Pb, 4, M_MAIN, bid, G));
  PHASE(7, gemm_run(lds, HN, (const bf16_t*)(p.ws + OFF_WT_GU), 5632, 1024, EpiSwiglu{Pb, 2816}, bid, G));
  PHASE(8, gemm_n1024<false>(lds, Pb, (const bf16_t*)(p.ws + OFF_WT_DN), 2816, EpiResNorm<false>{(bf16_t*)(p.ws + OFF_X), (bf16_t*)(p.ws + OFF_HN), p.in[11], p.in[8] + 1024, nullptr, (float*)(p.ws + OFF_XB) + 2 * (SZ_XB_SET / 4), (unsigned*)(p.ws + OFF_CNT) + 2 * (SZ_CNT_SET / 4), (unsigned*)(p.ws + OFF_BAR) + 64}, (float*)Ob, bid, G));
  PHASE(9, phase_rowwise(p, p.in[11], p.in[8] + 1024, false, (const float*)Ob, 11, M_MAIN, bid, G));
  PHASE(10, gemm_run(lds, HN, (const bf16_t*)(p.ws + OFF_WT_ODIN), LD_OD, 1024, EpiStoreBf16{Pb, LD_OD}, bid, G));
  PHASE(11, phase_conv(p, bid, G));
  PHASE(12, phase_scan_odd_a(p, lds, bid, G));
  PHASE(13, phase_scan_odd_c(p, bid, G));
  PHASE(14, phase_scan_odd_b(p, lds, bid, G));
  PHASE(15, phase_groupnorm(p, bid, G));
  PHASE(16, gemm_n1024<false>(lds, Ob, (const bf16_t*)(p.ws + OFF_WT_ODOUT), 2048, EpiResNorm<false>{(bf16_t*)(p.ws + OFF_X), (bf16_t*)(p.ws + OFF_HN), p.in[9] + 1024, p.in[10] + 1024, nullptr, (float*)(p.ws + OFF_XB) + 4 * (SZ_XB_SET / 4), (unsigned*)(p.ws + OFF_CNT) + 4 * (SZ_CNT_SET / 4), (unsigned*)(p.ws + OFF_BAR) + 64}, (float*)Pb, bid, G));
  PHASE(17, phase_rowwise(p, p.in[9] + 1024, p.in[10] + 1024, false, (const float*)Pb, 8, M_MAIN, bid, G));
  PHASE(18, gemm_run(lds, HN, (const bf16_t*)(p.ws + OFF_WT_GU + SZ_WT_GU1), 5632, 1024, EpiSwiglu{Pb, 2816}, bid, G));
  PHASE(19, gemm_n1024_plain(lds, Pb, (const bf16_t*)(p.ws + OFF_WT_DN + SZ_WT_DN1), 2816, MIX, (float*)Ob, bid, G));
  PHASE(20, phase_rowwise(p, p.in[11] + 1024, nullptr, true, (const float*)Ob, 11, 0, bid, G));
}

extern "C" void kernel_launch(void* const* d_in, const int* in_sizes, int n_in, void* d_out, int out_size, void* d_ws, size_t ws_size, hipStream_t stream) {
  static int grid_blocks = 0;
  if (!grid_blocks) {
    int dev = 0, cus = 0, per_cu = 0;
    hipGetDevice(&dev);
    hipDeviceGetAttribute(&cus, hipDeviceAttributeMultiprocessorCount, dev);
    hipFuncSetAttribute((const void*)fwd_mega, hipFuncAttributeMaxDynamicSharedMemorySize, LDS_BYTES);
    hipOccupancyMaxActiveBlocksPerMultiprocessor(&per_cu, (const void*)fwd_mega, NTHREADS, LDS_BYTES);
    if (per_cu < 1) per_cu = 1;
    if (per_cu > 1) per_cu = 1;
    grid_blocks = cus * per_cu;
    if (ws_size < WS_END) fprintf(stderr, "kernel_launch: workspace too small: %zu < %zu\n", ws_size, (size_t)WS_END);
  }
  Params p{};
  for (int i = 0; i < 29; ++i) p.in[i] = (const float*)d_in[i];
  p.out = (float*)d_out;
  p.ws = (char*)d_ws;
  (void)hipMemsetAsync((char*)d_ws + OFF_BAR, 0, 16384 + 8 * SZ_CNT_SET, stream);
#if ONE_LAUNCH
  int lo = 0, hi = N_PHASES - 1;
  void* args[] = {&p, &lo, &hi};
  hipError_t e = hipLaunchCooperativeKernel((const void*)fwd_mega, dim3(grid_blocks), dim3(NTHREADS), args, LDS_BYTES, stream);
  if (e != hipSuccess) fprintf(stderr, "cooperative launch failed: %s (grid %d)\n", hipGetErrorString(e), grid_blocks);
#else
  for (int ph = 0; ph < N_PHASES; ++ph) {
    int lo = ph, hi = ph;
    void* args[] = {&p, &lo, &hi};
    hipError_t e = hipLaunchCooperativeKernel((const void*)fwd_mega, dim3(grid_blocks), dim3(NTHREADS), args, LDS_BYTES, stream);
    if (e != hipSuccess) fprintf(stderr, "launch failed: %s (grid %d)\n", hipGetErrorString(e), grid_blocks);
  }
#endif
}
```

```cpp
#include <hip/hip_runtime.h>
#include <hip/hip_cooperative_groups.h>
#include <cstdio>
#include <cstdint>
namespace cg = cooperative_groups;

#ifndef ONE_LAUNCH
#define ONE_LAUNCH 1
#endif

#define DI __device__ __forceinline__
typedef unsigned short bf16_t;
typedef short bf16x8 __attribute__((ext_vector_type(8)));
typedef short s16x4 __attribute__((ext_vector_type(4)));
typedef float f32x16 __attribute__((ext_vector_type(16)));
typedef float f32x4 __attribute__((ext_vector_type(4)));
typedef float f32x2 __attribute__((ext_vector_type(2)));
typedef unsigned u32x4 __attribute__((ext_vector_type(4)));
typedef unsigned u32x2 __attribute__((ext_vector_type(2)));
typedef __bf16 bf16v2 __attribute__((ext_vector_type(2)));
#define MFMA32(a, b, c) __builtin_amdgcn_mfma_f32_32x32x16_bf16((a), (b), (c), 0, 0, 0)

constexpr int T_ALL = 17024, T_PAD = 17152, T_PROMPT = 16512, SEQP = 2064, NTHREADS = 512, HB = 256  ;
constexpr int LD_EV = 3840, LD_OD = 5376;
constexpr int HALF_LDS = 75776;
constexpr int LDS_BYTES = 2 * HALF_LDS + 32;
constexpr int M_MAIN = 16384;

constexpr size_t OFF_WT_EVIN = 0;
constexpr size_t OFF_WT_EVOUT = OFF_WT_EVIN + (size_t)3840 * 1024 * 2;
constexpr size_t OFF_WT_GU = OFF_WT_EVOUT + (size_t)1024 * 1024 * 2;
constexpr size_t SZ_WT_GU1 = (size_t)5632 * 1024 * 2;
constexpr size_t OFF_WT_DN = OFF_WT_GU + 2 * SZ_WT_GU1;
constexpr size_t SZ_WT_DN1 = (size_t)1024 * 2816 * 2;
constexpr size_t OFF_WT_ODIN = OFF_WT_DN + 2 * SZ_WT_DN1;
constexpr size_t OFF_WT_ODOUT = OFF_WT_ODIN + (size_t)5376 * 1024 * 2;
constexpr size_t OFF_X = OFF_WT_ODOUT + (size_t)1024 * 2048 * 2;
constexpr size_t OFF_HN = OFF_X + (size_t)T_PAD * 1024 * 4;
constexpr size_t OFF_P = OFF_HN + (size_t)T_PAD * 1024 * 2;
constexpr size_t OFF_O = OFF_P + (size_t)T_PAD * 5376 * 2;
constexpr size_t OFF_MIX = OFF_O + (size_t)T_PAD * 2048 * 2;
constexpr size_t OFF_SSQ = OFF_MIX + (size_t)T_PAD * 1024 * 4;
constexpr size_t OFF_BAR = OFF_SSQ + (size_t)T_PAD * 16 * 4;
constexpr size_t OFF_CNT = OFF_BAR + 16384;
constexpr size_t SZ_CNT_SET = 64 * 256;
constexpr size_t OFF_XB = OFF_CNT + 8 * SZ_CNT_SET;
constexpr size_t SZ_XB_SET = (size_t)64 * 256 * 4 * 4;
constexpr size_t WS_END = OFF_XB + 8 * SZ_XB_SET;

constexpr size_t OUT_YP = 0;
constexpr size_t OUT_YS = 16777216;
constexpr size_t OUT_HGP = OUT_YS + 524288;
constexpr size_t OUT_GLP = OUT_HGP + 524288;
constexpr size_t OUT_SSP = OUT_GLP + 262144;
constexpr size_t OUT_CVP = OUT_SSP + 2097152;
constexpr size_t OUT_HGS = OUT_CVP + 73728;
constexpr size_t OUT_GLS = OUT_HGS + 8388608;
constexpr size_t OUT_SSS = OUT_GLS + 4194304;
constexpr size_t OUT_CVS = OUT_SSS + 33554432;

struct Params { const float* in[29]; float* out; char* ws; };

DI unsigned pk2(float lo, float hi) { f32x2 v = {lo, hi}; bf16v2 b = __builtin_convertvector(v, bf16v2); return __builtin_bit_cast(unsigned, b); }
DI float bflo(unsigned u) { return __uint_as_float(u << 16); }
DI float bfhi(unsigned u) { return __uint_as_float(u & 0xffff0000u); }
DI f32x4 ld_bf4(const bf16_t* p) { const u32x2 u = *(const u32x2*)p; return (f32x4){bflo(u[0]), bfhi(u[0]), bflo(u[1]), bfhi(u[1])}; }
DI void st_bf4(bf16_t* p, f32x4 v) { u32x2 u; u[0] = pk2(v.x, v.y); u[1] = pk2(v.z, v.w); *(u32x2*)p = u; }
DI float sigmoidf_(float x) { return __builtin_amdgcn_rcpf(1.f + __expf(-x)); }
DI float siluf_(float x) { return x * sigmoidf_(x); }
DI int crow(int r, int h) { return (r & 3) + 8 * (r >> 2) + 4 * h; }
DI bf16x8 cat8(s16x4 lo, s16x4 hi) { return __builtin_shufflevector(lo, hi, 0, 1, 2, 3, 4, 5, 6, 7); }
template <int S> DI bf16x8 pack8(const f32x16& x) {
  u32x4 p;
  p[0] = pk2(x[8 * S + 0], x[8 * S + 1]); p[1] = pk2(x[8 * S + 2], x[8 * S + 3]);
  p[2] = pk2(x[8 * S + 4], x[8 * S + 5]); p[3] = pk2(x[8 * S + 6], x[8 * S + 7]);
  return __builtin_bit_cast(bf16x8, p);
}
DI float wave_sum(float v) {
#pragma unroll
  for (int o = 1; o < 64; o <<= 1) v += __shfl_xor(v, o);
  return v;
}
DI void zero16(f32x16& a) {
#pragma unroll
  for (int i = 0; i < 16; ++i) a[i] = 0.f;
}

DI void transpose_tile(const float* __restrict__ W, int K, int N, bf16_t* Wt, int mode, int kt, int nt, float* tile, bool active) {
  const int tid = threadIdx.x & (HB - 1), k0 = kt * 64, n0 = nt * 64;
  if (active) {
    const int c = tid & 63, r0 = tid >> 6, n = n0 + c;
#pragma unroll
    for (int i = 0; i < 16; ++i) { const int k = r0 + 4 * i; tile[k * 65 + c] = (n < N) ? W[(size_t)(k0 + k) * N + n] : 0.f; }
  }
  __syncthreads();
  if (active) {
    const int nl = tid >> 2, kc = (tid & 3) * 16, n = n0 + nl;
    int drow = n;
    if (mode == 1) drow = (n >> 7) * 256 + (n & 127);
    if (mode == 2) drow = (n >> 7) * 256 + 128 + (n & 127);
    u32x4 o0, o1;
#pragma unroll
    for (int j = 0; j < 4; ++j) {
      o0[j] = pk2(tile[(kc + 2 * j) * 65 + nl], tile[(kc + 2 * j + 1) * 65 + nl]);
      o1[j] = pk2(tile[(kc + 8 + 2 * j) * 65 + nl], tile[(kc + 8 + 2 * j + 1) * 65 + nl]);
    }
    u32x4* d = (u32x4*)(Wt + (size_t)drow * K + k0 + kc);
    d[0] = o0; d[1] = o1;
  }
  __syncthreads();
}

DI void rms_row_to_bf16(const f32x4 (&v)[4], const float* __restrict__ wn, bf16_t* dst, int lane) {
  float s = 0.f;
#pragma unroll
  for (int j = 0; j < 4; ++j) s += v[j].x * v[j].x + v[j].y * v[j].y + v[j].z * v[j].z + v[j].w * v[j].w;
  const float rstd = rsqrtf(wave_sum(s) * (1.f / 1024.f) + 1e-6f);
#pragma unroll
  for (int j = 0; j < 4; ++j) {
    const f32x4 g = *(const f32x4*)(wn + 256 * j + 4 * lane);
    u32x2 o; o[0] = pk2(v[j].x * rstd * g.x, v[j].y * rstd * g.y); o[1] = pk2(v[j].z * rstd * g.z, v[j].w * rstd * g.w);
    *(u32x2*)(dst + 256 * j + 4 * lane) = o;
  }
}

DI void phase_prep(const Params& p, char* lds, int bid, int G) {
  const int half = threadIdx.x >> 8;
  float* tile = (float*)(lds + half * HALF_LDS);
  constexpr int NT_TILES = 960 + 256 + 1408 + 1408 + 1408 + 1344 + 512;
  for (int tb = bid * 2; tb < NT_TILES; tb += G * 2) {
    const int t = tb + half;
    const bool active = t < NT_TILES;
    const float* W = p.in[12]; int K = 1024, N = 3600, nnt = 60, mode = 0; bf16_t* dst = (bf16_t*)(p.ws + OFF_WT_EVIN); int r = active ? t : 0;
    if (r < 960) { }
    else if ((r -= 960) < 256) { W = p.in[17]; K = 1024; N = 1024; nnt = 16; dst = (bf16_t*)(p.ws + OFF_WT_EVOUT); }
    else if ((r -= 256) < 1408) { const int l = r / 704; r -= l * 704; W = p.in[26] + (size_t)l * 1024 * 2816; K = 1024; N = 2816; nnt = 44; mode = 1; dst = (bf16_t*)(p.ws + OFF_WT_GU + l * SZ_WT_GU1); }
    else if ((r -= 1408) < 1408) { const int l = r / 704; r -= l * 704; W = p.in[27] + (size_t)l * 1024 * 2816; K = 1024; N = 2816; nnt = 44; mode = 2; dst = (bf16_t*)(p.ws + OFF_WT_GU + l * SZ_WT_GU1); }
    else if ((r -= 1408) < 1408) { const int l = r / 704; r -= l * 704; W = p.in[28] + (size_t)l * 2816 * 1024; K = 2816; N = 1024; nnt = 16; dst = (bf16_t*)(p.ws + OFF_WT_DN + l * SZ_WT_DN1); }
    else if ((r -= 1408) < 1344) { W = p.in[18]; K = 1024; N = 5152; nnt = 84; dst = (bf16_t*)(p.ws + OFF_WT_ODIN); }
    else { r -= 1344; W = p.in[25]; K = 2048; N = 1024; nnt = 16; dst = (bf16_t*)(p.ws + OFF_WT_ODOUT); }
    const int kt = r / nnt, nt = r - kt * nnt;
    transpose_tile(W, K, N, dst, mode, kt, nt, tile, active);
  }
  const int lane = threadIdx.x & 63, w = threadIdx.x >> 6;
  bf16_t* X = (bf16_t*)(p.ws + OFF_X);
  bf16_t* HN = (bf16_t*)(p.ws + OFF_HN);
  for (int row = bid * 8 + w; row < T_ALL; row += G * 8) {
    const float* src;
    if (row < T_PROMPT) { const int b = row / SEQP, t = row - b * SEQP; src = (t < 16) ? p.in[6] + (size_t)t * 1024 : p.in[0] + ((size_t)b * 2048 + (t - 16)) * 1024; }
    else src = p.in[1] + (size_t)(row - T_PROMPT) * 1024;
    f32x4 v[4];
#pragma unroll
    for (int j = 0; j < 4; ++j) { v[j] = *(const f32x4*)(src + 256 * j + 4 * lane); st_bf4(X + (size_t)row * 1024 + 256 * j + 4 * lane, v[j]); }
    rms_row_to_bf16(v, p.in[8], HN + (size_t)row * 1024, lane);
  }
}

DI void phase_rowwise(const Params& p, const float* __restrict__ wpost, const float* __restrict__ wpre, bool final_, const float* PART, int nsplit, int row_begin, int bid, int G) {
  const int lane = threadIdx.x & 63, w = threadIdx.x >> 6;
  bf16_t* X = (bf16_t*)(p.ws + OFF_X);
  const bf16_t* MIX = (const bf16_t*)(p.ws + OFF_MIX);
  bf16_t* HN = (bf16_t*)(p.ws + OFF_HN);
  for (int rowa = row_begin + bid * 8 + w; rowa < T_ALL; rowa += G * 16) {
    const int rowb = rowa + G * 8;
    const bool hasb = rowb < T_ALL;
    f32x4 m[2][4], x[2][4];
#pragma unroll
    for (int q = 0; q < 2; ++q) {
      const int row = q ? (hasb ? rowb : rowa) : rowa;
#pragma unroll
      for (int j = 0; j < 4; ++j) {
        if (row < 16384) m[q][j] = ld_bf4(MIX + (size_t)row * 1024 + 256 * j + 4 * lane);
        else {
          f32x4 a = {0.f, 0.f, 0.f, 0.f};
          for (int ks = 0; ks < nsplit; ++ks) a = a + *(const f32x4*)(PART + ((size_t)ks * 768 + (row - 16384)) * 1024 + 256 * j + 4 * lane);
          m[q][j] = a;
        }
        x[q][j] = ld_bf4(X + (size_t)row * 1024 + 256 * j + 4 * lane);
      }
    }
#pragma unroll
    for (int q = 0; q < 2; ++q) {
      if (q == 1 && !hasb) break;
      const int row = q ? rowb : rowa;
      float s = 0.f;
#pragma unroll
      for (int j = 0; j < 4; ++j) s += m[q][j].x * m[q][j].x + m[q][j].y * m[q][j].y + m[q][j].z * m[q][j].z + m[q][j].w * m[q][j].w;
      const float rstd = rsqrtf(wave_sum(s) * (1.f / 1024.f) + 1e-6f);
#pragma unroll
      for (int j = 0; j < 4; ++j) { const f32x4 g = *(const f32x4*)(wpost + 256 * j + 4 * lane); x[q][j] = x[q][j] + m[q][j] * rstd * g; }
      if (!final_) {
#pragma unroll
        for (int j = 0; j < 4; ++j) st_bf4(X + (size_t)row * 1024 + 256 * j + 4 * lane, x[q][j]);
        rms_row_to_bf16(x[q], wpre, HN + (size_t)row * 1024, lane);
      } else {
        float* dst = nullptr;
        if (row < T_PROMPT) { const int b = row / SEQP, t = row - b * SEQP; if (t >= 16) dst = p.out + OUT_YP + ((size_t)b * 2048 + (t - 16)) * 1024; }
        else dst = p.out + OUT_YS + (size_t)(row - T_PROMPT) * 1024;
        if (dst) {
#pragma unroll
          for (int j = 0; j < 4; ++j) *(f32x4*)(dst + 256 * j + 4 * lane) = x[q][j];
        }
      }
    }
  }
}

DI void phase_groupnorm(const Params& p, int bid, int G) {
  const int lane = threadIdx.x & 63, w = threadIdx.x >> 6;
  bf16_t* O = (bf16_t*)(p.ws + OFF_O);
  const float* SSQ = (const float*)(p.ws + OFF_SSQ);
  const float* __restrict__ nw = p.in[24];
  const int g = lane >> 4;
  for (int row = bid * 8 + w; row < T_ALL; row += G * 8) {
    const f32x4 q = *(const f32x4*)(SSQ + (size_t)row * 16 + 4 * g);
    const float rstd = rsqrtf((q.x + q.y + q.z + q.w) * (1.f / 512.f) + 1e-6f);
    bf16_t* o = O + (size_t)row * 2048 + lane * 32;
#pragma unroll
    for (int j = 0; j < 4; ++j) {
      u32x4 v = *(u32x4*)(o + 8 * j);
      const f32x4 w0 = *(const f32x4*)(nw + lane * 32 + 8 * j), w1 = *(const f32x4*)(nw + lane * 32 + 8 * j + 4);
      v[0] = pk2(bflo(v[0]) * rstd * w0.x, bfhi(v[0]) * rstd * w0.y); v[1] = pk2(bflo(v[1]) * rstd * w0.z, bfhi(v[1]) * rstd * w0.w);
      v[2] = pk2(bflo(v[2]) * rstd * w1.x, bfhi(v[2]) * rstd * w1.y); v[3] = pk2(bflo(v[3]) * rstd * w1.z, bfhi(v[3]) * rstd * w1.w);
      *(u32x4*)(o + 8 * j) = v;
    }
  }
}

namespace pg8 {
#define PG8_LAS __attribute__((address_space(3)))
typedef unsigned short bf16_t;
typedef short bf16x8 __attribute__((ext_vector_type(8)));
typedef float f32x4 __attribute__((ext_vector_type(4)));
typedef unsigned u32x4 __attribute__((ext_vector_type(4)));
constexpr int BM = 256, BK = 64, HALF = 128, HTB = HALF * BK * 2  , STAGE_BYTES = 8 * HTB, NXCD = 8, WGM = 8;

__host__ __device__ __forceinline__ int lds_byte(int r, int c) { const int st = (r >> 4) * 2 + (c >> 5), rr = r & 15, cc = c & 31, ob = rr * 64 + cc * 2; return st * 1024 + (ob ^ (((ob >> 9) & 1) << 5)); }
__host__ __device__ __forceinline__ void stage_rc(int b, int& R, int& C) { const int st = b / 1024, sb = b % 1024, swz = sb ^ (((sb >> 9) & 1) << 5); R = (st >> 1) * 16 + swz / 64; C = (st & 1) * 32 + (swz % 64) / 2; }
__host__ __device__ __forceinline__ int perm32(int rho) { const int n = rho >> 4, i = rho & 15; return 8 * (i >> 2) + 4 * n + (i & 3); }

struct Unit { int pm, pn, ks; };
struct Gemm { const bf16_t* A; const bf16_t* Bt; int M, N, K, ld; };

struct StaticOrder {
    int nM, nN, nwg, G, c;
    __host__ __device__ void init(int M, int N, int G_, int c_) { nM = M / BM; nN = N / BM; nwg = nM * nN; G = G_; c = c_; }
    __host__ __device__ bool next(int i, Unit& u) const {
        const long L = (long)i * G + c; if (L >= nwg) return false;
        int wgid = (int)L; { const int q = nwg / NXCD, r = nwg % NXCD, xcd = wgid % NXCD, off = wgid / NXCD; wgid = (xcd < r ? xcd * (q + 1) : r * (q + 1) + (xcd - r) * q) + off; }
        const int nig = WGM * nN, gid = wgid / nig, fm = gid * WGM, gsz = (nM - fm) < WGM ? (nM - fm) : WGM;
        u.pm = fm + ((wgid % nig) % gsz); u.pn = (wgid % nig) / gsz; u.ks = 0; return true;
    }
    __device__ __forceinline__ void a_ready(const Unit&) const {}
    __device__ __forceinline__ void done(const Unit&) const {}
};
__device__ __forceinline__ unsigned cvt_pk_bf16(float lo, float hi) { unsigned r; asm volatile("v_cvt_pk_bf16_f32 %0, %1, %2" : "=v"(r) : "v"(lo), "v"(hi)); return r; }
typedef float f32x2 __attribute__((ext_vector_type(2)));
template <class Epi, class Sched, bool ALIGN_EPI = false, bool SP2 = false>
__device__ __forceinline__ void gemm_phase(PG8_LAS unsigned char* lds, const Gemm g, const Sched& S, const Epi& E) {
    int tid_ = threadIdx.x; asm volatile("" : "+v"(tid_));
    const int tid = tid_, wid = __builtin_amdgcn_readfirstlane(tid >> 6), lane = tid & 63, wr = wid >> 2, wc = wid & 3, fr = lane & 15, fq = lane >> 4;
    const int K = g.ld, nt = g.K / BK;
    unsigned voffA[2], voffB[2];
#pragma unroll
    for (int i = 0; i < 2; ++i) { int R, C; stage_rc(tid * 16 + i * 8192, R, C); const int Rb = Epi::PERM ? ((R & ~31) + perm32(R & 31)) : R;
        voffA[i] = (unsigned)(R * K + C) * 2u; voffB[i] = (unsigned)(Rb * K + C) * 2u; }
    const size_t kstep = (size_t)(BK * 2);
    const size_t hstep = (size_t)HALF * K * 2;
    const size_t tstep = 2 * hstep;
    const unsigned ldsw = (unsigned)wid * 1024u;
    const int aoff = lds_byte(wr * 64 + fr, fq * 8), boff = lds_byte(wc * 32 + fr, fq * 8);
#define PG8_SA(b, h) (((b) * 2 + (h)) * HTB)
#define PG8_SB(b, h) ((4 + (b) * 2 + (h)) * HTB)
#define PG8_STAGE(bufoff, gbase, voff) do { _Pragma("unroll") for (int _i = 0; _i < 2; ++_i) \
        __builtin_amdgcn_global_load_lds((const unsigned*)((const char*)(gbase) + (voff)[_i]), (PG8_LAS unsigned*)(lds + (bufoff) + ldsw + _i * 8192), 16, 0, 0); } while (0)
#define PG8_LDA(dst, b, h) do { _Pragma("unroll") for (int m = 0; m < 4; ++m) _Pragma("unroll") for (int k = 0; k < 2; ++k) dst[m][k] = *(const PG8_LAS bf16x8*)(lds + PG8_SA(b, h) + aoff + m * 2048 + k * 1024); } while (0)
#define PG8_LDB(dst, b, h) do { _Pragma("unroll") for (int n = 0; n < 2; ++n) _Pragma("unroll") for (int k = 0; k < 2; ++k) dst[n][k] = *(const PG8_LAS bf16x8*)(lds + PG8_SB(b, h) + boff + n * 2048 + k * 1024); } while (0)
#define PG8_MMA(ai, bj, At, Bt) do { __builtin_amdgcn_s_setprio(1); _Pragma("unroll") for (int m = 0; m < 4; ++m) _Pragma("unroll") for (int n = 0; n < 2; ++n) _Pragma("unroll") for (int k = 0; k < 2; ++k) \
        acc[ai][bj][m][n] = __builtin_amdgcn_mfma_f32_16x16x32_bf16(Bt[n][k], At[m][k], acc[ai][bj][m][n], 0, 0, 0); __builtin_amdgcn_s_setprio(0); } while (0)
#define PG8_WAIT_V(n) asm volatile("s_waitcnt vmcnt(" #n ")" ::: "memory")
#define PG8_WAIT_L(n) asm volatile("s_waitcnt lgkmcnt(" #n ")" ::: "memory")
#define PG8_BAR __builtin_amdgcn_s_barrier()
#define PG8_SCHED __builtin_amdgcn_sched_barrier(0)
    Unit cur, nxt; int ui = 0;
    if (!S.next(0, cur)) return;
    f32x4 acc[2][2][4][2];
#pragma unroll
    for (int a = 0; a < 2; ++a)
#pragma unroll
        for (int b = 0; b < 2; ++b)
#pragma unroll
            for (int m = 0; m < 4; ++m)
#pragma unroll
                for (int n = 0; n < 2; ++n) acc[a][b][m][n] = (f32x4){0.f, 0.f, 0.f, 0.f};
    bf16x8 At[4][2], B0[2][2], B1[2][2];
    const char* cA = (const char*)g.A + (size_t)cur.pm * tstep + (size_t)cur.ks * g.K * 2; const char* cB = (const char*)g.Bt + (size_t)cur.pn * tstep + (size_t)cur.ks * g.K * 2;
    S.a_ready(cur);
    if constexpr (SP2) {
        PG8_STAGE(PG8_SB(0, 0), cB, voffB); PG8_STAGE(PG8_SB(0, 1), cB + hstep, voffB); PG8_STAGE(PG8_SA(0, 0), cA, voffA); PG8_STAGE(PG8_SA(0, 1), cA + hstep, voffA);
        if (wr == 1) PG8_BAR;
        PG8_WAIT_V(2); PG8_BAR;
        PG8_STAGE(PG8_SB(1, 0), cB + kstep, voffB); PG8_STAGE(PG8_SA(1, 0), cA + kstep, voffA); PG8_STAGE(PG8_SB(1, 1), cB + hstep + kstep, voffB);
        PG8_WAIT_V(6); PG8_BAR;
    } else {
        PG8_STAGE(PG8_SB(0, 0), cB, voffB); PG8_STAGE(PG8_SA(0, 0), cA, voffA); PG8_STAGE(PG8_SB(0, 1), cB + hstep, voffB); PG8_STAGE(PG8_SA(0, 1), cA + hstep, voffA);
        if (wr == 1) PG8_BAR;
        PG8_WAIT_V(4); PG8_BAR;
        PG8_STAGE(PG8_SB(1, 0), cB + kstep, voffB); PG8_STAGE(PG8_SA(1, 0), cA + kstep, voffA); PG8_STAGE(PG8_SB(1, 1), cB + hstep + kstep, voffB);
        PG8_WAIT_V(6); PG8_BAR;
    }
    for (;;) {
        const bool has_next = S.next(ui + 1, nxt);
        const char* nA = has_next ? (const char*)g.A + (size_t)nxt.pm * tstep + (size_t)nxt.ks * g.K * 2 : cA; const char* nB = has_next ? (const char*)g.Bt + (size_t)nxt.pn * tstep + (size_t)nxt.ks * g.K * 2 : cB;
        for (int t = 0; t < nt; t += 2) {
            const bool last = (t == nt - 2);
            const char* a1 = cA + (size_t)(t + 1) * kstep;
            const char* a2 = last ? nA : cA + (size_t)(t + 2) * kstep; const char* b2 = last ? nB : cB + (size_t)(t + 2) * kstep;
            const char* a3 = a2 + kstep; const char* b3 = b2 + kstep;
            if (last && has_next) S.a_ready(nxt);
            if constexpr (SP2) {
            PG8_LDB(B0, 0, 0); PG8_LDB(B1, 0, 1); PG8_SCHED; PG8_LDA(At, 0, 0); PG8_STAGE(PG8_SA(1, 1), a1 + hstep, voffA);
            PG8_WAIT_V(8); PG8_WAIT_L(0); PG8_BAR; PG8_MMA(0, 0, At, B0); PG8_MMA(0, 1, At, B1); PG8_BAR; PG8_SCHED;
            PG8_LDA(At, 0, 1); PG8_STAGE(PG8_SB(0, 0), b2, voffB); PG8_STAGE(PG8_SB(0, 1), b2 + hstep, voffB); PG8_STAGE(PG8_SA(0, 0), a2, voffA);
            PG8_WAIT_V(8); PG8_WAIT_L(0); PG8_BAR; PG8_MMA(1, 0, At, B0); PG8_MMA(1, 1, At, B1); PG8_BAR; PG8_SCHED;
            PG8_LDB(B0, 1, 0); PG8_LDB(B1, 1, 1); PG8_SCHED; PG8_LDA(At, 1, 0); PG8_STAGE(PG8_SA(0, 1), a2 + hstep, voffA);
            PG8_WAIT_V(8); PG8_WAIT_L(0); PG8_BAR; PG8_MMA(0, 0, At, B0); PG8_MMA(0, 1, At, B1); PG8_BAR; PG8_SCHED;
            PG8_LDA(At, 1, 1); PG8_STAGE(PG8_SB(1, 0), b3, voffB); PG8_STAGE(PG8_SB(1, 1), b3 + hstep, voffB); PG8_STAGE(PG8_SA(1, 0), a3, voffA);
            PG8_WAIT_V(8); PG8_WAIT_L(0); PG8_BAR; PG8_MMA(1, 0, At, B0); PG8_MMA(1, 1, At, B1); PG8_BAR; PG8_SCHED;
            } else {
            PG8_LDB(B0, 0, 0); PG8_SCHED; PG8_LDA(At, 0, 0); PG8_STAGE(PG8_SA(1, 1), a1 + hstep, voffA);
            PG8_WAIT_L(8); PG8_BAR; PG8_WAIT_L(0); PG8_MMA(0, 0, At, B0); PG8_BAR; PG8_SCHED;
            PG8_LDB(B1, 0, 1); PG8_STAGE(PG8_SB(0, 0), b2, voffB);
            PG8_BAR; PG8_WAIT_L(0); PG8_MMA(0, 1, At, B1); PG8_BAR;
            PG8_LDA(At, 0, 1); PG8_STAGE(PG8_SA(0, 0), a2, voffA);
            PG8_BAR; PG8_WAIT_L(0); PG8_MMA(1, 0, At, B0); PG8_BAR; PG8_SCHED;
            PG8_STAGE(PG8_SB(0, 1), b2 + hstep, voffB);
            PG8_WAIT_V(6); PG8_BAR; PG8_MMA(1, 1, At, B1); PG8_BAR;
            PG8_LDB(B0, 1, 0); PG8_SCHED; PG8_LDA(At, 1, 0); PG8_STAGE(PG8_SA(0, 1), a2 + hstep, voffA);
            PG8_WAIT_L(8); PG8_BAR; PG8_WAIT_L(0); PG8_MMA(0, 0, At, B0); PG8_BAR; PG8_SCHED;
            PG8_LDB(B1, 1, 1); PG8_STAGE(PG8_SB(1, 0), b3, voffB);
            PG8_BAR; PG8_WAIT_L(0); PG8_MMA(0, 1, At, B1); PG8_BAR;
            PG8_LDA(At, 1, 1); PG8_STAGE(PG8_SA(1, 0), a3, voffA);
            PG8_BAR; PG8_WAIT_L(0); PG8_MMA(1, 0, At, B0); PG8_BAR; PG8_SCHED;
            PG8_STAGE(PG8_SB(1, 1), b3 + hstep, voffB);
            PG8_WAIT_V(6); PG8_BAR; PG8_MMA(1, 1, At, B1); PG8_BAR;
            }
        }
        if constexpr (ALIGN_EPI) { if (wr == 0) PG8_BAR; }
        if constexpr (!Epi::AFTER_DRAIN) { E(acc, cur, wr, wc, fr, fq); S.done(cur); }
        if (!has_next) break;
#pragma unroll
        for (int a = 0; a < 2; ++a)
#pragma unroll
            for (int b = 0; b < 2; ++b)
#pragma unroll
                for (int m = 0; m < 4; ++m)
#pragma unroll
                    for (int n = 0; n < 2; ++n) acc[a][b][m][n] = (f32x4){0.f, 0.f, 0.f, 0.f};
        cur = nxt; cA = nA; cB = nB; ++ui;
        if constexpr (ALIGN_EPI) { if (wr == 1) PG8_BAR; }
    }
    PG8_WAIT_V(0);
    if constexpr (!ALIGN_EPI) { if (wr == 0) PG8_BAR; }
    PG8_BAR;
    if constexpr (Epi::AFTER_DRAIN) { E.fused(acc, cur, wr, wc, fr, fq, lds, wid, lane); S.done(cur); }
#undef PG8_SA
#undef PG8_SB
#undef PG8_STAGE
#undef PG8_LDA
#undef PG8_LDB
#undef PG8_MMA
#undef PG8_WAIT_V
#undef PG8_WAIT_L
#undef PG8_BAR
#undef PG8_SCHED
}
}

struct EpiStoreBf16 {
  static constexpr bool PERM = true, AFTER_DRAIN = false;
  bf16_t* C; int ldc;
  DI void operator()(const pg8::f32x4 (&acc)[2][2][4][2], const pg8::Unit& u, int wr, int wc, int fr, int fq) const {
    const int row0 = u.pm * 256 + wr * 64 + fr, col0 = u.pn * 256 + wc * 32 + 8 * fq;
#pragma unroll
    for (int ai = 0; ai < 2; ++ai)
#pragma unroll
      for (int m = 0; m < 4; ++m) {
        bf16_t* rowp = C + (size_t)(row0 + ai * 128 + m * 16) * ldc + col0;
#pragma unroll
        for (int bj = 0; bj < 2; ++bj) {
          const pg8::f32x4 v0 = acc[ai][bj][m][0], v1 = acc[ai][bj][m][1];
          u32x4 w_; w_[0] = pk2(v0[0], v0[1]); w_[1] = pk2(v0[2], v0[3]); w_[2] = pk2(v1[0], v1[1]); w_[3] = pk2(v1[2], v1[3]);
          *(u32x4*)(rowp + bj * 128) = w_;
        }
      }
  }
};
struct EpiStoreF32 {
  static constexpr bool PERM = false, AFTER_DRAIN = false;
  float* C0; int ldc; size_t ks_stride;
  DI void operator()(const pg8::f32x4 (&acc)[2][2][4][2], const pg8::Unit& u, int wr, int wc, int fr, int fq) const {
    float* C = C0 + (size_t)u.ks * ks_stride;
    const int row0 = u.pm * 256 + wr * 64 + fr, col0 = u.pn * 256 + wc * 32 + 4 * fq;
#pragma unroll
    for (int ai = 0; ai < 2; ++ai)
#pragma unroll
      for (int m = 0; m < 4; ++m) {
        float* rowp = C + (size_t)(row0 + ai * 128 + m * 16) * ldc + col0;
#pragma unroll
        for (int bj = 0; bj < 2; ++bj)
#pragma unroll
          for (int n = 0; n < 2; ++n) *(pg8::f32x4*)(rowp + bj * 128 + n * 16) = acc[ai][bj][m][n];
      }
  }
};
struct EpiSwiglu {
  static constexpr bool PERM = true, AFTER_DRAIN = false;
  bf16_t* C; int ldc;
  DI void operator()(const pg8::f32x4 (&acc)[2][2][4][2], const pg8::Unit& u, int wr, int wc, int fr, int fq) const {
    const int row0 = u.pm * 256 + wr * 64 + fr, col0 = u.pn * 128 + wc * 32 + 8 * fq;
#pragma unroll
    for (int ai = 0; ai < 2; ++ai)
#pragma unroll
      for (int m = 0; m < 4; ++m) {
        float y[8];
#pragma unroll
        for (int n = 0; n < 2; ++n)
#pragma unroll
          for (int e = 0; e < 4; ++e) y[4 * n + e] = siluf_(acc[ai][0][m][n][e]) * acc[ai][1][m][n][e];
        u32x4 w_; w_[0] = pk2(y[0], y[1]); w_[1] = pk2(y[2], y[3]); w_[2] = pk2(y[4], y[5]); w_[3] = pk2(y[6], y[7]);
        *(u32x4*)(C + (size_t)(row0 + ai * 128 + m * 16) * ldc + col0) = w_;
      }
  }
};

struct RowSumExchange {
  float* xbuf; unsigned* cnt; unsigned* tmo;
  DI void run(const float (&part)[2][4], const pg8::Unit& u, int wr, int wc, int fr, int fq, char* lds, float* S, int wid, int lane) const {
    float* P = (float*)lds;
    if (fq == 0) {
#pragma unroll
      for (int ai = 0; ai < 2; ++ai)
#pragma unroll
        for (int m = 0; m < 4; ++m) P[(ai * 128 + wr * 64 + m * 16 + fr) * 4 + wc] = part[ai][m];
    }
    __syncthreads();
    const int row = wid * 32 + (lane & 31);
    if (lane < 32) {
      const f32x4 a = *(const f32x4*)(P + row * 4);
      __hip_atomic_store(xbuf + ((size_t)u.pm * 256 + row) * 4 + u.pn, (a.x + a.y) + (a.z + a.w), __ATOMIC_RELAXED, __HIP_MEMORY_SCOPE_AGENT);
    }
    asm volatile("s_waitcnt vmcnt(0)" ::: "memory");
    if (lane == 0) __hip_atomic_fetch_add(cnt + 64 * u.pm, 1u, __ATOMIC_RELAXED, __HIP_MEMORY_SCOPE_AGENT);
    if (wid == 0) {
      unsigned it = 0;
      while ((unsigned)__builtin_amdgcn_readfirstlane(__hip_atomic_load(cnt + 64 * u.pm, __ATOMIC_RELAXED, __HIP_MEMORY_SCOPE_AGENT)) < 32u) {
        __builtin_amdgcn_s_sleep(2);
        if (++it > (1u << 21)) { if (lane == 0) __hip_atomic_store(tmo, 1u, __ATOMIC_RELAXED, __HIP_MEMORY_SCOPE_AGENT); break; }
      }
      __builtin_amdgcn_fence(__ATOMIC_ACQUIRE, "agent");
    }
    asm volatile("s_waitcnt vmcnt(0) lgkmcnt(0)" ::: "memory");
    __syncthreads();
    if (lane < 32) {
      const float* slot = xbuf + ((size_t)u.pm * 256 + row) * 4;
      float t = 0.f;
#pragma unroll
      for (int k = 0; k < 4; ++k) t += __hip_atomic_load(slot + k, __ATOMIC_RELAXED, __HIP_MEMORY_SCOPE_AGENT);
      S[row] = t;
    }
    __syncthreads();
  }
};
template <bool FINAL>
struct EpiResNorm {
  static constexpr bool PERM = true, AFTER_DRAIN = true;
  bf16_t* X; bf16_t* HN; const float* wpost; const float* wpre; float* yout;
  float* xbuf; unsigned* cnt; unsigned* tmo;
  DI void operator()(const pg8::f32x4 (&)[2][2][4][2], const pg8::Unit&, int, int, int, int) const {}
  DI static void ssq_rows(const pg8::f32x4 (&acc)[2][2][4][2], float (&part)[2][4]) {
#pragma unroll
    for (int ai = 0; ai < 2; ++ai)
#pragma unroll
      for (int m = 0; m < 4; ++m) {
        float q = 0.f;
#pragma unroll
        for (int bj = 0; bj < 2; ++bj)
#pragma unroll
          for (int n = 0; n < 2; ++n) { const pg8::f32x4 v = acc[ai][bj][m][n]; q += (v[0] * v[0] + v[1] * v[1]) + (v[2] * v[2] + v[3] * v[3]); }
        q += __shfl_xor(q, 16); q += __shfl_xor(q, 32);
        part[ai][m] = q;
      }
  }
  DI void fused(pg8::f32x4 (&acc)[2][2][4][2], const pg8::Unit& u, int wr, int wc, int fr, int fq, PG8_LAS unsigned char* ldsl, int wid, int lane) const {
    char* lds = (char*)ldsl;
    float* S1 = (float*)(lds + 4096);
    float* S2 = (float*)(lds + 5120);
    float part[2][4];
    ssq_rows(acc, part);
    RowSumExchange{xbuf, cnt, tmo}.run(part, u, wr, wc, fr, fq, lds, S1, wid, lane);
#pragma unroll
    for (int ai = 0; ai < 2; ++ai)
#pragma unroll
      for (int m = 0; m < 4; ++m) {
        if (m == 0) __builtin_amdgcn_sched_barrier(0);
        const int rl = ai * 128 + wr * 64 + m * 16 + fr;
        const float r1 = rsqrtf(S1[rl] * (1.f / 1024.f) + 1e-6f);
        const bf16_t* xrow = X + (size_t)(u.pm * 256 + rl) * 1024;
#pragma unroll
        for (int bj = 0; bj < 2; ++bj) {
          const int c8 = u.pn * 256 + bj * 128 + wc * 32 + 8 * fq;
          const u32x4 xr = *(const u32x4*)(xrow + c8);
          const f32x4 g0 = *(const f32x4*)(wpost + c8), g1 = *(const f32x4*)(wpost + c8 + 4);
          const f32x4 x0 = {bflo(xr[0]), bfhi(xr[0]), bflo(xr[1]), bfhi(xr[1])}, x1 = {bflo(xr[2]), bfhi(xr[2]), bflo(xr[3]), bfhi(xr[3])};
          acc[ai][bj][m][0] = x0 + acc[ai][bj][m][0] * r1 * g0;
          acc[ai][bj][m][1] = x1 + acc[ai][bj][m][1] * r1 * g1;
        }
      }
    if (FINAL) {
#pragma unroll
      for (int ai = 0; ai < 2; ++ai)
#pragma unroll
        for (int m = 0; m < 4; ++m) {
          if (m == 0) __builtin_amdgcn_sched_barrier(0);
          const int row = u.pm * 256 + ai * 128 + wr * 64 + m * 16 + fr;
          const int b = row / SEQP, t = row - b * SEQP;
          if (t >= 16) {
            float* dst = yout + ((size_t)b * 2048 + (t - 16)) * 1024;
#pragma unroll
            for (int bj = 0; bj < 2; ++bj)
#pragma unroll
              for (int n = 0; n < 2; ++n) *(f32x4*)(dst + u.pn * 256 + bj * 128 + wc * 32 + 8 * fq + 4 * n) = acc[ai][bj][m][n];
          }
        }
      return;
    }
    ssq_rows(acc, part);
    RowSumExchange{xbuf + SZ_XB_SET / 4, cnt + SZ_CNT_SET / 4, tmo}.run(part, u, wr, wc, fr, fq, lds, S2, wid, lane);
#pragma unroll
    for (int ai = 0; ai < 2; ++ai)
#pragma unroll
      for (int m = 0; m < 4; ++m) {
        if (m == 0) __builtin_amdgcn_sched_barrier(0);
        const int rl = ai * 128 + wr * 64 + m * 16 + fr;
        const float r2 = rsqrtf(S2[rl] * (1.f / 1024.f) + 1e-6f);
        bf16_t* xrow = X + (size_t)(u.pm * 256 + rl) * 1024;
        bf16_t* hrow = HN + (size_t)(u.pm * 256 + rl) * 1024;
#pragma unroll
        for (int bj = 0; bj < 2; ++bj) {
          const int c8 = u.pn * 256 + bj * 128 + wc * 32 + 8 * fq;
          const f32x4 g0 = *(const f32x4*)(wpre + c8), g1 = *(const f32x4*)(wpre + c8 + 4);
          const pg8::f32x4 v0 = acc[ai][bj][m][0], v1 = acc[ai][bj][m][1];
          u32x4 xo, ho;
          xo[0] = pk2(v0[0], v0[1]); xo[1] = pk2(v0[2], v0[3]); xo[2] = pk2(v1[0], v1[1]); xo[3] = pk2(v1[2], v1[3]);
          const pg8::f32x4 h0 = v0 * r2 * g0, h1 = v1 * r2 * g1;
          ho[0] = pk2(h0[0], h0[1]); ho[1] = pk2(h0[2], h0[3]); ho[2] = pk2(h1[0], h1[1]); ho[3] = pk2(h1[2], h1[3]);
          *(u32x4*)(xrow + c8) = xo;
          *(u32x4*)(hrow + c8) = ho;
        }
      }
  }
};
template <class Epi>
DI void gemm_run(char* lds, const bf16_t* A, const bf16_t* Bt, int N, int K, const Epi& E, int vcu, int G) {
  pg8::Gemm g{A, Bt, T_PAD, N, K, K};
  pg8::StaticOrder S; S.init(T_PAD, N, G, vcu);
  pg8::gemm_phase<Epi, pg8::StaticOrder, true, true>((PG8_LAS unsigned char*)lds, g, S, E);
}
struct SplitOrder {
  int nsplit, nitems, G, c;
  DI bool next(int i, pg8::Unit& u) const {
    const int L = i * G + c; if (L >= nitems) return false;
    const int q = L / nsplit; u.ks = L - q * nsplit; u.pm = q >> 2; u.pn = q & 3; return true;
  }
  DI void a_ready(const pg8::Unit&) const {}
  DI void done(const pg8::Unit&) const {}
};
DI void gemm_n1024_plain(char* lds, const bf16_t* A, const bf16_t* Bt, int K, float* MIXp, float* PART, int vcu, int G) {
  {
    pg8::Gemm g{A, Bt, M_MAIN, 1024, K, K};
    pg8::StaticOrder S; S.init(M_MAIN, 1024, G, vcu);
    pg8::gemm_phase<EpiStoreBf16, pg8::StaticOrder, true, true>((PG8_LAS unsigned char*)lds, g, S, EpiStoreBf16{(bf16_t*)MIXp, 1024});
  }
  {
    const int nsplit = K >> 8;
    pg8::Gemm g{A + (size_t)M_MAIN * K, Bt, 768, 1024, 256, K};
    SplitOrder S{nsplit, 12 * nsplit, G, (vcu + 128) % G};
    pg8::gemm_phase<EpiStoreF32, SplitOrder, true, true>((PG8_LAS unsigned char*)lds, g, S, EpiStoreF32{PART, 1024, (size_t)768 * 1024});
  }
}
template <bool FINAL>
DI void gemm_n1024(char* lds, const bf16_t* A, const bf16_t* Bt, int K, const EpiResNorm<FINAL>& E, float* PART, int vcu, int G) {
  {
    pg8::Gemm g{A, Bt, M_MAIN, 1024, K, K};
    pg8::StaticOrder S; S.init(M_MAIN, 1024, G, vcu);
    pg8::gemm_phase<EpiResNorm<FINAL>, pg8::StaticOrder, false, true>((PG8_LAS unsigned char*)lds, g, S, E);
  }
  __syncthreads();
  {
    const int nsplit = K >> 8;
    pg8::Gemm g{A + (size_t)M_MAIN * K, Bt, 768, 1024, 256, K};
    SplitOrder S{nsplit, 12 * nsplit, G, (vcu + 128) % G};
    pg8::gemm_phase<EpiStoreF32, SplitOrder, true, true>((PG8_LAS unsigned char*)lds, g, S, EpiStoreF32{PART, 1024, (size_t)768 * 1024});
  }
}

constexpr int L_QE = 0, L_KE = 8704, L_QI = 17408, L_G = 26112, L_KENDT = 34816, L_VT = 45056, L_DEC = 55296, L_TOT = 55808, L_SSQ = 57856;
constexpr int RS = 272, TS = 80;

template <int DK>
DI void pc_core(char* lds, f32x16 (&S)[DK / 32], f32x16& o, const int w, const int r32, const int h) {
  const char* QE = lds + L_QE + r32 * RS;
  const char* KE = lds + L_KE + r32 * RS;
  const char* QI = lds + L_QI + r32 * RS;
  f32x16 sc; zero16(sc);
#pragma unroll
  for (int s = 0; s < DK / 16; ++s) {
    const bf16x8 a = *(const bf16x8*)(KE + s * 32 + h * 16);
    const bf16x8 b = *(const bf16x8*)(QE + s * 32 + h * 16);
    sc = MFMA32(a, b, sc);
  }
#pragma unroll
  for (int r = 0; r < 16; ++r) if (crow(r, h) > r32) sc[r] = 0.f;
  const bf16x8 scb0 = pack8<0>(sc), scb1 = pack8<1>(sc);
  zero16(o);
#pragma unroll
  for (int kt = 0; kt < DK / 32; ++kt) {
    {
      const bf16x8 a = pack8<0>(S[kt]);
      const s16x4 lo = *(const s16x4*)(QI + (32 * kt + 4 * h) * 2), hi = *(const s16x4*)(QI + (32 * kt + 8 + 4 * h) * 2);
      o = MFMA32(a, cat8(lo, hi), o);
    }
    {
      const bf16x8 a = pack8<1>(S[kt]);
      const s16x4 lo = *(const s16x4*)(QI + (32 * kt + 16 + 4 * h) * 2), hi = *(const s16x4*)(QI + (32 * kt + 24 + 4 * h) * 2);
      o = MFMA32(a, cat8(lo, hi), o);
    }
  }
  const char* VTr = lds + L_VT + (32 * w + r32) * TS;
  {
    const s16x4 lo = *(const s16x4*)(VTr + (4 * h) * 2), hi = *(const s16x4*)(VTr + (8 + 4 * h) * 2);
    o = MFMA32(cat8(lo, hi), scb0, o);
  }
  {
    const s16x4 lo = *(const s16x4*)(VTr + (16 + 4 * h) * 2), hi = *(const s16x4*)(VTr + (24 + 4 * h) * 2);
    o = MFMA32(cat8(lo, hi), scb1, o);
  }
  const float* DEC = (const float*)(lds + L_DEC);
#pragma unroll
  for (int kt = 0; kt < DK / 32; ++kt)
#pragma unroll
    for (int g = 0; g < 4; ++g) {
      const f32x4 d = *(const f32x4*)(DEC + 32 * kt + 8 * g + 4 * h);
      S[kt][4 * g] *= d.x; S[kt][4 * g + 1] *= d.y; S[kt][4 * g + 2] *= d.z; S[kt][4 * g + 3] *= d.w;
    }
#pragma unroll
  for (int s = 0; s < 2; ++s) {
    const bf16x8 b = *(const bf16x8*)(VTr + s * 32 + h * 16);
#pragma unroll
    for (int kt = 0; kt < DK / 32; ++kt) {
      const bf16x8 a = *(const bf16x8*)(lds + L_KENDT + (32 * kt + r32) * TS + s * 32 + h * 16);
      S[kt] = MFMA32(a, b, S[kt]);
    }
  }
}

constexpr int NSC = 8;
DI int sc_beg(int sc) { return sc == 0 ? 0 : 16 + 256 * sc; }
DI int sc_end(int sc) { return 16 + 256 * (sc + 1); }
constexpr size_t SCR_HG_U = 0;
constexpr size_t SCR_GL_U = SCR_HG_U + (size_t)8 * 4 * 7 * 16384;
constexpr size_t SCR_HG_D = SCR_GL_U + (size_t)8 * 4 * 7 * 8192;
constexpr size_t SCR_GL_D = SCR_HG_D + (size_t)8 * 4 * 7 * 128;
constexpr size_t SCR_SS_U = 0;
constexpr size_t SCR_SS_D = SCR_SS_U + (size_t)8 * 32 * 7 * 8192;

template <int TYPE, bool SO>
DI void scan_even_job(const Params& p, char* lds, const int head, const int row0, const int ntok, const float* s_in, float* s_out, float* d_out) {
  constexpr int DK = TYPE == 0 ? 128 : 64;
  constexpr int KC = DK / 64;
  const int tid = threadIdx.x & (HB - 1), c = tid & 63, w = tid >> 6, r32 = c & 31, h = c >> 5;
  const bf16_t* P = (const bf16_t*)(p.ws + OFF_P);
  bf16_t* O = (bf16_t*)(p.ws + OFF_O);
  float* TOT = (float*)(lds + L_TOT);
  float* SSQ = (float*)(lds + L_SSQ);
  float* DEC = (float*)(lds + L_DEC);
  const int qcol = TYPE == 0 ? head * 128 : 2048 + head * 64;
  const int kcol = TYPE == 0 ? 512 + head * 128 : 2304 + head * 64;
  const int vcol = TYPE == 0 ? 1024 + head * 128 : 2560 + head * 128;
  const int gcol = TYPE == 0 ? 1536 + head * 128 : 3072 + head * 128;
  const int ocol = TYPE == 0 ? head * 128 : 512 + head * 128;
  float lb[2] = {0.f, 0.f}, wup[16], bal = 0.f;
  if (TYPE == 0) {
#pragma unroll
    for (int e = 0; e < 2; ++e) {
      const float g0 = p.in[7][head * 128 + 2 * c + e], g1 = p.in[7][512 + head * 128 + 2 * c + e], g2 = p.in[7][1024 + head * 128 + 2 * c + e];
      const float m = fmaxf(g0, fmaxf(g1, g2));
      const float e0 = __expf(g0 - m), e1 = __expf(g1 - m), e2 = __expf(g2 - m);
      lb[e] = e0 / (e0 + e1 + e2);
    }
  } else {
#pragma unroll
    for (int r = 0; r < 16; ++r) wup[r] = p.in[13][r * 256 + head * 64 + c];
    bal = p.in[14][head * 64 + c];
  }
  const float* __restrict__ nwp = TYPE == 0 ? p.in[15] : p.in[16];
  f32x16 S[DK / 32];
#pragma unroll
  for (int kt = 0; kt < DK / 32; ++kt)
#pragma unroll
    for (int r = 0; r < 16; ++r) S[kt][r] = (!SO && s_in) ? s_in[(size_t)(32 * kt + crow(r, h)) * 128 + 32 * w + r32] : 0.f;
  float dsum[KC];
#pragma unroll
  for (int e = 0; e < KC; ++e) dsum[e] = 0.f;

  unsigned rq[8], rk[8], rv[8], rg[8]; float ral[8];
  auto load_raw = [&](int ch) {
#pragma unroll
    for (int i = 0; i < 8; ++i) {
      const int t = min(ch * 32 + 8 * w + i, ntok - 1);
      const bf16_t* pr = P + (size_t)(row0 + t) * LD_EV;
      if (TYPE == 0) {
        if (!SO) rq[i] = *(const unsigned*)(pr + qcol + 2 * c);
        rk[i] = *(const unsigned*)(pr + kcol + 2 * c);
      } else {
        if (!SO) rq[i] = (unsigned)pr[qcol + c];
        rk[i] = (unsigned)pr[kcol + c];
        ral[i] = bflo((unsigned)pr[3584 + (c & 15)]);
      }
      rv[i] = *(const unsigned*)(pr + vcol + 2 * c);
      if (!SO) rg[i] = *(const unsigned*)(pr + gcol + 2 * c);
    }
  };
  const int nch = __builtin_amdgcn_readfirstlane((ntok + 31) >> 5);
  load_raw(0);
  for (int ch = 0; ch < nch; ++ch) {
    const int t0 = ch * 32;
    float kk[8][KC], cum[8][KC], run[KC];
#pragma unroll
    for (int e = 0; e < KC; ++e) run[e] = 0.f;
#pragma unroll
    for (int i = 0; i < 8; ++i) {
      const float vm = (t0 + 8 * w + i) < ntok ? 1.f : 0.f;
      if (TYPE == 0) {
#pragma unroll
        for (int e = 0; e < 2; ++e) {
          const float fa = e ? bfhi(rk[i]) : bflo(rk[i]);
          const float f = lb[e] + (1.f - lb[e]) * sigmoidf_(fa);
          kk[i][e] = vm - vm * f;
          run[e] += vm * __logf(f); cum[i][e] = run[e];
        }
      } else {
        float x = bal;
#pragma unroll
        for (int r = 0; r < 16; ++r) x += __int_as_float(__builtin_amdgcn_readlane(__float_as_int(ral[i]), r)) * wup[r];
        const float ls = fminf(x, 0.f) - __logf(1.f + __expf(-fabsf(x)));
        kk[i][0] = vm * bflo(rk[i]);
        run[0] += vm * ls * (1.f / 16.f); cum[i][0] = run[0];
      }
    }
#pragma unroll
    for (int e = 0; e < KC; ++e) TOT[w * 128 + KC * c + e] = run[e];
    __syncthreads();
    float off[KC], mid[KC], tot[KC];
#pragma unroll
    for (int e = 0; e < KC; ++e) {
      const float t0_ = TOT[KC * c + e], t1_ = TOT[128 + KC * c + e], t2_ = TOT[256 + KC * c + e], t3_ = TOT[384 + KC * c + e];
      mid[e] = t0_ + t1_; tot[e] = (t0_ + t1_) + (t2_ + t3_);
      off[e] = w == 0 ? 0.f : (w == 1 ? t0_ : (w == 2 ? t0_ + t1_ : t0_ + t1_ + t2_));
      dsum[e] += tot[e];
    }
    {
      u32x4 kp[KC];
#pragma unroll
      for (int m = 0; m < 4; ++m) {
        float kend[2][KC];
#pragma unroll
        for (int i2 = 0; i2 < 2; ++i2) {
          const int i = 2 * m + i2;
          const int ti = 8 * w + i;
          float qe[KC], ke[KC], qi[KC];
#pragma unroll
          for (int e = 0; e < KC; ++e) {
            const float cv = off[e] + cum[i][e];
            kend[i2][e] = kk[i][e] * __expf(tot[e] - cv);
            if (!SO) {
              const float qv = TYPE == 0 ? (e ? bfhi(rq[i]) : bflo(rq[i])) : bflo(rq[i]) * 0.125f;
              qe[e] = qv * __expf(cv - mid[e]);
              ke[e] = kk[i][e] * __expf(mid[e] - cv);
              qi[e] = qv * __expf(cv);
            }
          }
          if (!SO) {
            if (KC == 2) {
              *(unsigned*)(lds + L_QE + ti * RS + 4 * c) = pk2(qe[0], qe[KC - 1]);
              *(unsigned*)(lds + L_KE + ti * RS + 4 * c) = pk2(ke[0], ke[KC - 1]);
              *(unsigned*)(lds + L_QI + ti * RS + 4 * c) = pk2(qi[0], qi[KC - 1]);
            } else {
              *(bf16_t*)(lds + L_QE + ti * RS + 2 * c) = (bf16_t)pk2(qe[0], 0.f);
              *(bf16_t*)(lds + L_KE + ti * RS + 2 * c) = (bf16_t)pk2(ke[0], 0.f);
              *(bf16_t*)(lds + L_QI + ti * RS + 2 * c) = (bf16_t)pk2(qi[0], 0.f);
            }
            *(unsigned*)(lds + L_G + ti * RS + 4 * c) = rg[i];
          }
        }
#pragma unroll
        for (int e = 0; e < KC; ++e) kp[e][m] = pk2(kend[0][e], kend[1][e]);
      }
#pragma unroll
      for (int e = 0; e < KC; ++e) *(u32x4*)(lds + L_KENDT + (KC * c + e) * TS + 16 * w) = kp[e];
      u32x4 v0, v1;
#pragma unroll
      for (int m = 0; m < 4; ++m) {
        v0[m] = (rv[2 * m] & 0xffffu) | (rv[2 * m + 1] << 16);
        v1[m] = (rv[2 * m] >> 16) | (rv[2 * m + 1] & 0xffff0000u);
      }
      *(u32x4*)(lds + L_VT + (2 * c) * TS + 16 * w) = v0;
      *(u32x4*)(lds + L_VT + (2 * c + 1) * TS + 16 * w) = v1;
      if (w == 0) {
#pragma unroll
        for (int e = 0; e < KC; ++e) DEC[KC * c + e] = __expf(tot[e]);
      }
    }
    __syncthreads();
    load_raw(min(ch + 1, nch - 1));
    if (SO) {
      const char* VTr = lds + L_VT + (32 * w + r32) * TS;
#pragma unroll
      for (int kt = 0; kt < DK / 32; ++kt)
#pragma unroll
        for (int g = 0; g < 4; ++g) {
          const f32x4 d = *(const f32x4*)(DEC + 32 * kt + 8 * g + 4 * h);
          S[kt][4 * g] *= d.x; S[kt][4 * g + 1] *= d.y; S[kt][4 * g + 2] *= d.z; S[kt][4 * g + 3] *= d.w;
        }
#pragma unroll
      for (int s = 0; s < 2; ++s) {
        const bf16x8 bq = *(const bf16x8*)(VTr + s * 32 + h * 16);
#pragma unroll
        for (int kt = 0; kt < DK / 32; ++kt) {
          const bf16x8 a = *(const bf16x8*)(lds + L_KENDT + (32 * kt + r32) * TS + s * 32 + h * 16);
          S[kt] = MFMA32(a, bq, S[kt]);
        }
      }
      __syncthreads();
    } else {
      f32x16 o;
      pc_core<DK>(lds, S, o, w, r32, h);
      {
        float ss = 0.f;
#pragma unroll
        for (int r = 0; r < 16; ++r) ss += o[r] * o[r];
        ss += __shfl_xor(ss, 32);
        if (h == 0) SSQ[w * 32 + r32] = ss;
      }
      __syncthreads();
      {
        const float tot2 = (SSQ[r32] + SSQ[32 + r32]) + (SSQ[64 + r32] + SSQ[96 + r32]);
        const float rstd = rsqrtf(tot2 * (1.f / 128.f) + 1e-6f);
        if (t0 + r32 < ntok) {
          bf16_t* orow = O + (size_t)(row0 + t0 + r32) * 1024 + ocol + 32 * w + 4 * h;
#pragma unroll
          for (int g = 0; g < 4; ++g) {
            const u32x2 gp = *(const u32x2*)(lds + L_G + r32 * RS + (32 * w + 8 * g + 4 * h) * 2);
            const f32x4 nw = *(const f32x4*)(nwp + 32 * w + 8 * g + 4 * h);
            const float y0 = o[4 * g] * rstd * nw.x * siluf_(bflo(gp[0]));
            const float y1 = o[4 * g + 1] * rstd * nw.y * siluf_(bfhi(gp[0]));
            const float y2 = o[4 * g + 2] * rstd * nw.z * siluf_(bflo(gp[1]));
            const float y3 = o[4 * g + 3] * rstd * nw.w * siluf_(bfhi(gp[1]));
            u32x2 v; v[0] = pk2(y0, y1); v[1] = pk2(y2, y3);
            *(u32x2*)(orow + 8 * g) = v;
          }
        }
      }
    }
  }
  if (s_out) {
#pragma unroll
    for (int kt = 0; kt < DK / 32; ++kt)
#pragma unroll
      for (int r = 0; r < 16; ++r) s_out[(size_t)(32 * kt + crow(r, h)) * 128 + 32 * w + r32] = S[kt][r];
  }
  if (SO && w == 0) {
#pragma unroll
    for (int e = 0; e < KC; ++e) d_out[KC * c + e] = dsum[e];
  }
  __syncthreads();
}

DI void phase_scan_even_a(const Params& p, char* lds, int bid, int G) {
  float* scr = (float*)(p.ws + OFF_MIX);
  const int half = threadIdx.x >> 8; lds += half * HALF_LDS;
  for (int jb = bid * 2; jb < 448 + 1024; jb += G * 2) {
    const int j = jb + half;
    if (j < 448) {
      const int type = j & 1, head = (j >> 1) & 3, b = (j >> 3) & 7, sc = j >> 6;
      const int row0 = b * SEQP + sc_beg(sc), ntok = sc_end(sc) - sc_beg(sc);
      const size_t slot = ((size_t)b * 4 + head) * 7 + sc;
      if (type == 0) scan_even_job<0, true>(p, lds, head, row0, ntok, nullptr, scr + SCR_HG_U + slot * 16384, scr + SCR_HG_D + slot * 128);
      else scan_even_job<1, true>(p, lds, head, row0, ntok, nullptr, scr + SCR_GL_U + slot * 8192, scr + SCR_GL_D + slot * 64);
    } else {
      const int jj = j - 448, type = jj & 1, head = (jj >> 1) & 3, b = jj >> 3;
      const int row0 = T_PROMPT + 4 * b;
      if (type == 0) scan_even_job<0, false>(p, lds, head, row0, 4, p.in[2] + ((size_t)b * 4 + head) * 16384, p.out + OUT_HGS + ((size_t)b * 4 + head) * 16384, nullptr);
      else scan_even_job<1, false>(p, lds, head, row0, 4, p.in[3] + ((size_t)b * 4 + head) * 8192, p.out + OUT_GLS + ((size_t)b * 4 + head) * 8192, nullptr);
    }
  }
}
DI void phase_scan_even_c(const Params& p, int bid, int G) {
  float* scr = (float*)(p.ws + OFF_MIX);
  for (int i = bid * NTHREADS + threadIdx.x; i < 32 * 4096 + 32 * 2048; i += G * NTHREADS) {
    const bool gl = i >= 32 * 4096;
    const int ii = gl ? i - 32 * 4096 : i;
    const int per = gl ? 2048 : 4096, bh = ii / per, e4 = ii - bh * per, k = e4 >> 5;
    float* U = scr + (gl ? SCR_GL_U + (size_t)bh * 7 * 8192 : SCR_HG_U + (size_t)bh * 7 * 16384) + 4 * e4;
    const float* D = scr + (gl ? SCR_GL_D + (size_t)bh * 7 * 64 : SCR_HG_D + (size_t)bh * 7 * 128) + k;
    const int ustride = gl ? 8192 : 16384, dstride = gl ? 64 : 128;
    f32x4 run = {0.f, 0.f, 0.f, 0.f};
#pragma unroll
    for (int sc = 0; sc < 7; ++sc) {
      const float d = __expf(D[sc * dstride]);
      const f32x4 u = *(const f32x4*)(U + (size_t)sc * ustride);
      run = run * d + u;
      *(f32x4*)(U + (size_t)sc * ustride) = run;
    }
  }
}
DI void phase_scan_even_b(const Params& p, char* lds, int bid, int G) {
  float* scr = (float*)(p.ws + OFF_MIX);
  const int half = threadIdx.x >> 8; lds += half * HALF_LDS;
  for (int jb = bid * 2; jb < 512; jb += G * 2) {
    const int j = jb + half;
    {
      const int type = j & 1, head = (j >> 1) & 3, b = (j >> 3) & 7, sc = j >> 6;
      const int row0 = b * SEQP + sc_beg(sc), ntok = sc_end(sc) - sc_beg(sc);
      const size_t slot = ((size_t)b * 4 + head) * 7 + sc - 1;
      if (type == 0) scan_even_job<0, false>(p, lds, head, row0, ntok, sc ? scr + SCR_HG_U + slot * 16384 : nullptr,
                                             sc == NSC - 1 ? p.out + OUT_HGP + ((size_t)b * 4 + head) * 16384 : nullptr, nullptr);
      else scan_even_job<1, false>(p, lds, head, row0, ntok, sc ? scr + SCR_GL_U + slot * 8192 : nullptr,
                                   sc == NSC - 1 ? p.out + OUT_GLP + ((size_t)b * 4 + head) * 8192 : nullptr, nullptr);
    }
  }
}

constexpr int M_BM = 0, M_CM = 8704, M_XS = 17408, M_Z = 26112, M_BT = 34816, M_VT = 45056, M_VENDT = 55296, M_CUM = 65536, M_DT = 65792, M_SSQ = 66048, M_CW = 66560;

DI void phase_conv(const Params& p, int bid, int G) {
  const bf16_t* P = (const bf16_t*)(p.ws + OFF_P);
  bf16_t* O = (bf16_t*)(p.ws + OFF_O);
  bf16_t* HN = (bf16_t*)(p.ws + OFF_HN);
  const float* __restrict__ cwp = p.in[19];
  const float* __restrict__ cbp = p.in[20];
  const int gt = bid * NTHREADS + threadIdx.x, NPAR = (G * NTHREADS) / 384;
  const int cg = gt % 384, r0 = gt / 384, ch = 8 * cg;
  if (r0 >= NPAR) return;
  float w[4][8], bs[8];
#pragma unroll
  for (int k = 0; k < 4; ++k) {
    const f32x4 a = *(const f32x4*)(cwp + k * 3072 + ch), b_ = *(const f32x4*)(cwp + k * 3072 + ch + 4);
    w[k][0] = a.x; w[k][1] = a.y; w[k][2] = a.z; w[k][3] = a.w; w[k][4] = b_.x; w[k][5] = b_.y; w[k][6] = b_.z; w[k][7] = b_.w;
  }
  {
    const f32x4 a = *(const f32x4*)(cbp + ch), b_ = *(const f32x4*)(cbp + ch + 4);
    bs[0] = a.x; bs[1] = a.y; bs[2] = a.z; bs[3] = a.w; bs[4] = b_.x; bs[5] = b_.y; bs[6] = b_.z; bs[7] = b_.w;
  }
  bf16_t* dbase = ch < 2048 ? O + ch : HN + (ch - 2048);
  const int dld = ch < 2048 ? 2048 : 1024;
  for (int run = r0; run < 8 * 258; run += NPAR) {
    const int b = run / 258, t0 = (run - b * 258) * 8, row0 = b * SEQP + t0;
    u32x4 pre[11];
#pragma unroll
    for (int i = 0; i < 11; ++i) {
      const int r = row0 + i - 3;
      pre[i] = (i >= 3 || t0 > 0) ? *(const u32x4*)(P + (size_t)r * LD_OD + 2048 + ch) : (u32x4){0u, 0u, 0u, 0u};
    }
#pragma unroll
    for (int i = 0; i < 8; ++i) {
      u32x4 o;
#pragma unroll
      for (int q = 0; q < 4; ++q) {
        float a0 = bs[2 * q], a1 = bs[2 * q + 1];
#pragma unroll
        for (int k = 0; k < 4; ++k) { a0 += bflo(pre[i + k][q]) * w[k][2 * q]; a1 += bfhi(pre[i + k][q]) * w[k][2 * q + 1]; }
        o[q] = pk2(siluf_(a0), siluf_(a1));
      }
      *(u32x4*)(dbase + (size_t)(row0 + i) * dld) = o;
    }
  }
  for (int sq = r0; sq < 128; sq += NPAR) {
    const int row0 = T_PROMPT + 4 * sq;
    float pf[7][8];
#pragma unroll
    for (int i = 0; i < 3; ++i) {
      const f32x4 a = *(const f32x4*)(p.in[5] + ((size_t)sq * 3 + i) * 3072 + ch), b_ = *(const f32x4*)(p.in[5] + ((size_t)sq * 3 + i) * 3072 + ch + 4);
      pf[i][0] = a.x; pf[i][1] = a.y; pf[i][2] = a.z; pf[i][3] = a.w; pf[i][4] = b_.x; pf[i][5] = b_.y; pf[i][6] = b_.z; pf[i][7] = b_.w;
    }
#pragma unroll
    for (int i = 0; i < 4; ++i) {
      const u32x4 u = *(const u32x4*)(P + (size_t)(row0 + i) * LD_OD + 2048 + ch);
#pragma unroll
      for (int q = 0; q < 4; ++q) { pf[3 + i][2 * q] = bflo(u[q]); pf[3 + i][2 * q + 1] = bfhi(u[q]); }
    }
#pragma unroll
    for (int i = 0; i < 4; ++i) {
      u32x4 o;
#pragma unroll
      for (int q = 0; q < 4; ++q) {
        float a0 = bs[2 * q], a1 = bs[2 * q + 1];
#pragma unroll
        for (int k = 0; k < 4; ++k) { a0 += pf[i + k][2 * q] * w[k][2 * q]; a1 += pf[i + k][2 * q + 1] * w[k][2 * q + 1]; }
        o[q] = pk2(siluf_(a0), siluf_(a1));
      }
      *(u32x4*)(dbase + (size_t)(row0 + i) * dld) = o;
    }
  }
}

template <bool SO>
DI void scan_odd_job(const Params& p, char* lds, const int b, const int hp, const bool smp, const int tbeg, const int tend, const float* s_in, float* s_out, float* d_out) {
  const int tid = threadIdx.x & (HB - 1), c = tid & 63, w = tid >> 6, r32 = c & 31, h = c >> 5;
  const int grp = hp >> 2, hl = w >> 1, headw = 2 * hp + hl;
  const int row0 = (smp ? T_PROMPT + 4 * b : b * SEQP) + tbeg, ntok = tend - tbeg;
  const bf16_t* P = (const bf16_t*)(p.ws + OFF_P);
  bf16_t* O = (bf16_t*)(p.ws + OFF_O);
  const bf16_t* BC = (const bf16_t*)(p.ws + OFF_HN);
  float* CUM = (float*)(lds + M_CUM);
  float* DTL = (float*)(lds + M_DT);
  float* SSQ = (float*)(lds + M_SSQ);
  const int hd_l = 2 * hp + h;
  const float dtb = p.in[21][hd_l], aneg = -__expf(p.in[22][hd_l]);
  const float dsk = p.in[23][headw];
  f32x16 S[4];
  {
    const float* sin = s_in + ((size_t)hl * 64 + 32 * (w & 1) + r32) * 128;
#pragma unroll
    for (int kt = 0; kt < 4; ++kt)
#pragma unroll
      for (int g = 0; g < 4; ++g) {
        f32x4 v = {0.f, 0.f, 0.f, 0.f};
        if (!SO && s_in) v = *(const f32x4*)(sin + 32 * kt + 8 * g + 4 * h);
        S[kt][4 * g] = v.x; S[kt][4 * g + 1] = v.y; S[kt][4 * g + 2] = v.z; S[kt][4 * g + 3] = v.w;
      }
  }
  float dsum = 0.f;
  unsigned rx[8], rb[8], rc[8], rz[8]; float rdt;
  auto load_raw = [&](int ch) {
#pragma unroll
    for (int i = 0; i < 8; ++i) {
      const int t = min(ch * 32 + 8 * w + i, ntok - 1);
      rx[i] = *(const unsigned*)(O + (size_t)(row0 + t) * 2048 + hp * 128 + 2 * c);
      rb[i] = *(const unsigned*)(BC + (size_t)(row0 + t) * 1024 + grp * 128 + 2 * c);
      if (!SO) {
        rc[i] = *(const unsigned*)(BC + (size_t)(row0 + t) * 1024 + 512 + grp * 128 + 2 * c);
        rz[i] = *(const unsigned*)(P + (size_t)(row0 + t) * LD_OD + hp * 128 + 2 * c);
      }
    }
    {
      const int t = min(ch * 32 + r32, ntok - 1);
      rdt = bflo((unsigned)P[(size_t)(row0 + t) * LD_OD + 5120 + hd_l]);
    }
  };
  const int nch = __builtin_amdgcn_readfirstlane((ntok + 31) >> 5);
  load_raw(0);
  for (int ch = 0; ch < nch; ++ch) {
    const int t0 = ch * 32;
    {
      const float xdt = rdt + dtb;
      float dt = xdt > 20.f ? xdt : __logf(1.f + __expf(xdt));
      dt = (t0 + r32 < ntok) ? dt : 0.f;
      float cs = dt * aneg;
#pragma unroll
      for (int d = 1; d < 32; d <<= 1) { const float o_ = __shfl_up(cs, d, 32); if (r32 >= d) cs += o_; }
      if (w == 0) { CUM[h * 32 + r32] = cs; DTL[h * 32 + r32] = dt; }
    }
    {
#pragma unroll
      for (int i = 0; i < 8; ++i) {
        if (!SO) {
          *(unsigned*)(lds + M_BM + (8 * w + i) * RS + 4 * c) = rb[i];
          *(unsigned*)(lds + M_CM + (8 * w + i) * RS + 4 * c) = rc[i];
          *(unsigned*)(lds + M_XS + (8 * w + i) * RS + 4 * c) = rx[i];
          *(unsigned*)(lds + M_Z + (8 * w + i) * RS + 4 * c) = rz[i];
        }
      }
      u32x4 b0, b1;
#pragma unroll
      for (int m = 0; m < 4; ++m) {
        b0[m] = (rb[2 * m] & 0xffffu) | (rb[2 * m + 1] << 16);
        b1[m] = (rb[2 * m] >> 16) | (rb[2 * m + 1] & 0xffff0000u);
      }
      *(u32x4*)(lds + M_BT + (2 * c) * TS + 16 * w) = b0;
      *(u32x4*)(lds + M_BT + (2 * c + 1) * TS + 16 * w) = b1;
    }
    __syncthreads();
    {
      const int hx = c >> 5;
      const float last = CUM[hx * 32 + 31];
      float vt[8][2], ve[8][2];
#pragma unroll
      for (int i = 0; i < 8; ++i) {
        const int ti = 8 * w + i;
        const float dt = DTL[hx * 32 + ti], cm = CUM[hx * 32 + ti];
        const float ee = __expf(last - cm);
        vt[i][0] = bflo(rx[i]) * dt; vt[i][1] = bfhi(rx[i]) * dt;
        ve[i][0] = vt[i][0] * ee; ve[i][1] = vt[i][1] * ee;
      }
#pragma unroll
      for (int e = 0; e < 2; ++e) {
        u32x4 pv, pe;
#pragma unroll
        for (int m = 0; m < 4; ++m) { pv[m] = pk2(vt[2 * m][e], vt[2 * m + 1][e]); pe[m] = pk2(ve[2 * m][e], ve[2 * m + 1][e]); }
        if (!SO) *(u32x4*)(lds + M_VT + (2 * c + e) * TS + 16 * w) = pv;
        *(u32x4*)(lds + M_VENDT + (2 * c + e) * TS + 16 * w) = pe;
      }
    }
    __syncthreads();
    load_raw(min(ch + 1, nch - 1));
    f32x16 o;
    const float lastw = CUM[hl * 32 + 31];
    dsum += lastw;
    if (!SO) {
      const char* BMr = lds + M_BM + r32 * RS;
      const char* CMr = lds + M_CM + r32 * RS;
      f32x16 sc; zero16(sc);
#pragma unroll
      for (int s = 0; s < 8; ++s) {
        const bf16x8 a = *(const bf16x8*)(BMr + s * 32 + h * 16);
        const bf16x8 bq = *(const bf16x8*)(CMr + s * 32 + h * 16);
        sc = MFMA32(a, bq, sc);
      }
      const float ci = CUM[hl * 32 + r32];
#pragma unroll
      for (int g = 0; g < 4; ++g) {
        const f32x4 cj = *(const f32x4*)(CUM + hl * 32 + 8 * g + 4 * h);
#pragma unroll
        for (int e = 0; e < 4; ++e) {
          const int j = 8 * g + 4 * h + e;
          const float cje = e == 0 ? cj.x : (e == 1 ? cj.y : (e == 2 ? cj.z : cj.w));
          sc[4 * g + e] = (j <= r32) ? sc[4 * g + e] * __expf(ci - cje) : 0.f;
        }
      }
      const bf16x8 scb0 = pack8<0>(sc), scb1 = pack8<1>(sc);
      zero16(o);
#pragma unroll
      for (int kt = 0; kt < 4; ++kt) {
        {
          const bf16x8 a = pack8<0>(S[kt]);
          const s16x4 lo = *(const s16x4*)(CMr + (32 * kt + 4 * h) * 2), hi = *(const s16x4*)(CMr + (32 * kt + 8 + 4 * h) * 2);
          o = MFMA32(a, cat8(lo, hi), o);
        }
        {
          const bf16x8 a = pack8<1>(S[kt]);
          const s16x4 lo = *(const s16x4*)(CMr + (32 * kt + 16 + 4 * h) * 2), hi = *(const s16x4*)(CMr + (32 * kt + 24 + 4 * h) * 2);
          o = MFMA32(a, cat8(lo, hi), o);
        }
      }
      const float ei = __expf(ci);
#pragma unroll
      for (int r = 0; r < 16; ++r) o[r] *= ei;
      const char* VTr = lds + M_VT + (32 * w + r32) * TS;
      {
        const s16x4 lo = *(const s16x4*)(VTr + (4 * h) * 2), hi = *(const s16x4*)(VTr + (8 + 4 * h) * 2);
        o = MFMA32(cat8(lo, hi), scb0, o);
      }
      {
        const s16x4 lo = *(const s16x4*)(VTr + (16 + 4 * h) * 2), hi = *(const s16x4*)(VTr + (24 + 4 * h) * 2);
        o = MFMA32(cat8(lo, hi), scb1, o);
      }
    }
    {
      const float el = __expf(lastw);
#pragma unroll
      for (int kt = 0; kt < 4; ++kt)
#pragma unroll
        for (int r = 0; r < 16; ++r) S[kt][r] *= el;
      const char* VEr = lds + M_VENDT + (32 * w + r32) * TS;
#pragma unroll
      for (int s = 0; s < 2; ++s) {
        const bf16x8 bq = *(const bf16x8*)(VEr + s * 32 + h * 16);
#pragma unroll
        for (int kt = 0; kt < 4; ++kt) {
          const bf16x8 a = *(const bf16x8*)(lds + M_BT + (32 * kt + r32) * TS + s * 32 + h * 16);
          S[kt] = MFMA32(a, bq, S[kt]);
        }
      }
    }
    if (!SO) {
      float y[16]; float ss = 0.f;
#pragma unroll
      for (int g = 0; g < 4; ++g) {
        const u32x2 xp = *(const u32x2*)(lds + M_XS + r32 * RS + (32 * w + 8 * g + 4 * h) * 2);
        const u32x2 zp = *(const u32x2*)(lds + M_Z + r32 * RS + (32 * w + 8 * g + 4 * h) * 2);
        y[4 * g] = (o[4 * g] + dsk * bflo(xp[0])) * siluf_(bflo(zp[0]));
        y[4 * g + 1] = (o[4 * g + 1] + dsk * bfhi(xp[0])) * siluf_(bfhi(zp[0]));
        y[4 * g + 2] = (o[4 * g + 2] + dsk * bflo(xp[1])) * siluf_(bflo(zp[1]));
        y[4 * g + 3] = (o[4 * g + 3] + dsk * bfhi(xp[1])) * siluf_(bfhi(zp[1]));
      }
#pragma unroll
      for (int r = 0; r < 16; ++r) ss += y[r] * y[r];
      ss += __shfl_xor(ss, 32);
      if (h == 0) SSQ[w * 32 + r32] = ss;
      if (t0 + r32 < ntok) {
        bf16_t* orow = O + (size_t)(row0 + t0 + r32) * 2048 + hp * 128 + 32 * w + 4 * h;
#pragma unroll
        for (int g = 0; g < 4; ++g) { u32x2 v; v[0] = pk2(y[4 * g], y[4 * g + 1]); v[1] = pk2(y[4 * g + 2], y[4 * g + 3]); *(u32x2*)(orow + 8 * g) = v; }
      }
    }
    __syncthreads();
    if (!SO && tid < 32 && t0 + tid < ntok) {
      float* q = (float*)(p.ws + OFF_SSQ);
      q[(size_t)(row0 + t0 + tid) * 16 + hp] = (SSQ[tid] + SSQ[32 + tid]) + (SSQ[64 + tid] + SSQ[96 + tid]);
    }
  }
  if (s_out) {
    float* so = s_out + ((size_t)hl * 64 + 32 * (w & 1) + r32) * 128;
#pragma unroll
    for (int kt = 0; kt < 4; ++kt)
#pragma unroll
      for (int g = 0; g < 4; ++g) {
        f32x4 v = {S[kt][4 * g], S[kt][4 * g + 1], S[kt][4 * g + 2], S[kt][4 * g + 3]};
        *(f32x4*)(so + 32 * kt + 8 * g + 4 * h) = v;
      }
  }
  if (SO && (w & 1) == 0 && c == 0) d_out[hl * 7] = dsum;
  __syncthreads();
}

DI void phase_scan_odd_a(const Params& p, char* lds, int bid, int G) {
  float* scr = (float*)(p.ws + OFF_MIX);
  const int half = threadIdx.x >> 8; lds += half * HALF_LDS;
  for (int jb = bid * 2; jb < 896 + 2048; jb += G * 2) {
    const int j = jb + half;
    if (j >= 896) {
      const int jj = j - 896, hp = jj & 15, b = jj >> 4;
      scan_odd_job<false>(p, lds, b, hp, true, 0, 4, p.in[4] + ((size_t)b * 32 + 2 * hp) * 8192, p.out + OUT_SSS + ((size_t)b * 32 + 2 * hp) * 8192, nullptr);
      continue;
    }
    const int hp = j & 15, b = (j >> 4) & 7, sc = j >> 7;
    float* U = scr + SCR_SS_U + ((((size_t)b * 16 + hp) * 7 + sc) * 2) * 8192;
    float* D = scr + SCR_SS_D + ((size_t)b * 32 + 2 * hp) * 7 + sc;
    scan_odd_job<true>(p, lds, b, hp, false, sc_beg(sc), sc_end(sc), nullptr, U, D);
  }
}
DI void phase_scan_odd_c(const Params& p, int bid, int G) {
  float* scr = (float*)(p.ws + OFF_MIX);
  for (int i = bid * NTHREADS + threadIdx.x; i < 128 * 2 * 2048; i += G * NTHREADS) {
    const int e4 = i & 2047, hd = (i >> 11) & 1, bhp = i >> 12;
    float* U = scr + SCR_SS_U + ((size_t)bhp * 7 * 2 + hd) * 8192 + 4 * e4;
    const float* D = scr + SCR_SS_D + ((size_t)(bhp >> 4) * 32 + 2 * (bhp & 15) + hd) * 7;
    f32x4 run = {0.f, 0.f, 0.f, 0.f};
#pragma unroll
    for (int sc = 0; sc < 7; ++sc) {
      const float d = __expf(D[sc]);
      const f32x4 u = *(const f32x4*)(U + (size_t)sc * 16384);
      run = run * d + u;
      *(f32x4*)(U + (size_t)sc * 16384) = run;
    }
  }
}
DI void phase_scan_odd_b(const Params& p, char* lds, int bid, int G) {
  float* scr = (float*)(p.ws + OFF_MIX);
  const int half = threadIdx.x >> 8; lds += half * HALF_LDS;
  for (int jb = bid * 2; jb < 1024; jb += G * 2) {
    const int j = jb + half;
    {
      const int hp = j & 15, b = (j >> 4) & 7, sc = j >> 7;
      const float* s_in = sc ? scr + SCR_SS_U + ((((size_t)b * 16 + hp) * 7 + sc - 1) * 2) * 8192 : nullptr;
      float* s_out = sc == NSC - 1 ? p.out + OUT_SSP + ((size_t)b * 32 + 2 * hp) * 8192 : nullptr;
      scan_odd_job<false>(p, lds, b, hp, false, sc_beg(sc), sc_end(sc), s_in, s_out, nullptr);
    }
  }
  const bf16_t* P = (const bf16_t*)(p.ws + OFF_P);
  for (int i = bid * NTHREADS + threadIdx.x; i < 136 * 3 * 3072; i += G * NTHREADS) {
    const int ch = i % 3072, r = i / 3072, j = r % 3, b = r / 3;
    if (b < 8) p.out[OUT_CVP + ((size_t)b * 3 + j) * 3072 + ch] = bflo((unsigned)P[(size_t)(b * SEQP + 2061 + j) * LD_OD + 2048 + ch]);
    else { const int bs = b - 8; p.out[OUT_CVS + ((size_t)bs * 3 + j) * 3072 + ch] = bflo((unsigned)P[(size_t)(T_PROMPT + 4 * bs + 1 + j) * LD_OD + 2048 + ch]); }
  }
}

#define XB_TMO      128
#define XB_XCNT(j)  (256  + 64 * (j))
#define XB_XSUB(j)  (1280 + 64 * (j))
#define XB_XGEN(j)  (2304 + 64 * (j))
#define XB_TOP      3328
#define XB_TOPGEN   3392
#define XCD_BAR_WORDS 3456
#define XB_SPIN_CAP (1u << 20)
#define LAS __attribute__((address_space(3)))
DI unsigned xb_ld(unsigned* p) { return __hip_atomic_load(p, __ATOMIC_RELAXED, __HIP_MEMORY_SCOPE_AGENT); }
DI unsigned xb_add(unsigned* p, unsigned v) { return __hip_atomic_fetch_add(p, v, __ATOMIC_RELAXED, __HIP_MEMORY_SCOPE_AGENT); }
DI unsigned xb_xcc_id() { return (unsigned)__builtin_amdgcn_s_getreg((3 << 11) | 20) & 0xFu; }
#define XB_SPIN(cond, bar) do { unsigned _sp = 0; while (cond) { __builtin_amdgcn_s_sleep(1); \
    if ((++_sp & 255u) == 0u) { if (xb_ld(&(bar)[XB_TMO])) break; if (_sp > XB_SPIN_CAP) { atomicAdd(&(bar)[XB_TMO], 1u); break; } } } } while (0)
struct XcdBarrier { unsigned* bar; unsigned x; volatile LAS unsigned* st; };
DI XcdBarrier xcd_barrier_post(unsigned* bar, volatile LAS unsigned* st) {
  XcdBarrier b; b.bar = bar; b.x = xb_xcc_id(); b.st = st;
  if (threadIdx.x == 0) (void)xb_add(&bar[XB_XCNT(b.x)], 1u);
  return b;
}
DI void xcd_barrier_complete(unsigned* bar, unsigned x, unsigned& nloc, unsigned& nx) {
  const unsigned G = gridDim.x * gridDim.y * gridDim.z;
  unsigned sum, cnt, mine, sp = 0u;
  for (;;) {
    sum = 0u; cnt = 0u; mine = 0u;
#pragma unroll
    for (unsigned j = 0; j < 16; ++j) { const unsigned c = xb_ld(&bar[XB_XCNT(j)]); sum += c; cnt += (c > 0u) ? 1u : 0u; mine = (j == x) ? c : mine; }
    if (sum == G) break;
    __builtin_amdgcn_s_sleep(1);
    if ((++sp & 255u) == 0u) { if (xb_ld(&bar[XB_TMO])) break; if (sp > XB_SPIN_CAP) { atomicAdd(&bar[XB_TMO], 1u); break; } }
  }
  nloc = mine > 0u ? mine : 1u; nx = cnt > 0u ? cnt : 1u;
}
DI void xcd_barrier(const XcdBarrier& b) {
  asm volatile("s_waitcnt vmcnt(0)" ::: "memory");
  __syncthreads();
  if (threadIdx.x == 0) {
    unsigned* bar = b.bar;
    __builtin_amdgcn_s_waitcnt(0);
    unsigned nloc = b.st[0], nx = b.st[1];
    if (nloc == 0u) { xcd_barrier_complete(bar, b.x, nloc, nx); b.st[0] = nloc; b.st[1] = nx; }
    const unsigned old = xb_add(&bar[XB_XSUB(b.x)], 1u);
    const unsigned gen = old / nloc;
    if (old + 1u == (gen + 1u) * nloc) {
      __builtin_amdgcn_fence(__ATOMIC_RELEASE, "agent");
      asm volatile("s_waitcnt vmcnt(0)" ::: "memory");
      const unsigned og = xb_add(&bar[XB_TOP], 1u);
      const unsigned tg = og / nx;
      if (og + 1u == (tg + 1u) * nx) xb_add(&bar[XB_TOPGEN], 1u);
      else XB_SPIN(xb_ld(&bar[XB_TOPGEN]) == tg, bar);
      __builtin_amdgcn_fence(__ATOMIC_ACQUIRE, "agent");
      xb_add(&bar[XB_XGEN(b.x)], 1u);
      asm volatile("s_waitcnt vmcnt(0)" ::: "memory");
    } else {
      XB_SPIN(xb_ld(&bar[XB_XGEN(b.x)]) == gen, bar);
      __builtin_amdgcn_fence(__ATOMIC_ACQUIRE, "agent");
      asm volatile("s_waitcnt vmcnt(0)" ::: "memory");
    }
  }
  __syncthreads();
}

constexpr int N_PHASES = 21;
#ifndef ONLY_PHASE
#define ONLY_PHASE -1
#endif
#define PHASE(k, body) do { if ((ONLY_PHASE < 0 || ONLY_PHASE == (k)) && ph_lo <= (k) && (k) <= ph_hi) { body; } if (ph_lo <= (k) && (k) < ph_hi) xcd_barrier(xb); } while (0)

__global__ void __launch_bounds__(NTHREADS, 2) fwd_mega(Params p, int ph_lo, int ph_hi) {
  extern __shared__ __attribute__((aligned(16))) char lds[];
  cg::grid_group grid = cg::this_grid();
  const int G = gridDim.x, bid = blockIdx.x;
  if (ph_lo > 1000) grid.sync();
  volatile LAS unsigned* xst = (volatile LAS unsigned*)(lds + 2 * HALF_LDS);
  if (threadIdx.x == 0) { xst[0] = 0u; xst[1] = 0u; }
  __syncthreads();
  XcdBarrier xb = xcd_barrier_post((unsigned*)(p.ws + OFF_BAR), xst);
  bf16_t* HN = (bf16_t*)(p.ws + OFF_HN);
  bf16_t* Pb = (bf16_t*)(p.ws + OFF_P);
  bf16_t* Ob = (bf16_t*)(p.ws + OFF_O);
  float* MIX = (float*)(p.ws + OFF_MIX);
  PHASE(0, phase_prep(p, lds, bid, G));
  PHASE(1, gemm_run(lds, HN, (const bf16_t*)(p.ws + OFF_WT_EVIN), LD_EV, 1024, EpiStoreBf16{Pb, LD_EV}, bid, G));
  PHASE(2, phase_scan_even_a(p, lds, bid, G));
  PHASE(3, phase_scan_even_c(p, bid, G));
  PHASE(4, phase_scan_even_b(p, lds, bid, G));
  PHASE(5, gemm_n1024<false>(lds, Ob, (const bf16_t*)(p.ws + OFF_WT_EVOUT), 1024, EpiResNorm<false>{(bf16_t*)(p.ws + OFF_X), (bf16_t*)(p.ws + OFF_HN), p.in[9], p.in[10], nullptr, (float*)(p.ws + OFF_XB) + 0 * (SZ_XB_SET / 4), (unsigned*)(p.ws + OFF_CNT) + 0 * (SZ_CNT_SET / 4), (unsigned*)(p.ws + OFF_BAR) + 64}, (float*)Pb, bid, G));
  PHASE(6, phase_rowwise(p, p.in[9], p.in[10], false, (const float*)Pb, 4, M_MAIN, bid, G));
  PHASE(7, gemm_run(lds, HN, (const bf16_t*)(p.ws + OFF_WT_GU), 5632, 1024, EpiSwiglu{Pb, 2816}, bid, G));
  PHASE(8, gemm_n1024<false>(lds, Pb, (const bf16_t*)(p.ws + OFF_WT_DN), 2816, EpiResNorm<false>{(bf16_t*)(p.ws + OFF_X), (bf16_t*)(p.ws + OFF_HN), p.in[11], p.in[8] + 1024, nullptr, (float*)(p.ws + OFF_XB) + 2 * (SZ_XB_SET / 4), (unsigned*)(p.ws + OFF_CNT) + 2 * (SZ_CNT_SET / 4), (unsigned*)(p.ws + OFF_BAR) + 64}, (float*)Ob, bid, G));
  PHASE(9, phase_rowwise(p, p.in[11], p.in[8] + 1024, false, (const float*)Ob, 11, M_MAIN, bid, G));
  PHASE(10, gemm_run(lds, HN, (const bf16_t*)(p.ws + OFF_WT_ODIN), LD_OD, 1024, EpiStoreBf16{Pb, LD_OD}, bid, G));
  PHASE(11, phase_conv(p, bid, G));
  PHASE(12, phase_scan_odd_a(p, lds, bid, G));
  PHASE(13, phase_scan_odd_c(p, bid, G));
  PHASE(14, phase_scan_odd_b(p, lds, bid, G));
  PHASE(15, phase_groupnorm(p, bid, G));
  PHASE(16, gemm_n1024<false>(lds, Ob, (const bf16_t*)(p.ws + OFF_WT_ODOUT), 2048, EpiResNorm<false>{(bf16_t*)(p.ws + OFF_X), (bf16_t*)(p.ws + OFF_HN), p.in[9] + 1024, p.in[10] + 1024, nullptr, (float*)(p.ws + OFF_XB) + 4 * (SZ_XB_SET / 4), (unsigned*)(p.ws + OFF_CNT) + 4 * (SZ_CNT_SET / 4), (unsigned*)(p.ws + OFF_BAR) + 64}, (float*)Pb, bid, G));
  PHASE(17, phase_rowwise(p, p.in[9] + 1024, p.in[10] + 1024, false, (const float*)Pb, 8, M_MAIN, bid, G));
  PHASE(18, gemm_run(lds, HN, (const bf16_t*)(p.ws + OFF_WT_GU + SZ_WT_GU1), 5632, 1024, EpiSwiglu{Pb, 2816}, bid, G));
  PHASE(19, gemm_n1024<true>(lds, Pb, (const bf16_t*)(p.ws + OFF_WT_DN + SZ_WT_DN1), 2816, EpiResNorm<true>{(bf16_t*)(p.ws + OFF_X), (bf16_t*)(p.ws + OFF_HN), p.in[11] + 1024, nullptr, p.out + OUT_YP, (float*)(p.ws + OFF_XB) + 6 * (SZ_XB_SET / 4), (unsigned*)(p.ws + OFF_CNT) + 6 * (SZ_CNT_SET / 4), (unsigned*)(p.ws + OFF_BAR) + 64}, (float*)Ob, bid, G));
  PHASE(20, phase_rowwise(p, p.in[11] + 1024, nullptr, true, (const float*)Ob, 11, M_MAIN, bid, G));
}

extern "C" void kernel_launch(void* const* d_in, const int* in_sizes, int n_in, void* d_out, int out_size, void* d_ws, size_t ws_size, hipStream_t stream) {
  static int grid_blocks = 0;
  if (!grid_blocks) {
    int dev = 0, cus = 0, per_cu = 0;
    hipGetDevice(&dev);
    hipDeviceGetAttribute(&cus, hipDeviceAttributeMultiprocessorCount, dev);
    hipFuncSetAttribute((const void*)fwd_mega, hipFuncAttributeMaxDynamicSharedMemorySize, LDS_BYTES);
    hipOccupancyMaxActiveBlocksPerMultiprocessor(&per_cu, (const void*)fwd_mega, NTHREADS, LDS_BYTES);
    if (per_cu < 1) per_cu = 1;
    if (per_cu > 1) per_cu = 1;
    grid_blocks = cus * per_cu;
    if (ws_size < WS_END) fprintf(stderr, "kernel_launch: workspace too small: %zu < %zu\n", ws_size, (size_t)WS_END);
  }
  Params p{};
  for (int i = 0; i < 29; ++i) p.in[i] = (const float*)d_in[i];
  p.out = (float*)d_out;
  p.ws = (char*)d_ws;
  (void)hipMemsetAsync((char*)d_ws + OFF_BAR, 0, 16384 + 8 * SZ_CNT_SET, stream);
#if ONE_LAUNCH
  int lo = 0, hi = N_PHASES - 1;
  void* args[] = {&p, &lo, &hi};
  hipError_t e = hipLaunchCooperativeKernel((const void*)fwd_mega, dim3(grid_blocks), dim3(NTHREADS), args, LDS_BYTES, stream);
  if (e != hipSuccess) fprintf(stderr, "cooperative launch failed: %s (grid %d)\n", hipGetErrorString(e), grid_blocks);
#else
  for (int ph = 0; ph < N_PHASES; ++ph) {
    int lo = ph, hi = ph;
    void* args[] = {&p, &lo, &hi};
    hipError_t e = hipLaunchCooperativeKernel((const void*)fwd_mega, dim3(grid_blocks), dim3(NTHREADS), args, LDS_BYTES, stream);
    if (e != hipSuccess) fprintf(stderr, "launch failed: %s (grid %d)\n", hipGetErrorString(e), grid_blocks);
  }
#endif
}
```

```cpp
#include <hip/hip_runtime.h>
#include <hip/hip_cooperative_groups.h>
#include <cstdio>
#include <cstdint>
namespace cg = cooperative_groups;

#ifndef ONE_LAUNCH
#define ONE_LAUNCH 1
#endif

#define DI __device__ __forceinline__
typedef unsigned short bf16_t;
typedef short bf16x8 __attribute__((ext_vector_type(8)));
typedef short s16x4 __attribute__((ext_vector_type(4)));
typedef float f32x16 __attribute__((ext_vector_type(16)));
typedef float f32x4 __attribute__((ext_vector_type(4)));
typedef float f32x2 __attribute__((ext_vector_type(2)));
typedef unsigned u32x4 __attribute__((ext_vector_type(4)));
typedef unsigned u32x2 __attribute__((ext_vector_type(2)));
typedef __bf16 bf16v2 __attribute__((ext_vector_type(2)));
#define MFMA32(a, b, c) __builtin_amdgcn_mfma_f32_32x32x16_bf16((a), (b), (c), 0, 0, 0)

constexpr int T_ALL = 17024, T_PAD = 17152, T_PROMPT = 16512, SEQP = 2064, NTHREADS = 512, HB = 256  ;
constexpr int LD_EV = 3840, LD_OD = 5376;
constexpr int HALF_LDS = 75776;
constexpr int LDS_BYTES = 2 * HALF_LDS + 32;
constexpr int M_MAIN = 16384;

constexpr size_t OFF_WT_EVIN = 0;
constexpr size_t OFF_WT_EVOUT = OFF_WT_EVIN + (size_t)3840 * 1024 * 2;
constexpr size_t OFF_WT_GU = OFF_WT_EVOUT + (size_t)1024 * 1024 * 2;
constexpr size_t SZ_WT_GU1 = (size_t)5632 * 1024 * 2;
constexpr size_t OFF_WT_DN = OFF_WT_GU + 2 * SZ_WT_GU1;
constexpr size_t SZ_WT_DN1 = (size_t)1024 * 2816 * 2;
constexpr size_t OFF_WT_ODIN = OFF_WT_DN + 2 * SZ_WT_DN1;
constexpr size_t OFF_WT_ODOUT = OFF_WT_ODIN + (size_t)5376 * 1024 * 2;
constexpr size_t OFF_X = OFF_WT_ODOUT + (size_t)1024 * 2048 * 2;
constexpr size_t OFF_HN = OFF_X + (size_t)T_PAD * 1024 * 4;
constexpr size_t OFF_P = OFF_HN + (size_t)T_PAD * 1024 * 2;
constexpr size_t OFF_O = OFF_P + (size_t)T_PAD * 5376 * 2;
constexpr size_t OFF_MIX = OFF_O + (size_t)T_PAD * 2048 * 2;
constexpr size_t OFF_SSQ = OFF_MIX + (size_t)T_PAD * 1024 * 4;
constexpr size_t OFF_BAR = OFF_SSQ + (size_t)T_PAD * 16 * 4;
constexpr size_t OFF_CNT = OFF_BAR + 16384;
constexpr size_t SZ_CNT_SET = 64 * 256;
constexpr size_t OFF_XB = OFF_CNT + 8 * SZ_CNT_SET;
constexpr size_t SZ_XB_SET = (size_t)64 * 256 * 4 * 4;
constexpr size_t WS_END = OFF_XB + 8 * SZ_XB_SET;

constexpr size_t OUT_YP = 0;
constexpr size_t OUT_YS = 16777216;
constexpr size_t OUT_HGP = OUT_YS + 524288;
constexpr size_t OUT_GLP = OUT_HGP + 524288;
constexpr size_t OUT_SSP = OUT_GLP + 262144;
constexpr size_t OUT_CVP = OUT_SSP + 2097152;
constexpr size_t OUT_HGS = OUT_CVP + 73728;
constexpr size_t OUT_GLS = OUT_HGS + 8388608;
constexpr size_t OUT_SSS = OUT_GLS + 4194304;
constexpr size_t OUT_CVS = OUT_SSS + 33554432;

struct Params { const float* in[29]; float* out; char* ws; };

DI unsigned pk2(float lo, float hi) { f32x2 v = {lo, hi}; bf16v2 b = __builtin_convertvector(v, bf16v2); return __builtin_bit_cast(unsigned, b); }
DI float bflo(unsigned u) { return __uint_as_float(u << 16); }
DI float bfhi(unsigned u) { return __uint_as_float(u & 0xffff0000u); }
DI f32x4 ld_bf4(const bf16_t* p) { const u32x2 u = *(const u32x2*)p; return (f32x4){bflo(u[0]), bfhi(u[0]), bflo(u[1]), bfhi(u[1])}; }
DI void st_bf4(bf16_t* p, f32x4 v) { u32x2 u; u[0] = pk2(v.x, v.y); u[1] = pk2(v.z, v.w); *(u32x2*)p = u; }
DI float sigmoidf_(float x) { return __builtin_amdgcn_rcpf(1.f + __expf(-x)); }
DI float siluf_(float x) { return x * sigmoidf_(x); }
DI int crow(int r, int h) { return (r & 3) + 8 * (r >> 2) + 4 * h; }
DI bf16x8 cat8(s16x4 lo, s16x4 hi) { return __builtin_shufflevector(lo, hi, 0, 1, 2, 3, 4, 5, 6, 7); }
template <int S> DI bf16x8 pack8(const f32x16& x) {
  u32x4 p;
  p[0] = pk2(x[8 * S + 0], x[8 * S + 1]); p[1] = pk2(x[8 * S + 2], x[8 * S + 3]);
  p[2] = pk2(x[8 * S + 4], x[8 * S + 5]); p[3] = pk2(x[8 * S + 6], x[8 * S + 7]);
  return __builtin_bit_cast(bf16x8, p);
}
DI float wave_sum(float v) {
#pragma unroll
  for (int o = 1; o < 64; o <<= 1) v += __shfl_xor(v, o);
  return v;
}
DI void zero16(f32x16& a) {
#pragma unroll
  for (int i = 0; i < 16; ++i) a[i] = 0.f;
}

DI void transpose_tile(const float* __restrict__ W, int K, int N, bf16_t* Wt, int mode, int kt, int nt, float* tile, bool active) {
  const int tid = threadIdx.x & (HB - 1), k0 = kt * 64, n0 = nt * 64;
  if (active) {
    const int c = tid & 63, r0 = tid >> 6, n = n0 + c;
#pragma unroll
    for (int i = 0; i < 16; ++i) { const int k = r0 + 4 * i; tile[k * 65 + c] = (n < N) ? W[(size_t)(k0 + k) * N + n] : 0.f; }
  }
  __syncthreads();
  if (active) {
    const int nl = tid >> 2, kc = (tid & 3) * 16, n = n0 + nl;
    int drow = n;
    if (mode == 1) drow = (n >> 7) * 256 + (n & 127);
    if (mode == 2) drow = (n >> 7) * 256 + 128 + (n & 127);
    u32x4 o0, o1;
#pragma unroll
    for (int j = 0; j < 4; ++j) {
      o0[j] = pk2(tile[(kc + 2 * j) * 65 + nl], tile[(kc + 2 * j + 1) * 65 + nl]);
      o1[j] = pk2(tile[(kc + 8 + 2 * j) * 65 + nl], tile[(kc + 8 + 2 * j + 1) * 65 + nl]);
    }
    u32x4* d = (u32x4*)(Wt + (size_t)drow * K + k0 + kc);
    d[0] = o0; d[1] = o1;
  }
  __syncthreads();
}

DI void rms_row_to_bf16(const f32x4 (&v)[4], const float* __restrict__ wn, bf16_t* dst, int lane) {
  float s = 0.f;
#pragma unroll
  for (int j = 0; j < 4; ++j) s += v[j].x * v[j].x + v[j].y * v[j].y + v[j].z * v[j].z + v[j].w * v[j].w;
  const float rstd = rsqrtf(wave_sum(s) * (1.f / 1024.f) + 1e-6f);
#pragma unroll
  for (int j = 0; j < 4; ++j) {
    const f32x4 g = *(const f32x4*)(wn + 256 * j + 4 * lane);
    u32x2 o; o[0] = pk2(v[j].x * rstd * g.x, v[j].y * rstd * g.y); o[1] = pk2(v[j].z * rstd * g.z, v[j].w * rstd * g.w);
    *(u32x2*)(dst + 256 * j + 4 * lane) = o;
  }
}

DI void phase_prep(const Params& p, char* lds, int bid, int G) {
  const int half = threadIdx.x >> 8;
  float* tile = (float*)(lds + half * HALF_LDS);
  constexpr int NT_TILES = 960 + 256 + 1408 + 1408 + 1408 + 1344 + 512;
  for (int tb = bid * 2; tb < NT_TILES; tb += G * 2) {
    const int t = tb + half;
    const bool active = t < NT_TILES;
    const float* W = p.in[12]; int K = 1024, N = 3600, nnt = 60, mode = 0; bf16_t* dst = (bf16_t*)(p.ws + OFF_WT_EVIN); int r = active ? t : 0;
    if (r < 960) { }
    else if ((r -= 960) < 256) { W = p.in[17]; K = 1024; N = 1024; nnt = 16; dst = (bf16_t*)(p.ws + OFF_WT_EVOUT); }
    else if ((r -= 256) < 1408) { const int l = r / 704; r -= l * 704; W = p.in[26] + (size_t)l * 1024 * 2816; K = 1024; N = 2816; nnt = 44; mode = 1; dst = (bf16_t*)(p.ws + OFF_WT_GU + l * SZ_WT_GU1); }
    else if ((r -= 1408) < 1408) { const int l = r / 704; r -= l * 704; W = p.in[27] + (size_t)l * 1024 * 2816; K = 1024; N = 2816; nnt = 44; mode = 2; dst = (bf16_t*)(p.ws + OFF_WT_GU + l * SZ_WT_GU1); }
    else if ((r -= 1408) < 1408) { const int l = r / 704; r -= l * 704; W = p.in[28] + (size_t)l * 2816 * 1024; K = 2816; N = 1024; nnt = 16; dst = (bf16_t*)(p.ws + OFF_WT_DN + l * SZ_WT_DN1); }
    else if ((r -= 1408) < 1344) { W = p.in[18]; K = 1024; N = 5152; nnt = 84; dst = (bf16_t*)(p.ws + OFF_WT_ODIN); }
    else { r -= 1344; W = p.in[25]; K = 2048; N = 1024; nnt = 16; dst = (bf16_t*)(p.ws + OFF_WT_ODOUT); }
    const int kt = r / nnt, nt = r - kt * nnt;
    transpose_tile(W, K, N, dst, mode, kt, nt, tile, active);
  }
  const int lane = threadIdx.x & 63, w = threadIdx.x >> 6;
  bf16_t* X = (bf16_t*)(p.ws + OFF_X);
  bf16_t* HN = (bf16_t*)(p.ws + OFF_HN);
  for (int row = bid * 8 + w; row < T_ALL; row += G * 8) {
    const float* src;
    if (row < T_PROMPT) { const int b = row / SEQP, t = row - b * SEQP; src = (t < 16) ? p.in[6] + (size_t)t * 1024 : p.in[0] + ((size_t)b * 2048 + (t - 16)) * 1024; }
    else src = p.in[1] + (size_t)(row - T_PROMPT) * 1024;
    f32x4 v[4];
#pragma unroll
    for (int j = 0; j < 4; ++j) { v[j] = *(const f32x4*)(src + 256 * j + 4 * lane); st_bf4(X + (size_t)row * 1024 + 256 * j + 4 * lane, v[j]); }
    rms_row_to_bf16(v, p.in[8], HN + (size_t)row * 1024, lane);
  }
}

DI void phase_rowwise(const Params& p, const float* __restrict__ wpost, const float* __restrict__ wpre, bool final_, const float* PART, int nsplit, int row_begin, int bid, int G) {
  const int lane = threadIdx.x & 63, w = threadIdx.x >> 6;
  bf16_t* X = (bf16_t*)(p.ws + OFF_X);
  const bf16_t* MIX = (const bf16_t*)(p.ws + OFF_MIX);
  bf16_t* HN = (bf16_t*)(p.ws + OFF_HN);
  for (int rowa = row_begin + bid * 8 + w; rowa < T_ALL; rowa += G * 16) {
    const int rowb = rowa + G * 8;
    const bool hasb = rowb < T_ALL;
    f32x4 m[2][4], x[2][4];
#pragma unroll
    for (int q = 0; q < 2; ++q) {
      const int row = q ? (hasb ? rowb : rowa) : rowa;
#pragma unroll
      for (int j = 0; j < 4; ++j) {
        if (row < 16384) m[q][j] = ld_bf4(MIX + (size_t)row * 1024 + 256 * j + 4 * lane);
        else {
          f32x4 a = {0.f, 0.f, 0.f, 0.f};
          for (int ks = 0; ks < nsplit; ++ks) a = a + *(const f32x4*)(PART + ((size_t)ks * 768 + (row - 16384)) * 1024 + 256 * j + 4 * lane);
          m[q][j] = a;
        }
        x[q][j] = ld_bf4(X + (size_t)row * 1024 + 256 * j + 4 * lane);
      }
    }
#pragma unroll
    for (int q = 0; q < 2; ++q) {
      if (q == 1 && !hasb) break;
      const int row = q ? rowb : rowa;
      float s = 0.f;
#pragma unroll
      for (int j = 0; j < 4; ++j) s += m[q][j].x * m[q][j].x + m[q][j].y * m[q][j].y + m[q][j].z * m[q][j].z + m[q][j].w * m[q][j].w;
      const float rstd = rsqrtf(wave_sum(s) * (1.f / 1024.f) + 1e-6f);
#pragma unroll
      for (int j = 0; j < 4; ++j) { const f32x4 g = *(const f32x4*)(wpost + 256 * j + 4 * lane); x[q][j] = x[q][j] + m[q][j] * rstd * g; }
      if (!final_) {
#pragma unroll
        for (int j = 0; j < 4; ++j) st_bf4(X + (size_t)row * 1024 + 256 * j + 4 * lane, x[q][j]);
        rms_row_to_bf16(x[q], wpre, HN + (size_t)row * 1024, lane);
      } else {
        float* dst = nullptr;
        if (row < T_PROMPT) { const int b = row / SEQP, t = row - b * SEQP; if (t >= 16) dst = p.out + OUT_YP + ((size_t)b * 2048 + (t - 16)) * 1024; }
        else dst = p.out + OUT_YS + (size_t)(row - T_PROMPT) * 1024;
        if (dst) {
#pragma unroll
          for (int j = 0; j < 4; ++j) *(f32x4*)(dst + 256 * j + 4 * lane) = x[q][j];
        }
      }
    }
  }
}

DI void phase_groupnorm(const Params& p, int bid, int G) {
  const int lane = threadIdx.x & 63, w = threadIdx.x >> 6;
  bf16_t* O = (bf16_t*)(p.ws + OFF_O);
  const float* SSQ = (const float*)(p.ws + OFF_SSQ);
  const float* __restrict__ nw = p.in[24];
  const int g = lane >> 4;
  for (int row = bid * 8 + w; row < T_ALL; row += G * 8) {
    const f32x4 q = *(const f32x4*)(SSQ + (size_t)row * 16 + 4 * g);
    const float rstd = rsqrtf((q.x + q.y + q.z + q.w) * (1.f / 512.f) + 1e-6f);
    bf16_t* o = O + (size_t)row * 2048 + lane * 32;
#pragma unroll
    for (int j = 0; j < 4; ++j) {
      u32x4 v = *(u32x4*)(o + 8 * j);
      const f32x4 w0 = *(const f32x4*)(nw + lane * 32 + 8 * j), w1 = *(const f32x4*)(nw + lane * 32 + 8 * j + 4);
      v[0] = pk2(bflo(v[0]) * rstd * w0.x, bfhi(v[0]) * rstd * w0.y); v[1] = pk2(bflo(v[1]) * rstd * w0.z, bfhi(v[1]) * rstd * w0.w);
      v[2] = pk2(bflo(v[2]) * rstd * w1.x, bfhi(v[2]) * rstd * w1.y); v[3] = pk2(bflo(v[3]) * rstd * w1.z, bfhi(v[3]) * rstd * w1.w);
      *(u32x4*)(o + 8 * j) = v;
    }
  }
}

namespace pg8 {
#define PG8_LAS __attribute__((address_space(3)))
typedef unsigned short bf16_t;
typedef short bf16x8 __attribute__((ext_vector_type(8)));
typedef float f32x4 __attribute__((ext_vector_type(4)));
typedef unsigned u32x4 __attribute__((ext_vector_type(4)));
constexpr int BM = 256, BK = 64, HALF = 128, HTB = HALF * BK * 2  , STAGE_BYTES = 8 * HTB, NXCD = 8, WGM = 8;

__host__ __device__ __forceinline__ int lds_byte(int r, int c) { const int st = (r >> 4) * 2 + (c >> 5), rr = r & 15, cc = c & 31, ob = rr * 64 + cc * 2; return st * 1024 + (ob ^ (((ob >> 9) & 1) << 5)); }
__host__ __device__ __forceinline__ void stage_rc(int b, int& R, int& C) { const int st = b / 1024, sb = b % 1024, swz = sb ^ (((sb >> 9) & 1) << 5); R = (st >> 1) * 16 + swz / 64; C = (st & 1) * 32 + (swz % 64) / 2; }
__host__ __device__ __forceinline__ int perm32(int rho) { const int n = rho >> 4, i = rho & 15; return 8 * (i >> 2) + 4 * n + (i & 3); }

struct Unit { int pm, pn, ks; };
struct Gemm { const bf16_t* A; const bf16_t* Bt; int M, N, K, ld; };

struct StaticOrder {
    int nM, nN, nwg, G, c;
    __host__ __device__ void init(int M, int N, int G_, int c_) { nM = M / BM; nN = N / BM; nwg = nM * nN; G = G_; c = c_; }
    __host__ __device__ bool next(int i, Unit& u) const {
        const long L = (long)i * G + c; if (L >= nwg) return false;
        int wgid = (int)L; { const int q = nwg / NXCD, r = nwg % NXCD, xcd = wgid % NXCD, off = wgid / NXCD; wgid = (xcd < r ? xcd * (q + 1) : r * (q + 1) + (xcd - r) * q) + off; }
        const int nig = WGM * nN, gid = wgid / nig, fm = gid * WGM, gsz = (nM - fm) < WGM ? (nM - fm) : WGM;
        u.pm = fm + ((wgid % nig) % gsz); u.pn = (wgid % nig) / gsz; u.ks = 0; return true;
    }
    __device__ __forceinline__ void a_ready(const Unit&) const {}
    __device__ __forceinline__ void done(const Unit&) const {}
};
__device__ __forceinline__ unsigned cvt_pk_bf16(float lo, float hi) { unsigned r; asm volatile("v_cvt_pk_bf16_f32 %0, %1, %2" : "=v"(r) : "v"(lo), "v"(hi)); return r; }
typedef float f32x2 __attribute__((ext_vector_type(2)));
template <class Epi, class Sched, bool ALIGN_EPI = false, bool SP2 = false>
__device__ __forceinline__ void gemm_phase(PG8_LAS unsigned char* lds, const Gemm g, const Sched& S, const Epi& E) {
    int tid_ = threadIdx.x; asm volatile("" : "+v"(tid_));
    const int tid = tid_, wid = __builtin_amdgcn_readfirstlane(tid >> 6), lane = tid & 63, wr = wid >> 2, wc = wid & 3, fr = lane & 15, fq = lane >> 4;
    const int K = g.ld, nt = g.K / BK;
    unsigned voffA[2], voffB[2];
#pragma unroll
    for (int i = 0; i < 2; ++i) { int R, C; stage_rc(tid * 16 + i * 8192, R, C); const int Rb = Epi::PERM ? ((R & ~31) + perm32(R & 31)) : R;
        voffA[i] = (unsigned)(R * K + C) * 2u; voffB[i] = (unsigned)(Rb * K + C) * 2u; }
    const size_t kstep = (size_t)(BK * 2);
    const size_t hstep = (size_t)HALF * K * 2;
    const size_t tstep = 2 * hstep;
    const unsigned ldsw = (unsigned)wid * 1024u;
    const int aoff = lds_byte(wr * 64 + fr, fq * 8), boff = lds_byte(wc * 32 + fr, fq * 8);
#define PG8_SA(b, h) (((b) * 2 + (h)) * HTB)
#define PG8_SB(b, h) ((4 + (b) * 2 + (h)) * HTB)
#define PG8_STAGE(bufoff, gbase, voff) do { _Pragma("unroll") for (int _i = 0; _i < 2; ++_i) \
        __builtin_amdgcn_global_load_lds((const unsigned*)((const char*)(gbase) + (voff)[_i]), (PG8_LAS unsigned*)(lds + (bufoff) + ldsw + _i * 8192), 16, 0, 0); } while (0)
#define PG8_LDA(dst, b, h) do { _Pragma("unroll") for (int m = 0; m < 4; ++m) _Pragma("unroll") for (int k = 0; k < 2; ++k) dst[m][k] = *(const PG8_LAS bf16x8*)(lds + PG8_SA(b, h) + aoff + m * 2048 + k * 1024); } while (0)
#define PG8_LDB(dst, b, h) do { _Pragma("unroll") for (int n = 0; n < 2; ++n) _Pragma("unroll") for (int k = 0; k < 2; ++k) dst[n][k] = *(const PG8_LAS bf16x8*)(lds + PG8_SB(b, h) + boff + n * 2048 + k * 1024); } while (0)
#define PG8_MMA(ai, bj, At, Bt) do { __builtin_amdgcn_s_setprio(1); _Pragma("unroll") for (int m = 0; m < 4; ++m) _Pragma("unroll") for (int n = 0; n < 2; ++n) _Pragma("unroll") for (int k = 0; k < 2; ++k) \
        acc[ai][bj][m][n] = __builtin_amdgcn_mfma_f32_16x16x32_bf16(Bt[n][k], At[m][k], acc[ai][bj][m][n], 0, 0, 0); __builtin_amdgcn_s_setprio(0); } while (0)
#define PG8_WAIT_V(n) asm volatile("s_waitcnt vmcnt(" #n ")" ::: "memory")
#define PG8_WAIT_L(n) asm volatile("s_waitcnt lgkmcnt(" #n ")" ::: "memory")
#define PG8_BAR __builtin_amdgcn_s_barrier()
#define PG8_SCHED __builtin_amdgcn_sched_barrier(0)
    Unit cur, nxt; int ui = 0;
    if (!S.next(0, cur)) return;
    f32x4 acc[2][2][4][2];
#pragma unroll
    for (int a = 0; a < 2; ++a)
#pragma unroll
        for (int b = 0; b < 2; ++b)
#pragma unroll
            for (int m = 0; m < 4; ++m)
#pragma unroll
                for (int n = 0; n < 2; ++n) acc[a][b][m][n] = (f32x4){0.f, 0.f, 0.f, 0.f};
    bf16x8 At[4][2], B0[2][2], B1[2][2];
    const char* cA = (const char*)g.A + (size_t)cur.pm * tstep + (size_t)cur.ks * g.K * 2; const char* cB = (const char*)g.Bt + (size_t)cur.pn * tstep + (size_t)cur.ks * g.K * 2;
    S.a_ready(cur);
    if constexpr (SP2) {
        PG8_STAGE(PG8_SB(0, 0), cB, voffB); PG8_STAGE(PG8_SB(0, 1), cB + hstep, voffB); PG8_STAGE(PG8_SA(0, 0), cA, voffA); PG8_STAGE(PG8_SA(0, 1), cA + hstep, voffA);
        if (wr == 1) PG8_BAR;
        PG8_WAIT_V(2); PG8_BAR;
        PG8_STAGE(PG8_SB(1, 0), cB + kstep, voffB); PG8_STAGE(PG8_SA(1, 0), cA + kstep, voffA); PG8_STAGE(PG8_SB(1, 1), cB + hstep + kstep, voffB);
        PG8_WAIT_V(6); PG8_BAR;
    } else {
        PG8_STAGE(PG8_SB(0, 0), cB, voffB); PG8_STAGE(PG8_SA(0, 0), cA, voffA); PG8_STAGE(PG8_SB(0, 1), cB + hstep, voffB); PG8_STAGE(PG8_SA(0, 1), cA + hstep, voffA);
        if (wr == 1) PG8_BAR;
        PG8_WAIT_V(4); PG8_BAR;
        PG8_STAGE(PG8_SB(1, 0), cB + kstep, voffB); PG8_STAGE(PG8_SA(1, 0), cA + kstep, voffA); PG8_STAGE(PG8_SB(1, 1), cB + hstep + kstep, voffB);
        PG8_WAIT_V(6); PG8_BAR;
    }
    for (;;) {
        const bool has_next = S.next(ui + 1, nxt);
        const char* nA = has_next ? (const char*)g.A + (size_t)nxt.pm * tstep + (size_t)nxt.ks * g.K * 2 : cA; const char* nB = has_next ? (const char*)g.Bt + (size_t)nxt.pn * tstep + (size_t)nxt.ks * g.K * 2 : cB;
        for (int t = 0; t < nt; t += 2) {
            const bool last = (t == nt - 2);
            const char* a1 = cA + (size_t)(t + 1) * kstep;
            const char* a2 = last ? nA : cA + (size_t)(t + 2) * kstep; const char* b2 = last ? nB : cB + (size_t)(t + 2) * kstep;
            const char* a3 = a2 + kstep; const char* b3 = b2 + kstep;
            if (last && has_next) S.a_ready(nxt);
            if constexpr (SP2) {
            PG8_LDB(B0, 0, 0); PG8_LDB(B1, 0, 1); PG8_SCHED; PG8_LDA(At, 0, 0); PG8_STAGE(PG8_SA(1, 1), a1 + hstep, voffA);
            PG8_WAIT_V(8); PG8_WAIT_L(0); PG8_BAR; PG8_MMA(0, 0, At, B0); PG8_MMA(0, 1, At, B1); PG8_BAR; PG8_SCHED;
            PG8_LDA(At, 0, 1); PG8_STAGE(PG8_SB(0, 0), b2, voffB); PG8_STAGE(PG8_SB(0, 1), b2 + hstep, voffB); PG8_STAGE(PG8_SA(0, 0), a2, voffA);
            PG8_WAIT_V(8); PG8_WAIT_L(0); PG8_BAR; PG8_MMA(1, 0, At, B0); PG8_MMA(1, 1, At, B1); PG8_BAR; PG8_SCHED;
            PG8_LDB(B0, 1, 0); PG8_LDB(B1, 1, 1); PG8_SCHED; PG8_LDA(At, 1, 0); PG8_STAGE(PG8_SA(0, 1), a2 + hstep, voffA);
            PG8_WAIT_V(8); PG8_WAIT_L(0); PG8_BAR; PG8_MMA(0, 0, At, B0); PG8_MMA(0, 1, At, B1); PG8_BAR; PG8_SCHED;
            PG8_LDA(At, 1, 1); PG8_STAGE(PG8_SB(1, 0), b3, voffB); PG8_STAGE(PG8_SB(1, 1), b3 + hstep, voffB); PG8_STAGE(PG8_SA(1, 0), a3, voffA);
            PG8_WAIT_V(8); PG8_WAIT_L(0); PG8_BAR; PG8_MMA(1, 0, At, B0); PG8_MMA(1, 1, At, B1); PG8_BAR; PG8_SCHED;
            } else {
            PG8_LDB(B0, 0, 0); PG8_SCHED; PG8_LDA(At, 0, 0); PG8_STAGE(PG8_SA(1, 1), a1 + hstep, voffA);
            PG8_WAIT_L(8); PG8_BAR; PG8_WAIT_L(0); PG8_MMA(0, 0, At, B0); PG8_BAR; PG8_SCHED;
            PG8_LDB(B1, 0, 1); PG8_STAGE(PG8_SB(0, 0), b2, voffB);
            PG8_BAR; PG8_WAIT_L(0); PG8_MMA(0, 1, At, B1); PG8_BAR;
            PG8_LDA(At, 0, 1); PG8_STAGE(PG8_SA(0, 0), a2, voffA);
            PG8_BAR; PG8_WAIT_L(0); PG8_MMA(1, 0, At, B0); PG8_BAR; PG8_SCHED;
            PG8_STAGE(PG8_SB(0, 1), b2 + hstep, voffB);
            PG8_WAIT_V(6); PG8_BAR; PG8_MMA(1, 1, At, B1); PG8_BAR;
            PG8_LDB(B0, 1, 0); PG8_SCHED; PG8_LDA(At, 1, 0); PG8_STAGE(PG8_SA(0, 1), a2 + hstep, voffA);
            PG8_WAIT_L(8); PG8_BAR; PG8_WAIT_L(0); PG8_MMA(0, 0, At, B0); PG8_BAR; PG8_SCHED;
            PG8_LDB(B1, 1, 1); PG8_STAGE(PG8_SB(1, 0), b3, voffB);
            PG8_BAR; PG8_WAIT_L(0); PG8_MMA(0, 1, At, B1); PG8_BAR;
            PG8_LDA(At, 1, 1); PG8_STAGE(PG8_SA(1, 0), a3, voffA);
            PG8_BAR; PG8_WAIT_L(0); PG8_MMA(1, 0, At, B0); PG8_BAR; PG8_SCHED;
            PG8_STAGE(PG8_SB(1, 1), b3 + hstep, voffB);
            PG8_WAIT_V(6); PG8_BAR; PG8_MMA(1, 1, At, B1); PG8_BAR;
            }
        }
        if constexpr (ALIGN_EPI) { if (wr == 0) PG8_BAR; }
        if constexpr (!Epi::AFTER_DRAIN) { E(acc, cur, wr, wc, fr, fq); S.done(cur); }
        if (!has_next) break;
#pragma unroll
        for (int a = 0; a < 2; ++a)
#pragma unroll
            for (int b = 0; b < 2; ++b)
#pragma unroll
                for (int m = 0; m < 4; ++m)
#pragma unroll
                    for (int n = 0; n < 2; ++n) acc[a][b][m][n] = (f32x4){0.f, 0.f, 0.f, 0.f};
        cur = nxt; cA = nA; cB = nB; ++ui;
        if constexpr (ALIGN_EPI) { if (wr == 1) PG8_BAR; }
    }
    PG8_WAIT_V(0);
    if constexpr (!ALIGN_EPI) { if (wr == 0) PG8_BAR; }
    PG8_BAR;
    if constexpr (Epi::AFTER_DRAIN) { E.fused(acc, cur, wr, wc, fr, fq, lds, wid, lane); S.done(cur); }
#undef PG8_SA
#undef PG8_SB
#undef PG8_STAGE
#undef PG8_LDA
#undef PG8_LDB
#undef PG8_MMA
#undef PG8_WAIT_V
#undef PG8_WAIT_L
#undef PG8_BAR
#undef PG8_SCHED
}
}

struct EpiStoreBf16 {
  static constexpr bool PERM = true, AFTER_DRAIN = false;
  bf16_t* C; int ldc; unsigned silu_units;
  DI void operator()(const pg8::f32x4 (&acc)[2][2][4][2], const pg8::Unit& u, int wr, int wc, int fr, int fq) const {
    const int row0 = u.pm * 256 + wr * 64 + fr, col0 = u.pn * 256 + wc * 32 + 8 * fq;
    const bool gate = (silu_units >> u.pn) & 1u;
#pragma unroll
    for (int ai = 0; ai < 2; ++ai)
#pragma unroll
      for (int m = 0; m < 4; ++m) {
        bf16_t* rowp = C + (size_t)(row0 + ai * 128 + m * 16) * ldc + col0;
#pragma unroll
        for (int bj = 0; bj < 2; ++bj) {
          pg8::f32x4 v0 = acc[ai][bj][m][0], v1 = acc[ai][bj][m][1];
          if (gate) {
#pragma unroll
            for (int e = 0; e < 4; ++e) { v0[e] = siluf_(v0[e]); v1[e] = siluf_(v1[e]); }
          }
          u32x4 w_; w_[0] = pk2(v0[0], v0[1]); w_[1] = pk2(v0[2], v0[3]); w_[2] = pk2(v1[0], v1[1]); w_[3] = pk2(v1[2], v1[3]);
          *(u32x4*)(rowp + bj * 128) = w_;
        }
      }
  }
};
struct EpiStoreF32 {
  static constexpr bool PERM = false, AFTER_DRAIN = false;
  float* C0; int ldc; size_t ks_stride;
  DI void operator()(const pg8::f32x4 (&acc)[2][2][4][2], const pg8::Unit& u, int wr, int wc, int fr, int fq) const {
    float* C = C0 + (size_t)u.ks * ks_stride;
    const int row0 = u.pm * 256 + wr * 64 + fr, col0 = u.pn * 256 + wc * 32 + 4 * fq;
#pragma unroll
    for (int ai = 0; ai < 2; ++ai)
#pragma unroll
      for (int m = 0; m < 4; ++m) {
        float* rowp = C + (size_t)(row0 + ai * 128 + m * 16) * ldc + col0;
#pragma unroll
        for (int bj = 0; bj < 2; ++bj)
#pragma unroll
          for (int n = 0; n < 2; ++n) *(pg8::f32x4*)(rowp + bj * 128 + n * 16) = acc[ai][bj][m][n];
      }
  }
};
struct EpiSwiglu {
  static constexpr bool PERM = true, AFTER_DRAIN = false;
  bf16_t* C; int ldc;
  DI void operator()(const pg8::f32x4 (&acc)[2][2][4][2], const pg8::Unit& u, int wr, int wc, int fr, int fq) const {
    const int row0 = u.pm * 256 + wr * 64 + fr, col0 = u.pn * 128 + wc * 32 + 8 * fq;
#pragma unroll
    for (int ai = 0; ai < 2; ++ai)
#pragma unroll
      for (int m = 0; m < 4; ++m) {
        float y[8];
#pragma unroll
        for (int n = 0; n < 2; ++n)
#pragma unroll
          for (int e = 0; e < 4; ++e) y[4 * n + e] = siluf_(acc[ai][0][m][n][e]) * acc[ai][1][m][n][e];
        u32x4 w_; w_[0] = pk2(y[0], y[1]); w_[1] = pk2(y[2], y[3]); w_[2] = pk2(y[4], y[5]); w_[3] = pk2(y[6], y[7]);
        *(u32x4*)(C + (size_t)(row0 + ai * 128 + m * 16) * ldc + col0) = w_;
      }
  }
};

struct RowSumExchange {
  float* xbuf; unsigned* cnt; unsigned* tmo;
  DI void run(const float (&part)[2][4], const pg8::Unit& u, int wr, int wc, int fr, int fq, char* lds, float* S, int wid, int lane) const {
    float* P = (float*)lds;
    if (fq == 0) {
#pragma unroll
      for (int ai = 0; ai < 2; ++ai)
#pragma unroll
        for (int m = 0; m < 4; ++m) P[(ai * 128 + wr * 64 + m * 16 + fr) * 4 + wc] = part[ai][m];
    }
    __syncthreads();
    const int row = wid * 32 + (lane & 31);
    if (lane < 32) {
      const f32x4 a = *(const f32x4*)(P + row * 4);
      __hip_atomic_store(xbuf + ((size_t)u.pm * 256 + row) * 4 + u.pn, (a.x + a.y) + (a.z + a.w), __ATOMIC_RELAXED, __HIP_MEMORY_SCOPE_AGENT);
    }
    asm volatile("s_waitcnt vmcnt(0)" ::: "memory");
    if (lane == 0) __hip_atomic_fetch_add(cnt + 64 * u.pm, 1u, __ATOMIC_RELAXED, __HIP_MEMORY_SCOPE_AGENT);
    if (wid == 0) {
      unsigned it = 0;
      while ((unsigned)__builtin_amdgcn_readfirstlane(__hip_atomic_load(cnt + 64 * u.pm, __ATOMIC_RELAXED, __HIP_MEMORY_SCOPE_AGENT)) < 32u) {
        __builtin_amdgcn_s_sleep(2);
        if (++it > (1u << 21)) { if (lane == 0) __hip_atomic_store(tmo, 1u, __ATOMIC_RELAXED, __HIP_MEMORY_SCOPE_AGENT); break; }
      }
      __builtin_amdgcn_fence(__ATOMIC_ACQUIRE, "agent");
    }
    asm volatile("s_waitcnt vmcnt(0) lgkmcnt(0)" ::: "memory");
    __syncthreads();
    if (lane < 32) {
      const float* slot = xbuf + ((size_t)u.pm * 256 + row) * 4;
      float t = 0.f;
#pragma unroll
      for (int k = 0; k < 4; ++k) t += __hip_atomic_load(slot + k, __ATOMIC_RELAXED, __HIP_MEMORY_SCOPE_AGENT);
      S[row] = t;
    }
    __syncthreads();
  }
};
template <bool FINAL>
struct EpiResNorm {
  static constexpr bool PERM = true, AFTER_DRAIN = true;
  bf16_t* X; bf16_t* HN; const float* wpost; const float* wpre; float* yout;
  float* xbuf; unsigned* cnt; unsigned* tmo;
  DI void operator()(const pg8::f32x4 (&)[2][2][4][2], const pg8::Unit&, int, int, int, int) const {}
  DI static void ssq_rows(const pg8::f32x4 (&acc)[2][2][4][2], float (&part)[2][4]) {
#pragma unroll
    for (int ai = 0; ai < 2; ++ai)
#pragma unroll
      for (int m = 0; m < 4; ++m) {
        float q = 0.f;
#pragma unroll
        for (int bj = 0; bj < 2; ++bj)
#pragma unroll
          for (int n = 0; n < 2; ++n) { const pg8::f32x4 v = acc[ai][bj][m][n]; q += (v[0] * v[0] + v[1] * v[1]) + (v[2] * v[2] + v[3] * v[3]); }
        q += __shfl_xor(q, 16); q += __shfl_xor(q, 32);
        part[ai][m] = q;
      }
  }
  DI void fused(pg8::f32x4 (&acc)[2][2][4][2], const pg8::Unit& u, int wr, int wc, int fr, int fq, PG8_LAS unsigned char* ldsl, int wid, int lane) const {
    char* lds = (char*)ldsl;
    float* S1 = (float*)(lds + 4096);
    float* S2 = (float*)(lds + 5120);
    float part[2][4];
    ssq_rows(acc, part);
    RowSumExchange{xbuf, cnt, tmo}.run(part, u, wr, wc, fr, fq, lds, S1, wid, lane);
#pragma unroll
    for (int ai = 0; ai < 2; ++ai)
#pragma unroll
      for (int m = 0; m < 4; ++m) {
        if (m == 0) __builtin_amdgcn_sched_barrier(0);
        const int rl = ai * 128 + wr * 64 + m * 16 + fr;
        const float r1 = rsqrtf(S1[rl] * (1.f / 1024.f) + 1e-6f);
        const bf16_t* xrow = X + (size_t)(u.pm * 256 + rl) * 1024;
#pragma unroll
        for (int bj = 0; bj < 2; ++bj) {
          const int c8 = u.pn * 256 + bj * 128 + wc * 32 + 8 * fq;
          const u32x4 xr = *(const u32x4*)(xrow + c8);
          const f32x4 g0 = *(const f32x4*)(wpost + c8), g1 = *(const f32x4*)(wpost + c8 + 4);
          const f32x4 x0 = {bflo(xr[0]), bfhi(xr[0]), bflo(xr[1]), bfhi(xr[1])}, x1 = {bflo(xr[2]), bfhi(xr[2]), bflo(xr[3]), bfhi(xr[3])};
          acc[ai][bj][m][0] = x0 + acc[ai][bj][m][0] * r1 * g0;
          acc[ai][bj][m][1] = x1 + acc[ai][bj][m][1] * r1 * g1;
        }
      }
    if (FINAL) {
#pragma unroll
      for (int ai = 0; ai < 2; ++ai)
#pragma unroll
        for (int m = 0; m < 4; ++m) {
          if (m == 0) __builtin_amdgcn_sched_barrier(0);
          const int row = u.pm * 256 + ai * 128 + wr * 64 + m * 16 + fr;
          const int b = row / SEQP, t = row - b * SEQP;
          if (t >= 16) {
            float* dst = yout + ((size_t)b * 2048 + (t - 16)) * 1024;
#pragma unroll
            for (int bj = 0; bj < 2; ++bj)
#pragma unroll
              for (int n = 0; n < 2; ++n) *(f32x4*)(dst + u.pn * 256 + bj * 128 + wc * 32 + 8 * fq + 4 * n) = acc[ai][bj][m][n];
          }
        }
      return;
    }
    ssq_rows(acc, part);
    RowSumExchange{xbuf + SZ_XB_SET / 4, cnt + SZ_CNT_SET / 4, tmo}.run(part, u, wr, wc, fr, fq, lds, S2, wid, lane);
#pragma unroll
    for (int ai = 0; ai < 2; ++ai)
#pragma unroll
      for (int m = 0; m < 4; ++m) {
        if (m == 0) __builtin_amdgcn_sched_barrier(0);
        const int rl = ai * 128 + wr * 64 + m * 16 + fr;
        const float r2 = rsqrtf(S2[rl] * (1.f / 1024.f) + 1e-6f);
        bf16_t* xrow = X + (size_t)(u.pm * 256 + rl) * 1024;
        bf16_t* hrow = HN + (size_t)(u.pm * 256 + rl) * 1024;
#pragma unroll
        for (int bj = 0; bj < 2; ++bj) {
          const int c8 = u.pn * 256 + bj * 128 + wc * 32 + 8 * fq;
          const f32x4 g0 = *(const f32x4*)(wpre + c8), g1 = *(const f32x4*)(wpre + c8 + 4);
          const pg8::f32x4 v0 = acc[ai][bj][m][0], v1 = acc[ai][bj][m][1];
          u32x4 xo, ho;
          xo[0] = pk2(v0[0], v0[1]); xo[1] = pk2(v0[2], v0[3]); xo[2] = pk2(v1[0], v1[1]); xo[3] = pk2(v1[2], v1[3]);
          const pg8::f32x4 h0 = v0 * r2 * g0, h1 = v1 * r2 * g1;
          ho[0] = pk2(h0[0], h0[1]); ho[1] = pk2(h0[2], h0[3]); ho[2] = pk2(h1[0], h1[1]); ho[3] = pk2(h1[2], h1[3]);
          *(u32x4*)(xrow + c8) = xo;
          *(u32x4*)(hrow + c8) = ho;
        }
      }
  }
};
template <class Epi>
DI void gemm_run(char* lds, const bf16_t* A, const bf16_t* Bt, int N, int K, const Epi& E, int vcu, int G) {
  pg8::Gemm g{A, Bt, T_PAD, N, K, K};
  pg8::StaticOrder S; S.init(T_PAD, N, G, vcu);
  pg8::gemm_phase<Epi, pg8::StaticOrder, true, true>((PG8_LAS unsigned char*)lds, g, S, E);
}
struct SplitOrder {
  int nsplit, nitems, G, c;
  DI bool next(int i, pg8::Unit& u) const {
    const int L = i * G + c; if (L >= nitems) return false;
    const int q = L / nsplit; u.ks = L - q * nsplit; u.pm = q >> 2; u.pn = q & 3; return true;
  }
  DI void a_ready(const pg8::Unit&) const {}
  DI void done(const pg8::Unit&) const {}
};
DI void gemm_n1024_plain(char* lds, const bf16_t* A, const bf16_t* Bt, int K, float* MIXp, float* PART, int vcu, int G) {
  {
    pg8::Gemm g{A, Bt, M_MAIN, 1024, K, K};
    pg8::StaticOrder S; S.init(M_MAIN, 1024, G, vcu);
    pg8::gemm_phase<EpiStoreBf16, pg8::StaticOrder, true, true>((PG8_LAS unsigned char*)lds, g, S, EpiStoreBf16{(bf16_t*)MIXp, 1024, 0u});
  }
  {
    const int nsplit = K >> 8;
    pg8::Gemm g{A + (size_t)M_MAIN * K, Bt, 768, 1024, 256, K};
    SplitOrder S{nsplit, 12 * nsplit, G, (vcu + 128) % G};
    pg8::gemm_phase<EpiStoreF32, SplitOrder, true, true>((PG8_LAS unsigned char*)lds, g, S, EpiStoreF32{PART, 1024, (size_t)768 * 1024});
  }
}
template <bool FINAL>
DI void gemm_n1024(char* lds, const bf16_t* A, const bf16_t* Bt, int K, const EpiResNorm<FINAL>& E, float* PART, int vcu, int G) {
  {
    pg8::Gemm g{A, Bt, M_MAIN, 1024, K, K};
    pg8::StaticOrder S; S.init(M_MAIN, 1024, G, vcu);
    pg8::gemm_phase<EpiResNorm<FINAL>, pg8::StaticOrder, false, true>((PG8_LAS unsigned char*)lds, g, S, E);
  }
  __syncthreads();
  {
    const int nsplit = K >> 8;
    pg8::Gemm g{A + (size_t)M_MAIN * K, Bt, 768, 1024, 256, K};
    SplitOrder S{nsplit, 12 * nsplit, G, (vcu + 128) % G};
    pg8::gemm_phase<EpiStoreF32, SplitOrder, true, true>((PG8_LAS unsigned char*)lds, g, S, EpiStoreF32{PART, 1024, (size_t)768 * 1024});
  }
}

constexpr int L_QE = 0, L_KE = 8704, L_QI = 17408, L_G = 26112, L_KENDT = 34816, L_VT = 45056, L_DEC = 55296, L_TOT = 55808, L_SSQ = 57856;
constexpr int RS = 272, TS = 80;

template <int DK>
DI void pc_core(char* lds, f32x16 (&S)[DK / 32], f32x16& o, const int w, const int r32, const int h) {
  const char* QE = lds + L_QE + r32 * RS;
  const char* KE = lds + L_KE + r32 * RS;
  const char* QI = lds + L_QI + r32 * RS;
  f32x16 sc; zero16(sc);
#pragma unroll
  for (int s = 0; s < DK / 16; ++s) {
    const bf16x8 a = *(const bf16x8*)(KE + s * 32 + h * 16);
    const bf16x8 b = *(const bf16x8*)(QE + s * 32 + h * 16);
    sc = MFMA32(a, b, sc);
  }
#pragma unroll
  for (int r = 0; r < 16; ++r) if (crow(r, h) > r32) sc[r] = 0.f;
  const bf16x8 scb0 = pack8<0>(sc), scb1 = pack8<1>(sc);
  zero16(o);
#pragma unroll
  for (int kt = 0; kt < DK / 32; ++kt) {
    {
      const bf16x8 a = pack8<0>(S[kt]);
      const s16x4 lo = *(const s16x4*)(QI + (32 * kt + 4 * h) * 2), hi = *(const s16x4*)(QI + (32 * kt + 8 + 4 * h) * 2);
      o = MFMA32(a, cat8(lo, hi), o);
    }
    {
      const bf16x8 a = pack8<1>(S[kt]);
      const s16x4 lo = *(const s16x4*)(QI + (32 * kt + 16 + 4 * h) * 2), hi = *(const s16x4*)(QI + (32 * kt + 24 + 4 * h) * 2);
      o = MFMA32(a, cat8(lo, hi), o);
    }
  }
  const char* VTr = lds + L_VT + (32 * w + r32) * TS;
  {
    const s16x4 lo = *(const s16x4*)(VTr + (4 * h) * 2), hi = *(const s16x4*)(VTr + (8 + 4 * h) * 2);
    o = MFMA32(cat8(lo, hi), scb0, o);
  }
  {
    const s16x4 lo = *(const s16x4*)(VTr + (16 + 4 * h) * 2), hi = *(const s16x4*)(VTr + (24 + 4 * h) * 2);
    o = MFMA32(cat8(lo, hi), scb1, o);
  }
  const float* DEC = (const float*)(lds + L_DEC);
#pragma unroll
  for (int kt = 0; kt < DK / 32; ++kt)
#pragma unroll
    for (int g = 0; g < 4; ++g) {
      const f32x4 d = *(const f32x4*)(DEC + 32 * kt + 8 * g + 4 * h);
      S[kt][4 * g] *= d.x; S[kt][4 * g + 1] *= d.y; S[kt][4 * g + 2] *= d.z; S[kt][4 * g + 3] *= d.w;
    }
#pragma unroll
  for (int s = 0; s < 2; ++s) {
    const bf16x8 b = *(const bf16x8*)(VTr + s * 32 + h * 16);
#pragma unroll
    for (int kt = 0; kt < DK / 32; ++kt) {
      const bf16x8 a = *(const bf16x8*)(lds + L_KENDT + (32 * kt + r32) * TS + s * 32 + h * 16);
      S[kt] = MFMA32(a, b, S[kt]);
    }
  }
}

constexpr int NSC = 8;
DI int sc_beg(int sc) { return sc == 0 ? 0 : 16 + 256 * sc; }
DI int sc_end(int sc) { return 16 + 256 * (sc + 1); }
constexpr size_t SCR_HG_U = 0;
constexpr size_t SCR_GL_U = SCR_HG_U + (size_t)8 * 4 * 7 * 16384;
constexpr size_t SCR_HG_D = SCR_GL_U + (size_t)8 * 4 * 7 * 8192;
constexpr size_t SCR_GL_D = SCR_HG_D + (size_t)8 * 4 * 7 * 128;
constexpr size_t SCR_SS_U = 0;
constexpr size_t SCR_SS_D = SCR_SS_U + (size_t)8 * 32 * 7 * 8192;

template <int TYPE, bool SO>
DI void scan_even_job(const Params& p, char* lds, const int head, const int row0, const int ntok, const float* s_in, float* s_out, float* d_out) {
  constexpr int DK = TYPE == 0 ? 128 : 64;
  constexpr int KC = DK / 64;
  const int tid = threadIdx.x & (HB - 1), c = tid & 63, w = tid >> 6, r32 = c & 31, h = c >> 5;
  const bf16_t* P = (const bf16_t*)(p.ws + OFF_P);
  bf16_t* O = (bf16_t*)(p.ws + OFF_O);
  float* TOT = (float*)(lds + L_TOT);
  float* SSQ = (float*)(lds + L_SSQ);
  float* DEC = (float*)(lds + L_DEC);
  const int qcol = TYPE == 0 ? head * 128 : 2048 + head * 64;
  const int kcol = TYPE == 0 ? 512 + head * 128 : 2304 + head * 64;
  const int vcol = TYPE == 0 ? 1024 + head * 128 : 2560 + head * 128;
  const int gcol = TYPE == 0 ? 1536 + head * 128 : 3072 + head * 128;
  const int ocol = TYPE == 0 ? head * 128 : 512 + head * 128;
  float lb[2] = {0.f, 0.f}, wup[16], bal = 0.f;
  if (TYPE == 0) {
#pragma unroll
    for (int e = 0; e < 2; ++e) {
      const float g0 = p.in[7][head * 128 + 2 * c + e], g1 = p.in[7][512 + head * 128 + 2 * c + e], g2 = p.in[7][1024 + head * 128 + 2 * c + e];
      const float m = fmaxf(g0, fmaxf(g1, g2));
      const float e0 = __expf(g0 - m), e1 = __expf(g1 - m), e2 = __expf(g2 - m);
      lb[e] = e0 / (e0 + e1 + e2);
    }
  } else {
#pragma unroll
    for (int r = 0; r < 16; ++r) wup[r] = p.in[13][r * 256 + head * 64 + c];
    bal = p.in[14][head * 64 + c];
  }
  const float* __restrict__ nwp = TYPE == 0 ? p.in[15] : p.in[16];
  f32x16 S[DK / 32];
#pragma unroll
  for (int kt = 0; kt < DK / 32; ++kt)
#pragma unroll
    for (int r = 0; r < 16; ++r) S[kt][r] = (!SO && s_in) ? s_in[(size_t)(32 * kt + crow(r, h)) * 128 + 32 * w + r32] : 0.f;
  float dsum[KC];
#pragma unroll
  for (int e = 0; e < KC; ++e) dsum[e] = 0.f;

  unsigned rq[8], rk[8], rv[8], rg[8]; float ral[8];
  auto load_raw = [&](int ch) {
#pragma unroll
    for (int i = 0; i < 8; ++i) {
      const int t = min(ch * 32 + 8 * w + i, ntok - 1);
      const bf16_t* pr = P + (size_t)(row0 + t) * LD_EV;
      if (TYPE == 0) {
        if (!SO) rq[i] = *(const unsigned*)(pr + qcol + 2 * c);
        rk[i] = *(const unsigned*)(pr + kcol + 2 * c);
      } else {
        if (!SO) rq[i] = (unsigned)pr[qcol + c];
        rk[i] = (unsigned)pr[kcol + c];
        ral[i] = bflo((unsigned)pr[3584 + (c & 15)]);
      }
      rv[i] = *(const unsigned*)(pr + vcol + 2 * c);
      if (!SO) rg[i] = *(const unsigned*)(pr + gcol + 2 * c);
    }
  };
  const int nch = __builtin_amdgcn_readfirstlane((ntok + 31) >> 5);
  load_raw(0);
  for (int ch = 0; ch < nch; ++ch) {
    const int t0 = ch * 32;
    float kk[8][KC], cum[8][KC], run[KC];
#pragma unroll
    for (int e = 0; e < KC; ++e) run[e] = 0.f;
#pragma unroll
    for (int i = 0; i < 8; ++i) {
      const float vm = (t0 + 8 * w + i) < ntok ? 1.f : 0.f;
      if (TYPE == 0) {
#pragma unroll
        for (int e = 0; e < 2; ++e) {
          const float fa = e ? bfhi(rk[i]) : bflo(rk[i]);
          const float f = lb[e] + (1.f - lb[e]) * sigmoidf_(fa);
          kk[i][e] = vm - vm * f;
          run[e] += vm * __logf(f); cum[i][e] = run[e];
        }
      } else {
        float x = bal;
#pragma unroll
        for (int r = 0; r < 16; ++r) x += __int_as_float(__builtin_amdgcn_readlane(__float_as_int(ral[i]), r)) * wup[r];
        const float ls = fminf(x, 0.f) - __logf(1.f + __expf(-fabsf(x)));
        kk[i][0] = vm * bflo(rk[i]);
        run[0] += vm * ls * (1.f / 16.f); cum[i][0] = run[0];
      }
    }
#pragma unroll
    for (int e = 0; e < KC; ++e) TOT[w * 128 + KC * c + e] = run[e];
    __syncthreads();
    float off[KC], mid[KC], tot[KC];
#pragma unroll
    for (int e = 0; e < KC; ++e) {
      const float t0_ = TOT[KC * c + e], t1_ = TOT[128 + KC * c + e], t2_ = TOT[256 + KC * c + e], t3_ = TOT[384 + KC * c + e];
      mid[e] = t0_ + t1_; tot[e] = (t0_ + t1_) + (t2_ + t3_);
      off[e] = w == 0 ? 0.f : (w == 1 ? t0_ : (w == 2 ? t0_ + t1_ : t0_ + t1_ + t2_));
      dsum[e] += tot[e];
    }
    {
      u32x4 kp[KC];
#pragma unroll
      for (int m = 0; m < 4; ++m) {
        float kend[2][KC];
#pragma unroll
        for (int i2 = 0; i2 < 2; ++i2) {
          const int i = 2 * m + i2;
          const int ti = 8 * w + i;
          float qe[KC], ke[KC], qi[KC];
#pragma unroll
          for (int e = 0; e < KC; ++e) {
            const float cv = off[e] + cum[i][e];
            kend[i2][e] = kk[i][e] * __expf(tot[e] - cv);
            if (!SO) {
              const float qv = TYPE == 0 ? (e ? bfhi(rq[i]) : bflo(rq[i])) : bflo(rq[i]) * 0.125f;
              qe[e] = qv * __expf(cv - mid[e]);
              ke[e] = kk[i][e] * __expf(mid[e] - cv);
              qi[e] = qv * __expf(cv);
            }
          }
          if (!SO) {
            if (KC == 2) {
              *(unsigned*)(lds + L_QE + ti * RS + 4 * c) = pk2(qe[0], qe[KC - 1]);
              *(unsigned*)(lds + L_KE + ti * RS + 4 * c) = pk2(ke[0], ke[KC - 1]);
              *(unsigned*)(lds + L_QI + ti * RS + 4 * c) = pk2(qi[0], qi[KC - 1]);
            } else {
              *(bf16_t*)(lds + L_QE + ti * RS + 2 * c) = (bf16_t)pk2(qe[0], 0.f);
              *(bf16_t*)(lds + L_KE + ti * RS + 2 * c) = (bf16_t)pk2(ke[0], 0.f);
              *(bf16_t*)(lds + L_QI + ti * RS + 2 * c) = (bf16_t)pk2(qi[0], 0.f);
            }
            *(unsigned*)(lds + L_G + ti * RS + 4 * c) = rg[i];
          }
        }
#pragma unroll
        for (int e = 0; e < KC; ++e) kp[e][m] = pk2(kend[0][e], kend[1][e]);
      }
#pragma unroll
      for (int e = 0; e < KC; ++e) *(u32x4*)(lds + L_KENDT + (KC * c + e) * TS + 16 * w) = kp[e];
      u32x4 v0, v1;
#pragma unroll
      for (int m = 0; m < 4; ++m) {
        v0[m] = (rv[2 * m] & 0xffffu) | (rv[2 * m + 1] << 16);
        v1[m] = (rv[2 * m] >> 16) | (rv[2 * m + 1] & 0xffff0000u);
      }
      *(u32x4*)(lds + L_VT + (2 * c) * TS + 16 * w) = v0;
      *(u32x4*)(lds + L_VT + (2 * c + 1) * TS + 16 * w) = v1;
      if (w == 0) {
#pragma unroll
        for (int e = 0; e < KC; ++e) DEC[KC * c + e] = __expf(tot[e]);
      }
    }
    __syncthreads();
    load_raw(min(ch + 1, nch - 1));
    if (SO) {
      const char* VTr = lds + L_VT + (32 * w + r32) * TS;
#pragma unroll
      for (int kt = 0; kt < DK / 32; ++kt)
#pragma unroll
        for (int g = 0; g < 4; ++g) {
          const f32x4 d = *(const f32x4*)(DEC + 32 * kt + 8 * g + 4 * h);
          S[kt][4 * g] *= d.x; S[kt][4 * g + 1] *= d.y; S[kt][4 * g + 2] *= d.z; S[kt][4 * g + 3] *= d.w;
        }
#pragma unroll
      for (int s = 0; s < 2; ++s) {
        const bf16x8 bq = *(const bf16x8*)(VTr + s * 32 + h * 16);
#pragma unroll
        for (int kt = 0; kt < DK / 32; ++kt) {
          const bf16x8 a = *(const bf16x8*)(lds + L_KENDT + (32 * kt + r32) * TS + s * 32 + h * 16);
          S[kt] = MFMA32(a, bq, S[kt]);
        }
      }
      __syncthreads();
    } else {
      f32x16 o;
      pc_core<DK>(lds, S, o, w, r32, h);
      {
        float ss = 0.f;
#pragma unroll
        for (int r = 0; r < 16; ++r) ss += o[r] * o[r];
        ss += __shfl_xor(ss, 32);
        if (h == 0) SSQ[w * 32 + r32] = ss;
      }
      __syncthreads();
      {
        const float tot2 = (SSQ[r32] + SSQ[32 + r32]) + (SSQ[64 + r32] + SSQ[96 + r32]);
        const float rstd = rsqrtf(tot2 * (1.f / 128.f) + 1e-6f);
        if (t0 + r32 < ntok) {
          bf16_t* orow = O + (size_t)(row0 + t0 + r32) * 1024 + ocol + 32 * w + 4 * h;
#pragma unroll
          for (int g = 0; g < 4; ++g) {
            const u32x2 gp = *(const u32x2*)(lds + L_G + r32 * RS + (32 * w + 8 * g + 4 * h) * 2);
            const f32x4 nw = *(const f32x4*)(nwp + 32 * w + 8 * g + 4 * h);
            const float y0 = o[4 * g] * rstd * nw.x * bflo(gp[0]);
            const float y1 = o[4 * g + 1] * rstd * nw.y * bfhi(gp[0]);
            const float y2 = o[4 * g + 2] * rstd * nw.z * bflo(gp[1]);
            const float y3 = o[4 * g + 3] * rstd * nw.w * bfhi(gp[1]);
            u32x2 v; v[0] = pk2(y0, y1); v[1] = pk2(y2, y3);
            *(u32x2*)(orow + 8 * g) = v;
          }
        }
      }
    }
  }
  if (s_out) {
#pragma unroll
    for (int kt = 0; kt < DK / 32; ++kt)
#pragma unroll
      for (int r = 0; r < 16; ++r) s_out[(size_t)(32 * kt + crow(r, h)) * 128 + 32 * w + r32] = S[kt][r];
  }
  if (SO && w == 0) {
#pragma unroll
    for (int e = 0; e < KC; ++e) d_out[KC * c + e] = dsum[e];
  }
  __syncthreads();
}

DI void phase_scan_even_a(const Params& p, char* lds, int bid, int G) {
  float* scr = (float*)(p.ws + OFF_MIX);
  const int half = threadIdx.x >> 8; lds += half * HALF_LDS;
  for (int jb = bid * 2; jb < 448 + 1024; jb += G * 2) {
    const int j = jb + half;
    if (j < 448) {
      const int type = j & 1, head = (j >> 1) & 3, b = (j >> 3) & 7, sc = j >> 6;
      const int row0 = b * SEQP + sc_beg(sc), ntok = sc_end(sc) - sc_beg(sc);
      const size_t slot = ((size_t)b * 4 + head) * 7 + sc;
      if (type == 0) scan_even_job<0, true>(p, lds, head, row0, ntok, nullptr, scr + SCR_HG_U + slot * 16384, scr + SCR_HG_D + slot * 128);
      else scan_even_job<1, true>(p, lds, head, row0, ntok, nullptr, scr + SCR_GL_U + slot * 8192, scr + SCR_GL_D + slot * 64);
    } else {
      const int jj = j - 448, type = jj & 1, head = (jj >> 1) & 3, b = jj >> 3;
      const int row0 = T_PROMPT + 4 * b;
      if (type == 0) scan_even_job<0, false>(p, lds, head, row0, 4, p.in[2] + ((size_t)b * 4 + head) * 16384, p.out + OUT_HGS + ((size_t)b * 4 + head) * 16384, nullptr);
      else scan_even_job<1, false>(p, lds, head, row0, 4, p.in[3] + ((size_t)b * 4 + head) * 8192, p.out + OUT_GLS + ((size_t)b * 4 + head) * 8192, nullptr);
    }
  }
}
DI void phase_scan_even_c(const Params& p, int bid, int G) {
  float* scr = (float*)(p.ws + OFF_MIX);
  for (int i = bid * NTHREADS + threadIdx.x; i < 32 * 4096 + 32 * 2048; i += G * NTHREADS) {
    const bool gl = i >= 32 * 4096;
    const int ii = gl ? i - 32 * 4096 : i;
    const int per = gl ? 2048 : 4096, bh = ii / per, e4 = ii - bh * per, k = e4 >> 5;
    float* U = scr + (gl ? SCR_GL_U + (size_t)bh * 7 * 8192 : SCR_HG_U + (size_t)bh * 7 * 16384) + 4 * e4;
    const float* D = scr + (gl ? SCR_GL_D + (size_t)bh * 7 * 64 : SCR_HG_D + (size_t)bh * 7 * 128) + k;
    const int ustride = gl ? 8192 : 16384, dstride = gl ? 64 : 128;
    f32x4 run = {0.f, 0.f, 0.f, 0.f};
#pragma unroll
    for (int sc = 0; sc < 7; ++sc) {
      const float d = __expf(D[sc * dstride]);
      const f32x4 u = *(const f32x4*)(U + (size_t)sc * ustride);
      run = run * d + u;
      *(f32x4*)(U + (size_t)sc * ustride) = run;
    }
  }
}
DI void phase_scan_even_b(const Params& p, char* lds, int bid, int G) {
  float* scr = (float*)(p.ws + OFF_MIX);
  const int half = threadIdx.x >> 8; lds += half * HALF_LDS;
  for (int jb = bid * 2; jb < 512; jb += G * 2) {
    const int j = jb + half;
    {
      const int type = j & 1, head = (j >> 1) & 3, b = (j >> 3) & 7, sc = j >> 6;
      const int row0 = b * SEQP + sc_beg(sc), ntok = sc_end(sc) - sc_beg(sc);
      const size_t slot = ((size_t)b * 4 + head) * 7 + sc - 1;
      if (type == 0) scan_even_job<0, false>(p, lds, head, row0, ntok, sc ? scr + SCR_HG_U + slot * 16384 : nullptr,
                                             sc == NSC - 1 ? p.out + OUT_HGP + ((size_t)b * 4 + head) * 16384 : nullptr, nullptr);
      else scan_even_job<1, false>(p, lds, head, row0, ntok, sc ? scr + SCR_GL_U + slot * 8192 : nullptr,
                                   sc == NSC - 1 ? p.out + OUT_GLP + ((size_t)b * 4 + head) * 8192 : nullptr, nullptr);
    }
  }
}

constexpr int M_BM = 0, M_CM = 8704, M_XS = 17408, M_Z = 26112, M_BT = 34816, M_VT = 45056, M_VENDT = 55296, M_CUM = 65536, M_DT = 65792, M_SSQ = 66048, M_CW = 66560;

DI void phase_conv(const Params& p, int bid, int G) {
  const bf16_t* P = (const bf16_t*)(p.ws + OFF_P);
  bf16_t* O = (bf16_t*)(p.ws + OFF_O);
  bf16_t* HN = (bf16_t*)(p.ws + OFF_HN);
  const float* __restrict__ cwp = p.in[19];
  const float* __restrict__ cbp = p.in[20];
  const int gt = bid * NTHREADS + threadIdx.x, NPAR = (G * NTHREADS) / 384;
  const int cg = gt % 384, r0 = gt / 384, ch = 8 * cg;
  if (r0 >= NPAR) return;
  float w[4][8], bs[8];
#pragma unroll
  for (int k = 0; k < 4; ++k) {
    const f32x4 a = *(const f32x4*)(cwp + k * 3072 + ch), b_ = *(const f32x4*)(cwp + k * 3072 + ch + 4);
    w[k][0] = a.x; w[k][1] = a.y; w[k][2] = a.z; w[k][3] = a.w; w[k][4] = b_.x; w[k][5] = b_.y; w[k][6] = b_.z; w[k][7] = b_.w;
  }
  {
    const f32x4 a = *(const f32x4*)(cbp + ch), b_ = *(const f32x4*)(cbp + ch + 4);
    bs[0] = a.x; bs[1] = a.y; bs[2] = a.z; bs[3] = a.w; bs[4] = b_.x; bs[5] = b_.y; bs[6] = b_.z; bs[7] = b_.w;
  }
  bf16_t* dbase = ch < 2048 ? O + ch : HN + (ch - 2048);
  const int dld = ch < 2048 ? 2048 : 1024;
  for (int run = r0; run < 8 * 258; run += NPAR) {
    const int b = run / 258, t0 = (run - b * 258) * 8, row0 = b * SEQP + t0;
    u32x4 pre[11];
#pragma unroll
    for (int i = 0; i < 11; ++i) {
      const int r = row0 + i - 3;
      pre[i] = (i >= 3 || t0 > 0) ? *(const u32x4*)(P + (size_t)r * LD_OD + 2048 + ch) : (u32x4){0u, 0u, 0u, 0u};
    }
#pragma unroll
    for (int i = 0; i < 8; ++i) {
      u32x4 o;
#pragma unroll
      for (int q = 0; q < 4; ++q) {
        float a0 = bs[2 * q], a1 = bs[2 * q + 1];
#pragma unroll
        for (int k = 0; k < 4; ++k) { a0 += bflo(pre[i + k][q]) * w[k][2 * q]; a1 += bfhi(pre[i + k][q]) * w[k][2 * q + 1]; }
        o[q] = pk2(siluf_(a0), siluf_(a1));
      }
      *(u32x4*)(dbase + (size_t)(row0 + i) * dld) = o;
    }
  }
  for (int sq = r0; sq < 128; sq += NPAR) {
    const int row0 = T_PROMPT + 4 * sq;
    float pf[7][8];
#pragma unroll
    for (int i = 0; i < 3; ++i) {
      const f32x4 a = *(const f32x4*)(p.in[5] + ((size_t)sq * 3 + i) * 3072 + ch), b_ = *(const f32x4*)(p.in[5] + ((size_t)sq * 3 + i) * 3072 + ch + 4);
      pf[i][0] = a.x; pf[i][1] = a.y; pf[i][2] = a.z; pf[i][3] = a.w; pf[i][4] = b_.x; pf[i][5] = b_.y; pf[i][6] = b_.z; pf[i][7] = b_.w;
    }
#pragma unroll
    for (int i = 0; i < 4; ++i) {
      const u32x4 u = *(const u32x4*)(P + (size_t)(row0 + i) * LD_OD + 2048 + ch);
#pragma unroll
      for (int q = 0; q < 4; ++q) { pf[3 + i][2 * q] = bflo(u[q]); pf[3 + i][2 * q + 1] = bfhi(u[q]); }
    }
#pragma unroll
    for (int i = 0; i < 4; ++i) {
      u32x4 o;
#pragma unroll
      for (int q = 0; q < 4; ++q) {
        float a0 = bs[2 * q], a1 = bs[2 * q + 1];
#pragma unroll
        for (int k = 0; k < 4; ++k) { a0 += pf[i + k][2 * q] * w[k][2 * q]; a1 += pf[i + k][2 * q + 1] * w[k][2 * q + 1]; }
        o[q] = pk2(siluf_(a0), siluf_(a1));
      }
      *(u32x4*)(dbase + (size_t)(row0 + i) * dld) = o;
    }
  }
}

template <bool SO>
DI void scan_odd_job(const Params& p, char* lds, const int b, const int hp, const bool smp, const int tbeg, const int tend, const float* s_in, float* s_out, float* d_out) {
  const int tid = threadIdx.x & (HB - 1), c = tid & 63, w = tid >> 6, r32 = c & 31, h = c >> 5;
  const int grp = hp >> 2, hl = w >> 1, headw = 2 * hp + hl;
  const int row0 = (smp ? T_PROMPT + 4 * b : b * SEQP) + tbeg, ntok = tend - tbeg;
  const bf16_t* P = (const bf16_t*)(p.ws + OFF_P);
  bf16_t* O = (bf16_t*)(p.ws + OFF_O);
  const bf16_t* BC = (const bf16_t*)(p.ws + OFF_HN);
  float* CUM = (float*)(lds + M_CUM);
  float* DTL = (float*)(lds + M_DT);
  float* SSQ = (float*)(lds + M_SSQ);
  const int hd_l = 2 * hp + h;
  const float dtb = p.in[21][hd_l], aneg = -__expf(p.in[22][hd_l]);
  const float dsk = p.in[23][headw];
  f32x16 S[4];
  {
    const float* sin = s_in + ((size_t)hl * 64 + 32 * (w & 1) + r32) * 128;
#pragma unroll
    for (int kt = 0; kt < 4; ++kt)
#pragma unroll
      for (int g = 0; g < 4; ++g) {
        f32x4 v = {0.f, 0.f, 0.f, 0.f};
        if (!SO && s_in) v = *(const f32x4*)(sin + 32 * kt + 8 * g + 4 * h);
        S[kt][4 * g] = v.x; S[kt][4 * g + 1] = v.y; S[kt][4 * g + 2] = v.z; S[kt][4 * g + 3] = v.w;
      }
  }
  float dsum = 0.f;
  unsigned rx[8], rb[8], rc[8], rz[8]; float rdt;
  auto load_raw = [&](int ch) {
#pragma unroll
    for (int i = 0; i < 8; ++i) {
      const int t = min(ch * 32 + 8 * w + i, ntok - 1);
      rx[i] = *(const unsigned*)(O + (size_t)(row0 + t) * 2048 + hp * 128 + 2 * c);
      rb[i] = *(const unsigned*)(BC + (size_t)(row0 + t) * 1024 + grp * 128 + 2 * c);
      if (!SO) {
        rc[i] = *(const unsigned*)(BC + (size_t)(row0 + t) * 1024 + 512 + grp * 128 + 2 * c);
        rz[i] = *(const unsigned*)(P + (size_t)(row0 + t) * LD_OD + hp * 128 + 2 * c);
      }
    }
    {
      const int t = min(ch * 32 + r32, ntok - 1);
      rdt = bflo((unsigned)P[(size_t)(row0 + t) * LD_OD + 5120 + hd_l]);
    }
  };
  const int nch = __builtin_amdgcn_readfirstlane((ntok + 31) >> 5);
  load_raw(0);
  for (int ch = 0; ch < nch; ++ch) {
    const int t0 = ch * 32;
    {
      const float xdt = rdt + dtb;
      float dt = xdt > 20.f ? xdt : __logf(1.f + __expf(xdt));
      dt = (t0 + r32 < ntok) ? dt : 0.f;
      float cs = dt * aneg;
#pragma unroll
      for (int d = 1; d < 32; d <<= 1) { const float o_ = __shfl_up(cs, d, 32); if (r32 >= d) cs += o_; }
      if (w == 0) { CUM[h * 32 + r32] = cs; DTL[h * 32 + r32] = dt; }
    }
    {
#pragma unroll
      for (int i = 0; i < 8; ++i) {
        if (!SO) {
          *(unsigned*)(lds + M_BM + (8 * w + i) * RS + 4 * c) = rb[i];
          *(unsigned*)(lds + M_CM + (8 * w + i) * RS + 4 * c) = rc[i];
          *(unsigned*)(lds + M_XS + (8 * w + i) * RS + 4 * c) = rx[i];
          *(unsigned*)(lds + M_Z + (8 * w + i) * RS + 4 * c) = rz[i];
        }
      }
      u32x4 b0, b1;
#pragma unroll
      for (int m = 0; m < 4; ++m) {
        b0[m] = (rb[2 * m] & 0xffffu) | (rb[2 * m + 1] << 16);
        b1[m] = (rb[2 * m] >> 16) | (rb[2 * m + 1] & 0xffff0000u);
      }
      *(u32x4*)(lds + M_BT + (2 * c) * TS + 16 * w) = b0;
      *(u32x4*)(lds + M_BT + (2 * c + 1) * TS + 16 * w) = b1;
    }
    __syncthreads();
    {
      const int hx = c >> 5;
      const float last = CUM[hx * 32 + 31];
      float vt[8][2], ve[8][2];
#pragma unroll
      for (int i = 0; i < 8; ++i) {
        const int ti = 8 * w + i;
        const float dt = DTL[hx * 32 + ti], cm = CUM[hx * 32 + ti];
        const float ee = __expf(last - cm);
        vt[i][0] = bflo(rx[i]) * dt; vt[i][1] = bfhi(rx[i]) * dt;
        ve[i][0] = vt[i][0] * ee; ve[i][1] = vt[i][1] * ee;
      }
#pragma unroll
      for (int e = 0; e < 2; ++e) {
        u32x4 pv, pe;
#pragma unroll
        for (int m = 0; m < 4; ++m) { pv[m] = pk2(vt[2 * m][e], vt[2 * m + 1][e]); pe[m] = pk2(ve[2 * m][e], ve[2 * m + 1][e]); }
        if (!SO) *(u32x4*)(lds + M_VT + (2 * c + e) * TS + 16 * w) = pv;
        *(u32x4*)(lds + M_VENDT + (2 * c + e) * TS + 16 * w) = pe;
      }
    }
    __syncthreads();
    load_raw(min(ch + 1, nch - 1));
    f32x16 o;
    const float lastw = CUM[hl * 32 + 31];
    dsum += lastw;
    if (!SO) {
      const char* BMr = lds + M_BM + r32 * RS;
      const char* CMr = lds + M_CM + r32 * RS;
      f32x16 sc; zero16(sc);
#pragma unroll
      for (int s = 0; s < 8; ++s) {
        const bf16x8 a = *(const bf16x8*)(BMr + s * 32 + h * 16);
        const bf16x8 bq = *(const bf16x8*)(CMr + s * 32 + h * 16);
        sc = MFMA32(a, bq, sc);
      }
      const float ci = CUM[hl * 32 + r32];
#pragma unroll
      for (int g = 0; g < 4; ++g) {
        const f32x4 cj = *(const f32x4*)(CUM + hl * 32 + 8 * g + 4 * h);
#pragma unroll
        for (int e = 0; e < 4; ++e) {
          const int j = 8 * g + 4 * h + e;
          const float cje = e == 0 ? cj.x : (e == 1 ? cj.y : (e == 2 ? cj.z : cj.w));
          sc[4 * g + e] = (j <= r32) ? sc[4 * g + e] * __expf(ci - cje) : 0.f;
        }
      }
      const bf16x8 scb0 = pack8<0>(sc), scb1 = pack8<1>(sc);
      zero16(o);
#pragma unroll
      for (int kt = 0; kt < 4; ++kt) {
        {
          const bf16x8 a = pack8<0>(S[kt]);
          const s16x4 lo = *(const s16x4*)(CMr + (32 * kt + 4 * h) * 2), hi = *(const s16x4*)(CMr + (32 * kt + 8 + 4 * h) * 2);
          o = MFMA32(a, cat8(lo, hi), o);
        }
        {
          const bf16x8 a = pack8<1>(S[kt]);
          const s16x4 lo = *(const s16x4*)(CMr + (32 * kt + 16 + 4 * h) * 2), hi = *(const s16x4*)(CMr + (32 * kt + 24 + 4 * h) * 2);
          o = MFMA32(a, cat8(lo, hi), o);
        }
      }
      const float ei = __expf(ci);
#pragma unroll
      for (int r = 0; r < 16; ++r) o[r] *= ei;
      const char* VTr = lds + M_VT + (32 * w + r32) * TS;
      {
        const s16x4 lo = *(const s16x4*)(VTr + (4 * h) * 2), hi = *(const s16x4*)(VTr + (8 + 4 * h) * 2);
        o = MFMA32(cat8(lo, hi), scb0, o);
      }
      {
        const s16x4 lo = *(const s16x4*)(VTr + (16 + 4 * h) * 2), hi = *(const s16x4*)(VTr + (24 + 4 * h) * 2);
        o = MFMA32(cat8(lo, hi), scb1, o);
      }
    }
    {
      const float el = __expf(lastw);
#pragma unroll
      for (int kt = 0; kt < 4; ++kt)
#pragma unroll
        for (int r = 0; r < 16; ++r) S[kt][r] *= el;
      const char* VEr = lds + M_VENDT + (32 * w + r32) * TS;
#pragma unroll
      for (int s = 0; s < 2; ++s) {
        const bf16x8 bq = *(const bf16x8*)(VEr + s * 32 + h * 16);
#pragma unroll
        for (int kt = 0; kt < 4; ++kt) {
          const bf16x8 a = *(const bf16x8*)(lds + M_BT + (32 * kt + r32) * TS + s * 32 + h * 16);
          S[kt] = MFMA32(a, bq, S[kt]);
        }
      }
    }
    if (!SO) {
      float y[16]; float ss = 0.f;
#pragma unroll
      for (int g = 0; g < 4; ++g) {
        const u32x2 xp = *(const u32x2*)(lds + M_XS + r32 * RS + (32 * w + 8 * g + 4 * h) * 2);
        const u32x2 zp = *(const u32x2*)(lds + M_Z + r32 * RS + (32 * w + 8 * g + 4 * h) * 2);
        y[4 * g] = (o[4 * g] + dsk * bflo(xp[0])) * bflo(zp[0]);
        y[4 * g + 1] = (o[4 * g + 1] + dsk * bfhi(xp[0])) * bfhi(zp[0]);
        y[4 * g + 2] = (o[4 * g + 2] + dsk * bflo(xp[1])) * bflo(zp[1]);
        y[4 * g + 3] = (o[4 * g + 3] + dsk * bfhi(xp[1])) * bfhi(zp[1]);
      }
#pragma unroll
      for (int r = 0; r < 16; ++r) ss += y[r] * y[r];
      ss += __shfl_xor(ss, 32);
      if (h == 0) SSQ[w * 32 + r32] = ss;
      if (t0 + r32 < ntok) {
        bf16_t* orow = O + (size_t)(row0 + t0 + r32) * 2048 + hp * 128 + 32 * w + 4 * h;
#pragma unroll
        for (int g = 0; g < 4; ++g) { u32x2 v; v[0] = pk2(y[4 * g], y[4 * g + 1]); v[1] = pk2(y[4 * g + 2], y[4 * g + 3]); *(u32x2*)(orow + 8 * g) = v; }
      }
    }
    __syncthreads();
    if (!SO && tid < 32 && t0 + tid < ntok) {
      float* q = (float*)(p.ws + OFF_SSQ);
      q[(size_t)(row0 + t0 + tid) * 16 + hp] = (SSQ[tid] + SSQ[32 + tid]) + (SSQ[64 + tid] + SSQ[96 + tid]);
    }
  }
  if (s_out) {
    float* so = s_out + ((size_t)hl * 64 + 32 * (w & 1) + r32) * 128;
#pragma unroll
    for (int kt = 0; kt < 4; ++kt)
#pragma unroll
      for (int g = 0; g < 4; ++g) {
        f32x4 v = {S[kt][4 * g], S[kt][4 * g + 1], S[kt][4 * g + 2], S[kt][4 * g + 3]};
        *(f32x4*)(so + 32 * kt + 8 * g + 4 * h) = v;
      }
  }
  if (SO && (w & 1) == 0 && c == 0) d_out[hl * 7] = dsum;
  __syncthreads();
}

DI void phase_scan_odd_a(const Params& p, char* lds, int bid, int G) {
  float* scr = (float*)(p.ws + OFF_MIX);
  const int half = threadIdx.x >> 8; lds += half * HALF_LDS;
  for (int jb = bid * 2; jb < 896 + 2048; jb += G * 2) {
    const int j = jb + half;
    if (j >= 896) {
      const int jj = j - 896, hp = jj & 15, b = jj >> 4;
      scan_odd_job<false>(p, lds, b, hp, true, 0, 4, p.in[4] + ((size_t)b * 32 + 2 * hp) * 8192, p.out + OUT_SSS + ((size_t)b * 32 + 2 * hp) * 8192, nullptr);
      continue;
    }
    const int hp = j & 15, b = (j >> 4) & 7, sc = j >> 7;
    float* U = scr + SCR_SS_U + ((((size_t)b * 16 + hp) * 7 + sc) * 2) * 8192;
    float* D = scr + SCR_SS_D + ((size_t)b * 32 + 2 * hp) * 7 + sc;
    scan_odd_job<true>(p, lds, b, hp, false, sc_beg(sc), sc_end(sc), nullptr, U, D);
  }
}
DI void phase_scan_odd_c(const Params& p, int bid, int G) {
  float* scr = (float*)(p.ws + OFF_MIX);
  for (int i = bid * NTHREADS + threadIdx.x; i < 128 * 2 * 2048; i += G * NTHREADS) {
    const int e4 = i & 2047, hd = (i >> 11) & 1, bhp = i >> 12;
    float* U = scr + SCR_SS_U + ((size_t)bhp * 7 * 2 + hd) * 8192 + 4 * e4;
    const float* D = scr + SCR_SS_D + ((size_t)(bhp >> 4) * 32 + 2 * (bhp & 15) + hd) * 7;
    f32x4 run = {0.f, 0.f, 0.f, 0.f};
#pragma unroll
    for (int sc = 0; sc < 7; ++sc) {
      const float d = __expf(D[sc]);
      const f32x4 u = *(const f32x4*)(U + (size_t)sc * 16384);
      run = run * d + u;
      *(f32x4*)(U + (size_t)sc * 16384) = run;
    }
  }
}
DI void phase_scan_odd_b(const Params& p, char* lds, int bid, int G) {
  float* scr = (float*)(p.ws + OFF_MIX);
  const int half = threadIdx.x >> 8; lds += half * HALF_LDS;
  for (int jb = bid * 2; jb < 1024; jb += G * 2) {
    const int j = jb + half;
    {
      const int hp = j & 15, b = (j >> 4) & 7, sc = j >> 7;
      const float* s_in = sc ? scr + SCR_SS_U + ((((size_t)b * 16 + hp) * 7 + sc - 1) * 2) * 8192 : nullptr;
      float* s_out = sc == NSC - 1 ? p.out + OUT_SSP + ((size_t)b * 32 + 2 * hp) * 8192 : nullptr;
      scan_odd_job<false>(p, lds, b, hp, false, sc_beg(sc), sc_end(sc), s_in, s_out, nullptr);
    }
  }
  const bf16_t* P = (const bf16_t*)(p.ws + OFF_P);
  for (int i = bid * NTHREADS + threadIdx.x; i < 136 * 3 * 3072; i += G * NTHREADS) {
    const int ch = i % 3072, r = i / 3072, j = r % 3, b = r / 3;
    if (b < 8) p.out[OUT_CVP + ((size_t)b * 3 + j) * 3072 + ch] = bflo((unsigned)P[(size_t)(b * SEQP + 2061 + j) * LD_OD + 2048 + ch]);
    else { const int bs = b - 8; p.out[OUT_CVS + ((size_t)bs * 3 + j) * 3072 + ch] = bflo((unsigned)P[(size_t)(T_PROMPT + 4 * bs + 1 + j) * LD_OD + 2048 + ch]); }
  }
}

#define XB_TMO      128
#define XB_XCNT(j)  (256  + 64 * (j))
#define XB_XSUB(j)  (1280 + 64 * (j))
#define XB_XGEN(j)  (2304 + 64 * (j))
#define XB_TOP      3328
#define XB_TOPGEN   3392
#define XCD_BAR_WORDS 3456
#define XB_SPIN_CAP (1u << 20)
#define LAS __attribute__((address_space(3)))
DI unsigned xb_ld(unsigned* p) { return __hip_atomic_load(p, __ATOMIC_RELAXED, __HIP_MEMORY_SCOPE_AGENT); }
DI unsigned xb_add(unsigned* p, unsigned v) { return __hip_atomic_fetch_add(p, v, __ATOMIC_RELAXED, __HIP_MEMORY_SCOPE_AGENT); }
DI unsigned xb_xcc_id() { return (unsigned)__builtin_amdgcn_s_getreg((3 << 11) | 20) & 0xFu; }
#define XB_SPIN(cond, bar) do { unsigned _sp = 0; while (cond) { __builtin_amdgcn_s_sleep(1); \
    if ((++_sp & 255u) == 0u) { if (xb_ld(&(bar)[XB_TMO])) break; if (_sp > XB_SPIN_CAP) { atomicAdd(&(bar)[XB_TMO], 1u); break; } } } } while (0)
struct XcdBarrier { unsigned* bar; unsigned x; volatile LAS unsigned* st; };
DI XcdBarrier xcd_barrier_post(unsigned* bar, volatile LAS unsigned* st) {
  XcdBarrier b; b.bar = bar; b.x = xb_xcc_id(); b.st = st;
  if (threadIdx.x == 0) (void)xb_add(&bar[XB_XCNT(b.x)], 1u);
  return b;
}
DI void xcd_barrier_complete(unsigned* bar, unsigned x, unsigned& nloc, unsigned& nx) {
  const unsigned G = gridDim.x * gridDim.y * gridDim.z;
  unsigned sum, cnt, mine, sp = 0u;
  for (;;) {
    sum = 0u; cnt = 0u; mine = 0u;
#pragma unroll
    for (unsigned j = 0; j < 16; ++j) { const unsigned c = xb_ld(&bar[XB_XCNT(j)]); sum += c; cnt += (c > 0u) ? 1u : 0u; mine = (j == x) ? c : mine; }
    if (sum == G) break;
    __builtin_amdgcn_s_sleep(1);
    if ((++sp & 255u) == 0u) { if (xb_ld(&bar[XB_TMO])) break; if (sp > XB_SPIN_CAP) { atomicAdd(&bar[XB_TMO], 1u); break; } }
  }
  nloc = mine > 0u ? mine : 1u; nx = cnt > 0u ? cnt : 1u;
}
DI void xcd_barrier(const XcdBarrier& b) {
  asm volatile("s_waitcnt vmcnt(0)" ::: "memory");
  __syncthreads();
  if (threadIdx.x == 0) {
    unsigned* bar = b.bar;
    __builtin_amdgcn_s_waitcnt(0);
    unsigned nloc = b.st[0], nx = b.st[1];
    if (nloc == 0u) { xcd_barrier_complete(bar, b.x, nloc, nx); b.st[0] = nloc; b.st[1] = nx; }
    const unsigned old = xb_add(&bar[XB_XSUB(b.x)], 1u);
    const unsigned gen = old / nloc;
    if (old + 1u == (gen + 1u) * nloc) {
      __builtin_amdgcn_fence(__ATOMIC_RELEASE, "agent");
      asm volatile("s_waitcnt vmcnt(0)" ::: "memory");
      const unsigned og = xb_add(&bar[XB_TOP], 1u);
      const unsigned tg = og / nx;
      if (og + 1u == (tg + 1u) * nx) xb_add(&bar[XB_TOPGEN], 1u);
      else XB_SPIN(xb_ld(&bar[XB_TOPGEN]) == tg, bar);
      __builtin_amdgcn_fence(__ATOMIC_ACQUIRE, "agent");
      xb_add(&bar[XB_XGEN(b.x)], 1u);
      asm volatile("s_waitcnt vmcnt(0)" ::: "memory");
    } else {
      XB_SPIN(xb_ld(&bar[XB_XGEN(b.x)]) == gen, bar);
      __builtin_amdgcn_fence(__ATOMIC_ACQUIRE, "agent");
      asm volatile("s_waitcnt vmcnt(0)" ::: "memory");
    }
  }
  __syncthreads();
}

constexpr int N_PHASES = 21;
#ifndef ONLY_PHASE
#define ONLY_PHASE -1
#endif
#define PHASE(k, body) do { if ((ONLY_PHASE < 0 || ONLY_PHASE == (k)) && ph_lo <= (k) && (k) <= ph_hi) { body; } if (ph_lo <= (k) && (k) < ph_hi) xcd_barrier(xb); } while (0)

__global__ void __launch_bounds__(NTHREADS, 2) fwd_mega(Params p, int ph_lo, int ph_hi) {
  extern __shared__ __attribute__((aligned(16))) char lds[];
  cg::grid_group grid = cg::this_grid();
  const int G = gridDim.x, bid = blockIdx.x;
  if (ph_lo > 1000) grid.sync();
  volatile LAS unsigned* xst = (volatile LAS unsigned*)(lds + 2 * HALF_LDS);
  if (threadIdx.x == 0) { xst[0] = 0u; xst[1] = 0u; }
  __syncthreads();
  XcdBarrier xb = xcd_barrier_post((unsigned*)(p.ws + OFF_BAR), xst);
  bf16_t* HN = (bf16_t*)(p.ws + OFF_HN);
  bf16_t* Pb = (bf16_t*)(p.ws + OFF_P);
  bf16_t* Ob = (bf16_t*)(p.ws + OFF_O);
  float* MIX = (float*)(p.ws + OFF_MIX);
  PHASE(0, phase_prep(p, lds, bid, G));
  PHASE(1, gemm_run(lds, HN, (const bf16_t*)(p.ws + OFF_WT_EVIN), LD_EV, 1024, EpiStoreBf16{Pb, LD_EV, (1u << 6) | (1u << 7) | (1u << 12) | (1u << 13)}, bid, G));
  PHASE(2, phase_scan_even_a(p, lds, bid, G));
  PHASE(3, phase_scan_even_c(p, bid, G));
  PHASE(4, phase_scan_even_b(p, lds, bid, G));
  PHASE(5, gemm_n1024<false>(lds, Ob, (const bf16_t*)(p.ws + OFF_WT_EVOUT), 1024, EpiResNorm<false>{(bf16_t*)(p.ws + OFF_X), (bf16_t*)(p.ws + OFF_HN), p.in[9], p.in[10], nullptr, (float*)(p.ws + OFF_XB) + 0 * (SZ_XB_SET / 4), (unsigned*)(p.ws + OFF_CNT) + 0 * (SZ_CNT_SET / 4), (unsigned*)(p.ws + OFF_BAR) + 64}, (float*)Pb, bid, G));
  PHASE(6, phase_rowwise(p, p.in[9], p.in[10], false, (const float*)Pb, 4, M_MAIN, bid, G));
  PHASE(7, gemm_run(lds, HN, (const bf16_t*)(p.ws + OFF_WT_GU), 5632, 1024, EpiSwiglu{Pb, 2816}, bid, G));
  PHASE(8, gemm_n1024<false>(lds, Pb, (const bf16_t*)(p.ws + OFF_WT_DN), 2816, EpiResNorm<false>{(bf16_t*)(p.ws + OFF_X), (bf16_t*)(p.ws + OFF_HN), p.in[11], p.in[8] + 1024, nullptr, (float*)(p.ws + OFF_XB) + 2 * (SZ_XB_SET / 4), (unsigned*)(p.ws + OFF_CNT) + 2 * (SZ_CNT_SET / 4), (unsigned*)(p.ws + OFF_BAR) + 64}, (float*)Ob, bid, G));
  PHASE(9, phase_rowwise(p, p.in[11], p.in[8] + 1024, false, (const float*)Ob, 11, M_MAIN, bid, G));
  PHASE(10, gemm_run(lds, HN, (const bf16_t*)(p.ws + OFF_WT_ODIN), LD_OD, 1024, EpiStoreBf16{Pb, LD_OD, 0xffu}, bid, G));
  PHASE(11, phase_conv(p, bid, G));
  PHASE(12, phase_scan_odd_a(p, lds, bid, G));
  PHASE(13, phase_scan_odd_c(p, bid, G));
  PHASE(14, phase_scan_odd_b(p, lds, bid, G));
  PHASE(15, phase_groupnorm(p, bid, G));
  PHASE(16, gemm_n1024<false>(lds, Ob, (const bf16_t*)(p.ws + OFF_WT_ODOUT), 2048, EpiResNorm<false>{(bf16_t*)(p.ws + OFF_X), (bf16_t*)(p.ws + OFF_HN), p.in[9] + 1024, p.in[10] + 1024, nullptr, (float*)(p.ws + OFF_XB) + 4 * (SZ_XB_SET / 4), (unsigned*)(p.ws + OFF_CNT) + 4 * (SZ_CNT_SET / 4), (unsigned*)(p.ws + OFF_BAR) + 64}, (float*)Pb, bid, G));
  PHASE(17, phase_rowwise(p, p.in[9] + 1024, p.in[10] + 1024, false, (const float*)Pb, 8, M_MAIN, bid, G));
  PHASE(18, gemm_run(lds, HN, (const bf16_t*)(p.ws + OFF_WT_GU + SZ_WT_GU1), 5632, 1024, EpiSwiglu{Pb, 2816}, bid, G));
  PHASE(19, gemm_n1024<true>(lds, Pb, (const bf16_t*)(p.ws + OFF_WT_DN + SZ_WT_DN1), 2816, EpiResNorm<true>{(bf16_t*)(p.ws + OFF_X), (bf16_t*)(p.ws + OFF_HN), p.in[11] + 1024, nullptr, p.out + OUT_YP, (float*)(p.ws + OFF_XB) + 6 * (SZ_XB_SET / 4), (unsigned*)(p.ws + OFF_CNT) + 6 * (SZ_CNT_SET / 4), (unsigned*)(p.ws + OFF_BAR) + 64}, (float*)Ob, bid, G));
  PHASE(20, phase_rowwise(p, p.in[11] + 1024, nullptr, true, (const float*)Ob, 11, M_MAIN, bid, G));
}

extern "C" void kernel_launch(void* const* d_in, const int* in_sizes, int n_in, void* d_out, int out_size, void* d_ws, size_t ws_size, hipStream_t stream) {
  static int grid_blocks = 0;
  if (!grid_blocks) {
    int dev = 0, cus = 0, per_cu = 0;
    hipGetDevice(&dev);
    hipDeviceGetAttribute(&cus, hipDeviceAttributeMultiprocessorCount, dev);
    hipFuncSetAttribute((const void*)fwd_mega, hipFuncAttributeMaxDynamicSharedMemorySize, LDS_BYTES);
    hipOccupancyMaxActiveBlocksPerMultiprocessor(&per_cu, (const void*)fwd_mega, NTHREADS, LDS_BYTES);
    if (per_cu < 1) per_cu = 1;
    if (per_cu > 1) per_cu = 1;
    grid_blocks = cus * per_cu;
    if (ws_size < WS_END) fprintf(stderr, "kernel_launch: workspace too small: %zu < %zu\n", ws_size, (size_t)WS_END);
  }
  Params p{};
  for (int i = 0; i < 29; ++i) p.in[i] = (const float*)d_in[i];
  p.out = (float*)d_out;
  p.ws = (char*)d_ws;
  (void)hipMemsetAsync((char*)d_ws + OFF_BAR, 0, 16384 + 8 * SZ_CNT_SET, stream);
#if ONE_LAUNCH
  int lo = 0, hi = N_PHASES - 1;
  void* args[] = {&p, &lo, &hi};
  hipError_t e = hipLaunchCooperativeKernel((const void*)fwd_mega, dim3(grid_blocks), dim3(NTHREADS), args, LDS_BYTES, stream);
  if (e != hipSuccess) fprintf(stderr, "cooperative launch failed: %s (grid %d)\n", hipGetErrorString(e), grid_blocks);
#else
  for (int ph = 0; ph < N_PHASES; ++ph) {
    int lo = ph, hi = ph;
    void* args[] = {&p, &lo, &hi};
    hipError_t e = hipLaunchCooperativeKernel((const void*)fwd_mega, dim3(grid_blocks), dim3(NTHREADS), args, LDS_BYTES, stream);
    if (e != hipSuccess) fprintf(stderr, "launch failed: %s (grid %d)\n", hipGetErrorString(e), grid_blocks);
  }
#endif
}
```

```cpp
#include <hip/hip_runtime.h>
#include <hip/hip_cooperative_groups.h>
#include <cstdio>
#include <cstdint>
namespace cg = cooperative_groups;

#ifndef ONE_LAUNCH
#define ONE_LAUNCH 1
#endif

#define DI __device__ __forceinline__
typedef unsigned short bf16_t;
typedef short bf16x8 __attribute__((ext_vector_type(8)));
typedef short s16x4 __attribute__((ext_vector_type(4)));
typedef float f32x16 __attribute__((ext_vector_type(16)));
typedef float f32x4 __attribute__((ext_vector_type(4)));
typedef float f32x2 __attribute__((ext_vector_type(2)));
typedef unsigned u32x4 __attribute__((ext_vector_type(4)));
typedef unsigned u32x2 __attribute__((ext_vector_type(2)));
typedef __bf16 bf16v2 __attribute__((ext_vector_type(2)));
#define MFMA32(a, b, c) __builtin_amdgcn_mfma_f32_32x32x16_bf16((a), (b), (c), 0, 0, 0)

constexpr int T_ALL = 17024, T_PAD = 17152, T_PROMPT = 16512, SEQP = 2064, NTHREADS = 512, HB = 256  ;
constexpr int LD_EV = 3840, LD_OD = 5376;
constexpr int HALF_LDS = 75776;
constexpr int LDS_BYTES = 2 * HALF_LDS + 32;
constexpr int M_MAIN = 16384;

constexpr size_t OFF_WT_EVIN = 0;
constexpr size_t OFF_WT_EVOUT = OFF_WT_EVIN + (size_t)3840 * 1024 * 2;
constexpr size_t OFF_WT_GU = OFF_WT_EVOUT + (size_t)1024 * 1024 * 2;
constexpr size_t SZ_WT_GU1 = (size_t)5632 * 1024 * 2;
constexpr size_t OFF_WT_DN = OFF_WT_GU + 2 * SZ_WT_GU1;
constexpr size_t SZ_WT_DN1 = (size_t)1024 * 2816 * 2;
constexpr size_t OFF_WT_ODIN = OFF_WT_DN + 2 * SZ_WT_DN1;
constexpr size_t OFF_WT_ODOUT = OFF_WT_ODIN + (size_t)5376 * 1024 * 2;
constexpr size_t OFF_X = OFF_WT_ODOUT + (size_t)1024 * 2048 * 2;
constexpr size_t OFF_HN = OFF_X + (size_t)T_PAD * 1024 * 4;
constexpr size_t OFF_P = OFF_HN + (size_t)T_PAD * 1024 * 2;
constexpr size_t OFF_O = OFF_P + (size_t)T_PAD * 5376 * 2;
constexpr size_t OFF_MIX = OFF_O + (size_t)T_PAD * 2048 * 2;
constexpr size_t OFF_SSQ = OFF_MIX + (size_t)T_PAD * 1024 * 4;
constexpr size_t OFF_BAR = OFF_SSQ + (size_t)T_PAD * 16 * 4;
constexpr size_t OFF_CNT = OFF_BAR + 16384;
constexpr size_t SZ_CNT_SET = 64 * 256;
constexpr size_t OFF_XB = OFF_CNT + 8 * SZ_CNT_SET;
constexpr size_t SZ_XB_SET = (size_t)64 * 256 * 4 * 4;
constexpr size_t WS_END = OFF_XB + 8 * SZ_XB_SET;

constexpr size_t OUT_YP = 0;
constexpr size_t OUT_YS = 16777216;
constexpr size_t OUT_HGP = OUT_YS + 524288;
constexpr size_t OUT_GLP = OUT_HGP + 524288;
constexpr size_t OUT_SSP = OUT_GLP + 262144;
constexpr size_t OUT_CVP = OUT_SSP + 2097152;
constexpr size_t OUT_HGS = OUT_CVP + 73728;
constexpr size_t OUT_GLS = OUT_HGS + 8388608;
constexpr size_t OUT_SSS = OUT_GLS + 4194304;
constexpr size_t OUT_CVS = OUT_SSS + 33554432;

struct Params { const float* in[29]; float* out; char* ws; };

DI unsigned pk2(float lo, float hi) { f32x2 v = {lo, hi}; bf16v2 b = __builtin_convertvector(v, bf16v2); return __builtin_bit_cast(unsigned, b); }
DI float bflo(unsigned u) { return __uint_as_float(u << 16); }
DI float bfhi(unsigned u) { return __uint_as_float(u & 0xffff0000u); }
DI f32x4 ld_bf4(const bf16_t* p) { const u32x2 u = *(const u32x2*)p; return (f32x4){bflo(u[0]), bfhi(u[0]), bflo(u[1]), bfhi(u[1])}; }
DI void st_bf4(bf16_t* p, f32x4 v) { u32x2 u; u[0] = pk2(v.x, v.y); u[1] = pk2(v.z, v.w); *(u32x2*)p = u; }
DI float sigmoidf_(float x) { return __builtin_amdgcn_rcpf(1.f + __expf(-x)); }
DI float siluf_(float x) { return x * sigmoidf_(x); }
DI int crow(int r, int h) { return (r & 3) + 8 * (r >> 2) + 4 * h; }
DI bf16x8 cat8(s16x4 lo, s16x4 hi) { return __builtin_shufflevector(lo, hi, 0, 1, 2, 3, 4, 5, 6, 7); }
template <int S> DI bf16x8 pack8(const f32x16& x) {
  u32x4 p;
  p[0] = pk2(x[8 * S + 0], x[8 * S + 1]); p[1] = pk2(x[8 * S + 2], x[8 * S + 3]);
  p[2] = pk2(x[8 * S + 4], x[8 * S + 5]); p[3] = pk2(x[8 * S + 6], x[8 * S + 7]);
  return __builtin_bit_cast(bf16x8, p);
}
DI float wave_sum(float v) {
#pragma unroll
  for (int o = 1; o < 64; o <<= 1) v += __shfl_xor(v, o);
  return v;
}
DI void zero16(f32x16& a) {
#pragma unroll
  for (int i = 0; i < 16; ++i) a[i] = 0.f;
}

DI void transpose_tile(const float* __restrict__ W, int K, int N, bf16_t* Wt, int mode, int kt, int nt, float* tile, bool active) {
  const int tid = threadIdx.x & (HB - 1), k0 = kt * 64, n0 = nt * 64;
  if (active) {
    const int c = tid & 63, r0 = tid >> 6, n = n0 + c;
#pragma unroll
    for (int i = 0; i < 16; ++i) { const int k = r0 + 4 * i; tile[k * 65 + c] = (n < N) ? W[(size_t)(k0 + k) * N + n] : 0.f; }
  }
  __syncthreads();
  if (active) {
    const int nl = tid >> 2, kc = (tid & 3) * 16, n = n0 + nl;
    int drow = n;
    if (mode == 1) drow = (n >> 7) * 256 + (n & 127);
    if (mode == 2) drow = (n >> 7) * 256 + 128 + (n & 127);
    u32x4 o0, o1;
#pragma unroll
    for (int j = 0; j < 4; ++j) {
      o0[j] = pk2(tile[(kc + 2 * j) * 65 + nl], tile[(kc + 2 * j + 1) * 65 + nl]);
      o1[j] = pk2(tile[(kc + 8 + 2 * j) * 65 + nl], tile[(kc + 8 + 2 * j + 1) * 65 + nl]);
    }
    u32x4* d = (u32x4*)(Wt + (size_t)drow * K + k0 + kc);
    d[0] = o0; d[1] = o1;
  }
  __syncthreads();
}

DI void rms_row_to_bf16(const f32x4 (&v)[4], const float* __restrict__ wn, bf16_t* dst, int lane) {
  float s = 0.f;
#pragma unroll
  for (int j = 0; j < 4; ++j) s += v[j].x * v[j].x + v[j].y * v[j].y + v[j].z * v[j].z + v[j].w * v[j].w;
  const float rstd = rsqrtf(wave_sum(s) * (1.f / 1024.f) + 1e-6f);
#pragma unroll
  for (int j = 0; j < 4; ++j) {
    const f32x4 g = *(const f32x4*)(wn + 256 * j + 4 * lane);
    u32x2 o; o[0] = pk2(v[j].x * rstd * g.x, v[j].y * rstd * g.y); o[1] = pk2(v[j].z * rstd * g.z, v[j].w * rstd * g.w);
    *(u32x2*)(dst + 256 * j + 4 * lane) = o;
  }
}

DI void phase_prep(const Params& p, char* lds, int bid, int G) {
  const int half = threadIdx.x >> 8;
  float* tile = (float*)(lds + half * HALF_LDS);
  constexpr int NT_TILES = 960 + 256 + 1408 + 1408 + 1408 + 1344 + 512;
  for (int tb = bid * 2; tb < NT_TILES; tb += G * 2) {
    const int t = tb + half;
    const bool active = t < NT_TILES;
    const float* W = p.in[12]; int K = 1024, N = 3600, nnt = 60, mode = 0; bf16_t* dst = (bf16_t*)(p.ws + OFF_WT_EVIN); int r = active ? t : 0;
    if (r < 960) { }
    else if ((r -= 960) < 256) { W = p.in[17]; K = 1024; N = 1024; nnt = 16; dst = (bf16_t*)(p.ws + OFF_WT_EVOUT); }
    else if ((r -= 256) < 1408) { const int l = r / 704; r -= l * 704; W = p.in[26] + (size_t)l * 1024 * 2816; K = 1024; N = 2816; nnt = 44; mode = 1; dst = (bf16_t*)(p.ws + OFF_WT_GU + l * SZ_WT_GU1); }
    else if ((r -= 1408) < 1408) { const int l = r / 704; r -= l * 704; W = p.in[27] + (size_t)l * 1024 * 2816; K = 1024; N = 2816; nnt = 44; mode = 2; dst = (bf16_t*)(p.ws + OFF_WT_GU + l * SZ_WT_GU1); }
    else if ((r -= 1408) < 1408) { const int l = r / 704; r -= l * 704; W = p.in[28] + (size_t)l * 2816 * 1024; K = 2816; N = 1024; nnt = 16; dst = (bf16_t*)(p.ws + OFF_WT_DN + l * SZ_WT_DN1); }
    else if ((r -= 1408) < 1344) { W = p.in[18]; K = 1024; N = 5152; nnt = 84; dst = (bf16_t*)(p.ws + OFF_WT_ODIN); }
    else { r -= 1344; W = p.in[25]; K = 2048; N = 1024; nnt = 16; dst = (bf16_t*)(p.ws + OFF_WT_ODOUT); }
    const int kt = r / nnt, nt = r - kt * nnt;
    transpose_tile(W, K, N, dst, mode, kt, nt, tile, active);
  }
  const int lane = threadIdx.x & 63, w = threadIdx.x >> 6;
  bf16_t* X = (bf16_t*)(p.ws + OFF_X);
  bf16_t* HN = (bf16_t*)(p.ws + OFF_HN);
  for (int row = bid * 8 + w; row < T_ALL; row += G * 8) {
    const float* src;
    if (row < T_PROMPT) { const int b = row / SEQP, t = row - b * SEQP; src = (t < 16) ? p.in[6] + (size_t)t * 1024 : p.in[0] + ((size_t)b * 2048 + (t - 16)) * 1024; }
    else src = p.in[1] + (size_t)(row - T_PROMPT) * 1024;
    f32x4 v[4];
#pragma unroll
    for (int j = 0; j < 4; ++j) { v[j] = *(const f32x4*)(src + 256 * j + 4 * lane); st_bf4(X + (size_t)row * 1024 + 256 * j + 4 * lane, v[j]); }
    rms_row_to_bf16(v, p.in[8], HN + (size_t)row * 1024, lane);
  }
}

DI void phase_rowwise(const Params& p, const float* __restrict__ wpost, const float* __restrict__ wpre, bool final_, const float* PART, int nsplit, int row_begin, int bid, int G) {
  const int lane = threadIdx.x & 63, w = threadIdx.x >> 6;
  bf16_t* X = (bf16_t*)(p.ws + OFF_X);
  const bf16_t* MIX = (const bf16_t*)(p.ws + OFF_MIX);
  bf16_t* HN = (bf16_t*)(p.ws + OFF_HN);
  for (int rowa = row_begin + bid * 8 + w; rowa < T_ALL; rowa += G * 16) {
    const int rowb = rowa + G * 8;
    const bool hasb = rowb < T_ALL;
    f32x4 m[2][4], x[2][4];
#pragma unroll
    for (int q = 0; q < 2; ++q) {
      const int row = q ? (hasb ? rowb : rowa) : rowa;
#pragma unroll
      for (int j = 0; j < 4; ++j) {
        if (row < 16384) m[q][j] = ld_bf4(MIX + (size_t)row * 1024 + 256 * j + 4 * lane);
        else {
          f32x4 a = {0.f, 0.f, 0.f, 0.f};
          for (int ks = 0; ks < nsplit; ++ks) a = a + *(const f32x4*)(PART + ((size_t)ks * 768 + (row - 16384)) * 1024 + 256 * j + 4 * lane);
          m[q][j] = a;
        }
        x[q][j] = ld_bf4(X + (size_t)row * 1024 + 256 * j + 4 * lane);
      }
    }
#pragma unroll
    for (int q = 0; q < 2; ++q) {
      if (q == 1 && !hasb) break;
      const int row = q ? rowb : rowa;
      float s = 0.f;
#pragma unroll
      for (int j = 0; j < 4; ++j) s += m[q][j].x * m[q][j].x + m[q][j].y * m[q][j].y + m[q][j].z * m[q][j].z + m[q][j].w * m[q][j].w;
      const float rstd = rsqrtf(wave_sum(s) * (1.f / 1024.f) + 1e-6f);
#pragma unroll
      for (int j = 0; j < 4; ++j) { const f32x4 g = *(const f32x4*)(wpost + 256 * j + 4 * lane); x[q][j] = x[q][j] + m[q][j] * rstd * g; }
      if (!final_) {
#pragma unroll
        for (int j = 0; j < 4; ++j) st_bf4(X + (size_t)row * 1024 + 256 * j + 4 * lane, x[q][j]);
        rms_row_to_bf16(x[q], wpre, HN + (size_t)row * 1024, lane);
      } else {
        float* dst = nullptr;
        if (row < T_PROMPT) { const int b = row / SEQP, t = row - b * SEQP; if (t >= 16) dst = p.out + OUT_YP + ((size_t)b * 2048 + (t - 16)) * 1024; }
        else dst = p.out + OUT_YS + (size_t)(row - T_PROMPT) * 1024;
        if (dst) {
#pragma unroll
          for (int j = 0; j < 4; ++j) *(f32x4*)(dst + 256 * j + 4 * lane) = x[q][j];
        }
      }
    }
  }
}

DI void phase_groupnorm(const Params& p, int bid, int G) {
  const int lane = threadIdx.x & 63, w = threadIdx.x >> 6;
  bf16_t* O = (bf16_t*)(p.ws + OFF_O);
  const float* SSQ = (const float*)(p.ws + OFF_SSQ);
  const float* __restrict__ nw = p.in[24];
  const int g = lane >> 4;
  for (int row = bid * 8 + w; row < T_ALL; row += G * 8) {
    const f32x4 q = *(const f32x4*)(SSQ + (size_t)row * 16 + 4 * g);
    const float rstd = rsqrtf((q.x + q.y + q.z + q.w) * (1.f / 512.f) + 1e-6f);
    bf16_t* o = O + (size_t)row * 2048 + lane * 32;
#pragma unroll
    for (int j = 0; j < 4; ++j) {
      u32x4 v = *(u32x4*)(o + 8 * j);
      const f32x4 w0 = *(const f32x4*)(nw + lane * 32 + 8 * j), w1 = *(const f32x4*)(nw + lane * 32 + 8 * j + 4);
      v[0] = pk2(bflo(v[0]) * rstd * w0.x, bfhi(v[0]) * rstd * w0.y); v[1] = pk2(bflo(v[1]) * rstd * w0.z, bfhi(v[1]) * rstd * w0.w);
      v[2] = pk2(bflo(v[2]) * rstd * w1.x, bfhi(v[2]) * rstd * w1.y); v[3] = pk2(bflo(v[3]) * rstd * w1.z, bfhi(v[3]) * rstd * w1.w);
      *(u32x4*)(o + 8 * j) = v;
    }
  }
}

namespace pg8 {
#define PG8_LAS __attribute__((address_space(3)))
typedef unsigned short bf16_t;
typedef short bf16x8 __attribute__((ext_vector_type(8)));
typedef float f32x4 __attribute__((ext_vector_type(4)));
typedef unsigned u32x4 __attribute__((ext_vector_type(4)));
constexpr int BM = 256, BK = 64, HALF = 128, HTB = HALF * BK * 2  , STAGE_BYTES = 8 * HTB, NXCD = 8, WGM = 8;

__host__ __device__ __forceinline__ int lds_byte(int r, int c) { const int st = (r >> 4) * 2 + (c >> 5), rr = r & 15, cc = c & 31, ob = rr * 64 + cc * 2; return st * 1024 + (ob ^ (((ob >> 9) & 1) << 5)); }
__host__ __device__ __forceinline__ void stage_rc(int b, int& R, int& C) { const int st = b / 1024, sb = b % 1024, swz = sb ^ (((sb >> 9) & 1) << 5); R = (st >> 1) * 16 + swz / 64; C = (st & 1) * 32 + (swz % 64) / 2; }
__host__ __device__ __forceinline__ int perm32(int rho) { const int n = rho >> 4, i = rho & 15; return 8 * (i >> 2) + 4 * n + (i & 3); }

struct Unit { int pm, pn, ks; };
struct Gemm { const bf16_t* A; const bf16_t* Bt; int M, N, K, ld; };

struct StaticOrder {
    int nM, nN, nwg, G, c;
    __host__ __device__ void init(int M, int N, int G_, int c_) { nM = M / BM; nN = N / BM; nwg = nM * nN; G = G_; c = c_; }
    __host__ __device__ bool next(int i, Unit& u) const {
        const long L = (long)i * G + c; if (L >= nwg) return false;
        int wgid = (int)L; { const int q = nwg / NXCD, r = nwg % NXCD, xcd = wgid % NXCD, off = wgid / NXCD; wgid = (xcd < r ? xcd * (q + 1) : r * (q + 1) + (xcd - r) * q) + off; }
        const int nig = WGM * nN, gid = wgid / nig, fm = gid * WGM, gsz = (nM - fm) < WGM ? (nM - fm) : WGM;
        u.pm = fm + ((wgid % nig) % gsz); u.pn = (wgid % nig) / gsz; u.ks = 0; return true;
    }
    __device__ __forceinline__ void a_ready(const Unit&) const {}
    __device__ __forceinline__ void done(const Unit&) const {}
};
__device__ __forceinline__ unsigned cvt_pk_bf16(float lo, float hi) { unsigned r; asm volatile("v_cvt_pk_bf16_f32 %0, %1, %2" : "=v"(r) : "v"(lo), "v"(hi)); return r; }
typedef float f32x2 __attribute__((ext_vector_type(2)));
template <class Epi, class Sched, bool ALIGN_EPI = false, bool SP2 = false>
__device__ __forceinline__ void gemm_phase(PG8_LAS unsigned char* lds, const Gemm g, const Sched& S, const Epi& E) {
    int tid_ = threadIdx.x; asm volatile("" : "+v"(tid_));
    const int tid = tid_, wid = __builtin_amdgcn_readfirstlane(tid >> 6), lane = tid & 63, wr = wid >> 2, wc = wid & 3, fr = lane & 15, fq = lane >> 4;
    const int K = g.ld, nt = g.K / BK;
    unsigned voffA[2], voffB[2];
#pragma unroll
    for (int i = 0; i < 2; ++i) { int R, C; stage_rc(tid * 16 + i * 8192, R, C); const int Rb = Epi::PERM ? ((R & ~31) + perm32(R & 31)) : R;
        voffA[i] = (unsigned)(R * K + C) * 2u; voffB[i] = (unsigned)(Rb * K + C) * 2u; }
    const size_t kstep = (size_t)(BK * 2);
    const size_t hstep = (size_t)HALF * K * 2;
    const size_t tstep = 2 * hstep;
    const unsigned ldsw = (unsigned)wid * 1024u;
    const int aoff = lds_byte(wr * 64 + fr, fq * 8), boff = lds_byte(wc * 32 + fr, fq * 8);
#define PG8_SA(b, h) (((b) * 2 + (h)) * HTB)
#define PG8_SB(b, h) ((4 + (b) * 2 + (h)) * HTB)
#define PG8_STAGE(bufoff, gbase, voff) do { _Pragma("unroll") for (int _i = 0; _i < 2; ++_i) \
        __builtin_amdgcn_global_load_lds((const unsigned*)((const char*)(gbase) + (voff)[_i]), (PG8_LAS unsigned*)(lds + (bufoff) + ldsw + _i * 8192), 16, 0, 0); } while (0)
#define PG8_LDA(dst, b, h) do { _Pragma("unroll") for (int m = 0; m < 4; ++m) _Pragma("unroll") for (int k = 0; k < 2; ++k) dst[m][k] = *(const PG8_LAS bf16x8*)(lds + PG8_SA(b, h) + aoff + m * 2048 + k * 1024); } while (0)
#define PG8_LDB(dst, b, h) do { _Pragma("unroll") for (int n = 0; n < 2; ++n) _Pragma("unroll") for (int k = 0; k < 2; ++k) dst[n][k] = *(const PG8_LAS bf16x8*)(lds + PG8_SB(b, h) + boff + n * 2048 + k * 1024); } while (0)
#define PG8_MMA(ai, bj, At, Bt) do { __builtin_amdgcn_s_setprio(1); _Pragma("unroll") for (int m = 0; m < 4; ++m) _Pragma("unroll") for (int n = 0; n < 2; ++n) _Pragma("unroll") for (int k = 0; k < 2; ++k) \
        acc[ai][bj][m][n] = __builtin_amdgcn_mfma_f32_16x16x32_bf16(Bt[n][k], At[m][k], acc[ai][bj][m][n], 0, 0, 0); __builtin_amdgcn_s_setprio(0); } while (0)
#define PG8_WAIT_V(n) asm volatile("s_waitcnt vmcnt(" #n ")" ::: "memory")
#define PG8_WAIT_L(n) asm volatile("s_waitcnt lgkmcnt(" #n ")" ::: "memory")
#define PG8_BAR __builtin_amdgcn_s_barrier()
#define PG8_SCHED __builtin_amdgcn_sched_barrier(0)
    Unit cur, nxt; int ui = 0;
    if (!S.next(0, cur)) return;
    f32x4 acc[2][2][4][2];
#pragma unroll
    for (int a = 0; a < 2; ++a)
#pragma unroll
        for (int b = 0; b < 2; ++b)
#pragma unroll
            for (int m = 0; m < 4; ++m)
#pragma unroll
                for (int n = 0; n < 2; ++n) acc[a][b][m][n] = (f32x4){0.f, 0.f, 0.f, 0.f};
    bf16x8 At[4][2], B0[2][2], B1[2][2];
    const char* cA = (const char*)g.A + (size_t)cur.pm * tstep + (size_t)cur.ks * g.K * 2; const char* cB = (const char*)g.Bt + (size_t)cur.pn * tstep + (size_t)cur.ks * g.K * 2;
    S.a_ready(cur);
    if constexpr (SP2) {
        PG8_STAGE(PG8_SB(0, 0), cB, voffB); PG8_STAGE(PG8_SB(0, 1), cB + hstep, voffB); PG8_STAGE(PG8_SA(0, 0), cA, voffA); PG8_STAGE(PG8_SA(0, 1), cA + hstep, voffA);
        if (wr == 1) PG8_BAR;
        PG8_WAIT_V(2); PG8_BAR;
        PG8_STAGE(PG8_SB(1, 0), cB + kstep, voffB); PG8_STAGE(PG8_SA(1, 0), cA + kstep, voffA); PG8_STAGE(PG8_SB(1, 1), cB + hstep + kstep, voffB);
        PG8_WAIT_V(6); PG8_BAR;
    } else {
        PG8_STAGE(PG8_SB(0, 0), cB, voffB); PG8_STAGE(PG8_SA(0, 0), cA, voffA); PG8_STAGE(PG8_SB(0, 1), cB + hstep, voffB); PG8_STAGE(PG8_SA(0, 1), cA + hstep, voffA);
        if (wr == 1) PG8_BAR;
        PG8_WAIT_V(4); PG8_BAR;
        PG8_STAGE(PG8_SB(1, 0), cB + kstep, voffB); PG8_STAGE(PG8_SA(1, 0), cA + kstep, voffA); PG8_STAGE(PG8_SB(1, 1), cB + hstep + kstep, voffB);
        PG8_WAIT_V(6); PG8_BAR;
    }
    for (;;) {
        const bool has_next = S.next(ui + 1, nxt);
        const char* nA = has_next ? (const char*)g.A + (size_t)nxt.pm * tstep + (size_t)nxt.ks * g.K * 2 : cA; const char* nB = has_next ? (const char*)g.Bt + (size_t)nxt.pn * tstep + (size_t)nxt.ks * g.K * 2 : cB;
        for (int t = 0; t < nt; t += 2) {
            const bool last = (t == nt - 2);
            const char* a1 = cA + (size_t)(t + 1) * kstep;
            const char* a2 = last ? nA : cA + (size_t)(t + 2) * kstep; const char* b2 = last ? nB : cB + (size_t)(t + 2) * kstep;
            const char* a3 = a2 + kstep; const char* b3 = b2 + kstep;
            if (last && has_next) S.a_ready(nxt);
            if constexpr (SP2) {
            PG8_LDB(B0, 0, 0); PG8_LDB(B1, 0, 1); PG8_SCHED; PG8_LDA(At, 0, 0); PG8_STAGE(PG8_SA(1, 1), a1 + hstep, voffA);
            PG8_WAIT_V(8); PG8_WAIT_L(0); PG8_BAR; PG8_MMA(0, 0, At, B0); PG8_MMA(0, 1, At, B1); PG8_BAR; PG8_SCHED;
            PG8_LDA(At, 0, 1); PG8_STAGE(PG8_SB(0, 0), b2, voffB); PG8_STAGE(PG8_SB(0, 1), b2 + hstep, voffB); PG8_STAGE(PG8_SA(0, 0), a2, voffA);
            PG8_WAIT_V(8); PG8_WAIT_L(0); PG8_BAR; PG8_MMA(1, 0, At, B0); PG8_MMA(1, 1, At, B1); PG8_BAR; PG8_SCHED;
            PG8_LDB(B0, 1, 0); PG8_LDB(B1, 1, 1); PG8_SCHED; PG8_LDA(At, 1, 0); PG8_STAGE(PG8_SA(0, 1), a2 + hstep, voffA);
            PG8_WAIT_V(8); PG8_WAIT_L(0); PG8_BAR; PG8_MMA(0, 0, At, B0); PG8_MMA(0, 1, At, B1); PG8_BAR; PG8_SCHED;
            PG8_LDA(At, 1, 1); PG8_STAGE(PG8_SB(1, 0), b3, voffB); PG8_STAGE(PG8_SB(1, 1), b3 + hstep, voffB); PG8_STAGE(PG8_SA(1, 0), a3, voffA);
            PG8_WAIT_V(8); PG8_WAIT_L(0); PG8_BAR; PG8_MMA(1, 0, At, B0); PG8_MMA(1, 1, At, B1); PG8_BAR; PG8_SCHED;
            } else {
            PG8_LDB(B0, 0, 0); PG8_SCHED; PG8_LDA(At, 0, 0); PG8_STAGE(PG8_SA(1, 1), a1 + hstep, voffA);
            PG8_WAIT_L(8); PG8_BAR; PG8_WAIT_L(0); PG8_MMA(0, 0, At, B0); PG8_BAR; PG8_SCHED;
            PG8_LDB(B1, 0, 1); PG8_STAGE(PG8_SB(0, 0), b2, voffB);
            PG8_BAR; PG8_WAIT_L(0); PG8_MMA(0, 1, At, B1); PG8_BAR;
            PG8_LDA(At, 0, 1); PG8_STAGE(PG8_SA(0, 0), a2, voffA);
            PG8_BAR; PG8_WAIT_L(0); PG8_MMA(1, 0, At, B0); PG8_BAR; PG8_SCHED;
            PG8_STAGE(PG8_SB(0, 1), b2 + hstep, voffB);
            PG8_WAIT_V(6); PG8_BAR; PG8_MMA(1, 1, At, B1); PG8_BAR;
            PG8_LDB(B0, 1, 0); PG8_SCHED; PG8_LDA(At, 1, 0); PG8_STAGE(PG8_SA(0, 1), a2 + hstep, voffA);
            PG8_WAIT_L(8); PG8_BAR; PG8_WAIT_L(0); PG8_MMA(0, 0, At, B0); PG8_BAR; PG8_SCHED;
            PG8_LDB(B1, 1, 1); PG8_STAGE(PG8_SB(1, 0), b3, voffB);
            PG8_BAR; PG8_WAIT_L(0); PG8_MMA(0, 1, At, B1); PG8_BAR;
            PG8_LDA(At, 1, 1); PG8_STAGE(PG8_SA(1, 0), a3, voffA);
            PG8_BAR; PG8_WAIT_L(0); PG8_MMA(1, 0, At, B0); PG8_BAR; PG8_SCHED;
            PG8_STAGE(PG8_SB(1, 1), b3 + hstep, voffB);
            PG8_WAIT_V(6); PG8_BAR; PG8_MMA(1, 1, At, B1); PG8_BAR;
            }
        }
        if constexpr (ALIGN_EPI) { if (wr == 0) PG8_BAR; }
        if constexpr (!Epi::AFTER_DRAIN) { E(acc, cur, wr, wc, fr, fq); S.done(cur); }
        if (!has_next) break;
#pragma unroll
        for (int a = 0; a < 2; ++a)
#pragma unroll
            for (int b = 0; b < 2; ++b)
#pragma unroll
                for (int m = 0; m < 4; ++m)
#pragma unroll
                    for (int n = 0; n < 2; ++n) acc[a][b][m][n] = (f32x4){0.f, 0.f, 0.f, 0.f};
        cur = nxt; cA = nA; cB = nB; ++ui;
        if constexpr (ALIGN_EPI) { if (wr == 1) PG8_BAR; }
    }
    PG8_WAIT_V(0);
    if constexpr (!ALIGN_EPI) { if (wr == 0) PG8_BAR; }
    PG8_BAR;
    if constexpr (Epi::AFTER_DRAIN) { E.fused(acc, cur, wr, wc, fr, fq, lds, wid, lane); S.done(cur); }
#undef PG8_SA
#undef PG8_SB
#undef PG8_STAGE
#undef PG8_LDA
#undef PG8_LDB
#undef PG8_MMA
#undef PG8_WAIT_V
#undef PG8_WAIT_L
#undef PG8_BAR
#undef PG8_SCHED
}
}

struct EpiStoreBf16 {
  static constexpr bool PERM = true, AFTER_DRAIN = false;
  bf16_t* C; int ldc; unsigned silu_units, sigm_units;
  DI void operator()(const pg8::f32x4 (&acc)[2][2][4][2], const pg8::Unit& u, int wr, int wc, int fr, int fq) const {
    const int row0 = u.pm * 256 + wr * 64 + fr, col0 = u.pn * 256 + wc * 32 + 8 * fq;
    const bool gate = (silu_units >> u.pn) & 1u, sigm = (sigm_units >> u.pn) & 1u;
#pragma unroll
    for (int ai = 0; ai < 2; ++ai)
#pragma unroll
      for (int m = 0; m < 4; ++m) {
        bf16_t* rowp = C + (size_t)(row0 + ai * 128 + m * 16) * ldc + col0;
#pragma unroll
        for (int bj = 0; bj < 2; ++bj) {
          pg8::f32x4 v0 = acc[ai][bj][m][0], v1 = acc[ai][bj][m][1];
          if (gate) {
#pragma unroll
            for (int e = 0; e < 4; ++e) { v0[e] = siluf_(v0[e]); v1[e] = siluf_(v1[e]); }
          } else if (sigm) {
#pragma unroll
            for (int e = 0; e < 4; ++e) {
              { const float x = v0[e], ex = __expf(-fabsf(x)), mm = ex * __builtin_amdgcn_rcpf(1.f + ex); v0[e] = x < 0.f ? mm : -mm; }
              { const float x = v1[e], ex = __expf(-fabsf(x)), mm = ex * __builtin_amdgcn_rcpf(1.f + ex); v1[e] = x < 0.f ? mm : -mm; }
            }
          }
          u32x4 w_; w_[0] = pk2(v0[0], v0[1]); w_[1] = pk2(v0[2], v0[3]); w_[2] = pk2(v1[0], v1[1]); w_[3] = pk2(v1[2], v1[3]);
          *(u32x4*)(rowp + bj * 128) = w_;
        }
      }
  }
};
struct EpiStoreF32 {
  static constexpr bool PERM = false, AFTER_DRAIN = false;
  float* C0; int ldc; size_t ks_stride;
  DI void operator()(const pg8::f32x4 (&acc)[2][2][4][2], const pg8::Unit& u, int wr, int wc, int fr, int fq) const {
    float* C = C0 + (size_t)u.ks * ks_stride;
    const int row0 = u.pm * 256 + wr * 64 + fr, col0 = u.pn * 256 + wc * 32 + 4 * fq;
#pragma unroll
    for (int ai = 0; ai < 2; ++ai)
#pragma unroll
      for (int m = 0; m < 4; ++m) {
        float* rowp = C + (size_t)(row0 + ai * 128 + m * 16) * ldc + col0;
#pragma unroll
        for (int bj = 0; bj < 2; ++bj)
#pragma unroll
          for (int n = 0; n < 2; ++n) *(pg8::f32x4*)(rowp + bj * 128 + n * 16) = acc[ai][bj][m][n];
      }
  }
};
struct EpiSwiglu {
  static constexpr bool PERM = true, AFTER_DRAIN = false;
  bf16_t* C; int ldc;
  DI void operator()(const pg8::f32x4 (&acc)[2][2][4][2], const pg8::Unit& u, int wr, int wc, int fr, int fq) const {
    const int row0 = u.pm * 256 + wr * 64 + fr, col0 = u.pn * 128 + wc * 32 + 8 * fq;
#pragma unroll
    for (int ai = 0; ai < 2; ++ai)
#pragma unroll
      for (int m = 0; m < 4; ++m) {
        float y[8];
#pragma unroll
        for (int n = 0; n < 2; ++n)
#pragma unroll
          for (int e = 0; e < 4; ++e) y[4 * n + e] = siluf_(acc[ai][0][m][n][e]) * acc[ai][1][m][n][e];
        u32x4 w_; w_[0] = pk2(y[0], y[1]); w_[1] = pk2(y[2], y[3]); w_[2] = pk2(y[4], y[5]); w_[3] = pk2(y[6], y[7]);
        *(u32x4*)(C + (size_t)(row0 + ai * 128 + m * 16) * ldc + col0) = w_;
      }
  }
};

struct RowSumExchange {
  float* xbuf; unsigned* cnt; unsigned* tmo;
  DI void run(const float (&part)[2][4], const pg8::Unit& u, int wr, int wc, int fr, int fq, char* lds, float* S, int wid, int lane) const {
    float* P = (float*)lds;
    if (fq == 0) {
#pragma unroll
      for (int ai = 0; ai < 2; ++ai)
#pragma unroll
        for (int m = 0; m < 4; ++m) P[(ai * 128 + wr * 64 + m * 16 + fr) * 4 + wc] = part[ai][m];
    }
    __syncthreads();
    const int row = wid * 32 + (lane & 31);
    if (lane < 32) {
      const f32x4 a = *(const f32x4*)(P + row * 4);
      __hip_atomic_store(xbuf + ((size_t)u.pm * 256 + row) * 4 + u.pn, (a.x + a.y) + (a.z + a.w), __ATOMIC_RELAXED, __HIP_MEMORY_SCOPE_AGENT);
    }
    asm volatile("s_waitcnt vmcnt(0)" ::: "memory");
    if (lane == 0) __hip_atomic_fetch_add(cnt + 64 * u.pm, 1u, __ATOMIC_RELAXED, __HIP_MEMORY_SCOPE_AGENT);
    if (wid == 0) {
      unsigned it = 0;
      while ((unsigned)__builtin_amdgcn_readfirstlane(__hip_atomic_load(cnt + 64 * u.pm, __ATOMIC_RELAXED, __HIP_MEMORY_SCOPE_AGENT)) < 32u) {
        __builtin_amdgcn_s_sleep(2);
        if (++it > (1u << 21)) { if (lane == 0) __hip_atomic_store(tmo, 1u, __ATOMIC_RELAXED, __HIP_MEMORY_SCOPE_AGENT); break; }
      }
      __builtin_amdgcn_fence(__ATOMIC_ACQUIRE, "agent");
    }
    asm volatile("s_waitcnt vmcnt(0) lgkmcnt(0)" ::: "memory");
    __syncthreads();
    if (lane < 32) {
      const float* slot = xbuf + ((size_t)u.pm * 256 + row) * 4;
      float t = 0.f;
#pragma unroll
      for (int k = 0; k < 4; ++k) t += __hip_atomic_load(slot + k, __ATOMIC_RELAXED, __HIP_MEMORY_SCOPE_AGENT);
      S[row] = t;
    }
    __syncthreads();
  }
};
template <bool FINAL>
struct EpiResNorm {
  static constexpr bool PERM = true, AFTER_DRAIN = true;
  bf16_t* X; bf16_t* HN; const float* wpost; const float* wpre; float* yout;
  float* xbuf; unsigned* cnt; unsigned* tmo;
  DI void operator()(const pg8::f32x4 (&)[2][2][4][2], const pg8::Unit&, int, int, int, int) const {}
  DI static void ssq_rows(const pg8::f32x4 (&acc)[2][2][4][2], float (&part)[2][4]) {
#pragma unroll
    for (int ai = 0; ai < 2; ++ai)
#pragma unroll
      for (int m = 0; m < 4; ++m) {
        float q = 0.f;
#pragma unroll
        for (int bj = 0; bj < 2; ++bj)
#pragma unroll
          for (int n = 0; n < 2; ++n) { const pg8::f32x4 v = acc[ai][bj][m][n]; q += (v[0] * v[0] + v[1] * v[1]) + (v[2] * v[2] + v[3] * v[3]); }
        q += __shfl_xor(q, 16); q += __shfl_xor(q, 32);
        part[ai][m] = q;
      }
  }
  DI void fused(pg8::f32x4 (&acc)[2][2][4][2], const pg8::Unit& u, int wr, int wc, int fr, int fq, PG8_LAS unsigned char* ldsl, int wid, int lane) const {
    char* lds = (char*)ldsl;
    float* S1 = (float*)(lds + 4096);
    float* S2 = (float*)(lds + 5120);
    float part[2][4];
    ssq_rows(acc, part);
    RowSumExchange{xbuf, cnt, tmo}.run(part, u, wr, wc, fr, fq, lds, S1, wid, lane);
#pragma unroll
    for (int ai = 0; ai < 2; ++ai)
#pragma unroll
      for (int m = 0; m < 4; ++m) {
        if (m == 0) __builtin_amdgcn_sched_barrier(0);
        const int rl = ai * 128 + wr * 64 + m * 16 + fr;
        const float r1 = rsqrtf(S1[rl] * (1.f / 1024.f) + 1e-6f);
        const bf16_t* xrow = X + (size_t)(u.pm * 256 + rl) * 1024;
#pragma unroll
        for (int bj = 0; bj < 2; ++bj) {
          const int c8 = u.pn * 256 + bj * 128 + wc * 32 + 8 * fq;
          const u32x4 xr = *(const u32x4*)(xrow + c8);
          const f32x4 g0 = *(const f32x4*)(wpost + c8), g1 = *(const f32x4*)(wpost + c8 + 4);
          const f32x4 x0 = {bflo(xr[0]), bfhi(xr[0]), bflo(xr[1]), bfhi(xr[1])}, x1 = {bflo(xr[2]), bfhi(xr[2]), bflo(xr[3]), bfhi(xr[3])};
          acc[ai][bj][m][0] = x0 + acc[ai][bj][m][0] * r1 * g0;
          acc[ai][bj][m][1] = x1 + acc[ai][bj][m][1] * r1 * g1;
        }
      }
    if (FINAL) {
#pragma unroll
      for (int ai = 0; ai < 2; ++ai)
#pragma unroll
        for (int m = 0; m < 4; ++m) {
          if (m == 0) __builtin_amdgcn_sched_barrier(0);
          const int row = u.pm * 256 + ai * 128 + wr * 64 + m * 16 + fr;
          const int b = row / SEQP, t = row - b * SEQP;
          if (t >= 16) {
            float* dst = yout + ((size_t)b * 2048 + (t - 16)) * 1024;
#pragma unroll
            for (int bj = 0; bj < 2; ++bj)
#pragma unroll
              for (int n = 0; n < 2; ++n) *(f32x4*)(dst + u.pn * 256 + bj * 128 + wc * 32 + 8 * fq + 4 * n) = acc[ai][bj][m][n];
          }
        }
      return;
    }
    ssq_rows(acc, part);
    RowSumExchange{xbuf + SZ_XB_SET / 4, cnt + SZ_CNT_SET / 4, tmo}.run(part, u, wr, wc, fr, fq, lds, S2, wid, lane);
#pragma unroll
    for (int ai = 0; ai < 2; ++ai)
#pragma unroll
      for (int m = 0; m < 4; ++m) {
        if (m == 0) __builtin_amdgcn_sched_barrier(0);
        const int rl = ai * 128 + wr * 64 + m * 16 + fr;
        const float r2 = rsqrtf(S2[rl] * (1.f / 1024.f) + 1e-6f);
        bf16_t* xrow = X + (size_t)(u.pm * 256 + rl) * 1024;
        bf16_t* hrow = HN + (size_t)(u.pm * 256 + rl) * 1024;
#pragma unroll
        for (int bj = 0; bj < 2; ++bj) {
          const int c8 = u.pn * 256 + bj * 128 + wc * 32 + 8 * fq;
          const f32x4 g0 = *(const f32x4*)(wpre + c8), g1 = *(const f32x4*)(wpre + c8 + 4);
          const pg8::f32x4 v0 = acc[ai][bj][m][0], v1 = acc[ai][bj][m][1];
          u32x4 xo, ho;
          xo[0] = pk2(v0[0], v0[1]); xo[1] = pk2(v0[2], v0[3]); xo[2] = pk2(v1[0], v1[1]); xo[3] = pk2(v1[2], v1[3]);
          const pg8::f32x4 h0 = v0 * r2 * g0, h1 = v1 * r2 * g1;
          ho[0] = pk2(h0[0], h0[1]); ho[1] = pk2(h0[2], h0[3]); ho[2] = pk2(h1[0], h1[1]); ho[3] = pk2(h1[2], h1[3]);
          *(u32x4*)(xrow + c8) = xo;
          *(u32x4*)(hrow + c8) = ho;
        }
      }
  }
};
template <class Epi>
DI void gemm_run(char* lds, const bf16_t* A, const bf16_t* Bt, int N, int K, const Epi& E, int vcu, int G) {
  pg8::Gemm g{A, Bt, T_PAD, N, K, K};
  pg8::StaticOrder S; S.init(T_PAD, N, G, vcu);
  pg8::gemm_phase<Epi, pg8::StaticOrder, true, true>((PG8_LAS unsigned char*)lds, g, S, E);
}
struct SplitOrder {
  int nsplit, nitems, G, c;
  DI bool next(int i, pg8::Unit& u) const {
    const int L = i * G + c; if (L >= nitems) return false;
    const int q = L / nsplit; u.ks = L - q * nsplit; u.pm = q >> 2; u.pn = q & 3; return true;
  }
  DI void a_ready(const pg8::Unit&) const {}
  DI void done(const pg8::Unit&) const {}
};
DI void gemm_n1024_plain(char* lds, const bf16_t* A, const bf16_t* Bt, int K, float* MIXp, float* PART, int vcu, int G) {
  {
    pg8::Gemm g{A, Bt, M_MAIN, 1024, K, K};
    pg8::StaticOrder S; S.init(M_MAIN, 1024, G, vcu);
    pg8::gemm_phase<EpiStoreBf16, pg8::StaticOrder, true, true>((PG8_LAS unsigned char*)lds, g, S, EpiStoreBf16{(bf16_t*)MIXp, 1024, 0u, 0u});
  }
  {
    const int nsplit = K >> 8;
    pg8::Gemm g{A + (size_t)M_MAIN * K, Bt, 768, 1024, 256, K};
    SplitOrder S{nsplit, 12 * nsplit, G, (vcu + 128) % G};
    pg8::gemm_phase<EpiStoreF32, SplitOrder, true, true>((PG8_LAS unsigned char*)lds, g, S, EpiStoreF32{PART, 1024, (size_t)768 * 1024});
  }
}
template <bool FINAL>
DI void gemm_n1024(char* lds, const bf16_t* A, const bf16_t* Bt, int K, const EpiResNorm<FINAL>& E, float* PART, int vcu, int G) {
  {
    pg8::Gemm g{A, Bt, M_MAIN, 1024, K, K};
    pg8::StaticOrder S; S.init(M_MAIN, 1024, G, vcu);
    pg8::gemm_phase<EpiResNorm<FINAL>, pg8::StaticOrder, false, true>((PG8_LAS unsigned char*)lds, g, S, E);
  }
  __syncthreads();
  {
    const int nsplit = K >> 8;
    pg8::Gemm g{A + (size_t)M_MAIN * K, Bt, 768, 1024, 256, K};
    SplitOrder S{nsplit, 12 * nsplit, G, (vcu + 128) % G};
    pg8::gemm_phase<EpiStoreF32, SplitOrder, true, true>((PG8_LAS unsigned char*)lds, g, S, EpiStoreF32{PART, 1024, (size_t)768 * 1024});
  }
}

constexpr int L_QE = 0, L_KE = 8704, L_QI = 17408, L_G = 26112, L_KENDT = 34816, L_VT = 45056, L_DEC = 55296, L_TOT = 55808, L_SSQ = 57856;
constexpr int RS = 272, TS = 80;

template <int DK>
DI void pc_core(char* lds, f32x16 (&S)[DK / 32], f32x16& o, const int w, const int r32, const int h) {
  const char* QE = lds + L_QE + r32 * RS;
  const char* KE = lds + L_KE + r32 * RS;
  const char* QI = lds + L_QI + r32 * RS;
  f32x16 sc; zero16(sc);
#pragma unroll
  for (int s = 0; s < DK / 16; ++s) {
    const bf16x8 a = *(const bf16x8*)(KE + s * 32 + h * 16);
    const bf16x8 b = *(const bf16x8*)(QE + s * 32 + h * 16);
    sc = MFMA32(a, b, sc);
  }
#pragma unroll
  for (int r = 0; r < 16; ++r) if (crow(r, h) > r32) sc[r] = 0.f;
  const bf16x8 scb0 = pack8<0>(sc), scb1 = pack8<1>(sc);
  zero16(o);
#pragma unroll
  for (int kt = 0; kt < DK / 32; ++kt) {
    {
      const bf16x8 a = pack8<0>(S[kt]);
      const s16x4 lo = *(const s16x4*)(QI + (32 * kt + 4 * h) * 2), hi = *(const s16x4*)(QI + (32 * kt + 8 + 4 * h) * 2);
      o = MFMA32(a, cat8(lo, hi), o);
    }
    {
      const bf16x8 a = pack8<1>(S[kt]);
      const s16x4 lo = *(const s16x4*)(QI + (32 * kt + 16 + 4 * h) * 2), hi = *(const s16x4*)(QI + (32 * kt + 24 + 4 * h) * 2);
      o = MFMA32(a, cat8(lo, hi), o);
    }
  }
  const char* VTr = lds + L_VT + (32 * w + r32) * TS;
  {
    const s16x4 lo = *(const s16x4*)(VTr + (4 * h) * 2), hi = *(const s16x4*)(VTr + (8 + 4 * h) * 2);
    o = MFMA32(cat8(lo, hi), scb0, o);
  }
  {
    const s16x4 lo = *(const s16x4*)(VTr + (16 + 4 * h) * 2), hi = *(const s16x4*)(VTr + (24 + 4 * h) * 2);
    o = MFMA32(cat8(lo, hi), scb1, o);
  }
  const float* DEC = (const float*)(lds + L_DEC);
#pragma unroll
  for (int kt = 0; kt < DK / 32; ++kt)
#pragma unroll
    for (int g = 0; g < 4; ++g) {
      const f32x4 d = *(const f32x4*)(DEC + 32 * kt + 8 * g + 4 * h);
      S[kt][4 * g] *= d.x; S[kt][4 * g + 1] *= d.y; S[kt][4 * g + 2] *= d.z; S[kt][4 * g + 3] *= d.w;
    }
#pragma unroll
  for (int s = 0; s < 2; ++s) {
    const bf16x8 b = *(const bf16x8*)(VTr + s * 32 + h * 16);
#pragma unroll
    for (int kt = 0; kt < DK / 32; ++kt) {
      const bf16x8 a = *(const bf16x8*)(lds + L_KENDT + (32 * kt + r32) * TS + s * 32 + h * 16);
      S[kt] = MFMA32(a, b, S[kt]);
    }
  }
}

constexpr int NSC = 8;
DI int sc_beg(int sc) { return sc == 0 ? 0 : 16 + 256 * sc; }
DI int sc_end(int sc) { return 16 + 256 * (sc + 1); }
constexpr size_t SCR_HG_U = 0;
constexpr size_t SCR_GL_U = SCR_HG_U + (size_t)8 * 4 * 7 * 16384;
constexpr size_t SCR_HG_D = SCR_GL_U + (size_t)8 * 4 * 7 * 8192;
constexpr size_t SCR_GL_D = SCR_HG_D + (size_t)8 * 4 * 7 * 128;
constexpr size_t SCR_SS_U = 0;
constexpr size_t SCR_SS_D = SCR_SS_U + (size_t)8 * 32 * 7 * 8192;

template <int TYPE, bool SO>
DI void scan_even_job(const Params& p, char* lds, const int head, const int row0, const int ntok, const float* s_in, float* s_out, float* d_out) {
  constexpr int DK = TYPE == 0 ? 128 : 64;
  constexpr int KC = DK / 64;
  const int tid = threadIdx.x & (HB - 1), c = tid & 63, w = tid >> 6, r32 = c & 31, h = c >> 5;
  const bf16_t* P = (const bf16_t*)(p.ws + OFF_P);
  bf16_t* O = (bf16_t*)(p.ws + OFF_O);
  float* TOT = (float*)(lds + L_TOT);
  float* SSQ = (float*)(lds + L_SSQ);
  float* DEC = (float*)(lds + L_DEC);
  const int qcol = TYPE == 0 ? head * 128 : 2048 + head * 64;
  const int kcol = TYPE == 0 ? 512 + head * 128 : 2304 + head * 64;
  const int vcol = TYPE == 0 ? 1024 + head * 128 : 2560 + head * 128;
  const int gcol = TYPE == 0 ? 1536 + head * 128 : 3072 + head * 128;
  const int ocol = TYPE == 0 ? head * 128 : 512 + head * 128;
  float lb[2] = {0.f, 0.f}, wup[16], bal = 0.f;
  if (TYPE == 0) {
#pragma unroll
    for (int e = 0; e < 2; ++e) {
      const float g0 = p.in[7][head * 128 + 2 * c + e], g1 = p.in[7][512 + head * 128 + 2 * c + e], g2 = p.in[7][1024 + head * 128 + 2 * c + e];
      const float m = fmaxf(g0, fmaxf(g1, g2));
      const float e0 = __expf(g0 - m), e1 = __expf(g1 - m), e2 = __expf(g2 - m);
      lb[e] = e0 / (e0 + e1 + e2);
    }
  } else {
#pragma unroll
    for (int r = 0; r < 16; ++r) wup[r] = p.in[13][r * 256 + head * 64 + c];
    bal = p.in[14][head * 64 + c];
  }
  const float* __restrict__ nwp = TYPE == 0 ? p.in[15] : p.in[16];
  f32x16 S[DK / 32];
#pragma unroll
  for (int kt = 0; kt < DK / 32; ++kt)
#pragma unroll
    for (int r = 0; r < 16; ++r) S[kt][r] = (!SO && s_in) ? s_in[(size_t)(32 * kt + crow(r, h)) * 128 + 32 * w + r32] : 0.f;
  float dsum[KC];
#pragma unroll
  for (int e = 0; e < KC; ++e) dsum[e] = 0.f;

  unsigned rq[8], rk[8], rv[8], rg[8]; float ral[8];
  auto load_raw = [&](int ch) {
#pragma unroll
    for (int i = 0; i < 8; ++i) {
      const int t = min(ch * 32 + 8 * w + i, ntok - 1);
      const bf16_t* pr = P + (size_t)(row0 + t) * LD_EV;
      if (TYPE == 0) {
        if (!SO) rq[i] = *(const unsigned*)(pr + qcol + 2 * c);
        rk[i] = *(const unsigned*)(pr + kcol + 2 * c);
      } else {
        if (!SO) rq[i] = (unsigned)pr[qcol + c];
        rk[i] = (unsigned)pr[kcol + c];
        ral[i] = bflo((unsigned)pr[3584 + (c & 15)]);
      }
      rv[i] = *(const unsigned*)(pr + vcol + 2 * c);
      if (!SO) rg[i] = *(const unsigned*)(pr + gcol + 2 * c);
    }
  };
  const int nch = __builtin_amdgcn_readfirstlane((ntok + 31) >> 5);
  load_raw(0);
  for (int ch = 0; ch < nch; ++ch) {
    const int t0 = ch * 32;
    float kk[8][KC], cum[8][KC], run[KC];
#pragma unroll
    for (int e = 0; e < KC; ++e) run[e] = 0.f;
#pragma unroll
    for (int i = 0; i < 8; ++i) {
      const float vm = (t0 + 8 * w + i) < ntok ? 1.f : 0.f;
      if (TYPE == 0) {
#pragma unroll
        for (int e = 0; e < 2; ++e) {
          const float ts = e ? bfhi(rk[i]) : bflo(rk[i]);
          const float mm = fabsf(ts);
          const float km = (__float_as_uint(ts) >> 31) ? mm : 1.f - mm;
          const float k1 = (1.f - lb[e]) * km;
          const float f = 1.f - k1;
          kk[i][e] = vm * k1;
          run[e] += vm * __logf(f); cum[i][e] = run[e];
        }
      } else {
        float x = bal;
#pragma unroll
        for (int r = 0; r < 16; ++r) x += __int_as_float(__builtin_amdgcn_readlane(__float_as_int(ral[i]), r)) * wup[r];
        const float ls = fminf(x, 0.f) - __logf(1.f + __expf(-fabsf(x)));
        kk[i][0] = vm * bflo(rk[i]);
        run[0] += vm * ls * (1.f / 16.f); cum[i][0] = run[0];
      }
    }
#pragma unroll
    for (int e = 0; e < KC; ++e) TOT[w * 128 + KC * c + e] = run[e];
    __syncthreads();
    float off[KC], mid[KC], tot[KC];
#pragma unroll
    for (int e = 0; e < KC; ++e) {
      const float t0_ = TOT[KC * c + e], t1_ = TOT[128 + KC * c + e], t2_ = TOT[256 + KC * c + e], t3_ = TOT[384 + KC * c + e];
      mid[e] = t0_ + t1_; tot[e] = (t0_ + t1_) + (t2_ + t3_);
      off[e] = w == 0 ? 0.f : (w == 1 ? t0_ : (w == 2 ? t0_ + t1_ : t0_ + t1_ + t2_));
      dsum[e] += tot[e];
    }
    {
      u32x4 kp[KC];
#pragma unroll
      for (int m = 0; m < 4; ++m) {
        float kend[2][KC];
#pragma unroll
        for (int i2 = 0; i2 < 2; ++i2) {
          const int i = 2 * m + i2;
          const int ti = 8 * w + i;
          float qe[KC], ke[KC], qi[KC];
#pragma unroll
          for (int e = 0; e < KC; ++e) {
            const float cv = off[e] + cum[i][e];
            kend[i2][e] = kk[i][e] * __expf(tot[e] - cv);
            if (!SO) {
              const float qv = TYPE == 0 ? (e ? bfhi(rq[i]) : bflo(rq[i])) : bflo(rq[i]) * 0.125f;
              qe[e] = qv * __expf(cv - mid[e]);
              ke[e] = kk[i][e] * __expf(mid[e] - cv);
              qi[e] = qv * __expf(cv);
            }
          }
          if (!SO) {
            if (KC == 2) {
              *(unsigned*)(lds + L_QE + ti * RS + 4 * c) = pk2(qe[0], qe[KC - 1]);
              *(unsigned*)(lds + L_KE + ti * RS + 4 * c) = pk2(ke[0], ke[KC - 1]);
              *(unsigned*)(lds + L_QI + ti * RS + 4 * c) = pk2(qi[0], qi[KC - 1]);
            } else {
              *(bf16_t*)(lds + L_QE + ti * RS + 2 * c) = (bf16_t)pk2(qe[0], 0.f);
              *(bf16_t*)(lds + L_KE + ti * RS + 2 * c) = (bf16_t)pk2(ke[0], 0.f);
              *(bf16_t*)(lds + L_QI + ti * RS + 2 * c) = (bf16_t)pk2(qi[0], 0.f);
            }
            *(unsigned*)(lds + L_G + ti * RS + 4 * c) = rg[i];
          }
        }
#pragma unroll
        for (int e = 0; e < KC; ++e) kp[e][m] = pk2(kend[0][e], kend[1][e]);
      }
#pragma unroll
      for (int e = 0; e < KC; ++e) *(u32x4*)(lds + L_KENDT + (KC * c + e) * TS + 16 * w) = kp[e];
      u32x4 v0, v1;
#pragma unroll
      for (int m = 0; m < 4; ++m) {
        v0[m] = (rv[2 * m] & 0xffffu) | (rv[2 * m + 1] << 16);
        v1[m] = (rv[2 * m] >> 16) | (rv[2 * m + 1] & 0xffff0000u);
      }
      *(u32x4*)(lds + L_VT + (2 * c) * TS + 16 * w) = v0;
      *(u32x4*)(lds + L_VT + (2 * c + 1) * TS + 16 * w) = v1;
      if (w == 0) {
#pragma unroll
        for (int e = 0; e < KC; ++e) DEC[KC * c + e] = __expf(tot[e]);
      }
    }
    __syncthreads();
    load_raw(min(ch + 1, nch - 1));
    if (SO) {
      const char* VTr = lds + L_VT + (32 * w + r32) * TS;
#pragma unroll
      for (int kt = 0; kt < DK / 32; ++kt)
#pragma unroll
        for (int g = 0; g < 4; ++g) {
          const f32x4 d = *(const f32x4*)(DEC + 32 * kt + 8 * g + 4 * h);
          S[kt][4 * g] *= d.x; S[kt][4 * g + 1] *= d.y; S[kt][4 * g + 2] *= d.z; S[kt][4 * g + 3] *= d.w;
        }
#pragma unroll
      for (int s = 0; s < 2; ++s) {
        const bf16x8 bq = *(const bf16x8*)(VTr + s * 32 + h * 16);
#pragma unroll
        for (int kt = 0; kt < DK / 32; ++kt) {
          const bf16x8 a = *(const bf16x8*)(lds + L_KENDT + (32 * kt + r32) * TS + s * 32 + h * 16);
          S[kt] = MFMA32(a, bq, S[kt]);
        }
      }
      __syncthreads();
    } else {
      f32x16 o;
      pc_core<DK>(lds, S, o, w, r32, h);
      {
        float ss = 0.f;
#pragma unroll
        for (int r = 0; r < 16; ++r) ss += o[r] * o[r];
        ss += __shfl_xor(ss, 32);
        if (h == 0) SSQ[w * 32 + r32] = ss;
      }
      __syncthreads();
      {
        const float tot2 = (SSQ[r32] + SSQ[32 + r32]) + (SSQ[64 + r32] + SSQ[96 + r32]);
        const float rstd = rsqrtf(tot2 * (1.f / 128.f) + 1e-6f);
        if (t0 + r32 < ntok) {
          bf16_t* orow = O + (size_t)(row0 + t0 + r32) * 1024 + ocol + 32 * w + 4 * h;
#pragma unroll
          for (int g = 0; g < 4; ++g) {
            const u32x2 gp = *(const u32x2*)(lds + L_G + r32 * RS + (32 * w + 8 * g + 4 * h) * 2);
            const f32x4 nw = *(const f32x4*)(nwp + 32 * w + 8 * g + 4 * h);
            const float y0 = o[4 * g] * rstd * nw.x * bflo(gp[0]);
            const float y1 = o[4 * g + 1] * rstd * nw.y * bfhi(gp[0]);
            const float y2 = o[4 * g + 2] * rstd * nw.z * bflo(gp[1]);
            const float y3 = o[4 * g + 3] * rstd * nw.w * bfhi(gp[1]);
            u32x2 v; v[0] = pk2(y0, y1); v[1] = pk2(y2, y3);
            *(u32x2*)(orow + 8 * g) = v;
          }
        }
      }
    }
  }
  if (s_out) {
#pragma unroll
    for (int kt = 0; kt < DK / 32; ++kt)
#pragma unroll
      for (int r = 0; r < 16; ++r) s_out[(size_t)(32 * kt + crow(r, h)) * 128 + 32 * w + r32] = S[kt][r];
  }
  if (SO && w == 0) {
#pragma unroll
    for (int e = 0; e < KC; ++e) d_out[KC * c + e] = dsum[e];
  }
  __syncthreads();
}

DI void phase_scan_even_a(const Params& p, char* lds, int bid, int G) {
  float* scr = (float*)(p.ws + OFF_MIX);
  const int half = threadIdx.x >> 8; lds += half * HALF_LDS;
  for (int jb = bid * 2; jb < 448 + 1024; jb += G * 2) {
    const int j = jb + half;
    if (j < 448) {
      const int type = j & 1, head = (j >> 1) & 3, b = (j >> 3) & 7, sc = j >> 6;
      const int row0 = b * SEQP + sc_beg(sc), ntok = sc_end(sc) - sc_beg(sc);
      const size_t slot = ((size_t)b * 4 + head) * 7 + sc;
      if (type == 0) scan_even_job<0, true>(p, lds, head, row0, ntok, nullptr, scr + SCR_HG_U + slot * 16384, scr + SCR_HG_D + slot * 128);
      else scan_even_job<1, true>(p, lds, head, row0, ntok, nullptr, scr + SCR_GL_U + slot * 8192, scr + SCR_GL_D + slot * 64);
    } else {
      const int jj = j - 448, type = jj & 1, head = (jj >> 1) & 3, b = jj >> 3;
      const int row0 = T_PROMPT + 4 * b;
      if (type == 0) scan_even_job<0, false>(p, lds, head, row0, 4, p.in[2] + ((size_t)b * 4 + head) * 16384, p.out + OUT_HGS + ((size_t)b * 4 + head) * 16384, nullptr);
      else scan_even_job<1, false>(p, lds, head, row0, 4, p.in[3] + ((size_t)b * 4 + head) * 8192, p.out + OUT_GLS + ((size_t)b * 4 + head) * 8192, nullptr);
    }
  }
}
DI void phase_scan_even_c(const Params& p, int bid, int G) {
  float* scr = (float*)(p.ws + OFF_MIX);
  for (int i = bid * NTHREADS + threadIdx.x; i < 32 * 4096 + 32 * 2048; i += G * NTHREADS) {
    const bool gl = i >= 32 * 4096;
    const int ii = gl ? i - 32 * 4096 : i;
    const int per = gl ? 2048 : 4096, bh = ii / per, e4 = ii - bh * per, k = e4 >> 5;
    float* U = scr + (gl ? SCR_GL_U + (size_t)bh * 7 * 8192 : SCR_HG_U + (size_t)bh * 7 * 16384) + 4 * e4;
    const float* D = scr + (gl ? SCR_GL_D + (size_t)bh * 7 * 64 : SCR_HG_D + (size_t)bh * 7 * 128) + k;
    const int ustride = gl ? 8192 : 16384, dstride = gl ? 64 : 128;
    f32x4 run = {0.f, 0.f, 0.f, 0.f};
#pragma unroll
    for (int sc = 0; sc < 7; ++sc) {
      const float d = __expf(D[sc * dstride]);
      const f32x4 u = *(const f32x4*)(U + (size_t)sc * ustride);
      run = run * d + u;
      *(f32x4*)(U + (size_t)sc * ustride) = run;
    }
  }
}
DI void phase_scan_even_b(const Params& p, char* lds, int bid, int G) {
  float* scr = (float*)(p.ws + OFF_MIX);
  const int half = threadIdx.x >> 8; lds += half * HALF_LDS;
  for (int jb = bid * 2; jb < 512; jb += G * 2) {
    const int j = jb + half;
    {
      const int type = j & 1, head = (j >> 1) & 3, b = (j >> 3) & 7, sc = j >> 6;
      const int row0 = b * SEQP + sc_beg(sc), ntok = sc_end(sc) - sc_beg(sc);
      const size_t slot = ((size_t)b * 4 + head) * 7 + sc - 1;
      if (type == 0) scan_even_job<0, false>(p, lds, head, row0, ntok, sc ? scr + SCR_HG_U + slot * 16384 : nullptr,
                                             sc == NSC - 1 ? p.out + OUT_HGP + ((size_t)b * 4 + head) * 16384 : nullptr, nullptr);
      else scan_even_job<1, false>(p, lds, head, row0, ntok, sc ? scr + SCR_GL_U + slot * 8192 : nullptr,
                                   sc == NSC - 1 ? p.out + OUT_GLP + ((size_t)b * 4 + head) * 8192 : nullptr, nullptr);
    }
  }
}

constexpr int M_BM = 0, M_CM = 8704, M_XS = 17408, M_Z = 26112, M_BT = 34816, M_VT = 45056, M_VENDT = 55296, M_CUM = 65536, M_DT = 65792, M_SSQ = 66048, M_CW = 66560;

DI void phase_conv(const Params& p, int bid, int G) {
  const bf16_t* P = (const bf16_t*)(p.ws + OFF_P);
  bf16_t* O = (bf16_t*)(p.ws + OFF_O);
  bf16_t* HN = (bf16_t*)(p.ws + OFF_HN);
  const float* __restrict__ cwp = p.in[19];
  const float* __restrict__ cbp = p.in[20];
  const int gt = bid * NTHREADS + threadIdx.x, NPAR = (G * NTHREADS) / 384;
  const int cg = gt % 384, r0 = gt / 384, ch = 8 * cg;
  if (r0 >= NPAR) return;
  float w[4][8], bs[8];
#pragma unroll
  for (int k = 0; k < 4; ++k) {
    const f32x4 a = *(const f32x4*)(cwp + k * 3072 + ch), b_ = *(const f32x4*)(cwp + k * 3072 + ch + 4);
    w[k][0] = a.x; w[k][1] = a.y; w[k][2] = a.z; w[k][3] = a.w; w[k][4] = b_.x; w[k][5] = b_.y; w[k][6] = b_.z; w[k][7] = b_.w;
  }
  {
    const f32x4 a = *(const f32x4*)(cbp + ch), b_ = *(const f32x4*)(cbp + ch + 4);
    bs[0] = a.x; bs[1] = a.y; bs[2] = a.z; bs[3] = a.w; bs[4] = b_.x; bs[5] = b_.y; bs[6] = b_.z; bs[7] = b_.w;
  }
  bf16_t* dbase = ch < 2048 ? O + ch : HN + (ch - 2048);
  const int dld = ch < 2048 ? 2048 : 1024;
  for (int run = r0; run < 8 * 258; run += NPAR) {
    const int b = run / 258, t0 = (run - b * 258) * 8, row0 = b * SEQP + t0;
    u32x4 pre[11];
#pragma unroll
    for (int i = 0; i < 11; ++i) {
      const int r = row0 + i - 3;
      pre[i] = (i >= 3 || t0 > 0) ? *(const u32x4*)(P + (size_t)r * LD_OD + 2048 + ch) : (u32x4){0u, 0u, 0u, 0u};
    }
#pragma unroll
    for (int i = 0; i < 8; ++i) {
      u32x4 o;
#pragma unroll
      for (int q = 0; q < 4; ++q) {
        float a0 = bs[2 * q], a1 = bs[2 * q + 1];
#pragma unroll
        for (int k = 0; k < 4; ++k) { a0 += bflo(pre[i + k][q]) * w[k][2 * q]; a1 += bfhi(pre[i + k][q]) * w[k][2 * q + 1]; }
        o[q] = pk2(siluf_(a0), siluf_(a1));
      }
      *(u32x4*)(dbase + (size_t)(row0 + i) * dld) = o;
    }
  }
  for (int sq = r0; sq < 128; sq += NPAR) {
    const int row0 = T_PROMPT + 4 * sq;
    float pf[7][8];
#pragma unroll
    for (int i = 0; i < 3; ++i) {
      const f32x4 a = *(const f32x4*)(p.in[5] + ((size_t)sq * 3 + i) * 3072 + ch), b_ = *(const f32x4*)(p.in[5] + ((size_t)sq * 3 + i) * 3072 + ch + 4);
      pf[i][0] = a.x; pf[i][1] = a.y; pf[i][2] = a.z; pf[i][3] = a.w; pf[i][4] = b_.x; pf[i][5] = b_.y; pf[i][6] = b_.z; pf[i][7] = b_.w;
    }
#pragma unroll
    for (int i = 0; i < 4; ++i) {
      const u32x4 u = *(const u32x4*)(P + (size_t)(row0 + i) * LD_OD + 2048 + ch);
#pragma unroll
      for (int q = 0; q < 4; ++q) { pf[3 + i][2 * q] = bflo(u[q]); pf[3 + i][2 * q + 1] = bfhi(u[q]); }
    }
#pragma unroll
    for (int i = 0; i < 4; ++i) {
      u32x4 o;
#pragma unroll
      for (int q = 0; q < 4; ++q) {
        float a0 = bs[2 * q], a1 = bs[2 * q + 1];
#pragma unroll
        for (int k = 0; k < 4; ++k) { a0 += pf[i + k][2 * q] * w[k][2 * q]; a1 += pf[i + k][2 * q + 1] * w[k][2 * q + 1]; }
        o[q] = pk2(siluf_(a0), siluf_(a1));
      }
      *(u32x4*)(dbase + (size_t)(row0 + i) * dld) = o;
    }
  }
}

template <bool SO>
DI void scan_odd_job(const Params& p, char* lds, const int b, const int hp, const bool smp, const int tbeg, const int tend, const float* s_in, float* s_out, float* d_out) {
  const int tid = threadIdx.x & (HB - 1), c = tid & 63, w = tid >> 6, r32 = c & 31, h = c >> 5;
  const int grp = hp >> 2, hl = w >> 1, headw = 2 * hp + hl;
  const int row0 = (smp ? T_PROMPT + 4 * b : b * SEQP) + tbeg, ntok = tend - tbeg;
  const bf16_t* P = (const bf16_t*)(p.ws + OFF_P);
  bf16_t* O = (bf16_t*)(p.ws + OFF_O);
  const bf16_t* BC = (const bf16_t*)(p.ws + OFF_HN);
  float* CUM = (float*)(lds + M_CUM);
  float* DTL = (float*)(lds + M_DT);
  float* SSQ = (float*)(lds + M_SSQ);
  const int hd_l = 2 * hp + h;
  const float dtb = p.in[21][hd_l], aneg = -__expf(p.in[22][hd_l]);
  const float dsk = p.in[23][headw];
  f32x16 S[4];
  {
    const float* sin = s_in + ((size_t)hl * 64 + 32 * (w & 1) + r32) * 128;
#pragma unroll
    for (int kt = 0; kt < 4; ++kt)
#pragma unroll
      for (int g = 0; g < 4; ++g) {
        f32x4 v = {0.f, 0.f, 0.f, 0.f};
        if (!SO && s_in) v = *(const f32x4*)(sin + 32 * kt + 8 * g + 4 * h);
        S[kt][4 * g] = v.x; S[kt][4 * g + 1] = v.y; S[kt][4 * g + 2] = v.z; S[kt][4 * g + 3] = v.w;
      }
  }
  float dsum = 0.f;
  unsigned rx[8], rb[8], rc[8], rz[8]; float rdt;
  auto load_raw = [&](int ch) {
#pragma unroll
    for (int i = 0; i < 8; ++i) {
      const int t = min(ch * 32 + 8 * w + i, ntok - 1);
      rx[i] = *(const unsigned*)(O + (size_t)(row0 + t) * 2048 + hp * 128 + 2 * c);
      rb[i] = *(const unsigned*)(BC + (size_t)(row0 + t) * 1024 + grp * 128 + 2 * c);
      if (!SO) {
        rc[i] = *(const unsigned*)(BC + (size_t)(row0 + t) * 1024 + 512 + grp * 128 + 2 * c);
        rz[i] = *(const unsigned*)(P + (size_t)(row0 + t) * LD_OD + hp * 128 + 2 * c);
      }
    }
    {
      const int t = min(ch * 32 + r32, ntok - 1);
      rdt = bflo((unsigned)P[(size_t)(row0 + t) * LD_OD + 5120 + hd_l]);
    }
  };
  const int nch = __builtin_amdgcn_readfirstlane((ntok + 31) >> 5);
  load_raw(0);
  for (int ch = 0; ch < nch; ++ch) {
    const int t0 = ch * 32;
    {
      const float xdt = rdt + dtb;
      float dt = xdt > 20.f ? xdt : __logf(1.f + __expf(xdt));
      dt = (t0 + r32 < ntok) ? dt : 0.f;
      float cs = dt * aneg;
#pragma unroll
      for (int d = 1; d < 32; d <<= 1) { const float o_ = __shfl_up(cs, d, 32); if (r32 >= d) cs += o_; }
      if (w == 0) { CUM[h * 32 + r32] = cs; DTL[h * 32 + r32] = dt; }
    }
    {
#pragma unroll
      for (int i = 0; i < 8; ++i) {
        if (!SO) {
          *(unsigned*)(lds + M_BM + (8 * w + i) * RS + 4 * c) = rb[i];
          *(unsigned*)(lds + M_CM + (8 * w + i) * RS + 4 * c) = rc[i];
          *(unsigned*)(lds + M_XS + (8 * w + i) * RS + 4 * c) = rx[i];
          *(unsigned*)(lds + M_Z + (8 * w + i) * RS + 4 * c) = rz[i];
        }
      }
      u32x4 b0, b1;
#pragma unroll
      for (int m = 0; m < 4; ++m) {
        b0[m] = (rb[2 * m] & 0xffffu) | (rb[2 * m + 1] << 16);
        b1[m] = (rb[2 * m] >> 16) | (rb[2 * m + 1] & 0xffff0000u);
      }
      *(u32x4*)(lds + M_BT + (2 * c) * TS + 16 * w) = b0;
      *(u32x4*)(lds + M_BT + (2 * c + 1) * TS + 16 * w) = b1;
    }
    __syncthreads();
    {
      const int hx = c >> 5;
      const float last = CUM[hx * 32 + 31];
      float vt[8][2], ve[8][2];
#pragma unroll
      for (int i = 0; i < 8; ++i) {
        const int ti = 8 * w + i;
        const float dt = DTL[hx * 32 + ti], cm = CUM[hx * 32 + ti];
        const float ee = __expf(last - cm);
        vt[i][0] = bflo(rx[i]) * dt; vt[i][1] = bfhi(rx[i]) * dt;
        ve[i][0] = vt[i][0] * ee; ve[i][1] = vt[i][1] * ee;
      }
#pragma unroll
      for (int e = 0; e < 2; ++e) {
        u32x4 pv, pe;
#pragma unroll
        for (int m = 0; m < 4; ++m) { pv[m] = pk2(vt[2 * m][e], vt[2 * m + 1][e]); pe[m] = pk2(ve[2 * m][e], ve[2 * m + 1][e]); }
        if (!SO) *(u32x4*)(lds + M_VT + (2 * c + e) * TS + 16 * w) = pv;
        *(u32x4*)(lds + M_VENDT + (2 * c + e) * TS + 16 * w) = pe;
      }
    }
    __syncthreads();
    load_raw(min(ch + 1, nch - 1));
    f32x16 o;
    const float lastw = CUM[hl * 32 + 31];
    dsum += lastw;
    if (!SO) {
      const char* BMr = lds + M_BM + r32 * RS;
      const char* CMr = lds + M_CM + r32 * RS;
      f32x16 sc; zero16(sc);
#pragma unroll
      for (int s = 0; s < 8; ++s) {
        const bf16x8 a = *(const bf16x8*)(BMr + s * 32 + h * 16);
        const bf16x8 bq = *(const bf16x8*)(CMr + s * 32 + h * 16);
        sc = MFMA32(a, bq, sc);
      }
      const float ci = CUM[hl * 32 + r32];
#pragma unroll
      for (int g = 0; g < 4; ++g) {
        const f32x4 cj = *(const f32x4*)(CUM + hl * 32 + 8 * g + 4 * h);
#pragma unroll
        for (int e = 0; e < 4; ++e) {
          const int j = 8 * g + 4 * h + e;
          const float cje = e == 0 ? cj.x : (e == 1 ? cj.y : (e == 2 ? cj.z : cj.w));
          sc[4 * g + e] = (j <= r32) ? sc[4 * g + e] * __expf(ci - cje) : 0.f;
        }
      }
      const bf16x8 scb0 = pack8<0>(sc), scb1 = pack8<1>(sc);
      zero16(o);
#pragma unroll
      for (int kt = 0; kt < 4; ++kt) {
        {
          const bf16x8 a = pack8<0>(S[kt]);
          const s16x4 lo = *(const s16x4*)(CMr + (32 * kt + 4 * h) * 2), hi = *(const s16x4*)(CMr + (32 * kt + 8 + 4 * h) * 2);
          o = MFMA32(a, cat8(lo, hi), o);
        }
        {
          const bf16x8 a = pack8<1>(S[kt]);
          const s16x4 lo = *(const s16x4*)(CMr + (32 * kt + 16 + 4 * h) * 2), hi = *(const s16x4*)(CMr + (32 * kt + 24 + 4 * h) * 2);
          o = MFMA32(a, cat8(lo, hi), o);
        }
      }
      const float ei = __expf(ci);
#pragma unroll
      for (int r = 0; r < 16; ++r) o[r] *= ei;
      const char* VTr = lds + M_VT + (32 * w + r32) * TS;
      {
        const s16x4 lo = *(const s16x4*)(VTr + (4 * h) * 2), hi = *(const s16x4*)(VTr + (8 + 4 * h) * 2);
        o = MFMA32(cat8(lo, hi), scb0, o);
      }
      {
        const s16x4 lo = *(const s16x4*)(VTr + (16 + 4 * h) * 2), hi = *(const s16x4*)(VTr + (24 + 4 * h) * 2);
        o = MFMA32(cat8(lo, hi), scb1, o);
      }
    }
    {
      const float el = __expf(lastw);
#pragma unroll
      for (int kt = 0; kt < 4; ++kt)
#pragma unroll
        for (int r = 0; r < 16; ++r) S[kt][r] *= el;
      const char* VEr = lds + M_VENDT + (32 * w + r32) * TS;
#pragma unroll
      for (int s = 0; s < 2; ++s) {
        const bf16x8 bq = *(const bf16x8*)(VEr + s * 32 + h * 16);
#pragma unroll
        for (int kt = 0; kt < 4; ++kt) {
          const bf16x8 a = *(const bf16x8*)(lds + M_BT + (32 * kt + r32) * TS + s * 32 + h * 16);
          S[kt] = MFMA32(a, bq, S[kt]);
        }
      }
    }
    if (!SO) {
      float y[16]; float ss = 0.f;
#pragma unroll
      for (int g = 0; g < 4; ++g) {
        const u32x2 xp = *(const u32x2*)(lds + M_XS + r32 * RS + (32 * w + 8 * g + 4 * h) * 2);
        const u32x2 zp = *(const u32x2*)(lds + M_Z + r32 * RS + (32 * w + 8 * g + 4 * h) * 2);
        y[4 * g] = (o[4 * g] + dsk * bflo(xp[0])) * bflo(zp[0]);
        y[4 * g + 1] = (o[4 * g + 1] + dsk * bfhi(xp[0])) * bfhi(zp[0]);
        y[4 * g + 2] = (o[4 * g + 2] + dsk * bflo(xp[1])) * bflo(zp[1]);
        y[4 * g + 3] = (o[4 * g + 3] + dsk * bfhi(xp[1])) * bfhi(zp[1]);
      }
#pragma unroll
      for (int r = 0; r < 16; ++r) ss += y[r] * y[r];
      ss += __shfl_xor(ss, 32);
      if (h == 0) SSQ[w * 32 + r32] = ss;
      if (t0 + r32 < ntok) {
        bf16_t* orow = O + (size_t)(row0 + t0 + r32) * 2048 + hp * 128 + 32 * w + 4 * h;
#pragma unroll
        for (int g = 0; g < 4; ++g) { u32x2 v; v[0] = pk2(y[4 * g], y[4 * g + 1]); v[1] = pk2(y[4 * g + 2], y[4 * g + 3]); *(u32x2*)(orow + 8 * g) = v; }
      }
    }
    __syncthreads();
    if (!SO && tid < 32 && t0 + tid < ntok) {
      float* q = (float*)(p.ws + OFF_SSQ);
      q[(size_t)(row0 + t0 + tid) * 16 + hp] = (SSQ[tid] + SSQ[32 + tid]) + (SSQ[64 + tid] + SSQ[96 + tid]);
    }
  }
  if (s_out) {
    float* so = s_out + ((size_t)hl * 64 + 32 * (w & 1) + r32) * 128;
#pragma unroll
    for (int kt = 0; kt < 4; ++kt)
#pragma unroll
      for (int g = 0; g < 4; ++g) {
        f32x4 v = {S[kt][4 * g], S[kt][4 * g + 1], S[kt][4 * g + 2], S[kt][4 * g + 3]};
        *(f32x4*)(so + 32 * kt + 8 * g + 4 * h) = v;
      }
  }
  if (SO && (w & 1) == 0 && c == 0) d_out[hl * 7] = dsum;
  __syncthreads();
}

DI void phase_scan_odd_a(const Params& p, char* lds, int bid, int G) {
  float* scr = (float*)(p.ws + OFF_MIX);
  const int half = threadIdx.x >> 8; lds += half * HALF_LDS;
  for (int jb = bid * 2; jb < 896 + 2048; jb += G * 2) {
    const int j = jb + half;
    if (j >= 896) {
      const int jj = j - 896, hp = jj & 15, b = jj >> 4;
      scan_odd_job<false>(p, lds, b, hp, true, 0, 4, p.in[4] + ((size_t)b * 32 + 2 * hp) * 8192, p.out + OUT_SSS + ((size_t)b * 32 + 2 * hp) * 8192, nullptr);
      continue;
    }
    const int hp = j & 15, b = (j >> 4) & 7, sc = j >> 7;
    float* U = scr + SCR_SS_U + ((((size_t)b * 16 + hp) * 7 + sc) * 2) * 8192;
    float* D = scr + SCR_SS_D + ((size_t)b * 32 + 2 * hp) * 7 + sc;
    scan_odd_job<true>(p, lds, b, hp, false, sc_beg(sc), sc_end(sc), nullptr, U, D);
  }
}
DI void phase_scan_odd_c(const Params& p, int bid, int G) {
  float* scr = (float*)(p.ws + OFF_MIX);
  for (int i = bid * NTHREADS + threadIdx.x; i < 128 * 2 * 2048; i += G * NTHREADS) {
    const int e4 = i & 2047, hd = (i >> 11) & 1, bhp = i >> 12;
    float* U = scr + SCR_SS_U + ((size_t)bhp * 7 * 2 + hd) * 8192 + 4 * e4;
    const float* D = scr + SCR_SS_D + ((size_t)(bhp >> 4) * 32 + 2 * (bhp & 15) + hd) * 7;
    f32x4 run = {0.f, 0.f, 0.f, 0.f};
#pragma unroll
    for (int sc = 0; sc < 7; ++sc) {
      const float d = __expf(D[sc]);
      const f32x4 u = *(const f32x4*)(U + (size_t)sc * 16384);
      run = run * d + u;
      *(f32x4*)(U + (size_t)sc * 16384) = run;
    }
  }
}
DI void phase_scan_odd_b(const Params& p, char* lds, int bid, int G) {
  float* scr = (float*)(p.ws + OFF_MIX);
  const int half = threadIdx.x >> 8; lds += half * HALF_LDS;
  for (int jb = bid * 2; jb < 1024; jb += G * 2) {
    const int j = jb + half;
    {
      const int hp = j & 15, b = (j >> 4) & 7, sc = j >> 7;
      const float* s_in = sc ? scr + SCR_SS_U + ((((size_t)b * 16 + hp) * 7 + sc - 1) * 2) * 8192 : nullptr;
      float* s_out = sc == NSC - 1 ? p.out + OUT_SSP + ((size_t)b * 32 + 2 * hp) * 8192 : nullptr;
      scan_odd_job<false>(p, lds, b, hp, false, sc_beg(sc), sc_end(sc), s_in, s_out, nullptr);
    }
  }
  const bf16_t* P = (const bf16_t*)(p.ws + OFF_P);
  for (int i = bid * NTHREADS + threadIdx.x; i < 136 * 3 * 3072; i += G * NTHREADS) {
    const int ch = i % 3072, r = i / 3072, j = r % 3, b = r / 3;
    if (b < 8) p.out[OUT_CVP + ((size_t)b * 3 + j) * 3072 + ch] = bflo((unsigned)P[(size_t)(b * SEQP + 2061 + j) * LD_OD + 2048 + ch]);
    else { const int bs = b - 8; p.out[OUT_CVS + ((size_t)bs * 3 + j) * 3072 + ch] = bflo((unsigned)P[(size_t)(T_PROMPT + 4 * bs + 1 + j) * LD_OD + 2048 + ch]); }
  }
}

#define XB_TMO      128
#define XB_XCNT(j)  (256  + 64 * (j))
#define XB_XSUB(j)  (1280 + 64 * (j))
#define XB_XGEN(j)  (2304 + 64 * (j))
#define XB_TOP      3328
#define XB_TOPGEN   3392
#define XCD_BAR_WORDS 3456
#define XB_SPIN_CAP (1u << 20)
#define LAS __attribute__((address_space(3)))
DI unsigned xb_ld(unsigned* p) { return __hip_atomic_load(p, __ATOMIC_RELAXED, __HIP_MEMORY_SCOPE_AGENT); }
DI unsigned xb_add(unsigned* p, unsigned v) { return __hip_atomic_fetch_add(p, v, __ATOMIC_RELAXED, __HIP_MEMORY_SCOPE_AGENT); }
DI unsigned xb_xcc_id() { return (unsigned)__builtin_amdgcn_s_getreg((3 << 11) | 20) & 0xFu; }
#define XB_SPIN(cond, bar) do { unsigned _sp = 0; while (cond) { __builtin_amdgcn_s_sleep(1); \
    if ((++_sp & 255u) == 0u) { if (xb_ld(&(bar)[XB_TMO])) break; if (_sp > XB_SPIN_CAP) { atomicAdd(&(bar)[XB_TMO], 1u); break; } } } } while (0)
struct XcdBarrier { unsigned* bar; unsigned x; volatile LAS unsigned* st; };
DI XcdBarrier xcd_barrier_post(unsigned* bar, volatile LAS unsigned* st) {
  XcdBarrier b; b.bar = bar; b.x = xb_xcc_id(); b.st = st;
  if (threadIdx.x == 0) (void)xb_add(&bar[XB_XCNT(b.x)], 1u);
  return b;
}
DI void xcd_barrier_complete(unsigned* bar, unsigned x, unsigned& nloc, unsigned& nx) {
  const unsigned G = gridDim.x * gridDim.y * gridDim.z;
  unsigned sum, cnt, mine, sp = 0u;
  for (;;) {
    sum = 0u; cnt = 0u; mine = 0u;
#pragma unroll
    for (unsigned j = 0; j < 16; ++j) { const unsigned c = xb_ld(&bar[XB_XCNT(j)]); sum += c; cnt += (c > 0u) ? 1u : 0u; mine = (j == x) ? c : mine; }
    if (sum == G) break;
    __builtin_amdgcn_s_sleep(1);
    if ((++sp & 255u) == 0u) { if (xb_ld(&bar[XB_TMO])) break; if (sp > XB_SPIN_CAP) { atomicAdd(&bar[XB_TMO], 1u); break; } }
  }
  nloc = mine > 0u ? mine : 1u; nx = cnt > 0u ? cnt : 1u;
}
DI void xcd_barrier(const XcdBarrier& b) {
  asm volatile("s_waitcnt vmcnt(0)" ::: "memory");
  __syncthreads();
  if (threadIdx.x == 0) {
    unsigned* bar = b.bar;
    __builtin_amdgcn_s_waitcnt(0);
    unsigned nloc = b.st[0], nx = b.st[1];
    if (nloc == 0u) { xcd_barrier_complete(bar, b.x, nloc, nx); b.st[0] = nloc; b.st[1] = nx; }
    const unsigned old = xb_add(&bar[XB_XSUB(b.x)], 1u);
    const unsigned gen = old / nloc;
    if (old + 1u == (gen + 1u) * nloc) {
      __builtin_amdgcn_fence(__ATOMIC_RELEASE, "agent");
      asm volatile("s_waitcnt vmcnt(0)" ::: "memory");
      const unsigned og = xb_add(&bar[XB_TOP], 1u);
      const unsigned tg = og / nx;
      if (og + 1u == (tg + 1u) * nx) xb_add(&bar[XB_TOPGEN], 1u);
      else XB_SPIN(xb_ld(&bar[XB_TOPGEN]) == tg, bar);
      __builtin_amdgcn_fence(__ATOMIC_ACQUIRE, "agent");
      xb_add(&bar[XB_XGEN(b.x)], 1u);
      asm volatile("s_waitcnt vmcnt(0)" ::: "memory");
    } else {
      XB_SPIN(xb_ld(&bar[XB_XGEN(b.x)]) == gen, bar);
      __builtin_amdgcn_fence(__ATOMIC_ACQUIRE, "agent");
      asm volatile("s_waitcnt vmcnt(0)" ::: "memory");
    }
  }
  __syncthreads();
}

constexpr int N_PHASES = 21;
#ifndef ONLY_PHASE
#define ONLY_PHASE -1
#endif
#define PHASE(k, body) do { if ((ONLY_PHASE < 0 || ONLY_PHASE == (k)) && ph_lo <= (k) && (k) <= ph_hi) { body; } if (ph_lo <= (k) && (k) < ph_hi) xcd_barrier(xb); } while (0)

__global__ void __launch_bounds__(NTHREADS, 2) fwd_mega(Params p, int ph_lo, int ph_hi) {
  extern __shared__ __attribute__((aligned(16))) char lds[];
  cg::grid_group grid = cg::this_grid();
  const int G = gridDim.x, bid = blockIdx.x;
  if (ph_lo > 1000) grid.sync();
  volatile LAS unsigned* xst = (volatile LAS unsigned*)(lds + 2 * HALF_LDS);
  if (threadIdx.x == 0) { xst[0] = 0u; xst[1] = 0u; }
  __syncthreads();
  XcdBarrier xb = xcd_barrier_post((unsigned*)(p.ws + OFF_BAR), xst);
  bf16_t* HN = (bf16_t*)(p.ws + OFF_HN);
  bf16_t* Pb = (bf16_t*)(p.ws + OFF_P);
  bf16_t* Ob = (bf16_t*)(p.ws + OFF_O);
  float* MIX = (float*)(p.ws + OFF_MIX);
  PHASE(0, phase_prep(p, lds, bid, G));
  PHASE(1, gemm_run(lds, HN, (const bf16_t*)(p.ws + OFF_WT_EVIN), LD_EV, 1024, EpiStoreBf16{Pb, LD_EV, (1u << 6) | (1u << 7) | (1u << 12) | (1u << 13), (1u << 2) | (1u << 3)}, bid, G));
  PHASE(2, phase_scan_even_a(p, lds, bid, G));
  PHASE(3, phase_scan_even_c(p, bid, G));
  PHASE(4, phase_scan_even_b(p, lds, bid, G));
  PHASE(5, gemm_n1024<false>(lds, Ob, (const bf16_t*)(p.ws + OFF_WT_EVOUT), 1024, EpiResNorm<false>{(bf16_t*)(p.ws + OFF_X), (bf16_t*)(p.ws + OFF_HN), p.in[9], p.in[10], nullptr, (float*)(p.ws + OFF_XB) + 0 * (SZ_XB_SET / 4), (unsigned*)(p.ws + OFF_CNT) + 0 * (SZ_CNT_SET / 4), (unsigned*)(p.ws + OFF_BAR) + 64}, (float*)Pb, bid, G));
  PHASE(6, phase_rowwise(p, p.in[9], p.in[10], false, (const float*)Pb, 4, M_MAIN, bid, G));
  PHASE(7, gemm_run(lds, HN, (const bf16_t*)(p.ws + OFF_WT_GU), 5632, 1024, EpiSwiglu{Pb, 2816}, bid, G));
  PHASE(8, gemm_n1024<false>(lds, Pb, (const bf16_t*)(p.ws + OFF_WT_DN), 2816, EpiResNorm<false>{(bf16_t*)(p.ws + OFF_X), (bf16_t*)(p.ws + OFF_HN), p.in[11], p.in[8] + 1024, nullptr, (float*)(p.ws + OFF_XB) + 2 * (SZ_XB_SET / 4), (unsigned*)(p.ws + OFF_CNT) + 2 * (SZ_CNT_SET / 4), (unsigned*)(p.ws + OFF_BAR) + 64}, (float*)Ob, bid, G));
  PHASE(9, phase_rowwise(p, p.in[11], p.in[8] + 1024, false, (const float*)Ob, 11, M_MAIN, bid, G));
  PHASE(10, gemm_run(lds, HN, (const bf16_t*)(p.ws + OFF_WT_ODIN), LD_OD, 1024, EpiStoreBf16{Pb, LD_OD, 0xffu, 0u}, bid, G));
  PHASE(11, phase_conv(p, bid, G));
  PHASE(12, phase_scan_odd_a(p, lds, bid, G));
  PHASE(13, phase_scan_odd_c(p, bid, G));
  PHASE(14, phase_scan_odd_b(p, lds, bid, G));
  PHASE(15, phase_groupnorm(p, bid, G));
  PHASE(16, gemm_n1024<false>(lds, Ob, (const bf16_t*)(p.ws + OFF_WT_ODOUT), 2048, EpiResNorm<false>{(bf16_t*)(p.ws + OFF_X), (bf16_t*)(p.ws + OFF_HN), p.in[9] + 1024, p.in[10] + 1024, nullptr, (float*)(p.ws + OFF_XB) + 4 * (SZ_XB_SET / 4), (unsigned*)(p.ws + OFF_CNT) + 4 * (SZ_CNT_SET / 4), (unsigned*)(p.ws + OFF_BAR) + 64}, (float*)Pb, bid, G));
  PHASE(17, phase_rowwise(p, p.in[9] + 1024, p.in[10] + 1024, false, (const float*)Pb, 8, M_MAIN, bid, G));
  PHASE(18, gemm_run(lds, HN, (const bf16_t*)(p.ws + OFF_WT_GU + SZ_WT_GU1), 5632, 1024, EpiSwiglu{Pb, 2816}, bid, G));
  PHASE(19, gemm_n1024<true>(lds, Pb, (const bf16_t*)(p.ws + OFF_WT_DN + SZ_WT_DN1), 2816, EpiResNorm<true>{(bf16_t*)(p.ws + OFF_X), (bf16_t*)(p.ws + OFF_HN), p.in[11] + 1024, nullptr, p.out + OUT_YP, (float*)(p.ws + OFF_XB) + 6 * (SZ_XB_SET / 4), (unsigned*)(p.ws + OFF_CNT) + 6 * (SZ_CNT_SET / 4), (unsigned*)(p.ws + OFF_BAR) + 64}, (float*)Ob, bid, G));
  PHASE(20, phase_rowwise(p, p.in[11] + 1024, nullptr, true, (const float*)Ob, 11, M_MAIN, bid, G));
}

extern "C" void kernel_launch(void* const* d_in, const int* in_sizes, int n_in, void* d_out, int out_size, void* d_ws, size_t ws_size, hipStream_t stream) {
  static int grid_blocks = 0;
  if (!grid_blocks) {
    int dev = 0, cus = 0, per_cu = 0;
    hipGetDevice(&dev);
    hipDeviceGetAttribute(&cus, hipDeviceAttributeMultiprocessorCount, dev);
    hipFuncSetAttribute((const void*)fwd_mega, hipFuncAttributeMaxDynamicSharedMemorySize, LDS_BYTES);
    hipOccupancyMaxActiveBlocksPerMultiprocessor(&per_cu, (const void*)fwd_mega, NTHREADS, LDS_BYTES);
    if (per_cu < 1) per_cu = 1;
    if (per_cu > 1) per_cu = 1;
    grid_blocks = cus * per_cu;
    if (ws_size < WS_END) fprintf(stderr, "kernel_launch: workspace too small: %zu < %zu\n", ws_size, (size_t)WS_END);
  }
  Params p{};
  for (int i = 0; i < 29; ++i) p.in[i] = (const float*)d_in[i];
  p.out = (float*)d_out;
  p.ws = (char*)d_ws;
  (void)hipMemsetAsync((char*)d_ws + OFF_BAR, 0, 16384 + 8 * SZ_CNT_SET, stream);
#if ONE_LAUNCH
  int lo = 0, hi = N_PHASES - 1;
  void* args[] = {&p, &lo, &hi};
  hipError_t e = hipLaunchCooperativeKernel((const void*)fwd_mega, dim3(grid_blocks), dim3(NTHREADS), args, LDS_BYTES, stream);
  if (e != hipSuccess) fprintf(stderr, "cooperative launch failed: %s (grid %d)\n", hipGetErrorString(e), grid_blocks);
#else
  for (int ph = 0; ph < N_PHASES; ++ph) {
    int lo = ph, hi = ph;
    void* args[] = {&p, &lo, &hi};
    hipError_t e = hipLaunchCooperativeKernel((const void*)fwd_mega, dim3(grid_blocks), dim3(NTHREADS), args, LDS_BYTES, stream);
    if (e != hipSuccess) fprintf(stderr, "launch failed: %s (grid %d)\n", hipGetErrorString(e), grid_blocks);
  }
#endif
}
```

```cpp
#include <hip/hip_runtime.h>
#include <hip/hip_cooperative_groups.h>
#include <cstdio>
#include <cstdint>
namespace cg = cooperative_groups;

#ifndef ONE_LAUNCH
#define ONE_LAUNCH 1
#endif

#define DI __device__ __forceinline__
typedef unsigned short bf16_t;
typedef short bf16x8 __attribute__((ext_vector_type(8)));
typedef short s16x4 __attribute__((ext_vector_type(4)));
typedef float f32x16 __attribute__((ext_vector_type(16)));
typedef float f32x4 __attribute__((ext_vector_type(4)));
typedef float f32x2 __attribute__((ext_vector_type(2)));
typedef unsigned u32x4 __attribute__((ext_vector_type(4)));
typedef unsigned u32x2 __attribute__((ext_vector_type(2)));
typedef __bf16 bf16v2 __attribute__((ext_vector_type(2)));
#define MFMA32(a, b, c) __builtin_amdgcn_mfma_f32_32x32x16_bf16((a), (b), (c), 0, 0, 0)

constexpr int T_ALL = 17024, T_PAD = 17152, T_PROMPT = 16512, SEQP = 2064, NTHREADS = 512, HB = 256  ;
constexpr int LD_EV = 3840, LD_OD = 5376;
constexpr int HALF_LDS = 75776;
constexpr int LDS_BYTES = 2 * HALF_LDS + 32;
constexpr int M_MAIN = 16384;

constexpr size_t OFF_WT_EVIN = 0;
constexpr size_t OFF_WT_EVOUT = OFF_WT_EVIN + (size_t)3840 * 1024 * 2;
constexpr size_t OFF_WT_GU = OFF_WT_EVOUT + (size_t)1024 * 1024 * 2;
constexpr size_t SZ_WT_GU1 = (size_t)5632 * 1024 * 2;
constexpr size_t OFF_WT_DN = OFF_WT_GU + 2 * SZ_WT_GU1;
constexpr size_t SZ_WT_DN1 = (size_t)1024 * 2816 * 2;
constexpr size_t OFF_WT_ODIN = OFF_WT_DN + 2 * SZ_WT_DN1;
constexpr size_t OFF_WT_ODOUT = OFF_WT_ODIN + (size_t)5376 * 1024 * 2;
constexpr size_t OFF_X = OFF_WT_ODOUT + (size_t)1024 * 2048 * 2;
constexpr size_t OFF_HN = OFF_X + (size_t)T_PAD * 1024 * 4;
constexpr size_t OFF_P = OFF_HN + (size_t)T_PAD * 1024 * 2;
constexpr size_t OFF_O = OFF_P + (size_t)T_PAD * 5376 * 2;
constexpr size_t OFF_MIX = OFF_O + (size_t)T_PAD * 2048 * 2;
constexpr size_t OFF_SSQ = OFF_MIX + (size_t)T_PAD * 1024 * 4;
constexpr size_t OFF_BAR = OFF_SSQ + (size_t)T_PAD * 16 * 4;
constexpr size_t OFF_CNT = OFF_BAR + 16384;
constexpr size_t SZ_CNT_SET = 64 * 256;
constexpr size_t OFF_XB = OFF_CNT + 8 * SZ_CNT_SET;
constexpr size_t SZ_XB_SET = (size_t)64 * 256 * 4 * 4;
constexpr size_t WS_END = OFF_XB + 8 * SZ_XB_SET;

constexpr size_t OUT_YP = 0;
constexpr size_t OUT_YS = 16777216;
constexpr size_t OUT_HGP = OUT_YS + 524288;
constexpr size_t OUT_GLP = OUT_HGP + 524288;
constexpr size_t OUT_SSP = OUT_GLP + 262144;
constexpr size_t OUT_CVP = OUT_SSP + 2097152;
constexpr size_t OUT_HGS = OUT_CVP + 73728;
constexpr size_t OUT_GLS = OUT_HGS + 8388608;
constexpr size_t OUT_SSS = OUT_GLS + 4194304;
constexpr size_t OUT_CVS = OUT_SSS + 33554432;

struct Params { const float* in[29]; float* out; char* ws; };

DI unsigned pk2(float lo, float hi) { f32x2 v = {lo, hi}; bf16v2 b = __builtin_convertvector(v, bf16v2); return __builtin_bit_cast(unsigned, b); }
DI float bflo(unsigned u) { return __uint_as_float(u << 16); }
DI float bfhi(unsigned u) { return __uint_as_float(u & 0xffff0000u); }
DI f32x4 ld_bf4(const bf16_t* p) { const u32x2 u = *(const u32x2*)p; return (f32x4){bflo(u[0]), bfhi(u[0]), bflo(u[1]), bfhi(u[1])}; }
DI void st_bf4(bf16_t* p, f32x4 v) { u32x2 u; u[0] = pk2(v.x, v.y); u[1] = pk2(v.z, v.w); *(u32x2*)p = u; }
DI float sigmoidf_(float x) { return __builtin_amdgcn_rcpf(1.f + __expf(-x)); }
DI float siluf_(float x) { return x * sigmoidf_(x); }
DI int crow(int r, int h) { return (r & 3) + 8 * (r >> 2) + 4 * h; }
DI bf16x8 cat8(s16x4 lo, s16x4 hi) { return __builtin_shufflevector(lo, hi, 0, 1, 2, 3, 4, 5, 6, 7); }
template <int S> DI bf16x8 pack8(const f32x16& x) {
  u32x4 p;
  p[0] = pk2(x[8 * S + 0], x[8 * S + 1]); p[1] = pk2(x[8 * S + 2], x[8 * S + 3]);
  p[2] = pk2(x[8 * S + 4], x[8 * S + 5]); p[3] = pk2(x[8 * S + 6], x[8 * S + 7]);
  return __builtin_bit_cast(bf16x8, p);
}
DI float wave_sum(float v) {
#pragma unroll
  for (int o = 1; o < 64; o <<= 1) v += __shfl_xor(v, o);
  return v;
}
DI void zero16(f32x16& a) {
#pragma unroll
  for (int i = 0; i < 16; ++i) a[i] = 0.f;
}

DI void transpose_tile(const float* __restrict__ W, int K, int N, bf16_t* Wt, int mode, int kt, int nt, float* tile, bool active, const float* __restrict__ wup) {
  const int tid = threadIdx.x & (HB - 1), k0 = kt * 64, n0 = nt * 64;
  if (active) {
    const int c = tid & 63, r0 = tid >> 6, n = n0 + c;
    if (wup && n0 >= 3584) {
      float wc[16];
#pragma unroll
      for (int r = 0; r < 16; ++r) wc[r] = wup[r * 256 + (n - 3584)];
#pragma unroll
      for (int i = 0; i < 16; ++i) {
        const int k = r0 + 4 * i;
        const float* wr_ = W + (size_t)(k0 + k) * N + 3584;
        float a = 0.f;
#pragma unroll
        for (int r = 0; r < 16; ++r) a += wr_[r] * wc[r];
        tile[k * 65 + c] = a;
      }
    } else {
#pragma unroll
      for (int i = 0; i < 16; ++i) { const int k = r0 + 4 * i; tile[k * 65 + c] = (n < N) ? W[(size_t)(k0 + k) * N + n] : 0.f; }
    }
  }
  __syncthreads();
  if (active) {
    const int nl = tid >> 2, kc = (tid & 3) * 16, n = n0 + nl;
    int drow = n;
    if (mode == 1) drow = (n >> 7) * 256 + (n & 127);
    if (mode == 2) drow = (n >> 7) * 256 + 128 + (n & 127);
    u32x4 o0, o1;
#pragma unroll
    for (int j = 0; j < 4; ++j) {
      o0[j] = pk2(tile[(kc + 2 * j) * 65 + nl], tile[(kc + 2 * j + 1) * 65 + nl]);
      o1[j] = pk2(tile[(kc + 8 + 2 * j) * 65 + nl], tile[(kc + 8 + 2 * j + 1) * 65 + nl]);
    }
    u32x4* d = (u32x4*)(Wt + (size_t)drow * K + k0 + kc);
    d[0] = o0; d[1] = o1;
  }
  __syncthreads();
}

DI void rms_row_to_bf16(const f32x4 (&v)[4], const float* __restrict__ wn, bf16_t* dst, int lane) {
  float s = 0.f;
#pragma unroll
  for (int j = 0; j < 4; ++j) s += v[j].x * v[j].x + v[j].y * v[j].y + v[j].z * v[j].z + v[j].w * v[j].w;
  const float rstd = rsqrtf(wave_sum(s) * (1.f / 1024.f) + 1e-6f);
#pragma unroll
  for (int j = 0; j < 4; ++j) {
    const f32x4 g = *(const f32x4*)(wn + 256 * j + 4 * lane);
    u32x2 o; o[0] = pk2(v[j].x * rstd * g.x, v[j].y * rstd * g.y); o[1] = pk2(v[j].z * rstd * g.z, v[j].w * rstd * g.w);
    *(u32x2*)(dst + 256 * j + 4 * lane) = o;
  }
}

DI void phase_prep(const Params& p, char* lds, int bid, int G) {
  const int half = threadIdx.x >> 8;
  float* tile = (float*)(lds + half * HALF_LDS);
  constexpr int NT_TILES = 960 + 256 + 1408 + 1408 + 1408 + 1344 + 512;
  for (int tb = bid * 2; tb < NT_TILES; tb += G * 2) {
    const int t = tb + half;
    const bool active = t < NT_TILES;
    const float* W = p.in[12]; int K = 1024, N = 3600, nnt = 60, mode = 0; bf16_t* dst = (bf16_t*)(p.ws + OFF_WT_EVIN); int r = active ? t : 0;
    if (r < 960) { }
    else if ((r -= 960) < 256) { W = p.in[17]; K = 1024; N = 1024; nnt = 16; dst = (bf16_t*)(p.ws + OFF_WT_EVOUT); }
    else if ((r -= 256) < 1408) { const int l = r / 704; r -= l * 704; W = p.in[26] + (size_t)l * 1024 * 2816; K = 1024; N = 2816; nnt = 44; mode = 1; dst = (bf16_t*)(p.ws + OFF_WT_GU + l * SZ_WT_GU1); }
    else if ((r -= 1408) < 1408) { const int l = r / 704; r -= l * 704; W = p.in[27] + (size_t)l * 1024 * 2816; K = 1024; N = 2816; nnt = 44; mode = 2; dst = (bf16_t*)(p.ws + OFF_WT_GU + l * SZ_WT_GU1); }
    else if ((r -= 1408) < 1408) { const int l = r / 704; r -= l * 704; W = p.in[28] + (size_t)l * 2816 * 1024; K = 2816; N = 1024; nnt = 16; dst = (bf16_t*)(p.ws + OFF_WT_DN + l * SZ_WT_DN1); }
    else if ((r -= 1408) < 1344) { W = p.in[18]; K = 1024; N = 5152; nnt = 84; dst = (bf16_t*)(p.ws + OFF_WT_ODIN); }
    else { r -= 1344; W = p.in[25]; K = 2048; N = 1024; nnt = 16; dst = (bf16_t*)(p.ws + OFF_WT_ODOUT); }
    const int kt = r / nnt, nt = r - kt * nnt;
    transpose_tile(W, K, N, dst, mode, kt, nt, tile, active, (active && t < 960) ? p.in[13] : nullptr);
  }
  const int lane = threadIdx.x & 63, w = threadIdx.x >> 6;
  bf16_t* X = (bf16_t*)(p.ws + OFF_X);
  bf16_t* HN = (bf16_t*)(p.ws + OFF_HN);
  for (int row = bid * 8 + w; row < T_ALL; row += G * 8) {
    const float* src;
    if (row < T_PROMPT) { const int b = row / SEQP, t = row - b * SEQP; src = (t < 16) ? p.in[6] + (size_t)t * 1024 : p.in[0] + ((size_t)b * 2048 + (t - 16)) * 1024; }
    else src = p.in[1] + (size_t)(row - T_PROMPT) * 1024;
    f32x4 v[4];
#pragma unroll
    for (int j = 0; j < 4; ++j) { v[j] = *(const f32x4*)(src + 256 * j + 4 * lane); st_bf4(X + (size_t)row * 1024 + 256 * j + 4 * lane, v[j]); }
    rms_row_to_bf16(v, p.in[8], HN + (size_t)row * 1024, lane);
  }
}

DI void phase_rowwise(const Params& p, const float* __restrict__ wpost, const float* __restrict__ wpre, bool final_, const float* PART, int nsplit, int row_begin, int bid, int G) {
  const int lane = threadIdx.x & 63, w = threadIdx.x >> 6;
  bf16_t* X = (bf16_t*)(p.ws + OFF_X);
  const bf16_t* MIX = (const bf16_t*)(p.ws + OFF_MIX);
  bf16_t* HN = (bf16_t*)(p.ws + OFF_HN);
  for (int rowa = row_begin + bid * 8 + w; rowa < T_ALL; rowa += G * 16) {
    const int rowb = rowa + G * 8;
    const bool hasb = rowb < T_ALL;
    f32x4 m[2][4], x[2][4];
#pragma unroll
    for (int q = 0; q < 2; ++q) {
      const int row = q ? (hasb ? rowb : rowa) : rowa;
#pragma unroll
      for (int j = 0; j < 4; ++j) {
        if (row < 16384) m[q][j] = ld_bf4(MIX + (size_t)row * 1024 + 256 * j + 4 * lane);
        else {
          f32x4 a = {0.f, 0.f, 0.f, 0.f};
          for (int ks = 0; ks < nsplit; ++ks) a = a + *(const f32x4*)(PART + ((size_t)ks * 768 + (row - 16384)) * 1024 + 256 * j + 4 * lane);
          m[q][j] = a;
        }
        x[q][j] = ld_bf4(X + (size_t)row * 1024 + 256 * j + 4 * lane);
      }
    }
#pragma unroll
    for (int q = 0; q < 2; ++q) {
      if (q == 1 && !hasb) break;
      const int row = q ? rowb : rowa;
      float s = 0.f;
#pragma unroll
      for (int j = 0; j < 4; ++j) s += m[q][j].x * m[q][j].x + m[q][j].y * m[q][j].y + m[q][j].z * m[q][j].z + m[q][j].w * m[q][j].w;
      const float rstd = rsqrtf(wave_sum(s) * (1.f / 1024.f) + 1e-6f);
#pragma unroll
      for (int j = 0; j < 4; ++j) { const f32x4 g = *(const f32x4*)(wpost + 256 * j + 4 * lane); x[q][j] = x[q][j] + m[q][j] * rstd * g; }
      if (!final_) {
#pragma unroll
        for (int j = 0; j < 4; ++j) st_bf4(X + (size_t)row * 1024 + 256 * j + 4 * lane, x[q][j]);
        rms_row_to_bf16(x[q], wpre, HN + (size_t)row * 1024, lane);
      } else {
        float* dst = nullptr;
        if (row < T_PROMPT) { const int b = row / SEQP, t = row - b * SEQP; if (t >= 16) dst = p.out + OUT_YP + ((size_t)b * 2048 + (t - 16)) * 1024; }
        else dst = p.out + OUT_YS + (size_t)(row - T_PROMPT) * 1024;
        if (dst) {
#pragma unroll
          for (int j = 0; j < 4; ++j) *(f32x4*)(dst + 256 * j + 4 * lane) = x[q][j];
        }
      }
    }
  }
}

DI void phase_groupnorm(const Params& p, int bid, int G) {
  const int lane = threadIdx.x & 63, w = threadIdx.x >> 6;
  bf16_t* O = (bf16_t*)(p.ws + OFF_O);
  const float* SSQ = (const float*)(p.ws + OFF_SSQ);
  const float* __restrict__ nw = p.in[24];
  const int g = lane >> 4;
  for (int row = bid * 8 + w; row < T_ALL; row += G * 8) {
    const f32x4 q = *(const f32x4*)(SSQ + (size_t)row * 16 + 4 * g);
    const float rstd = rsqrtf((q.x + q.y + q.z + q.w) * (1.f / 512.f) + 1e-6f);
    bf16_t* o = O + (size_t)row * 2048 + lane * 32;
#pragma unroll
    for (int j = 0; j < 4; ++j) {
      u32x4 v = *(u32x4*)(o + 8 * j);
      const f32x4 w0 = *(const f32x4*)(nw + lane * 32 + 8 * j), w1 = *(const f32x4*)(nw + lane * 32 + 8 * j + 4);
      v[0] = pk2(bflo(v[0]) * rstd * w0.x, bfhi(v[0]) * rstd * w0.y); v[1] = pk2(bflo(v[1]) * rstd * w0.z, bfhi(v[1]) * rstd * w0.w);
      v[2] = pk2(bflo(v[2]) * rstd * w1.x, bfhi(v[2]) * rstd * w1.y); v[3] = pk2(bflo(v[3]) * rstd * w1.z, bfhi(v[3]) * rstd * w1.w);
      *(u32x4*)(o + 8 * j) = v;
    }
  }
}

namespace pg8 {
#define PG8_LAS __attribute__((address_space(3)))
typedef unsigned short bf16_t;
typedef short bf16x8 __attribute__((ext_vector_type(8)));
typedef float f32x4 __attribute__((ext_vector_type(4)));
typedef unsigned u32x4 __attribute__((ext_vector_type(4)));
constexpr int BM = 256, BK = 64, HALF = 128, HTB = HALF * BK * 2  , STAGE_BYTES = 8 * HTB, NXCD = 8, WGM = 8;

__host__ __device__ __forceinline__ int lds_byte(int r, int c) { const int st = (r >> 4) * 2 + (c >> 5), rr = r & 15, cc = c & 31, ob = rr * 64 + cc * 2; return st * 1024 + (ob ^ (((ob >> 9) & 1) << 5)); }
__host__ __device__ __forceinline__ void stage_rc(int b, int& R, int& C) { const int st = b / 1024, sb = b % 1024, swz = sb ^ (((sb >> 9) & 1) << 5); R = (st >> 1) * 16 + swz / 64; C = (st & 1) * 32 + (swz % 64) / 2; }
__host__ __device__ __forceinline__ int perm32(int rho) { const int n = rho >> 4, i = rho & 15; return 8 * (i >> 2) + 4 * n + (i & 3); }

struct Unit { int pm, pn, ks; };
struct Gemm { const bf16_t* A; const bf16_t* Bt; int M, N, K, ld; };

struct StaticOrder {
    int nM, nN, nwg, G, c;
    __host__ __device__ void init(int M, int N, int G_, int c_) { nM = M / BM; nN = N / BM; nwg = nM * nN; G = G_; c = c_; }
    __host__ __device__ bool next(int i, Unit& u) const {
        const long L = (long)i * G + c; if (L >= nwg) return false;
        int wgid = (int)L; { const int q = nwg / NXCD, r = nwg % NXCD, xcd = wgid % NXCD, off = wgid / NXCD; wgid = (xcd < r ? xcd * (q + 1) : r * (q + 1) + (xcd - r) * q) + off; }
        const int nig = WGM * nN, gid = wgid / nig, fm = gid * WGM, gsz = (nM - fm) < WGM ? (nM - fm) : WGM;
        u.pm = fm + ((wgid % nig) % gsz); u.pn = (wgid % nig) / gsz; u.ks = 0; return true;
    }
    __device__ __forceinline__ void a_ready(const Unit&) const {}
    __device__ __forceinline__ void done(const Unit&) const {}
};
__device__ __forceinline__ unsigned cvt_pk_bf16(float lo, float hi) { unsigned r; asm volatile("v_cvt_pk_bf16_f32 %0, %1, %2" : "=v"(r) : "v"(lo), "v"(hi)); return r; }
typedef float f32x2 __attribute__((ext_vector_type(2)));
template <class Epi, class Sched, bool ALIGN_EPI = false, bool SP2 = false>
__device__ __forceinline__ void gemm_phase(PG8_LAS unsigned char* lds, const Gemm g, const Sched& S, const Epi& E) {
    int tid_ = threadIdx.x; asm volatile("" : "+v"(tid_));
    const int tid = tid_, wid = __builtin_amdgcn_readfirstlane(tid >> 6), lane = tid & 63, wr = wid >> 2, wc = wid & 3, fr = lane & 15, fq = lane >> 4;
    const int K = g.ld, nt = g.K / BK;
    unsigned voffA[2], voffB[2];
#pragma unroll
    for (int i = 0; i < 2; ++i) { int R, C; stage_rc(tid * 16 + i * 8192, R, C); const int Rb = Epi::PERM ? ((R & ~31) + perm32(R & 31)) : R;
        voffA[i] = (unsigned)(R * K + C) * 2u; voffB[i] = (unsigned)(Rb * K + C) * 2u; }
    const size_t kstep = (size_t)(BK * 2);
    const size_t hstep = (size_t)HALF * K * 2;
    const size_t tstep = 2 * hstep;
    const unsigned ldsw = (unsigned)wid * 1024u;
    const int aoff = lds_byte(wr * 64 + fr, fq * 8), boff = lds_byte(wc * 32 + fr, fq * 8);
#define PG8_SA(b, h) (((b) * 2 + (h)) * HTB)
#define PG8_SB(b, h) ((4 + (b) * 2 + (h)) * HTB)
#define PG8_STAGE(bufoff, gbase, voff) do { _Pragma("unroll") for (int _i = 0; _i < 2; ++_i) \
        __builtin_amdgcn_global_load_lds((const unsigned*)((const char*)(gbase) + (voff)[_i]), (PG8_LAS unsigned*)(lds + (bufoff) + ldsw + _i * 8192), 16, 0, 0); } while (0)
#define PG8_LDA(dst, b, h) do { _Pragma("unroll") for (int m = 0; m < 4; ++m) _Pragma("unroll") for (int k = 0; k < 2; ++k) dst[m][k] = *(const PG8_LAS bf16x8*)(lds + PG8_SA(b, h) + aoff + m * 2048 + k * 1024); } while (0)
#define PG8_LDB(dst, b, h) do { _Pragma("unroll") for (int n = 0; n < 2; ++n) _Pragma("unroll") for (int k = 0; k < 2; ++k) dst[n][k] = *(const PG8_LAS bf16x8*)(lds + PG8_SB(b, h) + boff + n * 2048 + k * 1024); } while (0)
#define PG8_MMA(ai, bj, At, Bt) do { __builtin_amdgcn_s_setprio(1); _Pragma("unroll") for (int m = 0; m < 4; ++m) _Pragma("unroll") for (int n = 0; n < 2; ++n) _Pragma("unroll") for (int k = 0; k < 2; ++k) \
        acc[ai][bj][m][n] = __builtin_amdgcn_mfma_f32_16x16x32_bf16(Bt[n][k], At[m][k], acc[ai][bj][m][n], 0, 0, 0); __builtin_amdgcn_s_setprio(0); } while (0)
#define PG8_WAIT_V(n) asm volatile("s_waitcnt vmcnt(" #n ")" ::: "memory")
#define PG8_WAIT_L(n) asm volatile("s_waitcnt lgkmcnt(" #n ")" ::: "memory")
#define PG8_BAR __builtin_amdgcn_s_barrier()
#define PG8_SCHED __builtin_amdgcn_sched_barrier(0)
    Unit cur, nxt; int ui = 0;
    if (!S.next(0, cur)) return;
    f32x4 acc[2][2][4][2];
#pragma unroll
    for (int a = 0; a < 2; ++a)
#pragma unroll
        for (int b = 0; b < 2; ++b)
#pragma unroll
            for (int m = 0; m < 4; ++m)
#pragma unroll
                for (int n = 0; n < 2; ++n) acc[a][b][m][n] = (f32x4){0.f, 0.f, 0.f, 0.f};
    bf16x8 At[4][2], B0[2][2], B1[2][2];
    const char* cA = (const char*)g.A + (size_t)cur.pm * tstep + (size_t)cur.ks * g.K * 2; const char* cB = (const char*)g.Bt + (size_t)cur.pn * tstep + (size_t)cur.ks * g.K * 2;
    S.a_ready(cur);
    if constexpr (SP2) {
        PG8_STAGE(PG8_SB(0, 0), cB, voffB); PG8_STAGE(PG8_SB(0, 1), cB + hstep, voffB); PG8_STAGE(PG8_SA(0, 0), cA, voffA); PG8_STAGE(PG8_SA(0, 1), cA + hstep, voffA);
        if (wr == 1) PG8_BAR;
        PG8_WAIT_V(2); PG8_BAR;
        PG8_STAGE(PG8_SB(1, 0), cB + kstep, voffB); PG8_STAGE(PG8_SA(1, 0), cA + kstep, voffA); PG8_STAGE(PG8_SB(1, 1), cB + hstep + kstep, voffB);
        PG8_WAIT_V(6); PG8_BAR;
    } else {
        PG8_STAGE(PG8_SB(0, 0), cB, voffB); PG8_STAGE(PG8_SA(0, 0), cA, voffA); PG8_STAGE(PG8_SB(0, 1), cB + hstep, voffB); PG8_STAGE(PG8_SA(0, 1), cA + hstep, voffA);
        if (wr == 1) PG8_BAR;
        PG8_WAIT_V(4); PG8_BAR;
        PG8_STAGE(PG8_SB(1, 0), cB + kstep, voffB); PG8_STAGE(PG8_SA(1, 0), cA + kstep, voffA); PG8_STAGE(PG8_SB(1, 1), cB + hstep + kstep, voffB);
        PG8_WAIT_V(6); PG8_BAR;
    }
    for (;;) {
        const bool has_next = S.next(ui + 1, nxt);
        const char* nA = has_next ? (const char*)g.A + (size_t)nxt.pm * tstep + (size_t)nxt.ks * g.K * 2 : cA; const char* nB = has_next ? (const char*)g.Bt + (size_t)nxt.pn * tstep + (size_t)nxt.ks * g.K * 2 : cB;
        for (int t = 0; t < nt; t += 2) {
            const bool last = (t == nt - 2);
            const char* a1 = cA + (size_t)(t + 1) * kstep;
            const char* a2 = last ? nA : cA + (size_t)(t + 2) * kstep; const char* b2 = last ? nB : cB + (size_t)(t + 2) * kstep;
            const char* a3 = a2 + kstep; const char* b3 = b2 + kstep;
            if (last && has_next) S.a_ready(nxt);
            if constexpr (SP2) {
            PG8_LDB(B0, 0, 0); PG8_LDB(B1, 0, 1); PG8_SCHED; PG8_LDA(At, 0, 0); PG8_STAGE(PG8_SA(1, 1), a1 + hstep, voffA);
            PG8_WAIT_V(8); PG8_WAIT_L(0); PG8_BAR; PG8_MMA(0, 0, At, B0); PG8_MMA(0, 1, At, B1); PG8_BAR; PG8_SCHED;
            PG8_LDA(At, 0, 1); PG8_STAGE(PG8_SB(0, 0), b2, voffB); PG8_STAGE(PG8_SB(0, 1), b2 + hstep, voffB); PG8_STAGE(PG8_SA(0, 0), a2, voffA);
            PG8_WAIT_V(8); PG8_WAIT_L(0); PG8_BAR; PG8_MMA(1, 0, At, B0); PG8_MMA(1, 1, At, B1); PG8_BAR; PG8_SCHED;
            PG8_LDB(B0, 1, 0); PG8_LDB(B1, 1, 1); PG8_SCHED; PG8_LDA(At, 1, 0); PG8_STAGE(PG8_SA(0, 1), a2 + hstep, voffA);
            PG8_WAIT_V(8); PG8_WAIT_L(0); PG8_BAR; PG8_MMA(0, 0, At, B0); PG8_MMA(0, 1, At, B1); PG8_BAR; PG8_SCHED;
            PG8_LDA(At, 1, 1); PG8_STAGE(PG8_SB(1, 0), b3, voffB); PG8_STAGE(PG8_SB(1, 1), b3 + hstep, voffB); PG8_STAGE(PG8_SA(1, 0), a3, voffA);
            PG8_WAIT_V(8); PG8_WAIT_L(0); PG8_BAR; PG8_MMA(1, 0, At, B0); PG8_MMA(1, 1, At, B1); PG8_BAR; PG8_SCHED;
            } else {
            PG8_LDB(B0, 0, 0); PG8_SCHED; PG8_LDA(At, 0, 0); PG8_STAGE(PG8_SA(1, 1), a1 + hstep, voffA);
            PG8_WAIT_L(8); PG8_BAR; PG8_WAIT_L(0); PG8_MMA(0, 0, At, B0); PG8_BAR; PG8_SCHED;
            PG8_LDB(B1, 0, 1); PG8_STAGE(PG8_SB(0, 0), b2, voffB);
            PG8_BAR; PG8_WAIT_L(0); PG8_MMA(0, 1, At, B1); PG8_BAR;
            PG8_LDA(At, 0, 1); PG8_STAGE(PG8_SA(0, 0), a2, voffA);
            PG8_BAR; PG8_WAIT_L(0); PG8_MMA(1, 0, At, B0); PG8_BAR; PG8_SCHED;
            PG8_STAGE(PG8_SB(0, 1), b2 + hstep, voffB);
            PG8_WAIT_V(6); PG8_BAR; PG8_MMA(1, 1, At, B1); PG8_BAR;
            PG8_LDB(B0, 1, 0); PG8_SCHED; PG8_LDA(At, 1, 0); PG8_STAGE(PG8_SA(0, 1), a2 + hstep, voffA);
            PG8_WAIT_L(8); PG8_BAR; PG8_WAIT_L(0); PG8_MMA(0, 0, At, B0); PG8_BAR; PG8_SCHED;
            PG8_LDB(B1, 1, 1); PG8_STAGE(PG8_SB(1, 0), b3, voffB);
            PG8_BAR; PG8_WAIT_L(0); PG8_MMA(0, 1, At, B1); PG8_BAR;
            PG8_LDA(At, 1, 1); PG8_STAGE(PG8_SA(1, 0), a3, voffA);
            PG8_BAR; PG8_WAIT_L(0); PG8_MMA(1, 0, At, B0); PG8_BAR; PG8_SCHED;
            PG8_STAGE(PG8_SB(1, 1), b3 + hstep, voffB);
            PG8_WAIT_V(6); PG8_BAR; PG8_MMA(1, 1, At, B1); PG8_BAR;
            }
        }
        if constexpr (ALIGN_EPI) { if (wr == 0) PG8_BAR; }
        if constexpr (!Epi::AFTER_DRAIN) { E(acc, cur, wr, wc, fr, fq); S.done(cur); }
        if (!has_next) break;
#pragma unroll
        for (int a = 0; a < 2; ++a)
#pragma unroll
            for (int b = 0; b < 2; ++b)
#pragma unroll
                for (int m = 0; m < 4; ++m)
#pragma unroll
                    for (int n = 0; n < 2; ++n) acc[a][b][m][n] = (f32x4){0.f, 0.f, 0.f, 0.f};
        cur = nxt; cA = nA; cB = nB; ++ui;
        if constexpr (ALIGN_EPI) { if (wr == 1) PG8_BAR; }
    }
    PG8_WAIT_V(0);
    if constexpr (!ALIGN_EPI) { if (wr == 0) PG8_BAR; }
    PG8_BAR;
    if constexpr (Epi::AFTER_DRAIN) { E.fused(acc, cur, wr, wc, fr, fq, lds, wid, lane); S.done(cur); }
#undef PG8_SA
#undef PG8_SB
#undef PG8_STAGE
#undef PG8_LDA
#undef PG8_LDB
#undef PG8_MMA
#undef PG8_WAIT_V
#undef PG8_WAIT_L
#undef PG8_BAR
#undef PG8_SCHED
}
}

struct EpiStoreBf16 {
  static constexpr bool PERM = true, AFTER_DRAIN = false;
  bf16_t* C; int ldc; unsigned silu_units, sigm_units;
  DI void operator()(const pg8::f32x4 (&acc)[2][2][4][2], const pg8::Unit& u, int wr, int wc, int fr, int fq) const {
    const int row0 = u.pm * 256 + wr * 64 + fr, col0 = u.pn * 256 + wc * 32 + 8 * fq;
    const bool gate = (silu_units >> u.pn) & 1u, sigm = (sigm_units >> u.pn) & 1u;
#pragma unroll
    for (int ai = 0; ai < 2; ++ai)
#pragma unroll
      for (int m = 0; m < 4; ++m) {
        bf16_t* rowp = C + (size_t)(row0 + ai * 128 + m * 16) * ldc + col0;
#pragma unroll
        for (int bj = 0; bj < 2; ++bj) {
          pg8::f32x4 v0 = acc[ai][bj][m][0], v1 = acc[ai][bj][m][1];
          if (gate) {
#pragma unroll
            for (int e = 0; e < 4; ++e) { v0[e] = siluf_(v0[e]); v1[e] = siluf_(v1[e]); }
          } else if (sigm) {
#pragma unroll
            for (int e = 0; e < 4; ++e) {
              { const float x = v0[e], ex = __expf(-fabsf(x)), mm = ex * __builtin_amdgcn_rcpf(1.f + ex); v0[e] = x < 0.f ? mm : -mm; }
              { const float x = v1[e], ex = __expf(-fabsf(x)), mm = ex * __builtin_amdgcn_rcpf(1.f + ex); v1[e] = x < 0.f ? mm : -mm; }
            }
          }
          u32x4 w_; w_[0] = pk2(v0[0], v0[1]); w_[1] = pk2(v0[2], v0[3]); w_[2] = pk2(v1[0], v1[1]); w_[3] = pk2(v1[2], v1[3]);
          *(u32x4*)(rowp + bj * 128) = w_;
        }
      }
  }
};
struct EpiStoreF32 {
  static constexpr bool PERM = false, AFTER_DRAIN = false;
  float* C0; int ldc; size_t ks_stride;
  DI void operator()(const pg8::f32x4 (&acc)[2][2][4][2], const pg8::Unit& u, int wr, int wc, int fr, int fq) const {
    float* C = C0 + (size_t)u.ks * ks_stride;
    const int row0 = u.pm * 256 + wr * 64 + fr, col0 = u.pn * 256 + wc * 32 + 4 * fq;
#pragma unroll
    for (int ai = 0; ai < 2; ++ai)
#pragma unroll
      for (int m = 0; m < 4; ++m) {
        float* rowp = C + (size_t)(row0 + ai * 128 + m * 16) * ldc + col0;
#pragma unroll
        for (int bj = 0; bj < 2; ++bj)
#pragma unroll
          for (int n = 0; n < 2; ++n) *(pg8::f32x4*)(rowp + bj * 128 + n * 16) = acc[ai][bj][m][n];
      }
  }
};
struct EpiSwiglu {
  static constexpr bool PERM = true, AFTER_DRAIN = false;
  bf16_t* C; int ldc;
  DI void operator()(const pg8::f32x4 (&acc)[2][2][4][2], const pg8::Unit& u, int wr, int wc, int fr, int fq) const {
    const int row0 = u.pm * 256 + wr * 64 + fr, col0 = u.pn * 128 + wc * 32 + 8 * fq;
#pragma unroll
    for (int ai = 0; ai < 2; ++ai)
#pragma unroll
      for (int m = 0; m < 4; ++m) {
        float y[8];
#pragma unroll
        for (int n = 0; n < 2; ++n)
#pragma unroll
          for (int e = 0; e < 4; ++e) y[4 * n + e] = siluf_(acc[ai][0][m][n][e]) * acc[ai][1][m][n][e];
        u32x4 w_; w_[0] = pk2(y[0], y[1]); w_[1] = pk2(y[2], y[3]); w_[2] = pk2(y[4], y[5]); w_[3] = pk2(y[6], y[7]);
        *(u32x4*)(C + (size_t)(row0 + ai * 128 + m * 16) * ldc + col0) = w_;
      }
  }
};

struct RowSumExchange {
  float* xbuf; unsigned* cnt; unsigned* tmo;
  DI void run(const float (&part)[2][4], const pg8::Unit& u, int wr, int wc, int fr, int fq, char* lds, float* S, int wid, int lane) const {
    float* P = (float*)lds;
    if (fq == 0) {
#pragma unroll
      for (int ai = 0; ai < 2; ++ai)
#pragma unroll
        for (int m = 0; m < 4; ++m) P[(ai * 128 + wr * 64 + m * 16 + fr) * 4 + wc] = part[ai][m];
    }
    __syncthreads();
    const int row = wid * 32 + (lane & 31);
    if (lane < 32) {
      const f32x4 a = *(const f32x4*)(P + row * 4);
      __hip_atomic_store(xbuf + ((size_t)u.pm * 256 + row) * 4 + u.pn, (a.x + a.y) + (a.z + a.w), __ATOMIC_RELAXED, __HIP_MEMORY_SCOPE_AGENT);
    }
    asm volatile("s_waitcnt vmcnt(0)" ::: "memory");
    if (lane == 0) __hip_atomic_fetch_add(cnt + 64 * u.pm, 1u, __ATOMIC_RELAXED, __HIP_MEMORY_SCOPE_AGENT);
    if (wid == 0) {
      unsigned it = 0;
      while ((unsigned)__builtin_amdgcn_readfirstlane(__hip_atomic_load(cnt + 64 * u.pm, __ATOMIC_RELAXED, __HIP_MEMORY_SCOPE_AGENT)) < 32u) {
        __builtin_amdgcn_s_sleep(2);
        if (++it > (1u << 21)) { if (lane == 0) __hip_atomic_store(tmo, 1u, __ATOMIC_RELAXED, __HIP_MEMORY_SCOPE_AGENT); break; }
      }
      __builtin_amdgcn_fence(__ATOMIC_ACQUIRE, "agent");
    }
    asm volatile("s_waitcnt vmcnt(0) lgkmcnt(0)" ::: "memory");
    __syncthreads();
    if (lane < 32) {
      const float* slot = xbuf + ((size_t)u.pm * 256 + row) * 4;
      float t = 0.f;
#pragma unroll
      for (int k = 0; k < 4; ++k) t += __hip_atomic_load(slot + k, __ATOMIC_RELAXED, __HIP_MEMORY_SCOPE_AGENT);
      S[row] = t;
    }
    __syncthreads();
  }
};
template <bool FINAL>
struct EpiResNorm {
  static constexpr bool PERM = true, AFTER_DRAIN = true;
  bf16_t* X; bf16_t* HN; const float* wpost; const float* wpre; float* yout;
  float* xbuf; unsigned* cnt; unsigned* tmo;
  DI void operator()(const pg8::f32x4 (&)[2][2][4][2], const pg8::Unit&, int, int, int, int) const {}
  DI static void ssq_rows(const pg8::f32x4 (&acc)[2][2][4][2], float (&part)[2][4]) {
#pragma unroll
    for (int ai = 0; ai < 2; ++ai)
#pragma unroll
      for (int m = 0; m < 4; ++m) {
        float q = 0.f;
#pragma unroll
        for (int bj = 0; bj < 2; ++bj)
#pragma unroll
          for (int n = 0; n < 2; ++n) { const pg8::f32x4 v = acc[ai][bj][m][n]; q += (v[0] * v[0] + v[1] * v[1]) + (v[2] * v[2] + v[3] * v[3]); }
        q += __shfl_xor(q, 16); q += __shfl_xor(q, 32);
        part[ai][m] = q;
      }
  }
  DI void fused(pg8::f32x4 (&acc)[2][2][4][2], const pg8::Unit& u, int wr, int wc, int fr, int fq, PG8_LAS unsigned char* ldsl, int wid, int lane) const {
    char* lds = (char*)ldsl;
    float* S1 = (float*)(lds + 4096);
    float* S2 = (float*)(lds + 5120);
    float part[2][4];
    ssq_rows(acc, part);
    RowSumExchange{xbuf, cnt, tmo}.run(part, u, wr, wc, fr, fq, lds, S1, wid, lane);
#pragma unroll
    for (int ai = 0; ai < 2; ++ai)
#pragma unroll
      for (int m = 0; m < 4; ++m) {
        if (m == 0) __builtin_amdgcn_sched_barrier(0);
        const int rl = ai * 128 + wr * 64 + m * 16 + fr;
        const float r1 = rsqrtf(S1[rl] * (1.f / 1024.f) + 1e-6f);
        const bf16_t* xrow = X + (size_t)(u.pm * 256 + rl) * 1024;
#pragma unroll
        for (int bj = 0; bj < 2; ++bj) {
          const int c8 = u.pn * 256 + bj * 128 + wc * 32 + 8 * fq;
          const u32x4 xr = *(const u32x4*)(xrow + c8);
          const f32x4 g0 = *(const f32x4*)(wpost + c8), g1 = *(const f32x4*)(wpost + c8 + 4);
          const f32x4 x0 = {bflo(xr[0]), bfhi(xr[0]), bflo(xr[1]), bfhi(xr[1])}, x1 = {bflo(xr[2]), bfhi(xr[2]), bflo(xr[3]), bfhi(xr[3])};
          acc[ai][bj][m][0] = x0 + acc[ai][bj][m][0] * r1 * g0;
          acc[ai][bj][m][1] = x1 + acc[ai][bj][m][1] * r1 * g1;
        }
      }
    if (FINAL) {
#pragma unroll
      for (int ai = 0; ai < 2; ++ai)
#pragma unroll
        for (int m = 0; m < 4; ++m) {
          if (m == 0) __builtin_amdgcn_sched_barrier(0);
          const int row = u.pm * 256 + ai * 128 + wr * 64 + m * 16 + fr;
          const int b = row / SEQP, t = row - b * SEQP;
          if (t >= 16) {
            float* dst = yout + ((size_t)b * 2048 + (t - 16)) * 1024;
#pragma unroll
            for (int bj = 0; bj < 2; ++bj)
#pragma unroll
              for (int n = 0; n < 2; ++n) *(f32x4*)(dst + u.pn * 256 + bj * 128 + wc * 32 + 8 * fq + 4 * n) = acc[ai][bj][m][n];
          }
        }
      return;
    }
    ssq_rows(acc, part);
    RowSumExchange{xbuf + SZ_XB_SET / 4, cnt + SZ_CNT_SET / 4, tmo}.run(part, u, wr, wc, fr, fq, lds, S2, wid, lane);
#pragma unroll
    for (int ai = 0; ai < 2; ++ai)
#pragma unroll
      for (int m = 0; m < 4; ++m) {
        if (m == 0) __builtin_amdgcn_sched_barrier(0);
        const int rl = ai * 128 + wr * 64 + m * 16 + fr;
        const float r2 = rsqrtf(S2[rl] * (1.f / 1024.f) + 1e-6f);
        bf16_t* xrow = X + (size_t)(u.pm * 256 + rl) * 1024;
        bf16_t* hrow = HN + (size_t)(u.pm * 256 + rl) * 1024;
#pragma unroll
        for (int bj = 0; bj < 2; ++bj) {
          const int c8 = u.pn * 256 + bj * 128 + wc * 32 + 8 * fq;
          const f32x4 g0 = *(const f32x4*)(wpre + c8), g1 = *(const f32x4*)(wpre + c8 + 4);
          const pg8::f32x4 v0 = acc[ai][bj][m][0], v1 = acc[ai][bj][m][1];
          u32x4 xo, ho;
          xo[0] = pk2(v0[0], v0[1]); xo[1] = pk2(v0[2], v0[3]); xo[2] = pk2(v1[0], v1[1]); xo[3] = pk2(v1[2], v1[3]);
          const pg8::f32x4 h0 = v0 * r2 * g0, h1 = v1 * r2 * g1;
          ho[0] = pk2(h0[0], h0[1]); ho[1] = pk2(h0[2], h0[3]); ho[2] = pk2(h1[0], h1[1]); ho[3] = pk2(h1[2], h1[3]);
          *(u32x4*)(xrow + c8) = xo;
          *(u32x4*)(hrow + c8) = ho;
        }
      }
  }
};
template <class Epi>
DI void gemm_run(char* lds, const bf16_t* A, const bf16_t* Bt, int N, int K, const Epi& E, int vcu, int G) {
  pg8::Gemm g{A, Bt, T_PAD, N, K, K};
  pg8::StaticOrder S; S.init(T_PAD, N, G, vcu);
  pg8::gemm_phase<Epi, pg8::StaticOrder, true, true>((PG8_LAS unsigned char*)lds, g, S, E);
}
struct SplitOrder {
  int nsplit, nitems, G, c;
  DI bool next(int i, pg8::Unit& u) const {
    const int L = i * G + c; if (L >= nitems) return false;
    const int q = L / nsplit; u.ks = L - q * nsplit; u.pm = q >> 2; u.pn = q & 3; return true;
  }
  DI void a_ready(const pg8::Unit&) const {}
  DI void done(const pg8::Unit&) const {}
};
DI void gemm_n1024_plain(char* lds, const bf16_t* A, const bf16_t* Bt, int K, float* MIXp, float* PART, int vcu, int G) {
  {
    pg8::Gemm g{A, Bt, M_MAIN, 1024, K, K};
    pg8::StaticOrder S; S.init(M_MAIN, 1024, G, vcu);
    pg8::gemm_phase<EpiStoreBf16, pg8::StaticOrder, true, true>((PG8_LAS unsigned char*)lds, g, S, EpiStoreBf16{(bf16_t*)MIXp, 1024, 0u, 0u});
  }
  {
    const int nsplit = K >> 8;
    pg8::Gemm g{A + (size_t)M_MAIN * K, Bt, 768, 1024, 256, K};
    SplitOrder S{nsplit, 12 * nsplit, G, (vcu + 128) % G};
    pg8::gemm_phase<EpiStoreF32, SplitOrder, true, true>((PG8_LAS unsigned char*)lds, g, S, EpiStoreF32{PART, 1024, (size_t)768 * 1024});
  }
}
template <bool FINAL>
DI void gemm_n1024(char* lds, const bf16_t* A, const bf16_t* Bt, int K, const EpiResNorm<FINAL>& E, float* PART, int vcu, int G) {
  {
    pg8::Gemm g{A, Bt, M_MAIN, 1024, K, K};
    pg8::StaticOrder S; S.init(M_MAIN, 1024, G, vcu);
    pg8::gemm_phase<EpiResNorm<FINAL>, pg8::StaticOrder, false, true>((PG8_LAS unsigned char*)lds, g, S, E);
  }
  __syncthreads();
  {
    const int nsplit = K >> 8;
    pg8::Gemm g{A + (size_t)M_MAIN * K, Bt, 768, 1024, 256, K};
    SplitOrder S{nsplit, 12 * nsplit, G, (vcu + 128) % G};
    pg8::gemm_phase<EpiStoreF32, SplitOrder, true, true>((PG8_LAS unsigned char*)lds, g, S, EpiStoreF32{PART, 1024, (size_t)768 * 1024});
  }
}

constexpr int L_QE = 0, L_KE = 8704, L_QI = 17408, L_G = 26112, L_KENDT = 34816, L_VT = 45056, L_DEC = 55296, L_TOT = 55808, L_SSQ = 57856;
constexpr int RS = 272, TS = 80;

template <int DK>
DI void pc_core(char* lds, f32x16 (&S)[DK / 32], f32x16& o, const int w, const int r32, const int h) {
  const char* QE = lds + L_QE + r32 * RS;
  const char* KE = lds + L_KE + r32 * RS;
  const char* QI = lds + L_QI + r32 * RS;
  f32x16 sc; zero16(sc);
#pragma unroll
  for (int s = 0; s < DK / 16; ++s) {
    const bf16x8 a = *(const bf16x8*)(KE + s * 32 + h * 16);
    const bf16x8 b = *(const bf16x8*)(QE + s * 32 + h * 16);
    sc = MFMA32(a, b, sc);
  }
#pragma unroll
  for (int r = 0; r < 16; ++r) if (crow(r, h) > r32) sc[r] = 0.f;
  const bf16x8 scb0 = pack8<0>(sc), scb1 = pack8<1>(sc);
  zero16(o);
#pragma unroll
  for (int kt = 0; kt < DK / 32; ++kt) {
    {
      const bf16x8 a = pack8<0>(S[kt]);
      const s16x4 lo = *(const s16x4*)(QI + (32 * kt + 4 * h) * 2), hi = *(const s16x4*)(QI + (32 * kt + 8 + 4 * h) * 2);
      o = MFMA32(a, cat8(lo, hi), o);
    }
    {
      const bf16x8 a = pack8<1>(S[kt]);
      const s16x4 lo = *(const s16x4*)(QI + (32 * kt + 16 + 4 * h) * 2), hi = *(const s16x4*)(QI + (32 * kt + 24 + 4 * h) * 2);
      o = MFMA32(a, cat8(lo, hi), o);
    }
  }
  const char* VTr = lds + L_VT + (32 * w + r32) * TS;
  {
    const s16x4 lo = *(const s16x4*)(VTr + (4 * h) * 2), hi = *(const s16x4*)(VTr + (8 + 4 * h) * 2);
    o = MFMA32(cat8(lo, hi), scb0, o);
  }
  {
    const s16x4 lo = *(const s16x4*)(VTr + (16 + 4 * h) * 2), hi = *(const s16x4*)(VTr + (24 + 4 * h) * 2);
    o = MFMA32(cat8(lo, hi), scb1, o);
  }
  const float* DEC = (const float*)(lds + L_DEC);
#pragma unroll
  for (int kt = 0; kt < DK / 32; ++kt)
#pragma unroll
    for (int g = 0; g < 4; ++g) {
      const f32x4 d = *(const f32x4*)(DEC + 32 * kt + 8 * g + 4 * h);
      S[kt][4 * g] *= d.x; S[kt][4 * g + 1] *= d.y; S[kt][4 * g + 2] *= d.z; S[kt][4 * g + 3] *= d.w;
    }
#pragma unroll
  for (int s = 0; s < 2; ++s) {
    const bf16x8 b = *(const bf16x8*)(VTr + s * 32 + h * 16);
#pragma unroll
    for (int kt = 0; kt < DK / 32; ++kt) {
      const bf16x8 a = *(const bf16x8*)(lds + L_KENDT + (32 * kt + r32) * TS + s * 32 + h * 16);
      S[kt] = MFMA32(a, b, S[kt]);
    }
  }
}

constexpr int NSC = 8;
DI int sc_beg(int sc) { return sc == 0 ? 0 : 16 + 256 * sc; }
DI int sc_end(int sc) { return 16 + 256 * (sc + 1); }
constexpr size_t SCR_HG_U = 0;
constexpr size_t SCR_GL_U = SCR_HG_U + (size_t)8 * 4 * 7 * 16384;
constexpr size_t SCR_HG_D = SCR_GL_U + (size_t)8 * 4 * 7 * 8192;
constexpr size_t SCR_GL_D = SCR_HG_D + (size_t)8 * 4 * 7 * 128;
constexpr size_t SCR_SS_U = 0;
constexpr size_t SCR_SS_D = SCR_SS_U + (size_t)8 * 32 * 7 * 8192;

template <int TYPE, bool SO>
DI void scan_even_job(const Params& p, char* lds, const int head, const int row0, const int ntok, const float* s_in, float* s_out, float* d_out) {
  constexpr int DK = TYPE == 0 ? 128 : 64;
  constexpr int KC = DK / 64;
  const int tid = threadIdx.x & (HB - 1), c = tid & 63, w = tid >> 6, r32 = c & 31, h = c >> 5;
  const bf16_t* P = (const bf16_t*)(p.ws + OFF_P);
  bf16_t* O = (bf16_t*)(p.ws + OFF_O);
  float* TOT = (float*)(lds + L_TOT);
  float* SSQ = (float*)(lds + L_SSQ);
  float* DEC = (float*)(lds + L_DEC);
  const int qcol = TYPE == 0 ? head * 128 : 2048 + head * 64;
  const int kcol = TYPE == 0 ? 512 + head * 128 : 2304 + head * 64;
  const int vcol = TYPE == 0 ? 1024 + head * 128 : 2560 + head * 128;
  const int gcol = TYPE == 0 ? 1536 + head * 128 : 3072 + head * 128;
  const int ocol = TYPE == 0 ? head * 128 : 512 + head * 128;
  float lb[2] = {0.f, 0.f}, wup[16], bal = 0.f;
  if (TYPE == 0) {
#pragma unroll
    for (int e = 0; e < 2; ++e) {
      const float g0 = p.in[7][head * 128 + 2 * c + e], g1 = p.in[7][512 + head * 128 + 2 * c + e], g2 = p.in[7][1024 + head * 128 + 2 * c + e];
      const float m = fmaxf(g0, fmaxf(g1, g2));
      const float e0 = __expf(g0 - m), e1 = __expf(g1 - m), e2 = __expf(g2 - m);
      lb[e] = e0 / (e0 + e1 + e2);
    }
  } else {
#pragma unroll
    for (int r = 0; r < 16; ++r) wup[r] = 0.f;
    bal = p.in[14][head * 64 + c];
  }
  const float* __restrict__ nwp = TYPE == 0 ? p.in[15] : p.in[16];
  f32x16 S[DK / 32];
#pragma unroll
  for (int kt = 0; kt < DK / 32; ++kt)
#pragma unroll
    for (int r = 0; r < 16; ++r) S[kt][r] = (!SO && s_in) ? s_in[(size_t)(32 * kt + crow(r, h)) * 128 + 32 * w + r32] : 0.f;
  float dsum[KC];
#pragma unroll
  for (int e = 0; e < KC; ++e) dsum[e] = 0.f;

  unsigned rq[8], rk[8], rv[8], rg[8]; float ral[8];
  auto load_raw = [&](int ch) {
#pragma unroll
    for (int i = 0; i < 8; ++i) {
      const int t = min(ch * 32 + 8 * w + i, ntok - 1);
      const bf16_t* pr = P + (size_t)(row0 + t) * LD_EV;
      if (TYPE == 0) {
        if (!SO) rq[i] = *(const unsigned*)(pr + qcol + 2 * c);
        rk[i] = *(const unsigned*)(pr + kcol + 2 * c);
      } else {
        if (!SO) rq[i] = (unsigned)pr[qcol + c];
        rk[i] = (unsigned)pr[kcol + c];
        ral[i] = bflo((unsigned)pr[3584 + head * 64 + c]);
      }
      rv[i] = *(const unsigned*)(pr + vcol + 2 * c);
      if (!SO) rg[i] = *(const unsigned*)(pr + gcol + 2 * c);
    }
  };
  const int nch = __builtin_amdgcn_readfirstlane((ntok + 31) >> 5);
  load_raw(0);
  for (int ch = 0; ch < nch; ++ch) {
    const int t0 = ch * 32;
    float kk[8][KC], cum[8][KC], run[KC];
#pragma unroll
    for (int e = 0; e < KC; ++e) run[e] = 0.f;
#pragma unroll
    for (int i = 0; i < 8; ++i) {
      const float vm = (t0 + 8 * w + i) < ntok ? 1.f : 0.f;
      if (TYPE == 0) {
#pragma unroll
        for (int e = 0; e < 2; ++e) {
          const float ts = e ? bfhi(rk[i]) : bflo(rk[i]);
          const float mm = fabsf(ts);
          const float km = (__float_as_uint(ts) >> 31) ? mm : 1.f - mm;
          const float k1 = (1.f - lb[e]) * km;
          const float f = 1.f - k1;
          kk[i][e] = vm * k1;
          run[e] += vm * __logf(f); cum[i][e] = run[e];
        }
      } else {
        const float x = bal + ral[i];
        const float ls = fminf(x, 0.f) - __logf(1.f + __expf(-fabsf(x)));
        kk[i][0] = vm * bflo(rk[i]);
        run[0] += vm * ls * (1.f / 16.f); cum[i][0] = run[0];
      }
    }
#pragma unroll
    for (int e = 0; e < KC; ++e) TOT[w * 128 + KC * c + e] = run[e];
    __syncthreads();
    float off[KC], mid[KC], tot[KC];
#pragma unroll
    for (int e = 0; e < KC; ++e) {
      const float t0_ = TOT[KC * c + e], t1_ = TOT[128 + KC * c + e], t2_ = TOT[256 + KC * c + e], t3_ = TOT[384 + KC * c + e];
      mid[e] = t0_ + t1_; tot[e] = (t0_ + t1_) + (t2_ + t3_);
      off[e] = w == 0 ? 0.f : (w == 1 ? t0_ : (w == 2 ? t0_ + t1_ : t0_ + t1_ + t2_));
      dsum[e] += tot[e];
    }
    {
      u32x4 kp[KC];
#pragma unroll
      for (int m = 0; m < 4; ++m) {
        float kend[2][KC];
#pragma unroll
        for (int i2 = 0; i2 < 2; ++i2) {
          const int i = 2 * m + i2;
          const int ti = 8 * w + i;
          float qe[KC], ke[KC], qi[KC];
#pragma unroll
          for (int e = 0; e < KC; ++e) {
            const float cv = off[e] + cum[i][e];
            kend[i2][e] = kk[i][e] * __expf(tot[e] - cv);
            if (!SO) {
              const float qv = TYPE == 0 ? (e ? bfhi(rq[i]) : bflo(rq[i])) : bflo(rq[i]) * 0.125f;
              qe[e] = qv * __expf(cv - mid[e]);
              ke[e] = kk[i][e] * __expf(mid[e] - cv);
              qi[e] = qv * __expf(cv);
            }
          }
          if (!SO) {
            if (KC == 2) {
              *(unsigned*)(lds + L_QE + ti * RS + 4 * c) = pk2(qe[0], qe[KC - 1]);
              *(unsigned*)(lds + L_KE + ti * RS + 4 * c) = pk2(ke[0], ke[KC - 1]);
              *(unsigned*)(lds + L_QI + ti * RS + 4 * c) = pk2(qi[0], qi[KC - 1]);
            } else {
              *(bf16_t*)(lds + L_QE + ti * RS + 2 * c) = (bf16_t)pk2(qe[0], 0.f);
              *(bf16_t*)(lds + L_KE + ti * RS + 2 * c) = (bf16_t)pk2(ke[0], 0.f);
              *(bf16_t*)(lds + L_QI + ti * RS + 2 * c) = (bf16_t)pk2(qi[0], 0.f);
            }
            *(unsigned*)(lds + L_G + ti * RS + 4 * c) = rg[i];
          }
        }
#pragma unroll
        for (int e = 0; e < KC; ++e) kp[e][m] = pk2(kend[0][e], kend[1][e]);
      }
#pragma unroll
      for (int e = 0; e < KC; ++e) *(u32x4*)(lds + L_KENDT + (KC * c + e) * TS + 16 * w) = kp[e];
      u32x4 v0, v1;
#pragma unroll
      for (int m = 0; m < 4; ++m) {
        v0[m] = (rv[2 * m] & 0xffffu) | (rv[2 * m + 1] << 16);
        v1[m] = (rv[2 * m] >> 16) | (rv[2 * m + 1] & 0xffff0000u);
      }
      *(u32x4*)(lds + L_VT + (2 * c) * TS + 16 * w) = v0;
      *(u32x4*)(lds + L_VT + (2 * c + 1) * TS + 16 * w) = v1;
      if (w == 0) {
#pragma unroll
        for (int e = 0; e < KC; ++e) DEC[KC * c + e] = __expf(tot[e]);
      }
    }
    __syncthreads();
    load_raw(min(ch + 1, nch - 1));
    if (SO) {
      const char* VTr = lds + L_VT + (32 * w + r32) * TS;
#pragma unroll
      for (int kt = 0; kt < DK / 32; ++kt)
#pragma unroll
        for (int g = 0; g < 4; ++g) {
          const f32x4 d = *(const f32x4*)(DEC + 32 * kt + 8 * g + 4 * h);
          S[kt][4 * g] *= d.x; S[kt][4 * g + 1] *= d.y; S[kt][4 * g + 2] *= d.z; S[kt][4 * g + 3] *= d.w;
        }
#pragma unroll
      for (int s = 0; s < 2; ++s) {
        const bf16x8 bq = *(const bf16x8*)(VTr + s * 32 + h * 16);
#pragma unroll
        for (int kt = 0; kt < DK / 32; ++kt) {
          const bf16x8 a = *(const bf16x8*)(lds + L_KENDT + (32 * kt + r32) * TS + s * 32 + h * 16);
          S[kt] = MFMA32(a, bq, S[kt]);
        }
      }
      __syncthreads();
    } else {
      f32x16 o;
      pc_core<DK>(lds, S, o, w, r32, h);
      {
        float ss = 0.f;
#pragma unroll
        for (int r = 0; r < 16; ++r) ss += o[r] * o[r];
        ss += __shfl_xor(ss, 32);
        if (h == 0) SSQ[w * 32 + r32] = ss;
      }
      __syncthreads();
      {
        const float tot2 = (SSQ[r32] + SSQ[32 + r32]) + (SSQ[64 + r32] + SSQ[96 + r32]);
        const float rstd = rsqrtf(tot2 * (1.f / 128.f) + 1e-6f);
        if (t0 + r32 < ntok) {
          bf16_t* orow = O + (size_t)(row0 + t0 + r32) * 1024 + ocol + 32 * w + 4 * h;
#pragma unroll
          for (int g = 0; g < 4; ++g) {
            const u32x2 gp = *(const u32x2*)(lds + L_G + r32 * RS + (32 * w + 8 * g + 4 * h) * 2);
            const f32x4 nw = *(const f32x4*)(nwp + 32 * w + 8 * g + 4 * h);
            const float y0 = o[4 * g] * rstd * nw.x * bflo(gp[0]);
            const float y1 = o[4 * g + 1] * rstd * nw.y * bfhi(gp[0]);
            const float y2 = o[4 * g + 2] * rstd * nw.z * bflo(gp[1]);
            const float y3 = o[4 * g + 3] * rstd * nw.w * bfhi(gp[1]);
            u32x2 v; v[0] = pk2(y0, y1); v[1] = pk2(y2, y3);
            *(u32x2*)(orow + 8 * g) = v;
          }
        }
      }
    }
  }
  if (s_out) {
#pragma unroll
    for (int kt = 0; kt < DK / 32; ++kt)
#pragma unroll
      for (int r = 0; r < 16; ++r) s_out[(size_t)(32 * kt + crow(r, h)) * 128 + 32 * w + r32] = S[kt][r];
  }
  if (SO && w == 0) {
#pragma unroll
    for (int e = 0; e < KC; ++e) d_out[KC * c + e] = dsum[e];
  }
  __syncthreads();
}

DI void phase_scan_even_a(const Params& p, char* lds, int bid, int G) {
  float* scr = (float*)(p.ws + OFF_MIX);
  const int half = threadIdx.x >> 8; lds += half * HALF_LDS;
  for (int jb = bid * 2; jb < 448 + 1024; jb += G * 2) {
    const int j = jb + half;
    if (j < 448) {
      const int type = j & 1, head = (j >> 1) & 3, b = (j >> 3) & 7, sc = j >> 6;
      const int row0 = b * SEQP + sc_beg(sc), ntok = sc_end(sc) - sc_beg(sc);
      const size_t slot = ((size_t)b * 4 + head) * 7 + sc;
      if (type == 0) scan_even_job<0, true>(p, lds, head, row0, ntok, nullptr, scr + SCR_HG_U + slot * 16384, scr + SCR_HG_D + slot * 128);
      else scan_even_job<1, true>(p, lds, head, row0, ntok, nullptr, scr + SCR_GL_U + slot * 8192, scr + SCR_GL_D + slot * 64);
    } else {
      const int jj = j - 448, type = jj & 1, head = (jj >> 1) & 3, b = jj >> 3;
      const int row0 = T_PROMPT + 4 * b;
      if (type == 0) scan_even_job<0, false>(p, lds, head, row0, 4, p.in[2] + ((size_t)b * 4 + head) * 16384, p.out + OUT_HGS + ((size_t)b * 4 + head) * 16384, nullptr);
      else scan_even_job<1, false>(p, lds, head, row0, 4, p.in[3] + ((size_t)b * 4 + head) * 8192, p.out + OUT_GLS + ((size_t)b * 4 + head) * 8192, nullptr);
    }
  }
}
DI void phase_scan_even_c(const Params& p, int bid, int G) {
  float* scr = (float*)(p.ws + OFF_MIX);
  for (int i = bid * NTHREADS + threadIdx.x; i < 32 * 4096 + 32 * 2048; i += G * NTHREADS) {
    const bool gl = i >= 32 * 4096;
    const int ii = gl ? i - 32 * 4096 : i;
    const int per = gl ? 2048 : 4096, bh = ii / per, e4 = ii - bh * per, k = e4 >> 5;
    float* U = scr + (gl ? SCR_GL_U + (size_t)bh * 7 * 8192 : SCR_HG_U + (size_t)bh * 7 * 16384) + 4 * e4;
    const float* D = scr + (gl ? SCR_GL_D + (size_t)bh * 7 * 64 : SCR_HG_D + (size_t)bh * 7 * 128) + k;
    const int ustride = gl ? 8192 : 16384, dstride = gl ? 64 : 128;
    f32x4 run = {0.f, 0.f, 0.f, 0.f};
#pragma unroll
    for (int sc = 0; sc < 7; ++sc) {
      const float d = __expf(D[sc * dstride]);
      const f32x4 u = *(const f32x4*)(U + (size_t)sc * ustride);
      run = run * d + u;
      *(f32x4*)(U + (size_t)sc * ustride) = run;
    }
  }
}
DI void phase_scan_even_b(const Params& p, char* lds, int bid, int G) {
  float* scr = (float*)(p.ws + OFF_MIX);
  const int half = threadIdx.x >> 8; lds += half * HALF_LDS;
  for (int jb = bid * 2; jb < 512; jb += G * 2) {
    const int j = jb + half;
    {
      const int type = j & 1, head = (j >> 1) & 3, b = (j >> 3) & 7, sc = j >> 6;
      const int row0 = b * SEQP + sc_beg(sc), ntok = sc_end(sc) - sc_beg(sc);
      const size_t slot = ((size_t)b * 4 + head) * 7 + sc - 1;
      if (type == 0) scan_even_job<0, false>(p, lds, head, row0, ntok, sc ? scr + SCR_HG_U + slot * 16384 : nullptr,
                                             sc == NSC - 1 ? p.out + OUT_HGP + ((size_t)b * 4 + head) * 16384 : nullptr, nullptr);
      else scan_even_job<1, false>(p, lds, head, row0, ntok, sc ? scr + SCR_GL_U + slot * 8192 : nullptr,
                                   sc == NSC - 1 ? p.out + OUT_GLP + ((size_t)b * 4 + head) * 8192 : nullptr, nullptr);
    }
  }
}

constexpr int M_BM = 0, M_CM = 8704, M_XS = 17408, M_Z = 26112, M_BT = 34816, M_VT = 45056, M_VENDT = 55296, M_CUM = 65536, M_DT = 65792, M_SSQ = 66048, M_CW = 66560;

DI void phase_conv(const Params& p, int bid, int G) {
  const bf16_t* P = (const bf16_t*)(p.ws + OFF_P);
  bf16_t* O = (bf16_t*)(p.ws + OFF_O);
  bf16_t* HN = (bf16_t*)(p.ws + OFF_HN);
  const float* __restrict__ cwp = p.in[19];
  const float* __restrict__ cbp = p.in[20];
  const int gt = bid * NTHREADS + threadIdx.x, NPAR = (G * NTHREADS) / 384;
  const int cg = gt % 384, r0 = gt / 384, ch = 8 * cg;
  if (r0 >= NPAR) return;
  float w[4][8], bs[8];
#pragma unroll
  for (int k = 0; k < 4; ++k) {
    const f32x4 a = *(const f32x4*)(cwp + k * 3072 + ch), b_ = *(const f32x4*)(cwp + k * 3072 + ch + 4);
    w[k][0] = a.x; w[k][1] = a.y; w[k][2] = a.z; w[k][3] = a.w; w[k][4] = b_.x; w[k][5] = b_.y; w[k][6] = b_.z; w[k][7] = b_.w;
  }
  {
    const f32x4 a = *(const f32x4*)(cbp + ch), b_ = *(const f32x4*)(cbp + ch + 4);
    bs[0] = a.x; bs[1] = a.y; bs[2] = a.z; bs[3] = a.w; bs[4] = b_.x; bs[5] = b_.y; bs[6] = b_.z; bs[7] = b_.w;
  }
  bf16_t* dbase = ch < 2048 ? O + ch : HN + (ch - 2048);
  const int dld = ch < 2048 ? 2048 : 1024;
  for (int run = r0; run < 8 * 258; run += NPAR) {
    const int b = run / 258, t0 = (run - b * 258) * 8, row0 = b * SEQP + t0;
    u32x4 pre[11];
#pragma unroll
    for (int i = 0; i < 11; ++i) {
      const int r = row0 + i - 3;
      pre[i] = (i >= 3 || t0 > 0) ? *(const u32x4*)(P + (size_t)r * LD_OD + 2048 + ch) : (u32x4){0u, 0u, 0u, 0u};
    }
#pragma unroll
    for (int i = 0; i < 8; ++i) {
      u32x4 o;
#pragma unroll
      for (int q = 0; q < 4; ++q) {
        float a0 = bs[2 * q], a1 = bs[2 * q + 1];
#pragma unroll
        for (int k = 0; k < 4; ++k) { a0 += bflo(pre[i + k][q]) * w[k][2 * q]; a1 += bfhi(pre[i + k][q]) * w[k][2 * q + 1]; }
        o[q] = pk2(siluf_(a0), siluf_(a1));
      }
      *(u32x4*)(dbase + (size_t)(row0 + i) * dld) = o;
    }
  }
  for (int sq = r0; sq < 128; sq += NPAR) {
    const int row0 = T_PROMPT + 4 * sq;
    float pf[7][8];
#pragma unroll
    for (int i = 0; i < 3; ++i) {
      const f32x4 a = *(const f32x4*)(p.in[5] + ((size_t)sq * 3 + i) * 3072 + ch), b_ = *(const f32x4*)(p.in[5] + ((size_t)sq * 3 + i) * 3072 + ch + 4);
      pf[i][0] = a.x; pf[i][1] = a.y; pf[i][2] = a.z; pf[i][3] = a.w; pf[i][4] = b_.x; pf[i][5] = b_.y; pf[i][6] = b_.z; pf[i][7] = b_.w;
    }
#pragma unroll
    for (int i = 0; i < 4; ++i) {
      const u32x4 u = *(const u32x4*)(P + (size_t)(row0 + i) * LD_OD + 2048 + ch);
#pragma unroll
      for (int q = 0; q < 4; ++q) { pf[3 + i][2 * q] = bflo(u[q]); pf[3 + i][2 * q + 1] = bfhi(u[q]); }
    }
#pragma unroll
    for (int i = 0; i < 4; ++i) {
      u32x4 o;
#pragma unroll
      for (int q = 0; q < 4; ++q) {
        float a0 = bs[2 * q], a1 = bs[2 * q + 1];
#pragma unroll
        for (int k = 0; k < 4; ++k) { a0 += pf[i + k][2 * q] * w[k][2 * q]; a1 += pf[i + k][2 * q + 1] * w[k][2 * q + 1]; }
        o[q] = pk2(siluf_(a0), siluf_(a1));
      }
      *(u32x4*)(dbase + (size_t)(row0 + i) * dld) = o;
    }
  }
}

template <bool SO>
DI void scan_odd_job(const Params& p, char* lds, const int b, const int hp, const bool smp, const int tbeg, const int tend, const float* s_in, float* s_out, float* d_out) {
  const int tid = threadIdx.x & (HB - 1), c = tid & 63, w = tid >> 6, r32 = c & 31, h = c >> 5;
  const int grp = hp >> 2, hl = w >> 1, headw = 2 * hp + hl;
  const int row0 = (smp ? T_PROMPT + 4 * b : b * SEQP) + tbeg, ntok = tend - tbeg;
  const bf16_t* P = (const bf16_t*)(p.ws + OFF_P);
  bf16_t* O = (bf16_t*)(p.ws + OFF_O);
  const bf16_t* BC = (const bf16_t*)(p.ws + OFF_HN);
  float* CUM = (float*)(lds + M_CUM);
  float* DTL = (float*)(lds + M_DT);
  float* SSQ = (float*)(lds + M_SSQ);
  const int hd_l = 2 * hp + h;
  const float dtb = p.in[21][hd_l], aneg = -__expf(p.in[22][hd_l]);
  const float dsk = p.in[23][headw];
  f32x16 S[4];
  {
    const float* sin = s_in + ((size_t)hl * 64 + 32 * (w & 1) + r32) * 128;
#pragma unroll
    for (int kt = 0; kt < 4; ++kt)
#pragma unroll
      for (int g = 0; g < 4; ++g) {
        f32x4 v = {0.f, 0.f, 0.f, 0.f};
        if (!SO && s_in) v = *(const f32x4*)(sin + 32 * kt + 8 * g + 4 * h);
        S[kt][4 * g] = v.x; S[kt][4 * g + 1] = v.y; S[kt][4 * g + 2] = v.z; S[kt][4 * g + 3] = v.w;
      }
  }
  float dsum = 0.f;
  unsigned rx[8], rb[8], rc[8], rz[8]; float rdt;
  auto load_raw = [&](int ch) {
#pragma unroll
    for (int i = 0; i < 8; ++i) {
      const int t = min(ch * 32 + 8 * w + i, ntok - 1);
      rx[i] = *(const unsigned*)(O + (size_t)(row0 + t) * 2048 + hp * 128 + 2 * c);
      rb[i] = *(const unsigned*)(BC + (size_t)(row0 + t) * 1024 + grp * 128 + 2 * c);
      if (!SO) {
        rc[i] = *(const unsigned*)(BC + (size_t)(row0 + t) * 1024 + 512 + grp * 128 + 2 * c);
        rz[i] = *(const unsigned*)(P + (size_t)(row0 + t) * LD_OD + hp * 128 + 2 * c);
      }
    }
    {
      const int t = min(ch * 32 + r32, ntok - 1);
      rdt = bflo((unsigned)P[(size_t)(row0 + t) * LD_OD + 5120 + hd_l]);
    }
  };
  const int nch = __builtin_amdgcn_readfirstlane((ntok + 31) >> 5);
  load_raw(0);
  for (int ch = 0; ch < nch; ++ch) {
    const int t0 = ch * 32;
    {
      const float xdt = rdt + dtb;
      float dt = xdt > 20.f ? xdt : __logf(1.f + __expf(xdt));
      dt = (t0 + r32 < ntok) ? dt : 0.f;
      float cs = dt * aneg;
#pragma unroll
      for (int d = 1; d < 32; d <<= 1) { const float o_ = __shfl_up(cs, d, 32); if (r32 >= d) cs += o_; }
      if (w == 0) { CUM[h * 32 + r32] = cs; DTL[h * 32 + r32] = dt; }
    }
    {
#pragma unroll
      for (int i = 0; i < 8; ++i) {
        if (!SO) {
          *(unsigned*)(lds + M_BM + (8 * w + i) * RS + 4 * c) = rb[i];
          *(unsigned*)(lds + M_CM + (8 * w + i) * RS + 4 * c) = rc[i];
          *(unsigned*)(lds + M_XS + (8 * w + i) * RS + 4 * c) = rx[i];
          *(unsigned*)(lds + M_Z + (8 * w + i) * RS + 4 * c) = rz[i];
        }
      }
      u32x4 b0, b1;
#pragma unroll
      for (int m = 0; m < 4; ++m) {
        b0[m] = (rb[2 * m] & 0xffffu) | (rb[2 * m + 1] << 16);
        b1[m] = (rb[2 * m] >> 16) | (rb[2 * m + 1] & 0xffff0000u);
      }
      *(u32x4*)(lds + M_BT + (2 * c) * TS + 16 * w) = b0;
      *(u32x4*)(lds + M_BT + (2 * c + 1) * TS + 16 * w) = b1;
    }
    __syncthreads();
    {
      const int hx = c >> 5;
      const float last = CUM[hx * 32 + 31];
      float vt[8][2], ve[8][2];
#pragma unroll
      for (int i = 0; i < 8; ++i) {
        const int ti = 8 * w + i;
        const float dt = DTL[hx * 32 + ti], cm = CUM[hx * 32 + ti];
        const float ee = __expf(last - cm);
        vt[i][0] = bflo(rx[i]) * dt; vt[i][1] = bfhi(rx[i]) * dt;
        ve[i][0] = vt[i][0] * ee; ve[i][1] = vt[i][1] * ee;
      }
#pragma unroll
      for (int e = 0; e < 2; ++e) {
        u32x4 pv, pe;
#pragma unroll
        for (int m = 0; m < 4; ++m) { pv[m] = pk2(vt[2 * m][e], vt[2 * m + 1][e]); pe[m] = pk2(ve[2 * m][e], ve[2 * m + 1][e]); }
        if (!SO) *(u32x4*)(lds + M_VT + (2 * c + e) * TS + 16 * w) = pv;
        *(u32x4*)(lds + M_VENDT + (2 * c + e) * TS + 16 * w) = pe;
      }
    }
    __syncthreads();
    load_raw(min(ch + 1, nch - 1));
    f32x16 o;
    const float lastw = CUM[hl * 32 + 31];
    dsum += lastw;
    if (!SO) {
      const char* BMr = lds + M_BM + r32 * RS;
      const char* CMr = lds + M_CM + r32 * RS;
      f32x16 sc; zero16(sc);
#pragma unroll
      for (int s = 0; s < 8; ++s) {
        const bf16x8 a = *(const bf16x8*)(BMr + s * 32 + h * 16);
        const bf16x8 bq = *(const bf16x8*)(CMr + s * 32 + h * 16);
        sc = MFMA32(a, bq, sc);
      }
      const float ci = CUM[hl * 32 + r32];
#pragma unroll
      for (int g = 0; g < 4; ++g) {
        const f32x4 cj = *(const f32x4*)(CUM + hl * 32 + 8 * g + 4 * h);
#pragma unroll
        for (int e = 0; e < 4; ++e) {
          const int j = 8 * g + 4 * h + e;
          const float cje = e == 0 ? cj.x : (e == 1 ? cj.y : (e == 2 ? cj.z : cj.w));
          sc[4 * g + e] = (j <= r32) ? sc[4 * g + e] * __expf(ci - cje) : 0.f;
        }
      }
      const bf16x8 scb0 = pack8<0>(sc), scb1 = pack8<1>(sc);
      zero16(o);
#pragma unroll
      for (int kt = 0; kt < 4; ++kt) {
        {
          const bf16x8 a = pack8<0>(S[kt]);
          const s16x4 lo = *(const s16x4*)(CMr + (32 * kt + 4 * h) * 2), hi = *(const s16x4*)(CMr + (32 * kt + 8 + 4 * h) * 2);
          o = MFMA32(a, cat8(lo, hi), o);
        }
        {
          const bf16x8 a = pack8<1>(S[kt]);
          const s16x4 lo = *(const s16x4*)(CMr + (32 * kt + 16 + 4 * h) * 2), hi = *(const s16x4*)(CMr + (32 * kt + 24 + 4 * h) * 2);
          o = MFMA32(a, cat8(lo, hi), o);
        }
      }
      const float ei = __expf(ci);
#pragma unroll
      for (int r = 0; r < 16; ++r) o[r] *= ei;
      const char* VTr = lds + M_VT + (32 * w + r32) * TS;
      {
        const s16x4 lo = *(const s16x4*)(VTr + (4 * h) * 2), hi = *(const s16x4*)(VTr + (8 + 4 * h) * 2);
        o = MFMA32(cat8(lo, hi), scb0, o);
      }
      {
        const s16x4 lo = *(const s16x4*)(VTr + (16 + 4 * h) * 2), hi = *(const s16x4*)(VTr + (24 + 4 * h) * 2);
        o = MFMA32(cat8(lo, hi), scb1, o);
      }
    }
    {
      const float el = __expf(lastw);
#pragma unroll
      for (int kt = 0; kt < 4; ++kt)
#pragma unroll
        for (int r = 0; r < 16; ++r) S[kt][r] *= el;
      const char* VEr = lds + M_VENDT + (32 * w + r32) * TS;
#pragma unroll
      for (int s = 0; s < 2; ++s) {
        const bf16x8 bq = *(const bf16x8*)(VEr + s * 32 + h * 16);
#pragma unroll
        for (int kt = 0; kt < 4; ++kt) {
          const bf16x8 a = *(const bf16x8*)(lds + M_BT + (32 * kt + r32) * TS + s * 32 + h * 16);
          S[kt] = MFMA32(a, bq, S[kt]);
        }
      }
    }
    if (!SO) {
      float y[16]; float ss = 0.f;
#pragma unroll
      for (int g = 0; g < 4; ++g) {
        const u32x2 xp = *(const u32x2*)(lds + M_XS + r32 * RS + (32 * w + 8 * g + 4 * h) * 2);
        const u32x2 zp = *(const u32x2*)(lds + M_Z + r32 * RS + (32 * w + 8 * g + 4 * h) * 2);
        y[4 * g] = (o[4 * g] + dsk * bflo(xp[0])) * bflo(zp[0]);
        y[4 * g + 1] = (o[4 * g + 1] + dsk * bfhi(xp[0])) * bfhi(zp[0]);
        y[4 * g + 2] = (o[4 * g + 2] + dsk * bflo(xp[1])) * bflo(zp[1]);
        y[4 * g + 3] = (o[4 * g + 3] + dsk * bfhi(xp[1])) * bfhi(zp[1]);
      }
#pragma unroll
      for (int r = 0; r < 16; ++r) ss += y[r] * y[r];
      ss += __shfl_xor(ss, 32);
      if (h == 0) SSQ[w * 32 + r32] = ss;
      if (t0 + r32 < ntok) {
        bf16_t* orow = O + (size_t)(row0 + t0 + r32) * 2048 + hp * 128 + 32 * w + 4 * h;
#pragma unroll
        for (int g = 0; g < 4; ++g) { u32x2 v; v[0] = pk2(y[4 * g], y[4 * g + 1]); v[1] = pk2(y[4 * g + 2], y[4 * g + 3]); *(u32x2*)(orow + 8 * g) = v; }
      }
    }
    __syncthreads();
    if (!SO && tid < 32 && t0 + tid < ntok) {
      float* q = (float*)(p.ws + OFF_SSQ);
      q[(size_t)(row0 + t0 + tid) * 16 + hp] = (SSQ[tid] + SSQ[32 + tid]) + (SSQ[64 + tid] + SSQ[96 + tid]);
    }
  }
  if (s_out) {
    float* so = s_out + ((size_t)hl * 64 + 32 * (w & 1) + r32) * 128;
#pragma unroll
    for (int kt = 0; kt < 4; ++kt)
#pragma unroll
      for (int g = 0; g < 4; ++g) {
        f32x4 v = {S[kt][4 * g], S[kt][4 * g + 1], S[kt][4 * g + 2], S[kt][4 * g + 3]};
        *(f32x4*)(so + 32 * kt + 8 * g + 4 * h) = v;
      }
  }
  if (SO && (w & 1) == 0 && c == 0) d_out[hl * 7] = dsum;
  __syncthreads();
}

DI void phase_scan_odd_a(const Params& p, char* lds, int bid, int G) {
  float* scr = (float*)(p.ws + OFF_MIX);
  const int half = threadIdx.x >> 8; lds += half * HALF_LDS;
  for (int jb = bid * 2; jb < 896 + 2048; jb += G * 2) {
    const int j = jb + half;
    if (j >= 896) {
      const int jj = j - 896, hp = jj & 15, b = jj >> 4;
      scan_odd_job<false>(p, lds, b, hp, true, 0, 4, p.in[4] + ((size_t)b * 32 + 2 * hp) * 8192, p.out + OUT_SSS + ((size_t)b * 32 + 2 * hp) * 8192, nullptr);
      continue;
    }
    const int hp = j & 15, b = (j >> 4) & 7, sc = j >> 7;
    float* U = scr + SCR_SS_U + ((((size_t)b * 16 + hp) * 7 + sc) * 2) * 8192;
    float* D = scr + SCR_SS_D + ((size_t)b * 32 + 2 * hp) * 7 + sc;
    scan_odd_job<true>(p, lds, b, hp, false, sc_beg(sc), sc_end(sc), nullptr, U, D);
  }
}
DI void phase_scan_odd_c(const Params& p, int bid, int G) {
  float* scr = (float*)(p.ws + OFF_MIX);
  for (int i = bid * NTHREADS + threadIdx.x; i < 128 * 2 * 2048; i += G * NTHREADS) {
    const int e4 = i & 2047, hd = (i >> 11) & 1, bhp = i >> 12;
    float* U = scr + SCR_SS_U + ((size_t)bhp * 7 * 2 + hd) * 8192 + 4 * e4;
    const float* D = scr + SCR_SS_D + ((size_t)(bhp >> 4) * 32 + 2 * (bhp & 15) + hd) * 7;
    f32x4 run = {0.f, 0.f, 0.f, 0.f};
#pragma unroll
    for (int sc = 0; sc < 7; ++sc) {
      const float d = __expf(D[sc]);
      const f32x4 u = *(const f32x4*)(U + (size_t)sc * 16384);
      run = run * d + u;
      *(f32x4*)(U + (size_t)sc * 16384) = run;
    }
  }
}
DI void phase_scan_odd_b(const Params& p, char* lds, int bid, int G) {
  float* scr = (float*)(p.ws + OFF_MIX);
  const int half = threadIdx.x >> 8; lds += half * HALF_LDS;
  for (int jb = bid * 2; jb < 1024; jb += G * 2) {
    const int j = jb + half;
    {
      const int hp = j & 15, b = (j >> 4) & 7, sc = j >> 7;
      const float* s_in = sc ? scr + SCR_SS_U + ((((size_t)b * 16 + hp) * 7 + sc - 1) * 2) * 8192 : nullptr;
      float* s_out = sc == NSC - 1 ? p.out + OUT_SSP + ((size_t)b * 32 + 2 * hp) * 8192 : nullptr;
      scan_odd_job<false>(p, lds, b, hp, false, sc_beg(sc), sc_end(sc), s_in, s_out, nullptr);
    }
  }
  const bf16_t* P = (const bf16_t*)(p.ws + OFF_P);
  for (int i = bid * NTHREADS + threadIdx.x; i < 136 * 3 * 3072; i += G * NTHREADS) {
    const int ch = i % 3072, r = i / 3072, j = r % 3, b = r / 3;
    if (b < 8) p.out[OUT_CVP + ((size_t)b * 3 + j) * 3072 + ch] = bflo((unsigned)P[(size_t)(b * SEQP + 2061 + j) * LD_OD + 2048 + ch]);
    else { const int bs = b - 8; p.out[OUT_CVS + ((size_t)bs * 3 + j) * 3072 + ch] = bflo((unsigned)P[(size_t)(T_PROMPT + 4 * bs + 1 + j) * LD_OD + 2048 + ch]); }
  }
}

#define XB_TMO      128
#define XB_XCNT(j)  (256  + 64 * (j))
#define XB_XSUB(j)  (1280 + 64 * (j))
#define XB_XGEN(j)  (2304 + 64 * (j))
#define XB_TOP      3328
#define XB_TOPGEN   3392
#define XCD_BAR_WORDS 3456
#define XB_SPIN_CAP (1u << 20)
#define LAS __attribute__((address_space(3)))
DI unsigned xb_ld(unsigned* p) { return __hip_atomic_load(p, __ATOMIC_RELAXED, __HIP_MEMORY_SCOPE_AGENT); }
DI unsigned xb_add(unsigned* p, unsigned v) { return __hip_atomic_fetch_add(p, v, __ATOMIC_RELAXED, __HIP_MEMORY_SCOPE_AGENT); }
DI unsigned xb_xcc_id() { return (unsigned)__builtin_amdgcn_s_getreg((3 << 11) | 20) & 0xFu; }
#define XB_SPIN(cond, bar) do { unsigned _sp = 0; while (cond) { __builtin_amdgcn_s_sleep(1); \
    if ((++_sp & 255u) == 0u) { if (xb_ld(&(bar)[XB_TMO])) break; if (_sp > XB_SPIN_CAP) { atomicAdd(&(bar)[XB_TMO], 1u); break; } } } } while (0)
struct XcdBarrier { unsigned* bar; unsigned x; volatile LAS unsigned* st; };
DI XcdBarrier xcd_barrier_post(unsigned* bar, volatile LAS unsigned* st) {
  XcdBarrier b; b.bar = bar; b.x = xb_xcc_id(); b.st = st;
  if (threadIdx.x == 0) (void)xb_add(&bar[XB_XCNT(b.x)], 1u);
  return b;
}
DI void xcd_barrier_complete(unsigned* bar, unsigned x, unsigned& nloc, unsigned& nx) {
  const unsigned G = gridDim.x * gridDim.y * gridDim.z;
  unsigned sum, cnt, mine, sp = 0u;
  for (;;) {
    sum = 0u; cnt = 0u; mine = 0u;
#pragma unroll
    for (unsigned j = 0; j < 16; ++j) { const unsigned c = xb_ld(&bar[XB_XCNT(j)]); sum += c; cnt += (c > 0u) ? 1u : 0u; mine = (j == x) ? c : mine; }
    if (sum == G) break;
    __builtin_amdgcn_s_sleep(1);
    if ((++sp & 255u) == 0u) { if (xb_ld(&bar[XB_TMO])) break; if (sp > XB_SPIN_CAP) { atomicAdd(&bar[XB_TMO], 1u); break; } }
  }
  nloc = mine > 0u ? mine : 1u; nx = cnt > 0u ? cnt : 1u;
}
DI void xcd_barrier(const XcdBarrier& b) {
  asm volatile("s_waitcnt vmcnt(0)" ::: "memory");
  __syncthreads();
  if (threadIdx.x == 0) {
    unsigned* bar = b.bar;
    __builtin_amdgcn_s_waitcnt(0);
    unsigned nloc = b.st[0], nx = b.st[1];
    if (nloc == 0u) { xcd_barrier_complete(bar, b.x, nloc, nx); b.st[0] = nloc; b.st[1] = nx; }
    const unsigned old = xb_add(&bar[XB_XSUB(b.x)], 1u);
    const unsigned gen = old / nloc;
    if (old + 1u == (gen + 1u) * nloc) {
      __builtin_amdgcn_fence(__ATOMIC_RELEASE, "agent");
      asm volatile("s_waitcnt vmcnt(0)" ::: "memory");
      const unsigned og = xb_add(&bar[XB_TOP], 1u);
      const unsigned tg = og / nx;
      if (og + 1u == (tg + 1u) * nx) xb_add(&bar[XB_TOPGEN], 1u);
      else XB_SPIN(xb_ld(&bar[XB_TOPGEN]) == tg, bar);
      __builtin_amdgcn_fence(__ATOMIC_ACQUIRE, "agent");
      xb_add(&bar[XB_XGEN(b.x)], 1u);
      asm volatile("s_waitcnt vmcnt(0)" ::: "memory");
    } else {
      XB_SPIN(xb_ld(&bar[XB_XGEN(b.x)]) == gen, bar);
      __builtin_amdgcn_fence(__ATOMIC_ACQUIRE, "agent");
      asm volatile("s_waitcnt vmcnt(0)" ::: "memory");
    }
  }
  __syncthreads();
}

constexpr int N_PHASES = 21;
#ifndef ONLY_PHASE
#define ONLY_PHASE -1
#endif
#define PHASE(k, body) do { if ((ONLY_PHASE < 0 || ONLY_PHASE == (k)) && ph_lo <= (k) && (k) <= ph_hi) { body; } if (ph_lo <= (k) && (k) < ph_hi) xcd_barrier(xb); } while (0)

__global__ void __launch_bounds__(NTHREADS, 2) fwd_mega(Params p, int ph_lo, int ph_hi) {
  extern __shared__ __attribute__((aligned(16))) char lds[];
  cg::grid_group grid = cg::this_grid();
  const int G = gridDim.x, bid = blockIdx.x;
  if (ph_lo > 1000) grid.sync();
  volatile LAS unsigned* xst = (volatile LAS unsigned*)(lds + 2 * HALF_LDS);
  if (threadIdx.x == 0) { xst[0] = 0u; xst[1] = 0u; }
  __syncthreads();
  XcdBarrier xb = xcd_barrier_post((unsigned*)(p.ws + OFF_BAR), xst);
  bf16_t* HN = (bf16_t*)(p.ws + OFF_HN);
  bf16_t* Pb = (bf16_t*)(p.ws + OFF_P);
  bf16_t* Ob = (bf16_t*)(p.ws + OFF_O);
  float* MIX = (float*)(p.ws + OFF_MIX);
  PHASE(0, phase_prep(p, lds, bid, G));
  PHASE(1, gemm_run(lds, HN, (const bf16_t*)(p.ws + OFF_WT_EVIN), LD_EV, 1024, EpiStoreBf16{Pb, LD_EV, (1u << 6) | (1u << 7) | (1u << 12) | (1u << 13), (1u << 2) | (1u << 3)}, bid, G));
  PHASE(2, phase_scan_even_a(p, lds, bid, G));
  PHASE(3, phase_scan_even_c(p, bid, G));
  PHASE(4, phase_scan_even_b(p, lds, bid, G));
  PHASE(5, gemm_n1024<false>(lds, Ob, (const bf16_t*)(p.ws + OFF_WT_EVOUT), 1024, EpiResNorm<false>{(bf16_t*)(p.ws + OFF_X), (bf16_t*)(p.ws + OFF_HN), p.in[9], p.in[10], nullptr, (float*)(p.ws + OFF_XB) + 0 * (SZ_XB_SET / 4), (unsigned*)(p.ws + OFF_CNT) + 0 * (SZ_CNT_SET / 4), (unsigned*)(p.ws + OFF_BAR) + 64}, (float*)Pb, bid, G));
  PHASE(6, phase_rowwise(p, p.in[9], p.in[10], false, (const float*)Pb, 4, M_MAIN, bid, G));
  PHASE(7, gemm_run(lds, HN, (const bf16_t*)(p.ws + OFF_WT_GU), 5632, 1024, EpiSwiglu{Pb, 2816}, bid, G));
  PHASE(8, gemm_n1024<false>(lds, Pb, (const bf16_t*)(p.ws + OFF_WT_DN), 2816, EpiResNorm<false>{(bf16_t*)(p.ws + OFF_X), (bf16_t*)(p.ws + OFF_HN), p.in[11], p.in[8] + 1024, nullptr, (float*)(p.ws + OFF_XB) + 2 * (SZ_XB_SET / 4), (unsigned*)(p.ws + OFF_CNT) + 2 * (SZ_CNT_SET / 4), (unsigned*)(p.ws + OFF_BAR) + 64}, (float*)Ob, bid, G));
  PHASE(9, phase_rowwise(p, p.in[11], p.in[8] + 1024, false, (const float*)Ob, 11, M_MAIN, bid, G));
  PHASE(10, gemm_run(lds, HN, (const bf16_t*)(p.ws + OFF_WT_ODIN), LD_OD, 1024, EpiStoreBf16{Pb, LD_OD, 0xffu, 0u}, bid, G));
  PHASE(11, phase_conv(p, bid, G));
  PHASE(12, phase_scan_odd_a(p, lds, bid, G));
  PHASE(13, phase_scan_odd_c(p, bid, G));
  PHASE(14, phase_scan_odd_b(p, lds, bid, G));
  PHASE(15, phase_groupnorm(p, bid, G));
  PHASE(16, gemm_n1024<false>(lds, Ob, (const bf16_t*)(p.ws + OFF_WT_ODOUT), 2048, EpiResNorm<false>{(bf16_t*)(p.ws + OFF_X), (bf16_t*)(p.ws + OFF_HN), p.in[9] + 1024, p.in[10] + 1024, nullptr, (float*)(p.ws + OFF_XB) + 4 * (SZ_XB_SET / 4), (unsigned*)(p.ws + OFF_CNT) + 4 * (SZ_CNT_SET / 4), (unsigned*)(p.ws + OFF_BAR) + 64}, (float*)Pb, bid, G));
  PHASE(17, phase_rowwise(p, p.in[9] + 1024, p.in[10] + 1024, false, (const float*)Pb, 8, M_MAIN, bid, G));
  PHASE(18, gemm_run(lds, HN, (const bf16_t*)(p.ws + OFF_WT_GU + SZ_WT_GU1), 5632, 1024, EpiSwiglu{Pb, 2816}, bid, G));
  PHASE(19, gemm_n1024<true>(lds, Pb, (const bf16_t*)(p.ws + OFF_WT_DN + SZ_WT_DN1), 2816, EpiResNorm<true>{(bf16_t*)(p.ws + OFF_X), (bf16_t*)(p.ws + OFF_HN), p.in[11] + 1024, nullptr, p.out + OUT_YP, (float*)(p.ws + OFF_XB) + 6 * (SZ_XB_SET / 4), (unsigned*)(p.ws + OFF_CNT) + 6 * (SZ_CNT_SET / 4), (unsigned*)(p.ws + OFF_BAR) + 64}, (float*)Ob, bid, G));
  PHASE(20, phase_rowwise(p, p.in[11] + 1024, nullptr, true, (const float*)Ob, 11, M_MAIN, bid, G));
}

extern "C" void kernel_launch(void* const* d_in, const int* in_sizes, int n_in, void* d_out, int out_size, void* d_ws, size_t ws_size, hipStream_t stream) {
  static int grid_blocks = 0;
  if (!grid_blocks) {
    int dev = 0, cus = 0, per_cu = 0;
    hipGetDevice(&dev);
    hipDeviceGetAttribute(&cus, hipDeviceAttributeMultiprocessorCount, dev);
    hipFuncSetAttribute((const void*)fwd_mega, hipFuncAttributeMaxDynamicSharedMemorySize, LDS_BYTES);
    hipOccupancyMaxActiveBlocksPerMultiprocessor(&per_cu, (const void*)fwd_mega, NTHREADS, LDS_BYTES);
    if (per_cu < 1) per_cu = 1;
    if (per_cu > 1) per_cu = 1;
    grid_blocks = cus * per_cu;
    if (ws_size < WS_END) fprintf(stderr, "kernel_launch: workspace too small: %zu < %zu\n", ws_size, (size_t)WS_END);
  }
  Params p{};
  for (int i = 0; i < 29; ++i) p.in[i] = (const float*)d_in[i];
  p.out = (float*)d_out;
  p.ws = (char*)d_ws;
  (void)hipMemsetAsync((char*)d_ws + OFF_BAR, 0, 16384 + 8 * SZ_CNT_SET, stream);
#if ONE_LAUNCH
  int lo = 0, hi = N_PHASES - 1;
  void* args[] = {&p, &lo, &hi};
  hipError_t e = hipLaunchCooperativeKernel((const void*)fwd_mega, dim3(grid_blocks), dim3(NTHREADS), args, LDS_BYTES, stream);
  if (e != hipSuccess) fprintf(stderr, "cooperative launch failed: %s (grid %d)\n", hipGetErrorString(e), grid_blocks);
#else
  for (int ph = 0; ph < N_PHASES; ++ph) {
    int lo = ph, hi = ph;
    void* args[] = {&p, &lo, &hi};
    hipError_t e = hipLaunchCooperativeKernel((const void*)fwd_mega, dim3(grid_blocks), dim3(NTHREADS), args, LDS_BYTES, stream);
    if (e != hipSuccess) fprintf(stderr, "launch failed: %s (grid %d)\n", hipGetErrorString(e), grid_blocks);
  }
#endif
}
```

```cpp
#include <hip/hip_runtime.h>
#include <hip/hip_cooperative_groups.h>
#include <cstdio>
#include <cstdint>
namespace cg = cooperative_groups;

#ifndef ONE_LAUNCH
#define ONE_LAUNCH 1
#endif

#define DI __device__ __forceinline__
typedef unsigned short bf16_t;
typedef short bf16x8 __attribute__((ext_vector_type(8)));
typedef short s16x4 __attribute__((ext_vector_type(4)));
typedef float f32x16 __attribute__((ext_vector_type(16)));
typedef float f32x4 __attribute__((ext_vector_type(4)));
typedef float f32x2 __attribute__((ext_vector_type(2)));
typedef unsigned u32x4 __attribute__((ext_vector_type(4)));
typedef unsigned u32x2 __attribute__((ext_vector_type(2)));
typedef __bf16 bf16v2 __attribute__((ext_vector_type(2)));
#define MFMA32(a, b, c) __builtin_amdgcn_mfma_f32_32x32x16_bf16((a), (b), (c), 0, 0, 0)

constexpr int T_ALL = 17024, T_PAD = 17152, T_PROMPT = 16512, SEQP = 2064, NTHREADS = 512, HB = 256  ;
constexpr int LD_EV = 3840, LD_OD = 5376;
constexpr int HALF_LDS = 75776;
constexpr int LDS_BYTES = 2 * HALF_LDS + 32;
constexpr int M_MAIN = 16384;

constexpr size_t OFF_WT_EVIN = 0;
constexpr size_t OFF_WT_EVOUT = OFF_WT_EVIN + (size_t)3840 * 1024 * 2;
constexpr size_t OFF_WT_GU = OFF_WT_EVOUT + (size_t)1024 * 1024 * 2;
constexpr size_t SZ_WT_GU1 = (size_t)5632 * 1024 * 2;
constexpr size_t OFF_WT_DN = OFF_WT_GU + 2 * SZ_WT_GU1;
constexpr size_t SZ_WT_DN1 = (size_t)1024 * 2816 * 2;
constexpr size_t OFF_WT_ODIN = OFF_WT_DN + 2 * SZ_WT_DN1;
constexpr size_t OFF_WT_ODOUT = OFF_WT_ODIN + (size_t)5376 * 1024 * 2;
constexpr size_t OFF_X = OFF_WT_ODOUT + (size_t)1024 * 2048 * 2;
constexpr size_t OFF_HN = OFF_X + (size_t)T_PAD * 1024 * 4;
constexpr size_t OFF_P = OFF_HN + (size_t)T_PAD * 1024 * 2;
constexpr size_t OFF_O = OFF_P + (size_t)T_PAD * 5376 * 2;
constexpr size_t OFF_MIX = OFF_O + (size_t)T_PAD * 2048 * 2;
constexpr size_t OFF_SSQ = OFF_MIX + (size_t)T_PAD * 1024 * 4;
constexpr size_t OFF_BAR = OFF_SSQ + (size_t)T_PAD * 16 * 4;
constexpr size_t OFF_CNT = OFF_BAR + 16384;
constexpr size_t SZ_CNT_SET = 64 * 256;
constexpr size_t OFF_XB = OFF_CNT + 8 * SZ_CNT_SET;
constexpr size_t SZ_XB_SET = (size_t)64 * 256 * 4 * 4;
constexpr size_t WS_END = OFF_XB + 8 * SZ_XB_SET;

constexpr size_t OUT_YP = 0;
constexpr size_t OUT_YS = 16777216;
constexpr size_t OUT_HGP = OUT_YS + 524288;
constexpr size_t OUT_GLP = OUT_HGP + 524288;
constexpr size_t OUT_SSP = OUT_GLP + 262144;
constexpr size_t OUT_CVP = OUT_SSP + 2097152;
constexpr size_t OUT_HGS = OUT_CVP + 73728;
constexpr size_t OUT_GLS = OUT_HGS + 8388608;
constexpr size_t OUT_SSS = OUT_GLS + 4194304;
constexpr size_t OUT_CVS = OUT_SSS + 33554432;

struct Params { const float* in[29]; float* out; char* ws; };

DI unsigned pk2(float lo, float hi) { f32x2 v = {lo, hi}; bf16v2 b = __builtin_convertvector(v, bf16v2); return __builtin_bit_cast(unsigned, b); }
DI float bflo(unsigned u) { return __uint_as_float(u << 16); }
DI float bfhi(unsigned u) { return __uint_as_float(u & 0xffff0000u); }
DI f32x4 ld_bf4(const bf16_t* p) { const u32x2 u = *(const u32x2*)p; return (f32x4){bflo(u[0]), bfhi(u[0]), bflo(u[1]), bfhi(u[1])}; }
DI void st_bf4(bf16_t* p, f32x4 v) { u32x2 u; u[0] = pk2(v.x, v.y); u[1] = pk2(v.z, v.w); *(u32x2*)p = u; }
DI float sigmoidf_(float x) { return __builtin_amdgcn_rcpf(1.f + __expf(-x)); }
DI float siluf_(float x) { return x * sigmoidf_(x); }
DI int crow(int r, int h) { return (r & 3) + 8 * (r >> 2) + 4 * h; }
DI bf16x8 cat8(s16x4 lo, s16x4 hi) { return __builtin_shufflevector(lo, hi, 0, 1, 2, 3, 4, 5, 6, 7); }
template <int S> DI bf16x8 pack8(const f32x16& x) {
  u32x4 p;
  p[0] = pk2(x[8 * S + 0], x[8 * S + 1]); p[1] = pk2(x[8 * S + 2], x[8 * S + 3]);
  p[2] = pk2(x[8 * S + 4], x[8 * S + 5]); p[3] = pk2(x[8 * S + 6], x[8 * S + 7]);
  return __builtin_bit_cast(bf16x8, p);
}
DI float wave_sum(float v) {
#pragma unroll
  for (int o = 1; o < 64; o <<= 1) v += __shfl_xor(v, o);
  return v;
}
DI void zero16(f32x16& a) {
#pragma unroll
  for (int i = 0; i < 16; ++i) a[i] = 0.f;
}

struct TileDesc { const float* W; bf16_t* dst; const float* wup; int K, N, mode, kt, nt; bool active; };
DI void tile_fetch(const TileDesc& d, float (&v)[16]) {
  const int tid = threadIdx.x & (HB - 1), k0 = d.kt * 64, n0 = d.nt * 64;
  const int c = tid & 63, r0 = tid >> 6, nn = min(n0 + c, d.N - 1);
#pragma unroll
  for (int i = 0; i < 16; ++i) v[i] = d.W[(size_t)(k0 + r0 + 4 * i) * d.N + nn];
}
DI void tile_to_lds(const TileDesc& d, const float (&v)[16], float* tile) {
  const int tid = threadIdx.x & (HB - 1), c = tid & 63, r0 = tid >> 6, k0 = d.kt * 64, n0 = d.nt * 64, n = n0 + c;
  if (!d.active) return;
  if (d.wup && n0 >= 3584) {
    float wc[16];
#pragma unroll
    for (int r = 0; r < 16; ++r) wc[r] = d.wup[r * 256 + (n - 3584)];
#pragma unroll
    for (int i = 0; i < 16; ++i) {
      const float* wr_ = d.W + (size_t)(k0 + r0 + 4 * i) * d.N + 3584;
      float a = 0.f;
#pragma unroll
      for (int r = 0; r < 16; ++r) a += wr_[r] * wc[r];
      tile[(r0 + 4 * i) * 65 + c] = a;
    }
  } else {
#pragma unroll
    for (int i = 0; i < 16; ++i) tile[(r0 + 4 * i) * 65 + c] = (n < d.N) ? v[i] : 0.f;
  }
}
DI void tile_store(const TileDesc& d, const float* tile) {
  const int tid = threadIdx.x & (HB - 1), k0 = d.kt * 64, n0 = d.nt * 64;
  if (d.active) {
    const int nl = tid >> 2, kc = (tid & 3) * 16, n = n0 + nl;
    int drow = n;
    if (d.mode == 1) drow = (n >> 7) * 256 + (n & 127);
    if (d.mode == 2) drow = (n >> 7) * 256 + 128 + (n & 127);
    u32x4 o0, o1;
#pragma unroll
    for (int j = 0; j < 4; ++j) {
      o0[j] = pk2(tile[(kc + 2 * j) * 65 + nl], tile[(kc + 2 * j + 1) * 65 + nl]);
      o1[j] = pk2(tile[(kc + 8 + 2 * j) * 65 + nl], tile[(kc + 8 + 2 * j + 1) * 65 + nl]);
    }
    u32x4* dd = (u32x4*)(d.dst + (size_t)drow * d.K + k0 + kc);
    dd[0] = o0; dd[1] = o1;
  }
}

DI void rms_row_to_bf16(const f32x4 (&v)[4], const float* __restrict__ wn, bf16_t* dst, int lane) {
  float s = 0.f;
#pragma unroll
  for (int j = 0; j < 4; ++j) s += v[j].x * v[j].x + v[j].y * v[j].y + v[j].z * v[j].z + v[j].w * v[j].w;
  const float rstd = rsqrtf(wave_sum(s) * (1.f / 1024.f) + 1e-6f);
#pragma unroll
  for (int j = 0; j < 4; ++j) {
    const f32x4 g = *(const f32x4*)(wn + 256 * j + 4 * lane);
    u32x2 o; o[0] = pk2(v[j].x * rstd * g.x, v[j].y * rstd * g.y); o[1] = pk2(v[j].z * rstd * g.z, v[j].w * rstd * g.w);
    *(u32x2*)(dst + 256 * j + 4 * lane) = o;
  }
}

DI void phase_prep(const Params& p, char* lds, int bid, int G) {
  const int half = threadIdx.x >> 8;
  float* tile = (float*)(lds + half * HALF_LDS);
  constexpr int NT_TILES = 960 + 256 + 1408 + 1408 + 1408 + 1344 + 512;
  auto decode = [&](int t) {
    TileDesc d; d.active = t < NT_TILES; d.wup = (d.active && t < 960) ? p.in[13] : nullptr;
    d.W = p.in[12]; d.K = 1024; d.N = 3600; d.mode = 0; d.dst = (bf16_t*)(p.ws + OFF_WT_EVIN);
    int nnt = 60, r = d.active ? t : 0;
    if (r < 960) { }
    else if ((r -= 960) < 256) { d.W = p.in[17]; d.K = 1024; d.N = 1024; nnt = 16; d.dst = (bf16_t*)(p.ws + OFF_WT_EVOUT); }
    else if ((r -= 256) < 1408) { const int l = r / 704; r -= l * 704; d.W = p.in[26] + (size_t)l * 1024 * 2816; d.K = 1024; d.N = 2816; nnt = 44; d.mode = 1; d.dst = (bf16_t*)(p.ws + OFF_WT_GU + l * SZ_WT_GU1); }
    else if ((r -= 1408) < 1408) { const int l = r / 704; r -= l * 704; d.W = p.in[27] + (size_t)l * 1024 * 2816; d.K = 1024; d.N = 2816; nnt = 44; d.mode = 2; d.dst = (bf16_t*)(p.ws + OFF_WT_GU + l * SZ_WT_GU1); }
    else if ((r -= 1408) < 1408) { const int l = r / 704; r -= l * 704; d.W = p.in[28] + (size_t)l * 2816 * 1024; d.K = 2816; d.N = 1024; nnt = 16; d.dst = (bf16_t*)(p.ws + OFF_WT_DN + l * SZ_WT_DN1); }
    else if ((r -= 1408) < 1344) { d.W = p.in[18]; d.K = 1024; d.N = 5152; nnt = 84; d.dst = (bf16_t*)(p.ws + OFF_WT_ODIN); }
    else { r -= 1344; d.W = p.in[25]; d.K = 2048; d.N = 1024; nnt = 16; d.dst = (bf16_t*)(p.ws + OFF_WT_ODOUT); }
    d.kt = r / nnt; d.nt = r - d.kt * nnt;
    return d;
  };
  {
    float v[16];
    TileDesc d = decode(bid * 2 + half);
    tile_fetch(d, v);
    for (int tb = bid * 2; tb < NT_TILES; tb += G * 2) {
      tile_to_lds(d, v, tile);
      __syncthreads();
      const TileDesc dn = decode(tb + G * 2 + half);
      tile_fetch(dn, v);
      tile_store(d, tile);
      __syncthreads();
      d = dn;
    }
  }
  const int lane = threadIdx.x & 63, w = threadIdx.x >> 6;
  bf16_t* X = (bf16_t*)(p.ws + OFF_X);
  bf16_t* HN = (bf16_t*)(p.ws + OFF_HN);
  for (int row = bid * 8 + w; row < T_ALL; row += G * 8) {
    const float* src;
    if (row < T_PROMPT) { const int b = row / SEQP, t = row - b * SEQP; src = (t < 16) ? p.in[6] + (size_t)t * 1024 : p.in[0] + ((size_t)b * 2048 + (t - 16)) * 1024; }
    else src = p.in[1] + (size_t)(row - T_PROMPT) * 1024;
    f32x4 v[4];
#pragma unroll
    for (int j = 0; j < 4; ++j) { v[j] = *(const f32x4*)(src + 256 * j + 4 * lane); st_bf4(X + (size_t)row * 1024 + 256 * j + 4 * lane, v[j]); }
    rms_row_to_bf16(v, p.in[8], HN + (size_t)row * 1024, lane);
  }
}

DI void phase_rowwise(const Params& p, const float* __restrict__ wpost, const float* __restrict__ wpre, bool final_, const float* PART, int nsplit, int row_begin, int bid, int G) {
  const int lane = threadIdx.x & 63, w = threadIdx.x >> 6;
  bf16_t* X = (bf16_t*)(p.ws + OFF_X);
  const bf16_t* MIX = (const bf16_t*)(p.ws + OFF_MIX);
  bf16_t* HN = (bf16_t*)(p.ws + OFF_HN);
  for (int rowa = row_begin + bid * 8 + w; rowa < T_ALL; rowa += G * 16) {
    const int rowb = rowa + G * 8;
    const bool hasb = rowb < T_ALL;
    f32x4 m[2][4], x[2][4];
#pragma unroll
    for (int q = 0; q < 2; ++q) {
      const int row = q ? (hasb ? rowb : rowa) : rowa;
#pragma unroll
      for (int j = 0; j < 4; ++j) {
        if (row < 16384) m[q][j] = ld_bf4(MIX + (size_t)row * 1024 + 256 * j + 4 * lane);
        else {
          f32x4 a = {0.f, 0.f, 0.f, 0.f};
          for (int ks = 0; ks < nsplit; ++ks) a = a + *(const f32x4*)(PART + ((size_t)ks * 768 + (row - 16384)) * 1024 + 256 * j + 4 * lane);
          m[q][j] = a;
        }
        x[q][j] = ld_bf4(X + (size_t)row * 1024 + 256 * j + 4 * lane);
      }
    }
#pragma unroll
    for (int q = 0; q < 2; ++q) {
      if (q == 1 && !hasb) break;
      const int row = q ? rowb : rowa;
      float s = 0.f;
#pragma unroll
      for (int j = 0; j < 4; ++j) s += m[q][j].x * m[q][j].x + m[q][j].y * m[q][j].y + m[q][j].z * m[q][j].z + m[q][j].w * m[q][j].w;
      const float rstd = rsqrtf(wave_sum(s) * (1.f / 1024.f) + 1e-6f);
#pragma unroll
      for (int j = 0; j < 4; ++j) { const f32x4 g = *(const f32x4*)(wpost + 256 * j + 4 * lane); x[q][j] = x[q][j] + m[q][j] * rstd * g; }
      if (!final_) {
#pragma unroll
        for (int j = 0; j < 4; ++j) st_bf4(X + (size_t)row * 1024 + 256 * j + 4 * lane, x[q][j]);
        rms_row_to_bf16(x[q], wpre, HN + (size_t)row * 1024, lane);
      } else {
        float* dst = nullptr;
        if (row < T_PROMPT) { const int b = row / SEQP, t = row - b * SEQP; if (t >= 16) dst = p.out + OUT_YP + ((size_t)b * 2048 + (t - 16)) * 1024; }
        else dst = p.out + OUT_YS + (size_t)(row - T_PROMPT) * 1024;
        if (dst) {
#pragma unroll
          for (int j = 0; j < 4; ++j) *(f32x4*)(dst + 256 * j + 4 * lane) = x[q][j];
        }
      }
    }
  }
}

DI void phase_groupnorm(const Params& p, int bid, int G) {
  const int lane = threadIdx.x & 63, w = threadIdx.x >> 6;
  bf16_t* O = (bf16_t*)(p.ws + OFF_O);
  const float* SSQ = (const float*)(p.ws + OFF_SSQ);
  const float* __restrict__ nw = p.in[24];
  const int g = lane >> 4;
  for (int row = bid * 8 + w; row < T_ALL; row += G * 8) {
    const f32x4 q = *(const f32x4*)(SSQ + (size_t)row * 16 + 4 * g);
    const float rstd = rsqrtf((q.x + q.y + q.z + q.w) * (1.f / 512.f) + 1e-6f);
    bf16_t* o = O + (size_t)row * 2048 + lane * 32;
#pragma unroll
    for (int j = 0; j < 4; ++j) {
      u32x4 v = *(u32x4*)(o + 8 * j);
      const f32x4 w0 = *(const f32x4*)(nw + lane * 32 + 8 * j), w1 = *(const f32x4*)(nw + lane * 32 + 8 * j + 4);
      v[0] = pk2(bflo(v[0]) * rstd * w0.x, bfhi(v[0]) * rstd * w0.y); v[1] = pk2(bflo(v[1]) * rstd * w0.z, bfhi(v[1]) * rstd * w0.w);
      v[2] = pk2(bflo(v[2]) * rstd * w1.x, bfhi(v[2]) * rstd * w1.y); v[3] = pk2(bflo(v[3]) * rstd * w1.z, bfhi(v[3]) * rstd * w1.w);
      *(u32x4*)(o + 8 * j) = v;
    }
  }
}

namespace pg8 {
#define PG8_LAS __attribute__((address_space(3)))
typedef unsigned short bf16_t;
typedef short bf16x8 __attribute__((ext_vector_type(8)));
typedef float f32x4 __attribute__((ext_vector_type(4)));
typedef unsigned u32x4 __attribute__((ext_vector_type(4)));
constexpr int BM = 256, BK = 64, HALF = 128, HTB = HALF * BK * 2  , STAGE_BYTES = 8 * HTB, NXCD = 8, WGM = 8;

__host__ __device__ __forceinline__ int lds_byte(int r, int c) { const int st = (r >> 4) * 2 + (c >> 5), rr = r & 15, cc = c & 31, ob = rr * 64 + cc * 2; return st * 1024 + (ob ^ (((ob >> 9) & 1) << 5)); }
__host__ __device__ __forceinline__ void stage_rc(int b, int& R, int& C) { const int st = b / 1024, sb = b % 1024, swz = sb ^ (((sb >> 9) & 1) << 5); R = (st >> 1) * 16 + swz / 64; C = (st & 1) * 32 + (swz % 64) / 2; }
__host__ __device__ __forceinline__ int perm32(int rho) { const int n = rho >> 4, i = rho & 15; return 8 * (i >> 2) + 4 * n + (i & 3); }

struct Unit { int pm, pn, ks; };
struct Gemm { const bf16_t* A; const bf16_t* Bt; int M, N, K, ld; };

struct StaticOrder {
    int nM, nN, nwg, G, c;
    __host__ __device__ void init(int M, int N, int G_, int c_) { nM = M / BM; nN = N / BM; nwg = nM * nN; G = G_; c = c_; }
    __host__ __device__ bool next(int i, Unit& u) const {
        const long L = (long)i * G + c; if (L >= nwg) return false;
        int wgid = (int)L; { const int q = nwg / NXCD, r = nwg % NXCD, xcd = wgid % NXCD, off = wgid / NXCD; wgid = (xcd < r ? xcd * (q + 1) : r * (q + 1) + (xcd - r) * q) + off; }
        const int nig = WGM * nN, gid = wgid / nig, fm = gid * WGM, gsz = (nM - fm) < WGM ? (nM - fm) : WGM;
        u.pm = fm + ((wgid % nig) % gsz); u.pn = (wgid % nig) / gsz; u.ks = 0; return true;
    }
    __device__ __forceinline__ void a_ready(const Unit&) const {}
    __device__ __forceinline__ void done(const Unit&) const {}
};
__device__ __forceinline__ unsigned cvt_pk_bf16(float lo, float hi) { unsigned r; asm volatile("v_cvt_pk_bf16_f32 %0, %1, %2" : "=v"(r) : "v"(lo), "v"(hi)); return r; }
typedef float f32x2 __attribute__((ext_vector_type(2)));
template <class Epi, class Sched, bool ALIGN_EPI = false, bool SP2 = false>
__device__ __forceinline__ void gemm_phase(PG8_LAS unsigned char* lds, const Gemm g, const Sched& S, const Epi& E) {
    int tid_ = threadIdx.x; asm volatile("" : "+v"(tid_));
    const int tid = tid_, wid = __builtin_amdgcn_readfirstlane(tid >> 6), lane = tid & 63, wr = wid >> 2, wc = wid & 3, fr = lane & 15, fq = lane >> 4;
    const int K = g.ld, nt = g.K / BK;
    unsigned voffA[2], voffB[2];
#pragma unroll
    for (int i = 0; i < 2; ++i) { int R, C; stage_rc(tid * 16 + i * 8192, R, C); const int Rb = Epi::PERM ? ((R & ~31) + perm32(R & 31)) : R;
        voffA[i] = (unsigned)(R * K + C) * 2u; voffB[i] = (unsigned)(Rb * K + C) * 2u; }
    const size_t kstep = (size_t)(BK * 2);
    const size_t hstep = (size_t)HALF * K * 2;
    const size_t tstep = 2 * hstep;
    const unsigned ldsw = (unsigned)wid * 1024u;
    const int aoff = lds_byte(wr * 64 + fr, fq * 8), boff = lds_byte(wc * 32 + fr, fq * 8);
#define PG8_SA(b, h) (((b) * 2 + (h)) * HTB)
#define PG8_SB(b, h) ((4 + (b) * 2 + (h)) * HTB)
#define PG8_STAGE(bufoff, gbase, voff) do { _Pragma("unroll") for (int _i = 0; _i < 2; ++_i) \
        __builtin_amdgcn_global_load_lds((const unsigned*)((const char*)(gbase) + (voff)[_i]), (PG8_LAS unsigned*)(lds + (bufoff) + ldsw + _i * 8192), 16, 0, 0); } while (0)
#define PG8_LDA(dst, b, h) do { _Pragma("unroll") for (int m = 0; m < 4; ++m) _Pragma("unroll") for (int k = 0; k < 2; ++k) dst[m][k] = *(const PG8_LAS bf16x8*)(lds + PG8_SA(b, h) + aoff + m * 2048 + k * 1024); } while (0)
#define PG8_LDB(dst, b, h) do { _Pragma("unroll") for (int n = 0; n < 2; ++n) _Pragma("unroll") for (int k = 0; k < 2; ++k) dst[n][k] = *(const PG8_LAS bf16x8*)(lds + PG8_SB(b, h) + boff + n * 2048 + k * 1024); } while (0)
#define PG8_MMA(ai, bj, At, Bt) do { __builtin_amdgcn_s_setprio(1); _Pragma("unroll") for (int m = 0; m < 4; ++m) _Pragma("unroll") for (int n = 0; n < 2; ++n) _Pragma("unroll") for (int k = 0; k < 2; ++k) \
        acc[ai][bj][m][n] = __builtin_amdgcn_mfma_f32_16x16x32_bf16(Bt[n][k], At[m][k], acc[ai][bj][m][n], 0, 0, 0); __builtin_amdgcn_s_setprio(0); } while (0)
#define PG8_WAIT_V(n) asm volatile("s_waitcnt vmcnt(" #n ")" ::: "memory")
#define PG8_WAIT_L(n) asm volatile("s_waitcnt lgkmcnt(" #n ")" ::: "memory")
#define PG8_BAR __builtin_amdgcn_s_barrier()
#define PG8_SCHED __builtin_amdgcn_sched_barrier(0)
    Unit cur, nxt; int ui = 0;
    if (!S.next(0, cur)) return;
    f32x4 acc[2][2][4][2];
#pragma unroll
    for (int a = 0; a < 2; ++a)
#pragma unroll
        for (int b = 0; b < 2; ++b)
#pragma unroll
            for (int m = 0; m < 4; ++m)
#pragma unroll
                for (int n = 0; n < 2; ++n) acc[a][b][m][n] = (f32x4){0.f, 0.f, 0.f, 0.f};
    bf16x8 At[4][2], B0[2][2], B1[2][2];
    const char* cA = (const char*)g.A + (size_t)cur.pm * tstep + (size_t)cur.ks * g.K * 2; const char* cB = (const char*)g.Bt + (size_t)cur.pn * tstep + (size_t)cur.ks * g.K * 2;
    S.a_ready(cur);
    if constexpr (SP2) {
        PG8_STAGE(PG8_SB(0, 0), cB, voffB); PG8_STAGE(PG8_SB(0, 1), cB + hstep, voffB); PG8_STAGE(PG8_SA(0, 0), cA, voffA); PG8_STAGE(PG8_SA(0, 1), cA + hstep, voffA);
        if (wr == 1) PG8_BAR;
        PG8_WAIT_V(2); PG8_BAR;
        PG8_STAGE(PG8_SB(1, 0), cB + kstep, voffB); PG8_STAGE(PG8_SA(1, 0), cA + kstep, voffA); PG8_STAGE(PG8_SB(1, 1), cB + hstep + kstep, voffB);
        PG8_WAIT_V(6); PG8_BAR;
    } else {
        PG8_STAGE(PG8_SB(0, 0), cB, voffB); PG8_STAGE(PG8_SA(0, 0), cA, voffA); PG8_STAGE(PG8_SB(0, 1), cB + hstep, voffB); PG8_STAGE(PG8_SA(0, 1), cA + hstep, voffA);
        if (wr == 1) PG8_BAR;
        PG8_WAIT_V(4); PG8_BAR;
        PG8_STAGE(PG8_SB(1, 0), cB + kstep, voffB); PG8_STAGE(PG8_SA(1, 0), cA + kstep, voffA); PG8_STAGE(PG8_SB(1, 1), cB + hstep + kstep, voffB);
        PG8_WAIT_V(6); PG8_BAR;
    }
    for (;;) {
        const bool has_next = S.next(ui + 1, nxt);
        const char* nA = has_next ? (const char*)g.A + (size_t)nxt.pm * tstep + (size_t)nxt.ks * g.K * 2 : cA; const char* nB = has_next ? (const char*)g.Bt + (size_t)nxt.pn * tstep + (size_t)nxt.ks * g.K * 2 : cB;
        for (int t = 0; t < nt; t += 2) {
            const bool last = (t == nt - 2);
            const char* a1 = cA + (size_t)(t + 1) * kstep;
            const char* a2 = last ? nA : cA + (size_t)(t + 2) * kstep; const char* b2 = last ? nB : cB + (size_t)(t + 2) * kstep;
            const char* a3 = a2 + kstep; const char* b3 = b2 + kstep;
            if (last && has_next) S.a_ready(nxt);
            if constexpr (SP2) {
            PG8_LDB(B0, 0, 0); PG8_LDB(B1, 0, 1); PG8_SCHED; PG8_LDA(At, 0, 0); PG8_STAGE(PG8_SA(1, 1), a1 + hstep, voffA);
            PG8_WAIT_V(8); PG8_WAIT_L(0); PG8_BAR; PG8_MMA(0, 0, At, B0); PG8_MMA(0, 1, At, B1); PG8_BAR; PG8_SCHED;
            PG8_LDA(At, 0, 1); PG8_STAGE(PG8_SB(0, 0), b2, voffB); PG8_STAGE(PG8_SB(0, 1), b2 + hstep, voffB); PG8_STAGE(PG8_SA(0, 0), a2, voffA);
            PG8_WAIT_V(8); PG8_WAIT_L(0); PG8_BAR; PG8_MMA(1, 0, At, B0); PG8_MMA(1, 1, At, B1); PG8_BAR; PG8_SCHED;
            PG8_LDB(B0, 1, 0); PG8_LDB(B1, 1, 1); PG8_SCHED; PG8_LDA(At, 1, 0); PG8_STAGE(PG8_SA(0, 1), a2 + hstep, voffA);
            PG8_WAIT_V(8); PG8_WAIT_L(0); PG8_BAR; PG8_MMA(0, 0, At, B0); PG8_MMA(0, 1, At, B1); PG8_BAR; PG8_SCHED;
            PG8_LDA(At, 1, 1); PG8_STAGE(PG8_SB(1, 0), b3, voffB); PG8_STAGE(PG8_SB(1, 1), b3 + hstep, voffB); PG8_STAGE(PG8_SA(1, 0), a3, voffA);
            PG8_WAIT_V(8); PG8_WAIT_L(0); PG8_BAR; PG8_MMA(1, 0, At, B0); PG8_MMA(1, 1, At, B1); PG8_BAR; PG8_SCHED;
            } else {
            PG8_LDB(B0, 0, 0); PG8_SCHED; PG8_LDA(At, 0, 0); PG8_STAGE(PG8_SA(1, 1), a1 + hstep, voffA);
            PG8_WAIT_L(8); PG8_BAR; PG8_WAIT_L(0); PG8_MMA(0, 0, At, B0); PG8_BAR; PG8_SCHED;
            PG8_LDB(B1, 0, 1); PG8_STAGE(PG8_SB(0, 0), b2, voffB);
            PG8_BAR; PG8_WAIT_L(0); PG8_MMA(0, 1, At, B1); PG8_BAR;
            PG8_LDA(At, 0, 1); PG8_STAGE(PG8_SA(0, 0), a2, voffA);
            PG8_BAR; PG8_WAIT_L(0); PG8_MMA(1, 0, At, B0); PG8_BAR; PG8_SCHED;
            PG8_STAGE(PG8_SB(0, 1), b2 + hstep, voffB);
            PG8_WAIT_V(6); PG8_BAR; PG8_MMA(1, 1, At, B1); PG8_BAR;
            PG8_LDB(B0, 1, 0); PG8_SCHED; PG8_LDA(At, 1, 0); PG8_STAGE(PG8_SA(0, 1), a2 + hstep, voffA);
            PG8_WAIT_L(8); PG8_BAR; PG8_WAIT_L(0); PG8_MMA(0, 0, At, B0); PG8_BAR; PG8_SCHED;
            PG8_LDB(B1, 1, 1); PG8_STAGE(PG8_SB(1, 0), b3, voffB);
            PG8_BAR; PG8_WAIT_L(0); PG8_MMA(0, 1, At, B1); PG8_BAR;
            PG8_LDA(At, 1, 1); PG8_STAGE(PG8_SA(1, 0), a3, voffA);
            PG8_BAR; PG8_WAIT_L(0); PG8_MMA(1, 0, At, B0); PG8_BAR; PG8_SCHED;
            PG8_STAGE(PG8_SB(1, 1), b3 + hstep, voffB);
            PG8_WAIT_V(6); PG8_BAR; PG8_MMA(1, 1, At, B1); PG8_BAR;
            }
        }
        if constexpr (ALIGN_EPI) { if (wr == 0) PG8_BAR; }
        if constexpr (!Epi::AFTER_DRAIN) { E(acc, cur, wr, wc, fr, fq); S.done(cur); }
        if (!has_next) break;
#pragma unroll
        for (int a = 0; a < 2; ++a)
#pragma unroll
            for (int b = 0; b < 2; ++b)
#pragma unroll
                for (int m = 0; m < 4; ++m)
#pragma unroll
                    for (int n = 0; n < 2; ++n) acc[a][b][m][n] = (f32x4){0.f, 0.f, 0.f, 0.f};
        cur = nxt; cA = nA; cB = nB; ++ui;
        if constexpr (ALIGN_EPI) { if (wr == 1) PG8_BAR; }
    }
    PG8_WAIT_V(0);
    if constexpr (!ALIGN_EPI) { if (wr == 0) PG8_BAR; }
    PG8_BAR;
    if constexpr (Epi::AFTER_DRAIN) { E.fused(acc, cur, wr, wc, fr, fq, lds, wid, lane); S.done(cur); }
#undef PG8_SA
#undef PG8_SB
#undef PG8_STAGE
#undef PG8_LDA
#undef PG8_LDB
#undef PG8_MMA
#undef PG8_WAIT_V
#undef PG8_WAIT_L
#undef PG8_BAR
#undef PG8_SCHED
}
}

struct EpiStoreBf16 {
  static constexpr bool PERM = true, AFTER_DRAIN = false;
  bf16_t* C; int ldc; unsigned silu_units, sigm_units;
  DI void operator()(const pg8::f32x4 (&acc)[2][2][4][2], const pg8::Unit& u, int wr, int wc, int fr, int fq) const {
    const int row0 = u.pm * 256 + wr * 64 + fr, col0 = u.pn * 256 + wc * 32 + 8 * fq;
    const bool gate = (silu_units >> u.pn) & 1u, sigm = (sigm_units >> u.pn) & 1u;
#pragma unroll
    for (int ai = 0; ai < 2; ++ai)
#pragma unroll
      for (int m = 0; m < 4; ++m) {
        bf16_t* rowp = C + (size_t)(row0 + ai * 128 + m * 16) * ldc + col0;
#pragma unroll
        for (int bj = 0; bj < 2; ++bj) {
          pg8::f32x4 v0 = acc[ai][bj][m][0], v1 = acc[ai][bj][m][1];
          if (gate) {
#pragma unroll
            for (int e = 0; e < 4; ++e) { v0[e] = siluf_(v0[e]); v1[e] = siluf_(v1[e]); }
          } else if (sigm) {
#pragma unroll
            for (int e = 0; e < 4; ++e) {
              { const float x = v0[e], ex = __expf(-fabsf(x)), mm = ex * __builtin_amdgcn_rcpf(1.f + ex); v0[e] = x < 0.f ? mm : -mm; }
              { const float x = v1[e], ex = __expf(-fabsf(x)), mm = ex * __builtin_amdgcn_rcpf(1.f + ex); v1[e] = x < 0.f ? mm : -mm; }
            }
          }
          u32x4 w_; w_[0] = pk2(v0[0], v0[1]); w_[1] = pk2(v0[2], v0[3]); w_[2] = pk2(v1[0], v1[1]); w_[3] = pk2(v1[2], v1[3]);
          *(u32x4*)(rowp + bj * 128) = w_;
        }
      }
  }
};
struct EpiStoreF32 {
  static constexpr bool PERM = false, AFTER_DRAIN = false;
  float* C0; int ldc; size_t ks_stride;
  DI void operator()(const pg8::f32x4 (&acc)[2][2][4][2], const pg8::Unit& u, int wr, int wc, int fr, int fq) const {
    float* C = C0 + (size_t)u.ks * ks_stride;
    const int row0 = u.pm * 256 + wr * 64 + fr, col0 = u.pn * 256 + wc * 32 + 4 * fq;
#pragma unroll
    for (int ai = 0; ai < 2; ++ai)
#pragma unroll
      for (int m = 0; m < 4; ++m) {
        float* rowp = C + (size_t)(row0 + ai * 128 + m * 16) * ldc + col0;
#pragma unroll
        for (int bj = 0; bj < 2; ++bj)
#pragma unroll
          for (int n = 0; n < 2; ++n) *(pg8::f32x4*)(rowp + bj * 128 + n * 16) = acc[ai][bj][m][n];
      }
  }
};
struct EpiSwiglu {
  static constexpr bool PERM = true, AFTER_DRAIN = false;
  bf16_t* C; int ldc;
  DI void operator()(const pg8::f32x4 (&acc)[2][2][4][2], const pg8::Unit& u, int wr, int wc, int fr, int fq) const {
    const int row0 = u.pm * 256 + wr * 64 + fr, col0 = u.pn * 128 + wc * 32 + 8 * fq;
#pragma unroll
    for (int ai = 0; ai < 2; ++ai)
#pragma unroll
      for (int m = 0; m < 4; ++m) {
        float y[8];
#pragma unroll
        for (int n = 0; n < 2; ++n)
#pragma unroll
          for (int e = 0; e < 4; ++e) y[4 * n + e] = siluf_(acc[ai][0][m][n][e]) * acc[ai][1][m][n][e];
        u32x4 w_; w_[0] = pk2(y[0], y[1]); w_[1] = pk2(y[2], y[3]); w_[2] = pk2(y[4], y[5]); w_[3] = pk2(y[6], y[7]);
        *(u32x4*)(C + (size_t)(row0 + ai * 128 + m * 16) * ldc + col0) = w_;
      }
  }
};

struct RowSumExchange {
  float* xbuf; unsigned* cnt; unsigned* tmo;
  DI void run(const float (&part)[2][4], const pg8::Unit& u, int wr, int wc, int fr, int fq, char* lds, float* S, int wid, int lane) const {
    float* P = (float*)lds;
    if (fq == 0) {
#pragma unroll
      for (int ai = 0; ai < 2; ++ai)
#pragma unroll
        for (int m = 0; m < 4; ++m) P[(ai * 128 + wr * 64 + m * 16 + fr) * 4 + wc] = part[ai][m];
    }
    __syncthreads();
    const int row = wid * 32 + (lane & 31);
    if (lane < 32) {
      const f32x4 a = *(const f32x4*)(P + row * 4);
      __hip_atomic_store(xbuf + ((size_t)u.pm * 256 + row) * 4 + u.pn, (a.x + a.y) + (a.z + a.w), __ATOMIC_RELAXED, __HIP_MEMORY_SCOPE_AGENT);
    }
    asm volatile("s_waitcnt vmcnt(0)" ::: "memory");
    if (lane == 0) __hip_atomic_fetch_add(cnt + 64 * u.pm, 1u, __ATOMIC_RELAXED, __HIP_MEMORY_SCOPE_AGENT);
    if (wid == 0) {
      unsigned it = 0;
      while ((unsigned)__builtin_amdgcn_readfirstlane(__hip_atomic_load(cnt + 64 * u.pm, __ATOMIC_RELAXED, __HIP_MEMORY_SCOPE_AGENT)) < 32u) {
        __builtin_amdgcn_s_sleep(2);
        if (++it > (1u << 21)) { if (lane == 0) __hip_atomic_store(tmo, 1u, __ATOMIC_RELAXED, __HIP_MEMORY_SCOPE_AGENT); break; }
      }
      __builtin_amdgcn_fence(__ATOMIC_ACQUIRE, "agent");
    }
    asm volatile("s_waitcnt vmcnt(0) lgkmcnt(0)" ::: "memory");
    __syncthreads();
    if (lane < 32) {
      const float* slot = xbuf + ((size_t)u.pm * 256 + row) * 4;
      float t = 0.f;
#pragma unroll
      for (int k = 0; k < 4; ++k) t += __hip_atomic_load(slot + k, __ATOMIC_RELAXED, __HIP_MEMORY_SCOPE_AGENT);
      S[row] = t;
    }
    __syncthreads();
  }
};
template <bool FINAL>
struct EpiResNorm {
  static constexpr bool PERM = true, AFTER_DRAIN = true;
  bf16_t* X; bf16_t* HN; const float* wpost; const float* wpre; float* yout;
  float* xbuf; unsigned* cnt; unsigned* tmo;
  DI void operator()(const pg8::f32x4 (&)[2][2][4][2], const pg8::Unit&, int, int, int, int) const {}
  DI static void ssq_rows(const pg8::f32x4 (&acc)[2][2][4][2], float (&part)[2][4]) {
#pragma unroll
    for (int ai = 0; ai < 2; ++ai)
#pragma unroll
      for (int m = 0; m < 4; ++m) {
        float q = 0.f;
#pragma unroll
        for (int bj = 0; bj < 2; ++bj)
#pragma unroll
          for (int n = 0; n < 2; ++n) { const pg8::f32x4 v = acc[ai][bj][m][n]; q += (v[0] * v[0] + v[1] * v[1]) + (v[2] * v[2] + v[3] * v[3]); }
        q += __shfl_xor(q, 16); q += __shfl_xor(q, 32);
        part[ai][m] = q;
      }
  }
  DI void fused(pg8::f32x4 (&acc)[2][2][4][2], const pg8::Unit& u, int wr, int wc, int fr, int fq, PG8_LAS unsigned char* ldsl, int wid, int lane) const {
    char* lds = (char*)ldsl;
    float* S1 = (float*)(lds + 4096);
    float* S2 = (float*)(lds + 5120);
    float part[2][4];
    ssq_rows(acc, part);
    RowSumExchange{xbuf, cnt, tmo}.run(part, u, wr, wc, fr, fq, lds, S1, wid, lane);
#pragma unroll
    for (int ai = 0; ai < 2; ++ai)
#pragma unroll
      for (int m = 0; m < 4; ++m) {
        if (m == 0) __builtin_amdgcn_sched_barrier(0);
        const int rl = ai * 128 + wr * 64 + m * 16 + fr;
        const float r1 = rsqrtf(S1[rl] * (1.f / 1024.f) + 1e-6f);
        const bf16_t* xrow = X + (size_t)(u.pm * 256 + rl) * 1024;
#pragma unroll
        for (int bj = 0; bj < 2; ++bj) {
          const int c8 = u.pn * 256 + bj * 128 + wc * 32 + 8 * fq;
          const u32x4 xr = *(const u32x4*)(xrow + c8);
          const f32x4 g0 = *(const f32x4*)(wpost + c8), g1 = *(const f32x4*)(wpost + c8 + 4);
          const f32x4 x0 = {bflo(xr[0]), bfhi(xr[0]), bflo(xr[1]), bfhi(xr[1])}, x1 = {bflo(xr[2]), bfhi(xr[2]), bflo(xr[3]), bfhi(xr[3])};
          acc[ai][bj][m][0] = x0 + acc[ai][bj][m][0] * r1 * g0;
          acc[ai][bj][m][1] = x1 + acc[ai][bj][m][1] * r1 * g1;
        }
      }
    if (FINAL) {
#pragma unroll
      for (int ai = 0; ai < 2; ++ai)
#pragma unroll
        for (int m = 0; m < 4; ++m) {
          if (m == 0) __builtin_amdgcn_sched_barrier(0);
          const int row = u.pm * 256 + ai * 128 + wr * 64 + m * 16 + fr;
          const int b = row / SEQP, t = row - b * SEQP;
          if (t >= 16) {
            float* dst = yout + ((size_t)b * 2048 + (t - 16)) * 1024;
#pragma unroll
            for (int bj = 0; bj < 2; ++bj)
#pragma unroll
              for (int n = 0; n < 2; ++n) *(f32x4*)(dst + u.pn * 256 + bj * 128 + wc * 32 + 8 * fq + 4 * n) = acc[ai][bj][m][n];
          }
        }
      return;
    }
    ssq_rows(acc, part);
    RowSumExchange{xbuf + SZ_XB_SET / 4, cnt + SZ_CNT_SET / 4, tmo}.run(part, u, wr, wc, fr, fq, lds, S2, wid, lane);
#pragma unroll
    for (int ai = 0; ai < 2; ++ai)
#pragma unroll
      for (int m = 0; m < 4; ++m) {
        if (m == 0) __builtin_amdgcn_sched_barrier(0);
        const int rl = ai * 128 + wr * 64 + m * 16 + fr;
        const float r2 = rsqrtf(S2[rl] * (1.f / 1024.f) + 1e-6f);
        bf16_t* xrow = X + (size_t)(u.pm * 256 + rl) * 1024;
        bf16_t* hrow = HN + (size_t)(u.pm * 256 + rl) * 1024;
#pragma unroll
        for (int bj = 0; bj < 2; ++bj) {
          const int c8 = u.pn * 256 + bj * 128 + wc * 32 + 8 * fq;
          const f32x4 g0 = *(const f32x4*)(wpre + c8), g1 = *(const f32x4*)(wpre + c8 + 4);
          const pg8::f32x4 v0 = acc[ai][bj][m][0], v1 = acc[ai][bj][m][1];
          u32x4 xo, ho;
          xo[0] = pk2(v0[0], v0[1]); xo[1] = pk2(v0[2], v0[3]); xo[2] = pk2(v1[0], v1[1]); xo[3] = pk2(v1[2], v1[3]);
          const pg8::f32x4 h0 = v0 * r2 * g0, h1 = v1 * r2 * g1;
          ho[0] = pk2(h0[0], h0[1]); ho[1] = pk2(h0[2], h0[3]); ho[2] = pk2(h1[0], h1[1]); ho[3] = pk2(h1[2], h1[3]);
          *(u32x4*)(xrow + c8) = xo;
          *(u32x4*)(hrow + c8) = ho;
        }
      }
  }
};
template <class Epi>
DI void gemm_run(char* lds, const bf16_t* A, const bf16_t* Bt, int N, int K, const Epi& E, int vcu, int G) {
  pg8::Gemm g{A, Bt, T_PAD, N, K, K};
  pg8::StaticOrder S; S.init(T_PAD, N, G, vcu);
  pg8::gemm_phase<Epi, pg8::StaticOrder, true, true>((PG8_LAS unsigned char*)lds, g, S, E);
}
struct SplitOrder {
  int nsplit, nitems, G, c;
  DI bool next(int i, pg8::Unit& u) const {
    const int L = i * G + c; if (L >= nitems) return false;
    const int q = L / nsplit; u.ks = L - q * nsplit; u.pm = q >> 2; u.pn = q & 3; return true;
  }
  DI void a_ready(const pg8::Unit&) const {}
  DI void done(const pg8::Unit&) const {}
};
DI void gemm_n1024_plain(char* lds, const bf16_t* A, const bf16_t* Bt, int K, float* MIXp, float* PART, int vcu, int G) {
  {
    pg8::Gemm g{A, Bt, M_MAIN, 1024, K, K};
    pg8::StaticOrder S; S.init(M_MAIN, 1024, G, vcu);
    pg8::gemm_phase<EpiStoreBf16, pg8::StaticOrder, true, true>((PG8_LAS unsigned char*)lds, g, S, EpiStoreBf16{(bf16_t*)MIXp, 1024, 0u, 0u});
  }
  {
    const int nsplit = K >> 8;
    pg8::Gemm g{A + (size_t)M_MAIN * K, Bt, 768, 1024, 256, K};
    SplitOrder S{nsplit, 12 * nsplit, G, (vcu + 128) % G};
    pg8::gemm_phase<EpiStoreF32, SplitOrder, true, true>((PG8_LAS unsigned char*)lds, g, S, EpiStoreF32{PART, 1024, (size_t)768 * 1024});
  }
}
template <bool FINAL>
DI void gemm_n1024(char* lds, const bf16_t* A, const bf16_t* Bt, int K, const EpiResNorm<FINAL>& E, float* PART, int vcu, int G) {
  {
    pg8::Gemm g{A, Bt, M_MAIN, 1024, K, K};
    pg8::StaticOrder S; S.init(M_MAIN, 1024, G, vcu);
    pg8::gemm_phase<EpiResNorm<FINAL>, pg8::StaticOrder, false, true>((PG8_LAS unsigned char*)lds, g, S, E);
  }
  __syncthreads();
  {
    const int nsplit = K >> 8;
    pg8::Gemm g{A + (size_t)M_MAIN * K, Bt, 768, 1024, 256, K};
    SplitOrder S{nsplit, 12 * nsplit, G, (vcu + 128) % G};
    pg8::gemm_phase<EpiStoreF32, SplitOrder, true, true>((PG8_LAS unsigned char*)lds, g, S, EpiStoreF32{PART, 1024, (size_t)768 * 1024});
  }
}

constexpr int L_QE = 0, L_KE = 8704, L_QI = 17408, L_G = 26112, L_KENDT = 34816, L_VT = 45056, L_DEC = 55296, L_TOT = 55808, L_SSQ = 57856;
constexpr int RS = 272, TS = 80;

template <int DK>
DI void pc_core(char* lds, f32x16 (&S)[DK / 32], f32x16& o, const int w, const int r32, const int h) {
  const char* QE = lds + L_QE + r32 * RS;
  const char* KE = lds + L_KE + r32 * RS;
  const char* QI = lds + L_QI + r32 * RS;
  f32x16 sc; zero16(sc);
#pragma unroll
  for (int s = 0; s < DK / 16; ++s) {
    const bf16x8 a = *(const bf16x8*)(KE + s * 32 + h * 16);
    const bf16x8 b = *(const bf16x8*)(QE + s * 32 + h * 16);
    sc = MFMA32(a, b, sc);
  }
#pragma unroll
  for (int r = 0; r < 16; ++r) if (crow(r, h) > r32) sc[r] = 0.f;
  const bf16x8 scb0 = pack8<0>(sc), scb1 = pack8<1>(sc);
  zero16(o);
#pragma unroll
  for (int kt = 0; kt < DK / 32; ++kt) {
    {
      const bf16x8 a = pack8<0>(S[kt]);
      const s16x4 lo = *(const s16x4*)(QI + (32 * kt + 4 * h) * 2), hi = *(const s16x4*)(QI + (32 * kt + 8 + 4 * h) * 2);
      o = MFMA32(a, cat8(lo, hi), o);
    }
    {
      const bf16x8 a = pack8<1>(S[kt]);
      const s16x4 lo = *(const s16x4*)(QI + (32 * kt + 16 + 4 * h) * 2), hi = *(const s16x4*)(QI + (32 * kt + 24 + 4 * h) * 2);
      o = MFMA32(a, cat8(lo, hi), o);
    }
  }
  const char* VTr = lds + L_VT + (32 * w + r32) * TS;
  {
    const s16x4 lo = *(const s16x4*)(VTr + (4 * h) * 2), hi = *(const s16x4*)(VTr + (8 + 4 * h) * 2);
    o = MFMA32(cat8(lo, hi), scb0, o);
  }
  {
    const s16x4 lo = *(const s16x4*)(VTr + (16 + 4 * h) * 2), hi = *(const s16x4*)(VTr + (24 + 4 * h) * 2);
    o = MFMA32(cat8(lo, hi), scb1, o);
  }
  const float* DEC = (const float*)(lds + L_DEC);
#pragma unroll
  for (int kt = 0; kt < DK / 32; ++kt)
#pragma unroll
    for (int g = 0; g < 4; ++g) {
      const f32x4 d = *(const f32x4*)(DEC + 32 * kt + 8 * g + 4 * h);
      S[kt][4 * g] *= d.x; S[kt][4 * g + 1] *= d.y; S[kt][4 * g + 2] *= d.z; S[kt][4 * g + 3] *= d.w;
    }
#pragma unroll
  for (int s = 0; s < 2; ++s) {
    const bf16x8 b = *(const bf16x8*)(VTr + s * 32 + h * 16);
#pragma unroll
    for (int kt = 0; kt < DK / 32; ++kt) {
      const bf16x8 a = *(const bf16x8*)(lds + L_KENDT + (32 * kt + r32) * TS + s * 32 + h * 16);
      S[kt] = MFMA32(a, b, S[kt]);
    }
  }
}

constexpr int NSC = 8;
DI int sc_beg(int sc) { return sc == 0 ? 0 : 16 + 256 * sc; }
DI int sc_end(int sc) { return 16 + 256 * (sc + 1); }
constexpr size_t SCR_HG_U = 0;
constexpr size_t SCR_GL_U = SCR_HG_U + (size_t)8 * 4 * 7 * 16384;
constexpr size_t SCR_HG_D = SCR_GL_U + (size_t)8 * 4 * 7 * 8192;
constexpr size_t SCR_GL_D = SCR_HG_D + (size_t)8 * 4 * 7 * 128;
constexpr size_t SCR_SS_U = 0;
constexpr size_t SCR_SS_D = SCR_SS_U + (size_t)8 * 32 * 7 * 8192;

template <int TYPE, bool SO>
DI void scan_even_job(const Params& p, char* lds, const int head, const int row0, const int ntok, const float* s_in, float* s_out, float* d_out) {
  constexpr int DK = TYPE == 0 ? 128 : 64;
  constexpr int KC = DK / 64;
  const int tid = threadIdx.x & (HB - 1), c = tid & 63, w = tid >> 6, r32 = c & 31, h = c >> 5;
  const bf16_t* P = (const bf16_t*)(p.ws + OFF_P);
  bf16_t* O = (bf16_t*)(p.ws + OFF_O);
  float* TOT = (float*)(lds + L_TOT);
  float* SSQ = (float*)(lds + L_SSQ);
  float* DEC = (float*)(lds + L_DEC);
  const int qcol = TYPE == 0 ? head * 128 : 2048 + head * 64;
  const int kcol = TYPE == 0 ? 512 + head * 128 : 2304 + head * 64;
  const int vcol = TYPE == 0 ? 1024 + head * 128 : 2560 + head * 128;
  const int gcol = TYPE == 0 ? 1536 + head * 128 : 3072 + head * 128;
  const int ocol = TYPE == 0 ? head * 128 : 512 + head * 128;
  float lb[2] = {0.f, 0.f}, wup[16], bal = 0.f;
  if (TYPE == 0) {
#pragma unroll
    for (int e = 0; e < 2; ++e) {
      const float g0 = p.in[7][head * 128 + 2 * c + e], g1 = p.in[7][512 + head * 128 + 2 * c + e], g2 = p.in[7][1024 + head * 128 + 2 * c + e];
      const float m = fmaxf(g0, fmaxf(g1, g2));
      const float e0 = __expf(g0 - m), e1 = __expf(g1 - m), e2 = __expf(g2 - m);
      lb[e] = e0 / (e0 + e1 + e2);
    }
  } else {
#pragma unroll
    for (int r = 0; r < 16; ++r) wup[r] = 0.f;
    bal = p.in[14][head * 64 + c];
  }
  const float* __restrict__ nwp = TYPE == 0 ? p.in[15] : p.in[16];
  f32x16 S[DK / 32];
#pragma unroll
  for (int kt = 0; kt < DK / 32; ++kt)
#pragma unroll
    for (int r = 0; r < 16; ++r) S[kt][r] = (!SO && s_in) ? s_in[(size_t)(32 * kt + crow(r, h)) * 128 + 32 * w + r32] : 0.f;
  float dsum[KC];
#pragma unroll
  for (int e = 0; e < KC; ++e) dsum[e] = 0.f;

  unsigned rq[8], rk[8], rv[8], rg[8]; float ral[8];
  auto load_raw = [&](int ch) {
#pragma unroll
    for (int i = 0; i < 8; ++i) {
      const int t = min(ch * 32 + 8 * w + i, ntok - 1);
      const bf16_t* pr = P + (size_t)(row0 + t) * LD_EV;
      if (TYPE == 0) {
        if (!SO) rq[i] = *(const unsigned*)(pr + qcol + 2 * c);
        rk[i] = *(const unsigned*)(pr + kcol + 2 * c);
      } else {
        if (!SO) rq[i] = (unsigned)pr[qcol + c];
        rk[i] = (unsigned)pr[kcol + c];
        ral[i] = bflo((unsigned)pr[3584 + head * 64 + c]);
      }
      rv[i] = *(const unsigned*)(pr + vcol + 2 * c);
      if (!SO) rg[i] = *(const unsigned*)(pr + gcol + 2 * c);
    }
  };
  const int nch = __builtin_amdgcn_readfirstlane((ntok + 31) >> 5);
  load_raw(0);
  for (int ch = 0; ch < nch; ++ch) {
    const int t0 = ch * 32;
    float kk[8][KC], cum[8][KC], run[KC];
#pragma unroll
    for (int e = 0; e < KC; ++e) run[e] = 0.f;
#pragma unroll
    for (int i = 0; i < 8; ++i) {
      const float vm = (t0 + 8 * w + i) < ntok ? 1.f : 0.f;
      if (TYPE == 0) {
#pragma unroll
        for (int e = 0; e < 2; ++e) {
          const float ts = e ? bfhi(rk[i]) : bflo(rk[i]);
          const float mm = fabsf(ts);
          const float km = (__float_as_uint(ts) >> 31) ? mm : 1.f - mm;
          const float k1 = (1.f - lb[e]) * km;
          const float f = 1.f - k1;
          kk[i][e] = vm * k1;
          run[e] += vm * __logf(f); cum[i][e] = run[e];
        }
      } else {
        const float x = bal + ral[i];
        const float ls = fminf(x, 0.f) - __logf(1.f + __expf(-fabsf(x)));
        kk[i][0] = vm * bflo(rk[i]);
        run[0] += vm * ls * (1.f / 16.f); cum[i][0] = run[0];
      }
    }
#pragma unroll
    for (int e = 0; e < KC; ++e) TOT[w * 128 + KC * c + e] = run[e];
    __syncthreads();
    float off[KC], mid[KC], tot[KC];
#pragma unroll
    for (int e = 0; e < KC; ++e) {
      const float t0_ = TOT[KC * c + e], t1_ = TOT[128 + KC * c + e], t2_ = TOT[256 + KC * c + e], t3_ = TOT[384 + KC * c + e];
      mid[e] = t0_ + t1_; tot[e] = (t0_ + t1_) + (t2_ + t3_);
      off[e] = w == 0 ? 0.f : (w == 1 ? t0_ : (w == 2 ? t0_ + t1_ : t0_ + t1_ + t2_));
      dsum[e] += tot[e];
    }
    {
      u32x4 kp[KC];
#pragma unroll
      for (int m = 0; m < 4; ++m) {
        float kend[2][KC];
#pragma unroll
        for (int i2 = 0; i2 < 2; ++i2) {
          const int i = 2 * m + i2;
          const int ti = 8 * w + i;
          float qe[KC], ke[KC], qi[KC];
#pragma unroll
          for (int e = 0; e < KC; ++e) {
            const float cv = off[e] + cum[i][e];
            kend[i2][e] = kk[i][e] * __expf(tot[e] - cv);
            if (!SO) {
              const float qv = TYPE == 0 ? (e ? bfhi(rq[i]) : bflo(rq[i])) : bflo(rq[i]) * 0.125f;
              qe[e] = qv * __expf(cv - mid[e]);
              ke[e] = kk[i][e] * __expf(mid[e] - cv);
              qi[e] = qv * __expf(cv);
            }
          }
          if (!SO) {
            if (KC == 2) {
              *(unsigned*)(lds + L_QE + ti * RS + 4 * c) = pk2(qe[0], qe[KC - 1]);
              *(unsigned*)(lds + L_KE + ti * RS + 4 * c) = pk2(ke[0], ke[KC - 1]);
              *(unsigned*)(lds + L_QI + ti * RS + 4 * c) = pk2(qi[0], qi[KC - 1]);
            } else {
              *(bf16_t*)(lds + L_QE + ti * RS + 2 * c) = (bf16_t)pk2(qe[0], 0.f);
              *(bf16_t*)(lds + L_KE + ti * RS + 2 * c) = (bf16_t)pk2(ke[0], 0.f);
              *(bf16_t*)(lds + L_QI + ti * RS + 2 * c) = (bf16_t)pk2(qi[0], 0.f);
            }
            *(unsigned*)(lds + L_G + ti * RS + 4 * c) = rg[i];
          }
        }
#pragma unroll
        for (int e = 0; e < KC; ++e) kp[e][m] = pk2(kend[0][e], kend[1][e]);
      }
#pragma unroll
      for (int e = 0; e < KC; ++e) *(u32x4*)(lds + L_KENDT + (KC * c + e) * TS + 16 * w) = kp[e];
      u32x4 v0, v1;
#pragma unroll
      for (int m = 0; m < 4; ++m) {
        v0[m] = (rv[2 * m] & 0xffffu) | (rv[2 * m + 1] << 16);
        v1[m] = (rv[2 * m] >> 16) | (rv[2 * m + 1] & 0xffff0000u);
      }
      *(u32x4*)(lds + L_VT + (2 * c) * TS + 16 * w) = v0;
      *(u32x4*)(lds + L_VT + (2 * c + 1) * TS + 16 * w) = v1;
      if (w == 0) {
#pragma unroll
        for (int e = 0; e < KC; ++e) DEC[KC * c + e] = __expf(tot[e]);
      }
    }
    __syncthreads();
    load_raw(min(ch + 1, nch - 1));
    if (SO) {
      const char* VTr = lds + L_VT + (32 * w + r32) * TS;
#pragma unroll
      for (int kt = 0; kt < DK / 32; ++kt)
#pragma unroll
        for (int g = 0; g < 4; ++g) {
          const f32x4 d = *(const f32x4*)(DEC + 32 * kt + 8 * g + 4 * h);
          S[kt][4 * g] *= d.x; S[kt][4 * g + 1] *= d.y; S[kt][4 * g + 2] *= d.z; S[kt][4 * g + 3] *= d.w;
        }
#pragma unroll
      for (int s = 0; s < 2; ++s) {
        const bf16x8 bq = *(const bf16x8*)(VTr + s * 32 + h * 16);
#pragma unroll
        for (int kt = 0; kt < DK / 32; ++kt) {
          const bf16x8 a = *(const bf16x8*)(lds + L_KENDT + (32 * kt + r32) * TS + s * 32 + h * 16);
          S[kt] = MFMA32(a, bq, S[kt]);
        }
      }
      __syncthreads();
    } else {
      f32x16 o;
      pc_core<DK>(lds, S, o, w, r32, h);
      {
        float ss = 0.f;
#pragma unroll
        for (int r = 0; r < 16; ++r) ss += o[r] * o[r];
        ss += __shfl_xor(ss, 32);
        if (h == 0) SSQ[w * 32 + r32] = ss;
      }
      __syncthreads();
      {
        const float tot2 = (SSQ[r32] + SSQ[32 + r32]) + (SSQ[64 + r32] + SSQ[96 + r32]);
        const float rstd = rsqrtf(tot2 * (1.f / 128.f) + 1e-6f);
        if (t0 + r32 < ntok) {
          bf16_t* orow = O + (size_t)(row0 + t0 + r32) * 1024 + ocol + 32 * w + 4 * h;
#pragma unroll
          for (int g = 0; g < 4; ++g) {
            const u32x2 gp = *(const u32x2*)(lds + L_G + r32 * RS + (32 * w + 8 * g + 4 * h) * 2);
            const f32x4 nw = *(const f32x4*)(nwp + 32 * w + 8 * g + 4 * h);
            const float y0 = o[4 * g] * rstd * nw.x * bflo(gp[0]);
            const float y1 = o[4 * g + 1] * rstd * nw.y * bfhi(gp[0]);
            const float y2 = o[4 * g + 2] * rstd * nw.z * bflo(gp[1]);
            const float y3 = o[4 * g + 3] * rstd * nw.w * bfhi(gp[1]);
            u32x2 v; v[0] = pk2(y0, y1); v[1] = pk2(y2, y3);
            *(u32x2*)(orow + 8 * g) = v;
          }
        }
      }
    }
  }
  if (s_out) {
#pragma unroll
    for (int kt = 0; kt < DK / 32; ++kt)
#pragma unroll
      for (int r = 0; r < 16; ++r) s_out[(size_t)(32 * kt + crow(r, h)) * 128 + 32 * w + r32] = S[kt][r];
  }
  if (SO && w == 0) {
#pragma unroll
    for (int e = 0; e < KC; ++e) d_out[KC * c + e] = dsum[e];
  }
  __syncthreads();
}

DI void phase_scan_even_a(const Params& p, char* lds, int bid, int G) {
  float* scr = (float*)(p.ws + OFF_MIX);
  const int half = threadIdx.x >> 8; lds += half * HALF_LDS;
  for (int jb = bid * 2; jb < 448 + 1024; jb += G * 2) {
    const int j = jb + half;
    if (j < 448) {
      const int type = j & 1, head = (j >> 1) & 3, b = (j >> 3) & 7, sc = j >> 6;
      const int row0 = b * SEQP + sc_beg(sc), ntok = sc_end(sc) - sc_beg(sc);
      const size_t slot = ((size_t)b * 4 + head) * 7 + sc;
      if (type == 0) scan_even_job<0, true>(p, lds, head, row0, ntok, nullptr, scr + SCR_HG_U + slot * 16384, scr + SCR_HG_D + slot * 128);
      else scan_even_job<1, true>(p, lds, head, row0, ntok, nullptr, scr + SCR_GL_U + slot * 8192, scr + SCR_GL_D + slot * 64);
    } else {
      const int jj = j - 448, type = jj & 1, head = (jj >> 1) & 3, b = jj >> 3;
      const int row0 = T_PROMPT + 4 * b;
      if (type == 0) scan_even_job<0, false>(p, lds, head, row0, 4, p.in[2] + ((size_t)b * 4 + head) * 16384, p.out + OUT_HGS + ((size_t)b * 4 + head) * 16384, nullptr);
      else scan_even_job<1, false>(p, lds, head, row0, 4, p.in[3] + ((size_t)b * 4 + head) * 8192, p.out + OUT_GLS + ((size_t)b * 4 + head) * 8192, nullptr);
    }
  }
}
DI void phase_scan_even_c(const Params& p, int bid, int G) {
  float* scr = (float*)(p.ws + OFF_MIX);
  for (int i = bid * NTHREADS + threadIdx.x; i < 32 * 4096 + 32 * 2048; i += G * NTHREADS) {
    const bool gl = i >= 32 * 4096;
    const int ii = gl ? i - 32 * 4096 : i;
    const int per = gl ? 2048 : 4096, bh = ii / per, e4 = ii - bh * per, k = e4 >> 5;
    float* U = scr + (gl ? SCR_GL_U + (size_t)bh * 7 * 8192 : SCR_HG_U + (size_t)bh * 7 * 16384) + 4 * e4;
    const float* D = scr + (gl ? SCR_GL_D + (size_t)bh * 7 * 64 : SCR_HG_D + (size_t)bh * 7 * 128) + k;
    const int ustride = gl ? 8192 : 16384, dstride = gl ? 64 : 128;
    f32x4 run = {0.f, 0.f, 0.f, 0.f};
#pragma unroll
    for (int sc = 0; sc < 7; ++sc) {
      const float d = __expf(D[sc * dstride]);
      const f32x4 u = *(const f32x4*)(U + (size_t)sc * ustride);
      run = run * d + u;
      *(f32x4*)(U + (size_t)sc * ustride) = run;
    }
  }
}
DI void phase_scan_even_b(const Params& p, char* lds, int bid, int G) {
  float* scr = (float*)(p.ws + OFF_MIX);
  const int half = threadIdx.x >> 8; lds += half * HALF_LDS;
  for (int jb = bid * 2; jb < 512; jb += G * 2) {
    const int j = jb + half;
    {
      const int type = j & 1, head = (j >> 1) & 3, b = (j >> 3) & 7, sc = j >> 6;
      const int row0 = b * SEQP + sc_beg(sc), ntok = sc_end(sc) - sc_beg(sc);
      const size_t slot = ((size_t)b * 4 + head) * 7 + sc - 1;
      if (type == 0) scan_even_job<0, false>(p, lds, head, row0, ntok, sc ? scr + SCR_HG_U + slot * 16384 : nullptr,
                                             sc == NSC - 1 ? p.out + OUT_HGP + ((size_t)b * 4 + head) * 16384 : nullptr, nullptr);
      else scan_even_job<1, false>(p, lds, head, row0, ntok, sc ? scr + SCR_GL_U + slot * 8192 : nullptr,
                                   sc == NSC - 1 ? p.out + OUT_GLP + ((size_t)b * 4 + head) * 8192 : nullptr, nullptr);
    }
  }
}

constexpr int M_BM = 0, M_CM = 8704, M_XS = 17408, M_Z = 26112, M_BT = 34816, M_VT = 45056, M_VENDT = 55296, M_CUM = 65536, M_DT = 65792, M_SSQ = 66048, M_CW = 66560;

DI void phase_conv(const Params& p, int bid, int G) {
  const bf16_t* P = (const bf16_t*)(p.ws + OFF_P);
  bf16_t* O = (bf16_t*)(p.ws + OFF_O);
  bf16_t* HN = (bf16_t*)(p.ws + OFF_HN);
  const float* __restrict__ cwp = p.in[19];
  const float* __restrict__ cbp = p.in[20];
  const int gt = bid * NTHREADS + threadIdx.x, NPAR = (G * NTHREADS) / 384;
  const int cg = gt % 384, r0 = gt / 384, ch = 8 * cg;
  if (r0 >= NPAR) return;
  float w[4][8], bs[8];
#pragma unroll
  for (int k = 0; k < 4; ++k) {
    const f32x4 a = *(const f32x4*)(cwp + k * 3072 + ch), b_ = *(const f32x4*)(cwp + k * 3072 + ch + 4);
    w[k][0] = a.x; w[k][1] = a.y; w[k][2] = a.z; w[k][3] = a.w; w[k][4] = b_.x; w[k][5] = b_.y; w[k][6] = b_.z; w[k][7] = b_.w;
  }
  {
    const f32x4 a = *(const f32x4*)(cbp + ch), b_ = *(const f32x4*)(cbp + ch + 4);
    bs[0] = a.x; bs[1] = a.y; bs[2] = a.z; bs[3] = a.w; bs[4] = b_.x; bs[5] = b_.y; bs[6] = b_.z; bs[7] = b_.w;
  }
  bf16_t* dbase = ch < 2048 ? O + ch : HN + (ch - 2048);
  const int dld = ch < 2048 ? 2048 : 1024;
  for (int run = r0; run < 8 * 258; run += NPAR) {
    const int b = run / 258, t0 = (run - b * 258) * 8, row0 = b * SEQP + t0;
    u32x4 pre[11];
#pragma unroll
    for (int i = 0; i < 11; ++i) {
      const int r = row0 + i - 3;
      pre[i] = (i >= 3 || t0 > 0) ? *(const u32x4*)(P + (size_t)r * LD_OD + 2048 + ch) : (u32x4){0u, 0u, 0u, 0u};
    }
#pragma unroll
    for (int i = 0; i < 8; ++i) {
      u32x4 o;
#pragma unroll
      for (int q = 0; q < 4; ++q) {
        float a0 = bs[2 * q], a1 = bs[2 * q + 1];
#pragma unroll
        for (int k = 0; k < 4; ++k) { a0 += bflo(pre[i + k][q]) * w[k][2 * q]; a1 += bfhi(pre[i + k][q]) * w[k][2 * q + 1]; }
        o[q] = pk2(siluf_(a0), siluf_(a1));
      }
      *(u32x4*)(dbase + (size_t)(row0 + i) * dld) = o;
    }
  }
  for (int sq = r0; sq < 128; sq += NPAR) {
    const int row0 = T_PROMPT + 4 * sq;
    float pf[7][8];
#pragma unroll
    for (int i = 0; i < 3; ++i) {
      const f32x4 a = *(const f32x4*)(p.in[5] + ((size_t)sq * 3 + i) * 3072 + ch), b_ = *(const f32x4*)(p.in[5] + ((size_t)sq * 3 + i) * 3072 + ch + 4);
      pf[i][0] = a.x; pf[i][1] = a.y; pf[i][2] = a.z; pf[i][3] = a.w; pf[i][4] = b_.x; pf[i][5] = b_.y; pf[i][6] = b_.z; pf[i][7] = b_.w;
    }
#pragma unroll
    for (int i = 0; i < 4; ++i) {
      const u32x4 u = *(const u32x4*)(P + (size_t)(row0 + i) * LD_OD + 2048 + ch);
#pragma unroll
      for (int q = 0; q < 4; ++q) { pf[3 + i][2 * q] = bflo(u[q]); pf[3 + i][2 * q + 1] = bfhi(u[q]); }
    }
#pragma unroll
    for (int i = 0; i < 4; ++i) {
      u32x4 o;
#pragma unroll
      for (int q = 0; q < 4; ++q) {
        float a0 = bs[2 * q], a1 = bs[2 * q + 1];
#pragma unroll
        for (int k = 0; k < 4; ++k) { a0 += pf[i + k][2 * q] * w[k][2 * q]; a1 += pf[i + k][2 * q + 1] * w[k][2 * q + 1]; }
        o[q] = pk2(siluf_(a0), siluf_(a1));
      }
      *(u32x4*)(dbase + (size_t)(row0 + i) * dld) = o;
    }
  }
}

template <bool SO>
DI void scan_odd_job(const Params& p, char* lds, const int b, const int hp, const bool smp, const int tbeg, const int tend, const float* s_in, float* s_out, float* d_out) {
  const int tid = threadIdx.x & (HB - 1), c = tid & 63, w = tid >> 6, r32 = c & 31, h = c >> 5;
  const int grp = hp >> 2, hl = w >> 1, headw = 2 * hp + hl;
  const int row0 = (smp ? T_PROMPT + 4 * b : b * SEQP) + tbeg, ntok = tend - tbeg;
  const bf16_t* P = (const bf16_t*)(p.ws + OFF_P);
  bf16_t* O = (bf16_t*)(p.ws + OFF_O);
  const bf16_t* BC = (const bf16_t*)(p.ws + OFF_HN);
  float* CUM = (float*)(lds + M_CUM);
  float* DTL = (float*)(lds + M_DT);
  float* SSQ = (float*)(lds + M_SSQ);
  const int hd_l = 2 * hp + h;
  const float dtb = p.in[21][hd_l], aneg = -__expf(p.in[22][hd_l]);
  const float dsk = p.in[23][headw];
  f32x16 S[4];
  {
    const float* sin = s_in + ((size_t)hl * 64 + 32 * (w & 1) + r32) * 128;
#pragma unroll
    for (int kt = 0; kt < 4; ++kt)
#pragma unroll
      for (int g = 0; g < 4; ++g) {
        f32x4 v = {0.f, 0.f, 0.f, 0.f};
        if (!SO && s_in) v = *(const f32x4*)(sin + 32 * kt + 8 * g + 4 * h);
        S[kt][4 * g] = v.x; S[kt][4 * g + 1] = v.y; S[kt][4 * g + 2] = v.z; S[kt][4 * g + 3] = v.w;
      }
  }
  float dsum = 0.f;
  unsigned rx[8], rb[8], rc[8], rz[8]; float rdt;
  auto load_raw = [&](int ch) {
#pragma unroll
    for (int i = 0; i < 8; ++i) {
      const int t = min(ch * 32 + 8 * w + i, ntok - 1);
      rx[i] = *(const unsigned*)(O + (size_t)(row0 + t) * 2048 + hp * 128 + 2 * c);
      rb[i] = *(const unsigned*)(BC + (size_t)(row0 + t) * 1024 + grp * 128 + 2 * c);
      if (!SO) {
        rc[i] = *(const unsigned*)(BC + (size_t)(row0 + t) * 1024 + 512 + grp * 128 + 2 * c);
        rz[i] = *(const unsigned*)(P + (size_t)(row0 + t) * LD_OD + hp * 128 + 2 * c);
      }
    }
    {
      const int t = min(ch * 32 + r32, ntok - 1);
      rdt = bflo((unsigned)P[(size_t)(row0 + t) * LD_OD + 5120 + hd_l]);
    }
  };
  const int nch = __builtin_amdgcn_readfirstlane((ntok + 31) >> 5);
  load_raw(0);
  for (int ch = 0; ch < nch; ++ch) {
    const int t0 = ch * 32;
    {
      const float xdt = rdt + dtb;
      float dt = xdt > 20.f ? xdt : __logf(1.f + __expf(xdt));
      dt = (t0 + r32 < ntok) ? dt : 0.f;
      float cs = dt * aneg;
#pragma unroll
      for (int d = 1; d < 32; d <<= 1) { const float o_ = __shfl_up(cs, d, 32); if (r32 >= d) cs += o_; }
      if (w == 0) { CUM[h * 32 + r32] = cs; DTL[h * 32 + r32] = dt; }
    }
    {
#pragma unroll
      for (int i = 0; i < 8; ++i) {
        if (!SO) {
          *(unsigned*)(lds + M_BM + (8 * w + i) * RS + 4 * c) = rb[i];
          *(unsigned*)(lds + M_CM + (8 * w + i) * RS + 4 * c) = rc[i];
          *(unsigned*)(lds + M_XS + (8 * w + i) * RS + 4 * c) = rx[i];
          *(unsigned*)(lds + M_Z + (8 * w + i) * RS + 4 * c) = rz[i];
        }
      }
      u32x4 b0, b1;
#pragma unroll
      for (int m = 0; m < 4; ++m) {
        b0[m] = (rb[2 * m] & 0xffffu) | (rb[2 * m + 1] << 16);
        b1[m] = (rb[2 * m] >> 16) | (rb[2 * m + 1] & 0xffff0000u);
      }
      *(u32x4*)(lds + M_BT + (2 * c) * TS + 16 * w) = b0;
      *(u32x4*)(lds + M_BT + (2 * c + 1) * TS + 16 * w) = b1;
    }
    __syncthreads();
    {
      const int hx = c >> 5;
      const float last = CUM[hx * 32 + 31];
      float vt[8][2], ve[8][2];
#pragma unroll
      for (int i = 0; i < 8; ++i) {
        const int ti = 8 * w + i;
        const float dt = DTL[hx * 32 + ti], cm = CUM[hx * 32 + ti];
        const float ee = __expf(last - cm);
        vt[i][0] = bflo(rx[i]) * dt; vt[i][1] = bfhi(rx[i]) * dt;
        ve[i][0] = vt[i][0] * ee; ve[i][1] = vt[i][1] * ee;
      }
#pragma unroll
      for (int e = 0; e < 2; ++e) {
        u32x4 pv, pe;
#pragma unroll
        for (int m = 0; m < 4; ++m) { pv[m] = pk2(vt[2 * m][e], vt[2 * m + 1][e]); pe[m] = pk2(ve[2 * m][e], ve[2 * m + 1][e]); }
        if (!SO) *(u32x4*)(lds + M_VT + (2 * c + e) * TS + 16 * w) = pv;
        *(u32x4*)(lds + M_VENDT + (2 * c + e) * TS + 16 * w) = pe;
      }
    }
    __syncthreads();
    load_raw(min(ch + 1, nch - 1));
    f32x16 o;
    const float lastw = CUM[hl * 32 + 31];
    dsum += lastw;
    if (!SO) {
      const char* BMr = lds + M_BM + r32 * RS;
      const char* CMr = lds + M_CM + r32 * RS;
      f32x16 sc; zero16(sc);
#pragma unroll
      for (int s = 0; s < 8; ++s) {
        const bf16x8 a = *(const bf16x8*)(BMr + s * 32 + h * 16);
        const bf16x8 bq = *(const bf16x8*)(CMr + s * 32 + h * 16);
        sc = MFMA32(a, bq, sc);
      }
      const float ci = CUM[hl * 32 + r32];
#pragma unroll
      for (int g = 0; g < 4; ++g) {
        const f32x4 cj = *(const f32x4*)(CUM + hl * 32 + 8 * g + 4 * h);
#pragma unroll
        for (int e = 0; e < 4; ++e) {
          const int j = 8 * g + 4 * h + e;
          const float cje = e == 0 ? cj.x : (e == 1 ? cj.y : (e == 2 ? cj.z : cj.w));
          sc[4 * g + e] = (j <= r32) ? sc[4 * g + e] * __expf(ci - cje) : 0.f;
        }
      }
      const bf16x8 scb0 = pack8<0>(sc), scb1 = pack8<1>(sc);
      zero16(o);
#pragma unroll
      for (int kt = 0; kt < 4; ++kt) {
        {
          const bf16x8 a = pack8<0>(S[kt]);
          const s16x4 lo = *(const s16x4*)(CMr + (32 * kt + 4 * h) * 2), hi = *(const s16x4*)(CMr + (32 * kt + 8 + 4 * h) * 2);
          o = MFMA32(a, cat8(lo, hi), o);
        }
        {
          const bf16x8 a = pack8<1>(S[kt]);
          const s16x4 lo = *(const s16x4*)(CMr + (32 * kt + 16 + 4 * h) * 2), hi = *(const s16x4*)(CMr + (32 * kt + 24 + 4 * h) * 2);
          o = MFMA32(a, cat8(lo, hi), o);
        }
      }
      const float ei = __expf(ci);
#pragma unroll
      for (int r = 0; r < 16; ++r) o[r] *= ei;
      const char* VTr = lds + M_VT + (32 * w + r32) * TS;
      {
        const s16x4 lo = *(const s16x4*)(VTr + (4 * h) * 2), hi = *(const s16x4*)(VTr + (8 + 4 * h) * 2);
        o = MFMA32(cat8(lo, hi), scb0, o);
      }
      {
        const s16x4 lo = *(const s16x4*)(VTr + (16 + 4 * h) * 2), hi = *(const s16x4*)(VTr + (24 + 4 * h) * 2);
        o = MFMA32(cat8(lo, hi), scb1, o);
      }
    }
    {
      const float el = __expf(lastw);
#pragma unroll
      for (int kt = 0; kt < 4; ++kt)
#pragma unroll
        for (int r = 0; r < 16; ++r) S[kt][r] *= el;
      const char* VEr = lds + M_VENDT + (32 * w + r32) * TS;
#pragma unroll
      for (int s = 0; s < 2; ++s) {
        const bf16x8 bq = *(const bf16x8*)(VEr + s * 32 + h * 16);
#pragma unroll
        for (int kt = 0; kt < 4; ++kt) {
          const bf16x8 a = *(const bf16x8*)(lds + M_BT + (32 * kt + r32) * TS + s * 32 + h * 16);
          S[kt] = MFMA32(a, bq, S[kt]);
        }
      }
    }
    if (!SO) {
      float y[16]; float ss = 0.f;
#pragma unroll
      for (int g = 0; g < 4; ++g) {
        const u32x2 xp = *(const u32x2*)(lds + M_XS + r32 * RS + (32 * w + 8 * g + 4 * h) * 2);
        const u32x2 zp = *(const u32x2*)(lds + M_Z + r32 * RS + (32 * w + 8 * g + 4 * h) * 2);
        y[4 * g] = (o[4 * g] + dsk * bflo(xp[0])) * bflo(zp[0]);
        y[4 * g + 1] = (o[4 * g + 1] + dsk * bfhi(xp[0])) * bfhi(zp[0]);
        y[4 * g + 2] = (o[4 * g + 2] + dsk * bflo(xp[1])) * bflo(zp[1]);
        y[4 * g + 3] = (o[4 * g + 3] + dsk * bfhi(xp[1])) * bfhi(zp[1]);
      }
#pragma unroll
      for (int r = 0; r < 16; ++r) ss += y[r] * y[r];
      ss += __shfl_xor(ss, 32);
      if (h == 0) SSQ[w * 32 + r32] = ss;
      if (t0 + r32 < ntok) {
        bf16_t* orow = O + (size_t)(row0 + t0 + r32) * 2048 + hp * 128 + 32 * w + 4 * h;
#pragma unroll
        for (int g = 0; g < 4; ++g) { u32x2 v; v[0] = pk2(y[4 * g], y[4 * g + 1]); v[1] = pk2(y[4 * g + 2], y[4 * g + 3]); *(u32x2*)(orow + 8 * g) = v; }
      }
    }
    __syncthreads();
    if (!SO && tid < 32 && t0 + tid < ntok) {
      float* q = (float*)(p.ws + OFF_SSQ);
      q[(size_t)(row0 + t0 + tid) * 16 + hp] = (SSQ[tid] + SSQ[32 + tid]) + (SSQ[64 + tid] + SSQ[96 + tid]);
    }
  }
  if (s_out) {
    float* so = s_out + ((size_t)hl * 64 + 32 * (w & 1) + r32) * 128;
#pragma unroll
    for (int kt = 0; kt < 4; ++kt)
#pragma unroll
      for (int g = 0; g < 4; ++g) {
        f32x4 v = {S[kt][4 * g], S[kt][4 * g + 1], S[kt][4 * g + 2], S[kt][4 * g + 3]};
        *(f32x4*)(so + 32 * kt + 8 * g + 4 * h) = v;
      }
  }
  if (SO && (w & 1) == 0 && c == 0) d_out[hl * 7] = dsum;
  __syncthreads();
}

DI void phase_scan_odd_a(const Params& p, char* lds, int bid, int G) {
  float* scr = (float*)(p.ws + OFF_MIX);
  const int half = threadIdx.x >> 8; lds += half * HALF_LDS;
  for (int jb = bid * 2; jb < 896 + 2048; jb += G * 2) {
    const int j = jb + half;
    if (j >= 896) {
      const int jj = j - 896, hp = jj & 15, b = jj >> 4;
      scan_odd_job<false>(p, lds, b, hp, true, 0, 4, p.in[4] + ((size_t)b * 32 + 2 * hp) * 8192, p.out + OUT_SSS + ((size_t)b * 32 + 2 * hp) * 8192, nullptr);
      continue;
    }
    const int hp = j & 15, b = (j >> 4) & 7, sc = j >> 7;
    float* U = scr + SCR_SS_U + ((((size_t)b * 16 + hp) * 7 + sc) * 2) * 8192;
    float* D = scr + SCR_SS_D + ((size_t)b * 32 + 2 * hp) * 7 + sc;
    scan_odd_job<true>(p, lds, b, hp, false, sc_beg(sc), sc_end(sc), nullptr, U, D);
  }
}
DI void phase_scan_odd_c(const Params& p, int bid, int G) {
  float* scr = (float*)(p.ws + OFF_MIX);
  for (int i = bid * NTHREADS + threadIdx.x; i < 128 * 2 * 2048; i += G * NTHREADS) {
    const int e4 = i & 2047, hd = (i >> 11) & 1, bhp = i >> 12;
    float* U = scr + SCR_SS_U + ((size_t)bhp * 7 * 2 + hd) * 8192 + 4 * e4;
    const float* D = scr + SCR_SS_D + ((size_t)(bhp >> 4) * 32 + 2 * (bhp & 15) + hd) * 7;
    f32x4 run = {0.f, 0.f, 0.f, 0.f};
#pragma unroll
    for (int sc = 0; sc < 7; ++sc) {
      const float d = __expf(D[sc]);
      const f32x4 u = *(const f32x4*)(U + (size_t)sc * 16384);
      run = run * d + u;
      *(f32x4*)(U + (size_t)sc * 16384) = run;
    }
  }
}
DI void phase_scan_odd_b(const Params& p, char* lds, int bid, int G) {
  float* scr = (float*)(p.ws + OFF_MIX);
  const int half = threadIdx.x >> 8; lds += half * HALF_LDS;
  for (int jb = bid * 2; jb < 1024; jb += G * 2) {
    const int j = jb + half;
    {
      const int hp = j & 15, b = (j >> 4) & 7, sc = j >> 7;
      const float* s_in = sc ? scr + SCR_SS_U + ((((size_t)b * 16 + hp) * 7 + sc - 1) * 2) * 8192 : nullptr;
      float* s_out = sc == NSC - 1 ? p.out + OUT_SSP + ((size_t)b * 32 + 2 * hp) * 8192 : nullptr;
      scan_odd_job<false>(p, lds, b, hp, false, sc_beg(sc), sc_end(sc), s_in, s_out, nullptr);
    }
  }
  const bf16_t* P = (const bf16_t*)(p.ws + OFF_P);
  for (int i = bid * NTHREADS + threadIdx.x; i < 136 * 3 * 3072; i += G * NTHREADS) {
    const int ch = i % 3072, r = i / 3072, j = r % 3, b = r / 3;
    if (b < 8) p.out[OUT_CVP + ((size_t)b * 3 + j) * 3072 + ch] = bflo((unsigned)P[(size_t)(b * SEQP + 2061 + j) * LD_OD + 2048 + ch]);
    else { const int bs = b - 8; p.out[OUT_CVS + ((size_t)bs * 3 + j) * 3072 + ch] = bflo((unsigned)P[(size_t)(T_PROMPT + 4 * bs + 1 + j) * LD_OD + 2048 + ch]); }
  }
}

#define XB_TMO      128
#define XB_XCNT(j)  (256  + 64 * (j))
#define XB_XSUB(j)  (1280 + 64 * (j))
#define XB_XGEN(j)  (2304 + 64 * (j))
#define XB_TOP      3328
#define XB_TOPGEN   3392
#define XCD_BAR_WORDS 3456
#define XB_SPIN_CAP (1u << 20)
#define LAS __attribute__((address_space(3)))
DI unsigned xb_ld(unsigned* p) { return __hip_atomic_load(p, __ATOMIC_RELAXED, __HIP_MEMORY_SCOPE_AGENT); }
DI unsigned xb_add(unsigned* p, unsigned v) { return __hip_atomic_fetch_add(p, v, __ATOMIC_RELAXED, __HIP_MEMORY_SCOPE_AGENT); }
DI unsigned xb_xcc_id() { return (unsigned)__builtin_amdgcn_s_getreg((3 << 11) | 20) & 0xFu; }
#define XB_SPIN(cond, bar) do { unsigned _sp = 0; while (cond) { __builtin_amdgcn_s_sleep(1); \
    if ((++_sp & 255u) == 0u) { if (xb_ld(&(bar)[XB_TMO])) break; if (_sp > XB_SPIN_CAP) { atomicAdd(&(bar)[XB_TMO], 1u); break; } } } } while (0)
struct XcdBarrier { unsigned* bar; unsigned x; volatile LAS unsigned* st; };
DI XcdBarrier xcd_barrier_post(unsigned* bar, volatile LAS unsigned* st) {
  XcdBarrier b; b.bar = bar; b.x = xb_xcc_id(); b.st = st;
  if (threadIdx.x == 0) (void)xb_add(&bar[XB_XCNT(b.x)], 1u);
  return b;
}
DI void xcd_barrier_complete(unsigned* bar, unsigned x, unsigned& nloc, unsigned& nx) {
  const unsigned G = gridDim.x * gridDim.y * gridDim.z;
  unsigned sum, cnt, mine, sp = 0u;
  for (;;) {
    sum = 0u; cnt = 0u; mine = 0u;
#pragma unroll
    for (unsigned j = 0; j < 16; ++j) { const unsigned c = xb_ld(&bar[XB_XCNT(j)]); sum += c; cnt += (c > 0u) ? 1u : 0u; mine = (j == x) ? c : mine; }
    if (sum == G) break;
    __builtin_amdgcn_s_sleep(1);
    if ((++sp & 255u) == 0u) { if (xb_ld(&bar[XB_TMO])) break; if (sp > XB_SPIN_CAP) { atomicAdd(&bar[XB_TMO], 1u); break; } }
  }
  nloc = mine > 0u ? mine : 1u; nx = cnt > 0u ? cnt : 1u;
}
DI void xcd_barrier(const XcdBarrier& b) {
  asm volatile("s_waitcnt vmcnt(0)" ::: "memory");
  __syncthreads();
  if (threadIdx.x == 0) {
    unsigned* bar = b.bar;
    __builtin_amdgcn_s_waitcnt(0);
    unsigned nloc = b.st[0], nx = b.st[1];
    if (nloc == 0u) { xcd_barrier_complete(bar, b.x, nloc, nx); b.st[0] = nloc; b.st[1] = nx; }
    const unsigned old = xb_add(&bar[XB_XSUB(b.x)], 1u);
    const unsigned gen = old / nloc;
    if (old + 1u == (gen + 1u) * nloc) {
      __builtin_amdgcn_fence(__ATOMIC_RELEASE, "agent");
      asm volatile("s_waitcnt vmcnt(0)" ::: "memory");
      const unsigned og = xb_add(&bar[XB_TOP], 1u);
      const unsigned tg = og / nx;
      if (og + 1u == (tg + 1u) * nx) xb_add(&bar[XB_TOPGEN], 1u);
      else XB_SPIN(xb_ld(&bar[XB_TOPGEN]) == tg, bar);
      __builtin_amdgcn_fence(__ATOMIC_ACQUIRE, "agent");
      xb_add(&bar[XB_XGEN(b.x)], 1u);
      asm volatile("s_waitcnt vmcnt(0)" ::: "memory");
    } else {
      XB_SPIN(xb_ld(&bar[XB_XGEN(b.x)]) == gen, bar);
      __builtin_amdgcn_fence(__ATOMIC_ACQUIRE, "agent");
      asm volatile("s_waitcnt vmcnt(0)" ::: "memory");
    }
  }
  __syncthreads();
}

constexpr int N_PHASES = 21;
#ifndef ONLY_PHASE
#define ONLY_PHASE -1
#endif
#define PHASE(k, body) do { if ((ONLY_PHASE < 0 || ONLY_PHASE == (k)) && ph_lo <= (k) && (k) <= ph_hi) { body; } if (ph_lo <= (k) && (k) < ph_hi) xcd_barrier(xb); } while (0)

__global__ void __launch_bounds__(NTHREADS, 2) fwd_mega(Params p, int ph_lo, int ph_hi) {
  extern __shared__ __attribute__((aligned(16))) char lds[];
  cg::grid_group grid = cg::this_grid();
  const int G = gridDim.x, bid = blockIdx.x;
  if (ph_lo > 1000) grid.sync();
  volatile LAS unsigned* xst = (volatile LAS unsigned*)(lds + 2 * HALF_LDS);
  if (threadIdx.x == 0) { xst[0] = 0u; xst[1] = 0u; }
  __syncthreads();
  XcdBarrier xb = xcd_barrier_post((unsigned*)(p.ws + OFF_BAR), xst);
  bf16_t* HN = (bf16_t*)(p.ws + OFF_HN);
  bf16_t* Pb = (bf16_t*)(p.ws + OFF_P);
  bf16_t* Ob = (bf16_t*)(p.ws + OFF_O);
  float* MIX = (float*)(p.ws + OFF_MIX);
  PHASE(0, phase_prep(p, lds, bid, G));
  PHASE(1, gemm_run(lds, HN, (const bf16_t*)(p.ws + OFF_WT_EVIN), LD_EV, 1024, EpiStoreBf16{Pb, LD_EV, (1u << 6) | (1u << 7) | (1u << 12) | (1u << 13), (1u << 2) | (1u << 3)}, bid, G));
  PHASE(2, phase_scan_even_a(p, lds, bid, G));
  PHASE(3, phase_scan_even_c(p, bid, G));
  PHASE(4, phase_scan_even_b(p, lds, bid, G));
  PHASE(5, gemm_n1024<false>(lds, Ob, (const bf16_t*)(p.ws + OFF_WT_EVOUT), 1024, EpiResNorm<false>{(bf16_t*)(p.ws + OFF_X), (bf16_t*)(p.ws + OFF_HN), p.in[9], p.in[10], nullptr, (float*)(p.ws + OFF_XB) + 0 * (SZ_XB_SET / 4), (unsigned*)(p.ws + OFF_CNT) + 0 * (SZ_CNT_SET / 4), (unsigned*)(p.ws + OFF_BAR) + 64}, (float*)Pb, bid, G));
  PHASE(6, phase_rowwise(p, p.in[9], p.in[10], false, (const float*)Pb, 4, M_MAIN, bid, G));
  PHASE(7, gemm_run(lds, HN, (const bf16_t*)(p.ws + OFF_WT_GU), 5632, 1024, EpiSwiglu{Pb, 2816}, bid, G));
  PHASE(8, gemm_n1024<false>(lds, Pb, (const bf16_t*)(p.ws + OFF_WT_DN), 2816, EpiResNorm<false>{(bf16_t*)(p.ws + OFF_X), (bf16_t*)(p.ws + OFF_HN), p.in[11], p.in[8] + 1024, nullptr, (float*)(p.ws + OFF_XB) + 2 * (SZ_XB_SET / 4), (unsigned*)(p.ws + OFF_CNT) + 2 * (SZ_CNT_SET / 4), (unsigned*)(p.ws + OFF_BAR) + 64}, (float*)Ob, bid, G));
  PHASE(9, phase_rowwise(p, p.in[11], p.in[8] + 1024, false, (const float*)Ob, 11, M_MAIN, bid, G));
  PHASE(10, gemm_run(lds, HN, (const bf16_t*)(p.ws + OFF_WT_ODIN), LD_OD, 1024, EpiStoreBf16{Pb, LD_OD, 0xffu, 0u}, bid, G));
  PHASE(11, phase_conv(p, bid, G));
  PHASE(12, phase_scan_odd_a(p, lds, bid, G));
  PHASE(13, phase_scan_odd_c(p, bid, G));
  PHASE(14, phase_scan_odd_b(p, lds, bid, G));
  PHASE(15, phase_groupnorm(p, bid, G));
  PHASE(16, gemm_n1024<false>(lds, Ob, (const bf16_t*)(p.ws + OFF_WT_ODOUT), 2048, EpiResNorm<false>{(bf16_t*)(p.ws + OFF_X), (bf16_t*)(p.ws + OFF_HN), p.in[9] + 1024, p.in[10] + 1024, nullptr, (float*)(p.ws + OFF_XB) + 4 * (SZ_XB_SET / 4), (unsigned*)(p.ws + OFF_CNT) + 4 * (SZ_CNT_SET / 4), (unsigned*)(p.ws + OFF_BAR) + 64}, (float*)Pb, bid, G));
  PHASE(17, phase_rowwise(p, p.in[9] + 1024, p.in[10] + 1024, false, (const float*)Pb, 8, M_MAIN, bid, G));
  PHASE(18, gemm_run(lds, HN, (const bf16_t*)(p.ws + OFF_WT_GU + SZ_WT_GU1), 5632, 1024, EpiSwiglu{Pb, 2816}, bid, G));
  PHASE(19, gemm_n1024<true>(lds, Pb, (const bf16_t*)(p.ws + OFF_WT_DN + SZ_WT_DN1), 2816, EpiResNorm<true>{(bf16_t*)(p.ws + OFF_X), (bf16_t*)(p.ws + OFF_HN), p.in[11] + 1024, nullptr, p.out + OUT_YP, (float*)(p.ws + OFF_XB) + 6 * (SZ_XB_SET / 4), (unsigned*)(p.ws + OFF_CNT) + 6 * (SZ_CNT_SET / 4), (unsigned*)(p.ws + OFF_BAR) + 64}, (float*)Ob, bid, G));
  PHASE(20, phase_rowwise(p, p.in[11] + 1024, nullptr, true, (const float*)Ob, 11, M_MAIN, bid, G));
}

extern "C" void kernel_launch(void* const* d_in, const int* in_sizes, int n_in, void* d_out, int out_size, void* d_ws, size_t ws_size, hipStream_t stream) {
  static int grid_blocks = 0;
  if (!grid_blocks) {
    int dev = 0, cus = 0, per_cu = 0;
    hipGetDevice(&dev);
    hipDeviceGetAttribute(&cus, hipDeviceAttributeMultiprocessorCount, dev);
    hipFuncSetAttribute((const void*)fwd_mega, hipFuncAttributeMaxDynamicSharedMemorySize, LDS_BYTES);
    hipOccupancyMaxActiveBlocksPerMultiprocessor(&per_cu, (const void*)fwd_mega, NTHREADS, LDS_BYTES);
    if (per_cu < 1) per_cu = 1;
    if (per_cu > 1) per_cu = 1;
    grid_blocks = cus * per_cu;
    if (ws_size < WS_END) fprintf(stderr, "kernel_launch: workspace too small: %zu < %zu\n", ws_size, (size_t)WS_END);
  }
  Params p{};
  for (int i = 0; i < 29; ++i) p.in[i] = (const float*)d_in[i];
  p.out = (float*)d_out;
  p.ws = (char*)d_ws;
  (void)hipMemsetAsync((char*)d_ws + OFF_BAR, 0, 16384 + 8 * SZ_CNT_SET, stream);
#if ONE_LAUNCH
  int lo = 0, hi = N_PHASES - 1;
  void* args[] = {&p, &lo, &hi};
  hipError_t e = hipLaunchCooperativeKernel((const void*)fwd_mega, dim3(grid_blocks), dim3(NTHREADS), args, LDS_BYTES, stream);
  if (e != hipSuccess) fprintf(stderr, "cooperative launch failed: %s (grid %d)\n", hipGetErrorString(e), grid_blocks);
#else
  for (int ph = 0; ph < N_PHASES; ++ph) {
    int lo = ph, hi = ph;
    void* args[] = {&p, &lo, &hi};
    hipError_t e = hipLaunchCooperativeKernel((const void*)fwd_mega, dim3(grid_blocks), dim3(NTHREADS), args, LDS_BYTES, stream);
    if (e != hipSuccess) fprintf(stderr, "launch failed: %s (grid %d)\n", hipGetErrorString(e), grid_blocks);
  }
#endif
}
```

```cpp
#include <hip/hip_runtime.h>
#include <hip/hip_cooperative_groups.h>
#include <cstdio>
#include <cstdint>
namespace cg = cooperative_groups;

#ifndef ONE_LAUNCH
#define ONE_LAUNCH 1
#endif

#define DI __device__ __forceinline__
typedef unsigned short bf16_t;
typedef short bf16x8 __attribute__((ext_vector_type(8)));
typedef short s16x4 __attribute__((ext_vector_type(4)));
typedef float f32x16 __attribute__((ext_vector_type(16)));
typedef float f32x4 __attribute__((ext_vector_type(4)));
typedef float f32x2 __attribute__((ext_vector_type(2)));
typedef unsigned u32x4 __attribute__((ext_vector_type(4)));
typedef unsigned u32x2 __attribute__((ext_vector_type(2)));
typedef __bf16 bf16v2 __attribute__((ext_vector_type(2)));
#define MFMA32(a, b, c) __builtin_amdgcn_mfma_f32_32x32x16_bf16((a), (b), (c), 0, 0, 0)

constexpr int T_ALL = 17024, T_PAD = 17152, T_PROMPT = 16512, SEQP = 2064, NTHREADS = 512, HB = 256  ;
constexpr int LD_EV = 3840, LD_OD = 5376;
constexpr int HALF_LDS = 75776;
constexpr int LDS_BYTES = 2 * HALF_LDS + 32;
constexpr int M_MAIN = 16384;

constexpr size_t OFF_WT_EVIN = 0;
constexpr size_t OFF_WT_EVOUT = OFF_WT_EVIN + (size_t)3840 * 1024 * 2;
constexpr size_t OFF_WT_GU = OFF_WT_EVOUT + (size_t)1024 * 1024 * 2;
constexpr size_t SZ_WT_GU1 = (size_t)5632 * 1024 * 2;
constexpr size_t OFF_WT_DN = OFF_WT_GU + 2 * SZ_WT_GU1;
constexpr size_t SZ_WT_DN1 = (size_t)1024 * 2816 * 2;
constexpr size_t OFF_WT_ODIN = OFF_WT_DN + 2 * SZ_WT_DN1;
constexpr size_t OFF_WT_ODOUT = OFF_WT_ODIN + (size_t)5376 * 1024 * 2;
constexpr size_t OFF_X = OFF_WT_ODOUT + (size_t)1024 * 2048 * 2;
constexpr size_t OFF_HN = OFF_X + (size_t)T_PAD * 1024 * 4;
constexpr size_t OFF_P = OFF_HN + (size_t)T_PAD * 1024 * 2;
constexpr size_t OFF_O = OFF_P + (size_t)T_PAD * 5376 * 2;
constexpr size_t OFF_MIX = OFF_O + (size_t)T_PAD * 2048 * 2;
constexpr size_t OFF_SSQ = OFF_MIX + (size_t)T_PAD * 1024 * 4;
constexpr size_t OFF_BAR = OFF_SSQ + (size_t)T_PAD * 16 * 4;
constexpr size_t OFF_CNT = OFF_BAR + 16384;
constexpr size_t SZ_CNT_SET = 64 * 256;
constexpr size_t OFF_XB = OFF_CNT + 8 * SZ_CNT_SET;
constexpr size_t SZ_XB_SET = (size_t)64 * 256 * 4 * 4;
constexpr size_t WS_END = OFF_XB + 8 * SZ_XB_SET;

constexpr size_t OUT_YP = 0;
constexpr size_t OUT_YS = 16777216;
constexpr size_t OUT_HGP = OUT_YS + 524288;
constexpr size_t OUT_GLP = OUT_HGP + 524288;
constexpr size_t OUT_SSP = OUT_GLP + 262144;
constexpr size_t OUT_CVP = OUT_SSP + 2097152;
constexpr size_t OUT_HGS = OUT_CVP + 73728;
constexpr size_t OUT_GLS = OUT_HGS + 8388608;
constexpr size_t OUT_SSS = OUT_GLS + 4194304;
constexpr size_t OUT_CVS = OUT_SSS + 33554432;

struct Params { const float* in[29]; float* out; char* ws; };

DI unsigned pk2(float lo, float hi) { f32x2 v = {lo, hi}; bf16v2 b = __builtin_convertvector(v, bf16v2); return __builtin_bit_cast(unsigned, b); }
DI float bflo(unsigned u) { return __uint_as_float(u << 16); }
DI float bfhi(unsigned u) { return __uint_as_float(u & 0xffff0000u); }
DI f32x4 ld_bf4(const bf16_t* p) { const u32x2 u = *(const u32x2*)p; return (f32x4){bflo(u[0]), bfhi(u[0]), bflo(u[1]), bfhi(u[1])}; }
DI void st_bf4(bf16_t* p, f32x4 v) { u32x2 u; u[0] = pk2(v.x, v.y); u[1] = pk2(v.z, v.w); *(u32x2*)p = u; }
DI float sigmoidf_(float x) { return __builtin_amdgcn_rcpf(1.f + __expf(-x)); }
DI float siluf_(float x) { return x * sigmoidf_(x); }
DI int crow(int r, int h) { return (r & 3) + 8 * (r >> 2) + 4 * h; }
DI bf16x8 cat8(s16x4 lo, s16x4 hi) { return __builtin_shufflevector(lo, hi, 0, 1, 2, 3, 4, 5, 6, 7); }
template <int S> DI bf16x8 pack8(const f32x16& x) {
  u32x4 p;
  p[0] = pk2(x[8 * S + 0], x[8 * S + 1]); p[1] = pk2(x[8 * S + 2], x[8 * S + 3]);
  p[2] = pk2(x[8 * S + 4], x[8 * S + 5]); p[3] = pk2(x[8 * S + 6], x[8 * S + 7]);
  return __builtin_bit_cast(bf16x8, p);
}
DI float wave_sum(float v) {
#pragma unroll
  for (int o = 1; o < 64; o <<= 1) v += __shfl_xor(v, o);
  return v;
}
DI void zero16(f32x16& a) {
#pragma unroll
  for (int i = 0; i < 16; ++i) a[i] = 0.f;
}

struct TileDesc { const float* W; bf16_t* dst; const float* wup; int K, N, mode, kt, nt; bool active; };
DI void tile_fetch(const TileDesc& d, float (&v)[16]) {
  const int tid = threadIdx.x & (HB - 1), k0 = d.kt * 64, n0 = d.nt * 64;
  const int c = tid & 63, r0 = tid >> 6, nn = min(n0 + c, d.N - 1);
#pragma unroll
  for (int i = 0; i < 16; ++i) v[i] = d.W[(size_t)(k0 + r0 + 4 * i) * d.N + nn];
}
DI void tile_to_lds(const TileDesc& d, const float (&v)[16], float* tile) {
  const int tid = threadIdx.x & (HB - 1), c = tid & 63, r0 = tid >> 6, k0 = d.kt * 64, n0 = d.nt * 64, n = n0 + c;
  if (!d.active) return;
  if (d.wup && n0 >= 3584) {
    float wc[16];
#pragma unroll
    for (int r = 0; r < 16; ++r) wc[r] = d.wup[r * 256 + (n - 3584)];
#pragma unroll
    for (int i = 0; i < 16; ++i) {
      const float* wr_ = d.W + (size_t)(k0 + r0 + 4 * i) * d.N + 3584;
      float a = 0.f;
#pragma unroll
      for (int r = 0; r < 16; ++r) a += wr_[r] * wc[r];
      tile[(r0 + 4 * i) * 65 + c] = a;
    }
  } else {
#pragma unroll
    for (int i = 0; i < 16; ++i) tile[(r0 + 4 * i) * 65 + c] = (n < d.N) ? v[i] : 0.f;
  }
}
DI void tile_store(const TileDesc& d, const float* tile) {
  const int tid = threadIdx.x & (HB - 1), k0 = d.kt * 64, n0 = d.nt * 64;
  if (d.active) {
    const int nl = tid >> 2, kc = (tid & 3) * 16, n = n0 + nl;
    int drow = n;
    if (d.mode == 1) drow = (n >> 7) * 256 + (n & 127);
    if (d.mode == 2) drow = (n >> 7) * 256 + 128 + (n & 127);
    u32x4 o0, o1;
#pragma unroll
    for (int j = 0; j < 4; ++j) {
      o0[j] = pk2(tile[(kc + 2 * j) * 65 + nl], tile[(kc + 2 * j + 1) * 65 + nl]);
      o1[j] = pk2(tile[(kc + 8 + 2 * j) * 65 + nl], tile[(kc + 8 + 2 * j + 1) * 65 + nl]);
    }
    u32x4* dd = (u32x4*)(d.dst + (size_t)drow * d.K + k0 + kc);
    dd[0] = o0; dd[1] = o1;
  }
}

DI void rms_row_to_bf16(const f32x4 (&v)[4], const float* __restrict__ wn, bf16_t* dst, int lane) {
  float s = 0.f;
#pragma unroll
  for (int j = 0; j < 4; ++j) s += v[j].x * v[j].x + v[j].y * v[j].y + v[j].z * v[j].z + v[j].w * v[j].w;
  const float rstd = rsqrtf(wave_sum(s) * (1.f / 1024.f) + 1e-6f);
#pragma unroll
  for (int j = 0; j < 4; ++j) {
    const f32x4 g = *(const f32x4*)(wn + 256 * j + 4 * lane);
    u32x2 o; o[0] = pk2(v[j].x * rstd * g.x, v[j].y * rstd * g.y); o[1] = pk2(v[j].z * rstd * g.z, v[j].w * rstd * g.w);
    *(u32x2*)(dst + 256 * j + 4 * lane) = o;
  }
}

DI void phase_prep(const Params& p, char* lds, int bid, int G) {
  const int half = threadIdx.x >> 8;
  float* tile = (float*)(lds + half * HALF_LDS);
  constexpr int NT_TILES = 960 + 256 + 1408 + 1408 + 1408 + 1344 + 512;
  auto decode = [&](int t) {
    TileDesc d; d.active = t < NT_TILES; d.wup = (d.active && t < 960) ? p.in[13] : nullptr;
    d.W = p.in[12]; d.K = 1024; d.N = 3600; d.mode = 0; d.dst = (bf16_t*)(p.ws + OFF_WT_EVIN);
    int nnt = 60, r = d.active ? t : 0;
    if (r < 960) { }
    else if ((r -= 960) < 256) { d.W = p.in[17]; d.K = 1024; d.N = 1024; nnt = 16; d.dst = (bf16_t*)(p.ws + OFF_WT_EVOUT); }
    else if ((r -= 256) < 1408) { const int l = r / 704; r -= l * 704; d.W = p.in[26] + (size_t)l * 1024 * 2816; d.K = 1024; d.N = 2816; nnt = 44; d.mode = 1; d.dst = (bf16_t*)(p.ws + OFF_WT_GU + l * SZ_WT_GU1); }
    else if ((r -= 1408) < 1408) { const int l = r / 704; r -= l * 704; d.W = p.in[27] + (size_t)l * 1024 * 2816; d.K = 1024; d.N = 2816; nnt = 44; d.mode = 2; d.dst = (bf16_t*)(p.ws + OFF_WT_GU + l * SZ_WT_GU1); }
    else if ((r -= 1408) < 1408) { const int l = r / 704; r -= l * 704; d.W = p.in[28] + (size_t)l * 2816 * 1024; d.K = 2816; d.N = 1024; nnt = 16; d.dst = (bf16_t*)(p.ws + OFF_WT_DN + l * SZ_WT_DN1); }
    else if ((r -= 1408) < 1344) { d.W = p.in[18]; d.K = 1024; d.N = 5152; nnt = 84; d.dst = (bf16_t*)(p.ws + OFF_WT_ODIN); }
    else { r -= 1344; d.W = p.in[25]; d.K = 2048; d.N = 1024; nnt = 16; d.dst = (bf16_t*)(p.ws + OFF_WT_ODOUT); }
    d.kt = r / nnt; d.nt = r - d.kt * nnt;
    return d;
  };
  {
    float v[16];
    TileDesc d = decode(bid * 2 + half);
    tile_fetch(d, v);
    for (int tb = bid * 2; tb < NT_TILES; tb += G * 2) {
      tile_to_lds(d, v, tile);
      __syncthreads();
      const TileDesc dn = decode(tb + G * 2 + half);
      tile_fetch(dn, v);
      tile_store(d, tile);
      __syncthreads();
      d = dn;
    }
  }
  const int lane = threadIdx.x & 63, w = threadIdx.x >> 6;
  bf16_t* X = (bf16_t*)(p.ws + OFF_X);
  bf16_t* HN = (bf16_t*)(p.ws + OFF_HN);
  for (int row = bid * 8 + w; row < T_ALL; row += G * 8) {
    const float* src;
    if (row < T_PROMPT) { const int b = row / SEQP, t = row - b * SEQP; src = (t < 16) ? p.in[6] + (size_t)t * 1024 : p.in[0] + ((size_t)b * 2048 + (t - 16)) * 1024; }
    else src = p.in[1] + (size_t)(row - T_PROMPT) * 1024;
    f32x4 v[4];
#pragma unroll
    for (int j = 0; j < 4; ++j) { v[j] = *(const f32x4*)(src + 256 * j + 4 * lane); st_bf4(X + (size_t)row * 1024 + 256 * j + 4 * lane, v[j]); }
    rms_row_to_bf16(v, p.in[8], HN + (size_t)row * 1024, lane);
  }
}

DI void phase_rowwise(const Params& p, const float* __restrict__ wpost, const float* __restrict__ wpre, bool final_, const float* PART, int nsplit, int row_begin, int bid, int G) {
  const int lane = threadIdx.x & 63, w = threadIdx.x >> 6;
  bf16_t* X = (bf16_t*)(p.ws + OFF_X);
  const bf16_t* MIX = (const bf16_t*)(p.ws + OFF_MIX);
  bf16_t* HN = (bf16_t*)(p.ws + OFF_HN);
  for (int rowa = row_begin + bid * 8 + w; rowa < T_ALL; rowa += G * 16) {
    const int rowb = rowa + G * 8;
    const bool hasb = rowb < T_ALL;
    f32x4 m[2][4], x[2][4];
#pragma unroll
    for (int q = 0; q < 2; ++q) {
      const int row = q ? (hasb ? rowb : rowa) : rowa;
#pragma unroll
      for (int j = 0; j < 4; ++j) {
        if (row < 16384) m[q][j] = ld_bf4(MIX + (size_t)row * 1024 + 256 * j + 4 * lane);
        else {
          f32x4 a = {0.f, 0.f, 0.f, 0.f};
          for (int ks = 0; ks < nsplit; ++ks) a = a + *(const f32x4*)(PART + ((size_t)ks * 768 + (row - 16384)) * 1024 + 256 * j + 4 * lane);
          m[q][j] = a;
        }
        x[q][j] = ld_bf4(X + (size_t)row * 1024 + 256 * j + 4 * lane);
      }
    }
#pragma unroll
    for (int q = 0; q < 2; ++q) {
      if (q == 1 && !hasb) break;
      const int row = q ? rowb : rowa;
      float s = 0.f;
#pragma unroll
      for (int j = 0; j < 4; ++j) s += m[q][j].x * m[q][j].x + m[q][j].y * m[q][j].y + m[q][j].z * m[q][j].z + m[q][j].w * m[q][j].w;
      const float rstd = rsqrtf(wave_sum(s) * (1.f / 1024.f) + 1e-6f);
#pragma unroll
      for (int j = 0; j < 4; ++j) { const f32x4 g = *(const f32x4*)(wpost + 256 * j + 4 * lane); x[q][j] = x[q][j] + m[q][j] * rstd * g; }
      if (!final_) {
#pragma unroll
        for (int j = 0; j < 4; ++j) st_bf4(X + (size_t)row * 1024 + 256 * j + 4 * lane, x[q][j]);
        rms_row_to_bf16(x[q], wpre, HN + (size_t)row * 1024, lane);
      } else {
        float* dst = nullptr;
        if (row < T_PROMPT) { const int b = row / SEQP, t = row - b * SEQP; if (t >= 16) dst = p.out + OUT_YP + ((size_t)b * 2048 + (t - 16)) * 1024; }
        else dst = p.out + OUT_YS + (size_t)(row - T_PROMPT) * 1024;
        if (dst) {
#pragma unroll
          for (int j = 0; j < 4; ++j) *(f32x4*)(dst + 256 * j + 4 * lane) = x[q][j];
        }
      }
    }
  }
}

DI void phase_groupnorm(const Params& p, int bid, int G) {
  const int lane = threadIdx.x & 63, w = threadIdx.x >> 6;
  bf16_t* O = (bf16_t*)(p.ws + OFF_O);
  const float* SSQ = (const float*)(p.ws + OFF_SSQ);
  const float* __restrict__ nw = p.in[24];
  const int g = lane >> 4;
  for (int row = bid * 8 + w; row < T_ALL; row += G * 8) {
    const f32x4 q = *(const f32x4*)(SSQ + (size_t)row * 16 + 4 * g);
    const float rstd = rsqrtf((q.x + q.y + q.z + q.w) * (1.f / 512.f) + 1e-6f);
    bf16_t* o = O + (size_t)row * 2048 + lane * 32;
#pragma unroll
    for (int j = 0; j < 4; ++j) {
      u32x4 v = *(u32x4*)(o + 8 * j);
      const f32x4 w0 = *(const f32x4*)(nw + lane * 32 + 8 * j), w1 = *(const f32x4*)(nw + lane * 32 + 8 * j + 4);
      v[0] = pk2(bflo(v[0]) * rstd * w0.x, bfhi(v[0]) * rstd * w0.y); v[1] = pk2(bflo(v[1]) * rstd * w0.z, bfhi(v[1]) * rstd * w0.w);
      v[2] = pk2(bflo(v[2]) * rstd * w1.x, bfhi(v[2]) * rstd * w1.y); v[3] = pk2(bflo(v[3]) * rstd * w1.z, bfhi(v[3]) * rstd * w1.w);
      *(u32x4*)(o + 8 * j) = v;
    }
  }
}

namespace pg8 {
#define PG8_LAS __attribute__((address_space(3)))
typedef unsigned short bf16_t;
typedef short bf16x8 __attribute__((ext_vector_type(8)));
typedef float f32x4 __attribute__((ext_vector_type(4)));
typedef unsigned u32x4 __attribute__((ext_vector_type(4)));
constexpr int BM = 256, BK = 64, HALF = 128, HTB = HALF * BK * 2  , STAGE_BYTES = 8 * HTB, NXCD = 8, WGM = 8;

__host__ __device__ __forceinline__ int lds_byte(int r, int c) { const int st = (r >> 4) * 2 + (c >> 5), rr = r & 15, cc = c & 31, ob = rr * 64 + cc * 2; return st * 1024 + (ob ^ (((ob >> 9) & 1) << 5)); }
__host__ __device__ __forceinline__ void stage_rc(int b, int& R, int& C) { const int st = b / 1024, sb = b % 1024, swz = sb ^ (((sb >> 9) & 1) << 5); R = (st >> 1) * 16 + swz / 64; C = (st & 1) * 32 + (swz % 64) / 2; }
__host__ __device__ __forceinline__ int perm32(int rho) { const int n = rho >> 4, i = rho & 15; return 8 * (i >> 2) + 4 * n + (i & 3); }

struct Unit { int pm, pn, ks; };
struct Gemm { const bf16_t* A; const bf16_t* Bt; int M, N, K, ld; };

struct StaticOrder {
    int nM, nN, nwg, G, c;
    __host__ __device__ void init(int M, int N, int G_, int c_) { nM = M / BM; nN = N / BM; nwg = nM * nN; G = G_; c = c_; }
    __host__ __device__ bool next(int i, Unit& u) const {
        const long L = (long)i * G + c; if (L >= nwg) return false;
        int wgid = (int)L; { const int q = nwg / NXCD, r = nwg % NXCD, xcd = wgid % NXCD, off = wgid / NXCD; wgid = (xcd < r ? xcd * (q + 1) : r * (q + 1) + (xcd - r) * q) + off; }
        const int nig = WGM * nN, gid = wgid / nig, fm = gid * WGM, gsz = (nM - fm) < WGM ? (nM - fm) : WGM;
        u.pm = fm + ((wgid % nig) % gsz); u.pn = (wgid % nig) / gsz; u.ks = 0; return true;
    }
    __device__ __forceinline__ void a_ready(const Unit&) const {}
    __device__ __forceinline__ void done(const Unit&) const {}
};
__device__ __forceinline__ unsigned cvt_pk_bf16(float lo, float hi) { unsigned r; asm volatile("v_cvt_pk_bf16_f32 %0, %1, %2" : "=v"(r) : "v"(lo), "v"(hi)); return r; }
typedef float f32x2 __attribute__((ext_vector_type(2)));
template <class Epi, class Sched, bool ALIGN_EPI = false, bool SP2 = false>
__device__ __forceinline__ void gemm_phase(PG8_LAS unsigned char* lds, const Gemm g, const Sched& S, const Epi& E) {
    int tid_ = threadIdx.x; asm volatile("" : "+v"(tid_));
    const int tid = tid_, wid = __builtin_amdgcn_readfirstlane(tid >> 6), lane = tid & 63, wr = wid >> 2, wc = wid & 3, fr = lane & 15, fq = lane >> 4;
    const int K = g.ld, nt = g.K / BK;
    unsigned voffA[2], voffB[2];
#pragma unroll
    for (int i = 0; i < 2; ++i) { int R, C; stage_rc(tid * 16 + i * 8192, R, C); const int Rb = Epi::PERM ? ((R & ~31) + perm32(R & 31)) : R;
        voffA[i] = (unsigned)(R * K + C) * 2u; voffB[i] = (unsigned)(Rb * K + C) * 2u; }
    const size_t kstep = (size_t)(BK * 2);
    const size_t hstep = (size_t)HALF * K * 2;
    const size_t tstep = 2 * hstep;
    const unsigned ldsw = (unsigned)wid * 1024u;
    const int aoff = lds_byte(wr * 64 + fr, fq * 8), boff = lds_byte(wc * 32 + fr, fq * 8);
#define PG8_SA(b, h) (((b) * 2 + (h)) * HTB)
#define PG8_SB(b, h) ((4 + (b) * 2 + (h)) * HTB)
#define PG8_STAGE(bufoff, gbase, voff) do { _Pragma("unroll") for (int _i = 0; _i < 2; ++_i) \
        __builtin_amdgcn_global_load_lds((const unsigned*)((const char*)(gbase) + (voff)[_i]), (PG8_LAS unsigned*)(lds + (bufoff) + ldsw + _i * 8192), 16, 0, 0); } while (0)
#define PG8_LDA(dst, b, h) do { _Pragma("unroll") for (int m = 0; m < 4; ++m) _Pragma("unroll") for (int k = 0; k < 2; ++k) dst[m][k] = *(const PG8_LAS bf16x8*)(lds + PG8_SA(b, h) + aoff + m * 2048 + k * 1024); } while (0)
#define PG8_LDB(dst, b, h) do { _Pragma("unroll") for (int n = 0; n < 2; ++n) _Pragma("unroll") for (int k = 0; k < 2; ++k) dst[n][k] = *(const PG8_LAS bf16x8*)(lds + PG8_SB(b, h) + boff + n * 2048 + k * 1024); } while (0)
#define PG8_MMA(ai, bj, At, Bt) do { __builtin_amdgcn_s_setprio(1); _Pragma("unroll") for (int m = 0; m < 4; ++m) _Pragma("unroll") for (int n = 0; n < 2; ++n) _Pragma("unroll") for (int k = 0; k < 2; ++k) \
        acc[ai][bj][m][n] = __builtin_amdgcn_mfma_f32_16x16x32_bf16(Bt[n][k], At[m][k], acc[ai][bj][m][n], 0, 0, 0); __builtin_amdgcn_s_setprio(0); } while (0)
#define PG8_WAIT_V(n) asm volatile("s_waitcnt vmcnt(" #n ")" ::: "memory")
#define PG8_WAIT_L(n) asm volatile("s_waitcnt lgkmcnt(" #n ")" ::: "memory")
#define PG8_BAR __builtin_amdgcn_s_barrier()
#define PG8_SCHED __builtin_amdgcn_sched_barrier(0)
    Unit cur, nxt; int ui = 0;
    if (!S.next(0, cur)) return;
    f32x4 acc[2][2][4][2];
#pragma unroll
    for (int a = 0; a < 2; ++a)
#pragma unroll
        for (int b = 0; b < 2; ++b)
#pragma unroll
            for (int m = 0; m < 4; ++m)
#pragma unroll
                for (int n = 0; n < 2; ++n) acc[a][b][m][n] = (f32x4){0.f, 0.f, 0.f, 0.f};
    bf16x8 At[4][2], B0[2][2], B1[2][2];
    const char* cA = (const char*)g.A + (size_t)cur.pm * tstep + (size_t)cur.ks * g.K * 2; const char* cB = (const char*)g.Bt + (size_t)cur.pn * tstep + (size_t)cur.ks * g.K * 2;
    S.a_ready(cur);
    if constexpr (SP2) {
        PG8_STAGE(PG8_SB(0, 0), cB, voffB); PG8_STAGE(PG8_SB(0, 1), cB + hstep, voffB); PG8_STAGE(PG8_SA(0, 0), cA, voffA); PG8_STAGE(PG8_SA(0, 1), cA + hstep, voffA);
        if (wr == 1) PG8_BAR;
        PG8_WAIT_V(2); PG8_BAR;
        PG8_STAGE(PG8_SB(1, 0), cB + kstep, voffB); PG8_STAGE(PG8_SA(1, 0), cA + kstep, voffA); PG8_STAGE(PG8_SB(1, 1), cB + hstep + kstep, voffB);
        PG8_WAIT_V(6); PG8_BAR;
    } else {
        PG8_STAGE(PG8_SB(0, 0), cB, voffB); PG8_STAGE(PG8_SA(0, 0), cA, voffA); PG8_STAGE(PG8_SB(0, 1), cB + hstep, voffB); PG8_STAGE(PG8_SA(0, 1), cA + hstep, voffA);
        if (wr == 1) PG8_BAR;
        PG8_WAIT_V(4); PG8_BAR;
        PG8_STAGE(PG8_SB(1, 0), cB + kstep, voffB); PG8_STAGE(PG8_SA(1, 0), cA + kstep, voffA); PG8_STAGE(PG8_SB(1, 1), cB + hstep + kstep, voffB);
        PG8_WAIT_V(6); PG8_BAR;
    }
    for (;;) {
        const bool has_next = S.next(ui + 1, nxt);
        const char* nA = has_next ? (const char*)g.A + (size_t)nxt.pm * tstep + (size_t)nxt.ks * g.K * 2 : cA; const char* nB = has_next ? (const char*)g.Bt + (size_t)nxt.pn * tstep + (size_t)nxt.ks * g.K * 2 : cB;
        for (int t = 0; t < nt; t += 2) {
            const bool last = (t == nt - 2);
            const char* a1 = cA + (size_t)(t + 1) * kstep;
            const char* a2 = last ? nA : cA + (size_t)(t + 2) * kstep; const char* b2 = last ? nB : cB + (size_t)(t + 2) * kstep;
            const char* a3 = a2 + kstep; const char* b3 = b2 + kstep;
            if (last && has_next) S.a_ready(nxt);
            if constexpr (SP2) {
            PG8_LDB(B0, 0, 0); PG8_LDB(B1, 0, 1); PG8_SCHED; PG8_LDA(At, 0, 0); PG8_STAGE(PG8_SA(1, 1), a1 + hstep, voffA);
            PG8_WAIT_V(8); PG8_WAIT_L(0); PG8_BAR; PG8_MMA(0, 0, At, B0); PG8_MMA(0, 1, At, B1); PG8_BAR; PG8_SCHED;
            PG8_LDA(At, 0, 1); PG8_STAGE(PG8_SB(0, 0), b2, voffB); PG8_STAGE(PG8_SB(0, 1), b2 + hstep, voffB); PG8_STAGE(PG8_SA(0, 0), a2, voffA);
            PG8_WAIT_V(8); PG8_WAIT_L(0); PG8_BAR; PG8_MMA(1, 0, At, B0); PG8_MMA(1, 1, At, B1); PG8_BAR; PG8_SCHED;
            PG8_LDB(B0, 1, 0); PG8_LDB(B1, 1, 1); PG8_SCHED; PG8_LDA(At, 1, 0); PG8_STAGE(PG8_SA(0, 1), a2 + hstep, voffA);
            PG8_WAIT_V(8); PG8_WAIT_L(0); PG8_BAR; PG8_MMA(0, 0, At, B0); PG8_MMA(0, 1, At, B1); PG8_BAR; PG8_SCHED;
            PG8_LDA(At, 1, 1); PG8_STAGE(PG8_SB(1, 0), b3, voffB); PG8_STAGE(PG8_SB(1, 1), b3 + hstep, voffB); PG8_STAGE(PG8_SA(1, 0), a3, voffA);
            PG8_WAIT_V(8); PG8_WAIT_L(0); PG8_BAR; PG8_MMA(1, 0, At, B0); PG8_MMA(1, 1, At, B1); PG8_BAR; PG8_SCHED;
            } else {
            PG8_LDB(B0, 0, 0); PG8_SCHED; PG8_LDA(At, 0, 0); PG8_STAGE(PG8_SA(1, 1), a1 + hstep, voffA);
            PG8_WAIT_L(8); PG8_BAR; PG8_WAIT_L(0); PG8_MMA(0, 0, At, B0); PG8_BAR; PG8_SCHED;
            PG8_LDB(B1, 0, 1); PG8_STAGE(PG8_SB(0, 0), b2, voffB);
            PG8_BAR; PG8_WAIT_L(0); PG8_MMA(0, 1, At, B1); PG8_BAR;
            PG8_LDA(At, 0, 1); PG8_STAGE(PG8_SA(0, 0), a2, voffA);
            PG8_BAR; PG8_WAIT_L(0); PG8_MMA(1, 0, At, B0); PG8_BAR; PG8_SCHED;
            PG8_STAGE(PG8_SB(0, 1), b2 + hstep, voffB);
            PG8_WAIT_V(6); PG8_BAR; PG8_MMA(1, 1, At, B1); PG8_BAR;
            PG8_LDB(B0, 1, 0); PG8_SCHED; PG8_LDA(At, 1, 0); PG8_STAGE(PG8_SA(0, 1), a2 + hstep, voffA);
            PG8_WAIT_L(8); PG8_BAR; PG8_WAIT_L(0); PG8_MMA(0, 0, At, B0); PG8_BAR; PG8_SCHED;
            PG8_LDB(B1, 1, 1); PG8_STAGE(PG8_SB(1, 0), b3, voffB);
            PG8_BAR; PG8_WAIT_L(0); PG8_MMA(0, 1, At, B1); PG8_BAR;
            PG8_LDA(At, 1, 1); PG8_STAGE(PG8_SA(1, 0), a3, voffA);
            PG8_BAR; PG8_WAIT_L(0); PG8_MMA(1, 0, At, B0); PG8_BAR; PG8_SCHED;
            PG8_STAGE(PG8_SB(1, 1), b3 + hstep, voffB);
            PG8_WAIT_V(6); PG8_BAR; PG8_MMA(1, 1, At, B1); PG8_BAR;
            }
        }
        if constexpr (ALIGN_EPI) { if (wr == 0) PG8_BAR; }
        if constexpr (!Epi::AFTER_DRAIN) { E(acc, cur, wr, wc, fr, fq); S.done(cur); }
        if (!has_next) break;
#pragma unroll
        for (int a = 0; a < 2; ++a)
#pragma unroll
            for (int b = 0; b < 2; ++b)
#pragma unroll
                for (int m = 0; m < 4; ++m)
#pragma unroll
                    for (int n = 0; n < 2; ++n) acc[a][b][m][n] = (f32x4){0.f, 0.f, 0.f, 0.f};
        cur = nxt; cA = nA; cB = nB; ++ui;
        if constexpr (ALIGN_EPI) { if (wr == 1) PG8_BAR; }
    }
    PG8_WAIT_V(0);
    if constexpr (!ALIGN_EPI) { if (wr == 0) PG8_BAR; }
    PG8_BAR;
    if constexpr (Epi::AFTER_DRAIN) { E.fused(acc, cur, wr, wc, fr, fq, lds, wid, lane); S.done(cur); }
#undef PG8_SA
#undef PG8_SB
#undef PG8_STAGE
#undef PG8_LDA
#undef PG8_LDB
#undef PG8_MMA
#undef PG8_WAIT_V
#undef PG8_WAIT_L
#undef PG8_BAR
#undef PG8_SCHED
}
}

struct EpiStoreBf16 {
  static constexpr bool PERM = true, AFTER_DRAIN = false;
  bf16_t* C; int ldc; unsigned silu_units, sigm_units;
  DI void operator()(const pg8::f32x4 (&acc)[2][2][4][2], const pg8::Unit& u, int wr, int wc, int fr, int fq) const {
    const int row0 = u.pm * 256 + wr * 64 + fr, col0 = u.pn * 256 + wc * 32 + 8 * fq;
    const bool gate = (silu_units >> u.pn) & 1u, sigm = (sigm_units >> u.pn) & 1u;
#pragma unroll
    for (int ai = 0; ai < 2; ++ai)
#pragma unroll
      for (int m = 0; m < 4; ++m) {
        bf16_t* rowp = C + (size_t)(row0 + ai * 128 + m * 16) * ldc + col0;
#pragma unroll
        for (int bj = 0; bj < 2; ++bj) {
          pg8::f32x4 v0 = acc[ai][bj][m][0], v1 = acc[ai][bj][m][1];
          if (gate) {
#pragma unroll
            for (int e = 0; e < 4; ++e) { v0[e] = siluf_(v0[e]); v1[e] = siluf_(v1[e]); }
          } else if (sigm) {
#pragma unroll
            for (int e = 0; e < 4; ++e) {
              { const float x = v0[e], ex = __expf(-fabsf(x)), mm = ex * __builtin_amdgcn_rcpf(1.f + ex); v0[e] = x < 0.f ? mm : -mm; }
              { const float x = v1[e], ex = __expf(-fabsf(x)), mm = ex * __builtin_amdgcn_rcpf(1.f + ex); v1[e] = x < 0.f ? mm : -mm; }
            }
          }
          u32x4 w_; w_[0] = pk2(v0[0], v0[1]); w_[1] = pk2(v0[2], v0[3]); w_[2] = pk2(v1[0], v1[1]); w_[3] = pk2(v1[2], v1[3]);
          *(u32x4*)(rowp + bj * 128) = w_;
        }
      }
  }
};
struct EpiStoreF32 {
  static constexpr bool PERM = false, AFTER_DRAIN = false;
  float* C0; int ldc; size_t ks_stride;
  DI void operator()(const pg8::f32x4 (&acc)[2][2][4][2], const pg8::Unit& u, int wr, int wc, int fr, int fq) const {
    float* C = C0 + (size_t)u.ks * ks_stride;
    const int row0 = u.pm * 256 + wr * 64 + fr, col0 = u.pn * 256 + wc * 32 + 4 * fq;
#pragma unroll
    for (int ai = 0; ai < 2; ++ai)
#pragma unroll
      for (int m = 0; m < 4; ++m) {
        float* rowp = C + (size_t)(row0 + ai * 128 + m * 16) * ldc + col0;
#pragma unroll
        for (int bj = 0; bj < 2; ++bj)
#pragma unroll
          for (int n = 0; n < 2; ++n) *(pg8::f32x4*)(rowp + bj * 128 + n * 16) = acc[ai][bj][m][n];
      }
  }
};
struct EpiSwiglu {
  static constexpr bool PERM = true, AFTER_DRAIN = false;
  bf16_t* C; int ldc;
  DI void operator()(const pg8::f32x4 (&acc)[2][2][4][2], const pg8::Unit& u, int wr, int wc, int fr, int fq) const {
    const int row0 = u.pm * 256 + wr * 64 + fr, col0 = u.pn * 128 + wc * 32 + 8 * fq;
#pragma unroll
    for (int ai = 0; ai < 2; ++ai)
#pragma unroll
      for (int m = 0; m < 4; ++m) {
        float y[8];
#pragma unroll
        for (int n = 0; n < 2; ++n)
#pragma unroll
          for (int e = 0; e < 4; ++e) y[4 * n + e] = siluf_(acc[ai][0][m][n][e]) * acc[ai][1][m][n][e];
        u32x4 w_; w_[0] = pk2(y[0], y[1]); w_[1] = pk2(y[2], y[3]); w_[2] = pk2(y[4], y[5]); w_[3] = pk2(y[6], y[7]);
        *(u32x4*)(C + (size_t)(row0 + ai * 128 + m * 16) * ldc + col0) = w_;
      }
  }
};

struct RowSumExchange {
  float* xbuf; unsigned* cnt; unsigned* tmo;
  DI void run(const float (&part)[2][4], const pg8::Unit& u, int wr, int wc, int fr, int fq, char* lds, float* S, int wid, int lane) const {
    float* P = (float*)lds;
    if (fq == 0) {
#pragma unroll
      for (int ai = 0; ai < 2; ++ai)
#pragma unroll
        for (int m = 0; m < 4; ++m) P[(ai * 128 + wr * 64 + m * 16 + fr) * 4 + wc] = part[ai][m];
    }
    __syncthreads();
    const int row = wid * 32 + (lane & 31);
    if (lane < 32) {
      const f32x4 a = *(const f32x4*)(P + row * 4);
      __hip_atomic_store(xbuf + ((size_t)u.pm * 256 + row) * 4 + u.pn, (a.x + a.y) + (a.z + a.w), __ATOMIC_RELAXED, __HIP_MEMORY_SCOPE_AGENT);
    }
    asm volatile("s_waitcnt vmcnt(0)" ::: "memory");
    if (lane == 0) __hip_atomic_fetch_add(cnt + 64 * u.pm, 1u, __ATOMIC_RELAXED, __HIP_MEMORY_SCOPE_AGENT);
    if (wid == 0) {
      unsigned it = 0;
      while ((unsigned)__builtin_amdgcn_readfirstlane(__hip_atomic_load(cnt + 64 * u.pm, __ATOMIC_RELAXED, __HIP_MEMORY_SCOPE_AGENT)) < 32u) {
        __builtin_amdgcn_s_sleep(2);
        if (++it > (1u << 21)) { if (lane == 0) __hip_atomic_store(tmo, 1u, __ATOMIC_RELAXED, __HIP_MEMORY_SCOPE_AGENT); break; }
      }
      __builtin_amdgcn_fence(__ATOMIC_ACQUIRE, "agent");
    }
    asm volatile("s_waitcnt vmcnt(0) lgkmcnt(0)" ::: "memory");
    __syncthreads();
    if (lane < 32) {
      const float* slot = xbuf + ((size_t)u.pm * 256 + row) * 4;
      float t = 0.f;
#pragma unroll
      for (int k = 0; k < 4; ++k) t += __hip_atomic_load(slot + k, __ATOMIC_RELAXED, __HIP_MEMORY_SCOPE_AGENT);
      S[row] = t;
    }
    __syncthreads();
  }
};
template <bool FINAL>
struct EpiResNorm {
  static constexpr bool PERM = true, AFTER_DRAIN = true;
  bf16_t* X; bf16_t* HN; const float* wpost; const float* wpre; float* yout;
  float* xbuf; unsigned* cnt; unsigned* tmo;
  DI void operator()(const pg8::f32x4 (&)[2][2][4][2], const pg8::Unit&, int, int, int, int) const {}
  DI static void ssq_rows(const pg8::f32x4 (&acc)[2][2][4][2], float (&part)[2][4]) {
#pragma unroll
    for (int ai = 0; ai < 2; ++ai)
#pragma unroll
      for (int m = 0; m < 4; ++m) {
        float q = 0.f;
#pragma unroll
        for (int bj = 0; bj < 2; ++bj)
#pragma unroll
          for (int n = 0; n < 2; ++n) { const pg8::f32x4 v = acc[ai][bj][m][n]; q += (v[0] * v[0] + v[1] * v[1]) + (v[2] * v[2] + v[3] * v[3]); }
        q += __shfl_xor(q, 16); q += __shfl_xor(q, 32);
        part[ai][m] = q;
      }
  }
  DI void fused(pg8::f32x4 (&acc)[2][2][4][2], const pg8::Unit& u, int wr, int wc, int fr, int fq, PG8_LAS unsigned char* ldsl, int wid, int lane) const {
    char* lds = (char*)ldsl;
    float* S1 = (float*)(lds + 4096);
    float* S2 = (float*)(lds + 5120);
    float part[2][4];
    ssq_rows(acc, part);
    RowSumExchange{xbuf, cnt, tmo}.run(part, u, wr, wc, fr, fq, lds, S1, wid, lane);
#pragma unroll
    for (int ai = 0; ai < 2; ++ai)
#pragma unroll
      for (int m = 0; m < 4; ++m) {
        if (m == 0) __builtin_amdgcn_sched_barrier(0);
        const int rl = ai * 128 + wr * 64 + m * 16 + fr;
        const float r1 = rsqrtf(S1[rl] * (1.f / 1024.f) + 1e-6f);
        const bf16_t* xrow = X + (size_t)(u.pm * 256 + rl) * 1024;
#pragma unroll
        for (int bj = 0; bj < 2; ++bj) {
          const int c8 = u.pn * 256 + bj * 128 + wc * 32 + 8 * fq;
          const u32x4 xr = *(const u32x4*)(xrow + c8);
          const f32x4 g0 = *(const f32x4*)(wpost + c8), g1 = *(const f32x4*)(wpost + c8 + 4);
          const f32x4 x0 = {bflo(xr[0]), bfhi(xr[0]), bflo(xr[1]), bfhi(xr[1])}, x1 = {bflo(xr[2]), bfhi(xr[2]), bflo(xr[3]), bfhi(xr[3])};
          acc[ai][bj][m][0] = x0 + acc[ai][bj][m][0] * r1 * g0;
          acc[ai][bj][m][1] = x1 + acc[ai][bj][m][1] * r1 * g1;
        }
      }
    if (FINAL) {
#pragma unroll
      for (int ai = 0; ai < 2; ++ai)
#pragma unroll
        for (int m = 0; m < 4; ++m) {
          if (m == 0) __builtin_amdgcn_sched_barrier(0);
          const int row = u.pm * 256 + ai * 128 + wr * 64 + m * 16 + fr;
          const int b = row / SEQP, t = row - b * SEQP;
          if (t >= 16) {
            float* dst = yout + ((size_t)b * 2048 + (t - 16)) * 1024;
#pragma unroll
            for (int bj = 0; bj < 2; ++bj)
#pragma unroll
              for (int n = 0; n < 2; ++n) *(f32x4*)(dst + u.pn * 256 + bj * 128 + wc * 32 + 8 * fq + 4 * n) = acc[ai][bj][m][n];
          }
        }
      return;
    }
    ssq_rows(acc, part);
    RowSumExchange{xbuf + SZ_XB_SET / 4, cnt + SZ_CNT_SET / 4, tmo}.run(part, u, wr, wc, fr, fq, lds, S2, wid, lane);
#pragma unroll
    for (int ai = 0; ai < 2; ++ai)
#pragma unroll
      for (int m = 0; m < 4; ++m) {
        if (m == 0) __builtin_amdgcn_sched_barrier(0);
        const int rl = ai * 128 + wr * 64 + m * 16 + fr;
        const float r2 = rsqrtf(S2[rl] * (1.f / 1024.f) + 1e-6f);
        bf16_t* xrow = X + (size_t)(u.pm * 256 + rl) * 1024;
        bf16_t* hrow = HN + (size_t)(u.pm * 256 + rl) * 1024;
#pragma unroll
        for (int bj = 0; bj < 2; ++bj) {
          const int c8 = u.pn * 256 + bj * 128 + wc * 32 + 8 * fq;
          const f32x4 g0 = *(const f32x4*)(wpre + c8), g1 = *(const f32x4*)(wpre + c8 + 4);
          const pg8::f32x4 v0 = acc[ai][bj][m][0], v1 = acc[ai][bj][m][1];
          u32x4 xo, ho;
          xo[0] = pk2(v0[0], v0[1]); xo[1] = pk2(v0[2], v0[3]); xo[2] = pk2(v1[0], v1[1]); xo[3] = pk2(v1[2], v1[3]);
          const pg8::f32x4 h0 = v0 * r2 * g0, h1 = v1 * r2 * g1;
          ho[0] = pk2(h0[0], h0[1]); ho[1] = pk2(h0[2], h0[3]); ho[2] = pk2(h1[0], h1[1]); ho[3] = pk2(h1[2], h1[3]);
          *(u32x4*)(xrow + c8) = xo;
          *(u32x4*)(hrow + c8) = ho;
        }
      }
  }
};
template <class Epi>
DI void gemm_run(char* lds, const bf16_t* A, const bf16_t* Bt, int N, int K, const Epi& E, int vcu, int G) {
  pg8::Gemm g{A, Bt, T_PAD, N, K, K};
  pg8::StaticOrder S; S.init(T_PAD, N, G, vcu);
  pg8::gemm_phase<Epi, pg8::StaticOrder, true, true>((PG8_LAS unsigned char*)lds, g, S, E);
}
struct SplitOrder {
  int nsplit, nitems, G, c;
  DI bool next(int i, pg8::Unit& u) const {
    const int L = i * G + c; if (L >= nitems) return false;
    const int q = L / nsplit; u.ks = L - q * nsplit; u.pm = q >> 2; u.pn = q & 3; return true;
  }
  DI void a_ready(const pg8::Unit&) const {}
  DI void done(const pg8::Unit&) const {}
};
DI void gemm_n1024_plain(char* lds, const bf16_t* A, const bf16_t* Bt, int K, float* MIXp, float* PART, int vcu, int G) {
  {
    pg8::Gemm g{A, Bt, M_MAIN, 1024, K, K};
    pg8::StaticOrder S; S.init(M_MAIN, 1024, G, vcu);
    pg8::gemm_phase<EpiStoreBf16, pg8::StaticOrder, true, true>((PG8_LAS unsigned char*)lds, g, S, EpiStoreBf16{(bf16_t*)MIXp, 1024, 0u, 0u});
  }
  {
    const int nsplit = K >> 8;
    pg8::Gemm g{A + (size_t)M_MAIN * K, Bt, 768, 1024, 256, K};
    SplitOrder S{nsplit, 12 * nsplit, G, (vcu + 128) % G};
    pg8::gemm_phase<EpiStoreF32, SplitOrder, true, true>((PG8_LAS unsigned char*)lds, g, S, EpiStoreF32{PART, 1024, (size_t)768 * 1024});
  }
}
template <bool FINAL>
DI void gemm_n1024(char* lds, const bf16_t* A, const bf16_t* Bt, int K, const EpiResNorm<FINAL>& E, float* PART, int vcu, int G) {
  {
    pg8::Gemm g{A, Bt, M_MAIN, 1024, K, K};
    pg8::StaticOrder S; S.init(M_MAIN, 1024, G, vcu);
    pg8::gemm_phase<EpiResNorm<FINAL>, pg8::StaticOrder, false, true>((PG8_LAS unsigned char*)lds, g, S, E);
  }
  __syncthreads();
  {
    const int nsplit = K >> 8;
    pg8::Gemm g{A + (size_t)M_MAIN * K, Bt, 768, 1024, 256, K};
    SplitOrder S{nsplit, 12 * nsplit, G, (vcu + 128) % G};
    pg8::gemm_phase<EpiStoreF32, SplitOrder, true, true>((PG8_LAS unsigned char*)lds, g, S, EpiStoreF32{PART, 1024, (size_t)768 * 1024});
  }
}

constexpr int L_QE = 0, L_KE = 8704, L_QI = 17408, L_G = 26112, L_KENDT = 34816, L_VT = 45056, L_DEC = 55296, L_TOT = 55808, L_SSQ = 57856;
constexpr int RS = 272, TS = 80;

template <int DK>
DI void pc_core(char* lds, f32x16 (&S)[DK / 32], f32x16& o, const int w, const int r32, const int h) {
  const char* QE = lds + L_QE + r32 * RS;
  const char* KE = lds + L_KE + r32 * RS;
  const char* QI = lds + L_QI + r32 * RS;
  f32x16 sc; zero16(sc);
#pragma unroll
  for (int s = 0; s < DK / 16; ++s) {
    const bf16x8 a = *(const bf16x8*)(KE + s * 32 + h * 16);
    const bf16x8 b = *(const bf16x8*)(QE + s * 32 + h * 16);
    sc = MFMA32(a, b, sc);
  }
#pragma unroll
  for (int r = 0; r < 16; ++r) if (crow(r, h) > r32) sc[r] = 0.f;
  const bf16x8 scb0 = pack8<0>(sc), scb1 = pack8<1>(sc);
  zero16(o);
#pragma unroll
  for (int kt = 0; kt < DK / 32; ++kt) {
    {
      const bf16x8 a = pack8<0>(S[kt]);
      const s16x4 lo = *(const s16x4*)(QI + (32 * kt + 4 * h) * 2), hi = *(const s16x4*)(QI + (32 * kt + 8 + 4 * h) * 2);
      o = MFMA32(a, cat8(lo, hi), o);
    }
    {
      const bf16x8 a = pack8<1>(S[kt]);
      const s16x4 lo = *(const s16x4*)(QI + (32 * kt + 16 + 4 * h) * 2), hi = *(const s16x4*)(QI + (32 * kt + 24 + 4 * h) * 2);
      o = MFMA32(a, cat8(lo, hi), o);
    }
  }
  const char* VTr = lds + L_VT + (32 * w + r32) * TS;
  {
    const s16x4 lo = *(const s16x4*)(VTr + (4 * h) * 2), hi = *(const s16x4*)(VTr + (8 + 4 * h) * 2);
    o = MFMA32(cat8(lo, hi), scb0, o);
  }
  {
    const s16x4 lo = *(const s16x4*)(VTr + (16 + 4 * h) * 2), hi = *(const s16x4*)(VTr + (24 + 4 * h) * 2);
    o = MFMA32(cat8(lo, hi), scb1, o);
  }
  const float* DEC = (const float*)(lds + L_DEC);
#pragma unroll
  for (int kt = 0; kt < DK / 32; ++kt)
#pragma unroll
    for (int g = 0; g < 4; ++g) {
      const f32x4 d = *(const f32x4*)(DEC + 32 * kt + 8 * g + 4 * h);
      S[kt][4 * g] *= d.x; S[kt][4 * g + 1] *= d.y; S[kt][4 * g + 2] *= d.z; S[kt][4 * g + 3] *= d.w;
    }
#pragma unroll
  for (int s = 0; s < 2; ++s) {
    const bf16x8 b = *(const bf16x8*)(VTr + s * 32 + h * 16);
#pragma unroll
    for (int kt = 0; kt < DK / 32; ++kt) {
      const bf16x8 a = *(const bf16x8*)(lds + L_KENDT + (32 * kt + r32) * TS + s * 32 + h * 16);
      S[kt] = MFMA32(a, b, S[kt]);
    }
  }
}

constexpr int NSC = 8;
DI int sc_beg(int sc) { return sc == 0 ? 0 : 16 + 256 * sc; }
DI int sc_end(int sc) { return 16 + 256 * (sc + 1); }
constexpr size_t SCR_HG_U = 0;
constexpr size_t SCR_GL_U = SCR_HG_U + (size_t)8 * 4 * 7 * 16384;
constexpr size_t SCR_HG_D = SCR_GL_U + (size_t)8 * 4 * 7 * 8192;
constexpr size_t SCR_GL_D = SCR_HG_D + (size_t)8 * 4 * 7 * 128;
constexpr size_t SCR_SS_U = 0;
constexpr size_t SCR_SS_D = SCR_SS_U + (size_t)8 * 32 * 7 * 8192;

template <int TYPE, bool SO>
DI void scan_even_job(const Params& p, char* lds, const int head, const int row0, const int ntok, const float* s_in, float* s_out, float* d_out) {
  constexpr int DK = TYPE == 0 ? 128 : 64;
  constexpr int KC = DK / 64;
  const int tid = threadIdx.x & (HB - 1), c = tid & 63, w = tid >> 6, r32 = c & 31, h = c >> 5;
  const bf16_t* P = (const bf16_t*)(p.ws + OFF_P);
  bf16_t* O = (bf16_t*)(p.ws + OFF_O);
  float* TOT = (float*)(lds + L_TOT);
  float* SSQ = (float*)(lds + L_SSQ);
  float* DEC = (float*)(lds + L_DEC);
  const int qcol = TYPE == 0 ? head * 128 : 2048 + head * 64;
  const int kcol = TYPE == 0 ? 512 + head * 128 : 2304 + head * 64;
  const int vcol = TYPE == 0 ? 1024 + head * 128 : 2560 + head * 128;
  const int gcol = TYPE == 0 ? 1536 + head * 128 : 3072 + head * 128;
  const int ocol = TYPE == 0 ? head * 128 : 512 + head * 128;
  float lb[2] = {0.f, 0.f}, wup[16], bal = 0.f;
  if (TYPE == 0) {
#pragma unroll
    for (int e = 0; e < 2; ++e) {
      const float g0 = p.in[7][head * 128 + 2 * c + e], g1 = p.in[7][512 + head * 128 + 2 * c + e], g2 = p.in[7][1024 + head * 128 + 2 * c + e];
      const float m = fmaxf(g0, fmaxf(g1, g2));
      const float e0 = __expf(g0 - m), e1 = __expf(g1 - m), e2 = __expf(g2 - m);
      lb[e] = e0 / (e0 + e1 + e2);
    }
  } else {
#pragma unroll
    for (int r = 0; r < 16; ++r) wup[r] = 0.f;
    bal = p.in[14][head * 64 + c];
  }
  const float* __restrict__ nwp = TYPE == 0 ? p.in[15] : p.in[16];
  f32x16 S[DK / 32];
#pragma unroll
  for (int kt = 0; kt < DK / 32; ++kt) zero16(S[kt]);
  if (!SO && s_in) {
#pragma unroll
    for (int kt = 0; kt < DK / 32; ++kt)
#pragma unroll
      for (int r = 0; r < 16; ++r) S[kt][r] = s_in[(size_t)(32 * kt + crow(r, h)) * 128 + 32 * w + r32];
  }
  float dsum[KC];
#pragma unroll
  for (int e = 0; e < KC; ++e) dsum[e] = 0.f;

  unsigned rq[8], rk[8], rv[8], rg[8]; float ral[8];
  auto load_raw = [&](int ch) {
#pragma unroll
    for (int i = 0; i < 8; ++i) {
      const int t = min(ch * 32 + 8 * w + i, ntok - 1);
      const bf16_t* pr = P + (size_t)(row0 + t) * LD_EV;
      if (TYPE == 0) {
        if (!SO) rq[i] = *(const unsigned*)(pr + qcol + 2 * c);
        rk[i] = *(const unsigned*)(pr + kcol + 2 * c);
      } else {
        if (!SO) rq[i] = (unsigned)pr[qcol + c];
        rk[i] = (unsigned)pr[kcol + c];
        ral[i] = bflo((unsigned)pr[3584 + head * 64 + c]);
      }
      rv[i] = *(const unsigned*)(pr + vcol + 2 * c);
      if (!SO) rg[i] = *(const unsigned*)(pr + gcol + 2 * c);
    }
  };
  const int nch = __builtin_amdgcn_readfirstlane((ntok + 31) >> 5);
  load_raw(0);
  for (int ch = 0; ch < nch; ++ch) {
    const int t0 = ch * 32;
    float kk[8][KC], cum[8][KC], run[KC];
#pragma unroll
    for (int e = 0; e < KC; ++e) run[e] = 0.f;
#pragma unroll
    for (int i = 0; i < 8; ++i) {
      const float vm = (t0 + 8 * w + i) < ntok ? 1.f : 0.f;
      if (TYPE == 0) {
#pragma unroll
        for (int e = 0; e < 2; ++e) {
          const float ts = e ? bfhi(rk[i]) : bflo(rk[i]);
          const float mm = fabsf(ts);
          const float km = (__float_as_uint(ts) >> 31) ? mm : 1.f - mm;
          const float k1 = (1.f - lb[e]) * km;
          const float f = 1.f - k1;
          kk[i][e] = vm * k1;
          run[e] += vm * __logf(f); cum[i][e] = run[e];
        }
      } else {
        const float x = bal + ral[i];
        const float ls = fminf(x, 0.f) - __logf(1.f + __expf(-fabsf(x)));
        kk[i][0] = vm * bflo(rk[i]);
        run[0] += vm * ls * (1.f / 16.f); cum[i][0] = run[0];
      }
    }
#pragma unroll
    for (int e = 0; e < KC; ++e) TOT[w * 128 + KC * c + e] = run[e];
    __syncthreads();
    float off[KC], mid[KC], tot[KC];
#pragma unroll
    for (int e = 0; e < KC; ++e) {
      const float t0_ = TOT[KC * c + e], t1_ = TOT[128 + KC * c + e], t2_ = TOT[256 + KC * c + e], t3_ = TOT[384 + KC * c + e];
      mid[e] = t0_ + t1_; tot[e] = (t0_ + t1_) + (t2_ + t3_);
      off[e] = w == 0 ? 0.f : (w == 1 ? t0_ : (w == 2 ? t0_ + t1_ : t0_ + t1_ + t2_));
      dsum[e] += tot[e];
    }
    {
      u32x4 kp[KC];
#pragma unroll
      for (int m = 0; m < 4; ++m) {
        float kend[2][KC];
#pragma unroll
        for (int i2 = 0; i2 < 2; ++i2) {
          const int i = 2 * m + i2;
          const int ti = 8 * w + i;
          float qe[KC], ke[KC], qi[KC];
#pragma unroll
          for (int e = 0; e < KC; ++e) {
            const float cv = off[e] + cum[i][e];
            kend[i2][e] = kk[i][e] * __expf(tot[e] - cv);
            if (!SO) {
              const float qv = TYPE == 0 ? (e ? bfhi(rq[i]) : bflo(rq[i])) : bflo(rq[i]) * 0.125f;
              qe[e] = qv * __expf(cv - mid[e]);
              ke[e] = kk[i][e] * __expf(mid[e] - cv);
              qi[e] = qv * __expf(cv);
            }
          }
          if (!SO) {
            if (KC == 2) {
              *(unsigned*)(lds + L_QE + ti * RS + 4 * c) = pk2(qe[0], qe[KC - 1]);
              *(unsigned*)(lds + L_KE + ti * RS + 4 * c) = pk2(ke[0], ke[KC - 1]);
              *(unsigned*)(lds + L_QI + ti * RS + 4 * c) = pk2(qi[0], qi[KC - 1]);
            } else {
              *(bf16_t*)(lds + L_QE + ti * RS + 2 * c) = (bf16_t)pk2(qe[0], 0.f);
              *(bf16_t*)(lds + L_KE + ti * RS + 2 * c) = (bf16_t)pk2(ke[0], 0.f);
              *(bf16_t*)(lds + L_QI + ti * RS + 2 * c) = (bf16_t)pk2(qi[0], 0.f);
            }
            *(unsigned*)(lds + L_G + ti * RS + 4 * c) = rg[i];
          }
        }
#pragma unroll
        for (int e = 0; e < KC; ++e) kp[e][m] = pk2(kend[0][e], kend[1][e]);
      }
#pragma unroll
      for (int e = 0; e < KC; ++e) *(u32x4*)(lds + L_KENDT + (KC * c + e) * TS + 16 * w) = kp[e];
      u32x4 v0, v1;
#pragma unroll
      for (int m = 0; m < 4; ++m) {
        v0[m] = (rv[2 * m] & 0xffffu) | (rv[2 * m + 1] << 16);
        v1[m] = (rv[2 * m] >> 16) | (rv[2 * m + 1] & 0xffff0000u);
      }
      *(u32x4*)(lds + L_VT + (2 * c) * TS + 16 * w) = v0;
      *(u32x4*)(lds + L_VT + (2 * c + 1) * TS + 16 * w) = v1;
      if (w == 0) {
#pragma unroll
        for (int e = 0; e < KC; ++e) DEC[KC * c + e] = __expf(tot[e]);
      }
    }
    __syncthreads();
    load_raw(min(ch + 1, nch - 1));
    if (SO) {
      const char* VTr = lds + L_VT + (32 * w + r32) * TS;
#pragma unroll
      for (int kt = 0; kt < DK / 32; ++kt)
#pragma unroll
        for (int g = 0; g < 4; ++g) {
          const f32x4 d = *(const f32x4*)(DEC + 32 * kt + 8 * g + 4 * h);
          S[kt][4 * g] *= d.x; S[kt][4 * g + 1] *= d.y; S[kt][4 * g + 2] *= d.z; S[kt][4 * g + 3] *= d.w;
        }
#pragma unroll
      for (int s = 0; s < 2; ++s) {
        const bf16x8 bq = *(const bf16x8*)(VTr + s * 32 + h * 16);
#pragma unroll
        for (int kt = 0; kt < DK / 32; ++kt) {
          const bf16x8 a = *(const bf16x8*)(lds + L_KENDT + (32 * kt + r32) * TS + s * 32 + h * 16);
          S[kt] = MFMA32(a, bq, S[kt]);
        }
      }
      __syncthreads();
    } else {
      f32x16 o;
      pc_core<DK>(lds, S, o, w, r32, h);
      {
        float ss = 0.f;
#pragma unroll
        for (int r = 0; r < 16; ++r) ss += o[r] * o[r];
        ss += __shfl_xor(ss, 32);
        if (h == 0) SSQ[w * 32 + r32] = ss;
      }
      __syncthreads();
      {
        const float tot2 = (SSQ[r32] + SSQ[32 + r32]) + (SSQ[64 + r32] + SSQ[96 + r32]);
        const float rstd = rsqrtf(tot2 * (1.f / 128.f) + 1e-6f);
        if (t0 + r32 < ntok) {
          bf16_t* orow = O + (size_t)(row0 + t0 + r32) * 1024 + ocol + 32 * w + 4 * h;
#pragma unroll
          for (int g = 0; g < 4; ++g) {
            const u32x2 gp = *(const u32x2*)(lds + L_G + r32 * RS + (32 * w + 8 * g + 4 * h) * 2);
            const f32x4 nw = *(const f32x4*)(nwp + 32 * w + 8 * g + 4 * h);
            const float y0 = o[4 * g] * rstd * nw.x * bflo(gp[0]);
            const float y1 = o[4 * g + 1] * rstd * nw.y * bfhi(gp[0]);
            const float y2 = o[4 * g + 2] * rstd * nw.z * bflo(gp[1]);
            const float y3 = o[4 * g + 3] * rstd * nw.w * bfhi(gp[1]);
            u32x2 v; v[0] = pk2(y0, y1); v[1] = pk2(y2, y3);
            *(u32x2*)(orow + 8 * g) = v;
          }
        }
      }
    }
  }
  if (s_out) {
#pragma unroll
    for (int kt = 0; kt < DK / 32; ++kt)
#pragma unroll
      for (int r = 0; r < 16; ++r) s_out[(size_t)(32 * kt + crow(r, h)) * 128 + 32 * w + r32] = S[kt][r];
  }
  if (SO && w == 0) {
#pragma unroll
    for (int e = 0; e < KC; ++e) d_out[KC * c + e] = dsum[e];
  }
  __syncthreads();
}

DI void phase_scan_even_a(const Params& p, char* lds, int bid, int G) {
  float* scr = (float*)(p.ws + OFF_MIX);
  const int half = threadIdx.x >> 8; lds += half * HALF_LDS;
  for (int jb = bid * 2; jb < 448 + 1024; jb += G * 2) {
    const int j = jb + half;
    if (j < 448) {
      const int type = j & 1, head = (j >> 1) & 3, b = (j >> 3) & 7, sc = j >> 6;
      const int row0 = b * SEQP + sc_beg(sc), ntok = sc_end(sc) - sc_beg(sc);
      const size_t slot = ((size_t)b * 4 + head) * 7 + sc;
      if (type == 0) scan_even_job<0, true>(p, lds, head, row0, ntok, nullptr, scr + SCR_HG_U + slot * 16384, scr + SCR_HG_D + slot * 128);
      else scan_even_job<1, true>(p, lds, head, row0, ntok, nullptr, scr + SCR_GL_U + slot * 8192, scr + SCR_GL_D + slot * 64);
    } else {
      const int jj = j - 448, type = jj & 1, head = (jj >> 1) & 3, b = jj >> 3;
      const int row0 = T_PROMPT + 4 * b;
      if (type == 0) scan_even_job<0, false>(p, lds, head, row0, 4, p.in[2] + ((size_t)b * 4 + head) * 16384, p.out + OUT_HGS + ((size_t)b * 4 + head) * 16384, nullptr);
      else scan_even_job<1, false>(p, lds, head, row0, 4, p.in[3] + ((size_t)b * 4 + head) * 8192, p.out + OUT_GLS + ((size_t)b * 4 + head) * 8192, nullptr);
    }
  }
}
DI void phase_scan_even_c(const Params& p, int bid, int G) {
  float* scr = (float*)(p.ws + OFF_MIX);
  for (int i = bid * NTHREADS + threadIdx.x; i < 32 * 4096 + 32 * 2048; i += G * NTHREADS) {
    const bool gl = i >= 32 * 4096;
    const int ii = gl ? i - 32 * 4096 : i;
    const int per = gl ? 2048 : 4096, bh = ii / per, e4 = ii - bh * per, k = e4 >> 5;
    float* U = scr + (gl ? SCR_GL_U + (size_t)bh * 7 * 8192 : SCR_HG_U + (size_t)bh * 7 * 16384) + 4 * e4;
    const float* D = scr + (gl ? SCR_GL_D + (size_t)bh * 7 * 64 : SCR_HG_D + (size_t)bh * 7 * 128) + k;
    const int ustride = gl ? 8192 : 16384, dstride = gl ? 64 : 128;
    f32x4 run = {0.f, 0.f, 0.f, 0.f};
#pragma unroll
    for (int sc = 0; sc < 7; ++sc) {
      const float d = __expf(D[sc * dstride]);
      const f32x4 u = *(const f32x4*)(U + (size_t)sc * ustride);
      run = run * d + u;
      *(f32x4*)(U + (size_t)sc * ustride) = run;
    }
  }
}
DI void phase_scan_even_b(const Params& p, char* lds, int bid, int G) {
  float* scr = (float*)(p.ws + OFF_MIX);
  const int half = threadIdx.x >> 8; lds += half * HALF_LDS;
  for (int jb = bid * 2; jb < 512; jb += G * 2) {
    const int j = jb + half;
    {
      const int type = j & 1, head = (j >> 1) & 3, b = (j >> 3) & 7, sc = j >> 6;
      const int row0 = b * SEQP + sc_beg(sc), ntok = sc_end(sc) - sc_beg(sc);
      const size_t slot = ((size_t)b * 4 + head) * 7 + sc - 1;
      if (type == 0) scan_even_job<0, false>(p, lds, head, row0, ntok, sc ? scr + SCR_HG_U + slot * 16384 : nullptr,
                                             sc == NSC - 1 ? p.out + OUT_HGP + ((size_t)b * 4 + head) * 16384 : nullptr, nullptr);
      else scan_even_job<1, false>(p, lds, head, row0, ntok, sc ? scr + SCR_GL_U + slot * 8192 : nullptr,
                                   sc == NSC - 1 ? p.out + OUT_GLP + ((size_t)b * 4 + head) * 8192 : nullptr, nullptr);
    }
  }
}

constexpr int M_BM = 0, M_CM = 8704, M_XS = 17408, M_Z = 26112, M_BT = 34816, M_VT = 45056, M_VENDT = 55296, M_CUM = 65536, M_DT = 65792, M_SSQ = 66048, M_CW = 66560;

DI void phase_conv(const Params& p, int bid, int G) {
  const bf16_t* P = (const bf16_t*)(p.ws + OFF_P);
  bf16_t* O = (bf16_t*)(p.ws + OFF_O);
  bf16_t* HN = (bf16_t*)(p.ws + OFF_HN);
  const float* __restrict__ cwp = p.in[19];
  const float* __restrict__ cbp = p.in[20];
  const int gt = bid * NTHREADS + threadIdx.x, NPAR = (G * NTHREADS) / 384;
  const int cg = gt % 384, r0 = gt / 384, ch = 8 * cg;
  if (r0 >= NPAR) return;
  float w[4][8], bs[8];
#pragma unroll
  for (int k = 0; k < 4; ++k) {
    const f32x4 a = *(const f32x4*)(cwp + k * 3072 + ch), b_ = *(const f32x4*)(cwp + k * 3072 + ch + 4);
    w[k][0] = a.x; w[k][1] = a.y; w[k][2] = a.z; w[k][3] = a.w; w[k][4] = b_.x; w[k][5] = b_.y; w[k][6] = b_.z; w[k][7] = b_.w;
  }
  {
    const f32x4 a = *(const f32x4*)(cbp + ch), b_ = *(const f32x4*)(cbp + ch + 4);
    bs[0] = a.x; bs[1] = a.y; bs[2] = a.z; bs[3] = a.w; bs[4] = b_.x; bs[5] = b_.y; bs[6] = b_.z; bs[7] = b_.w;
  }
  bf16_t* dbase = ch < 2048 ? O + ch : HN + (ch - 2048);
  const int dld = ch < 2048 ? 2048 : 1024;
  for (int run = r0; run < 8 * 258; run += NPAR) {
    const int b = run / 258, t0 = (run - b * 258) * 8, row0 = b * SEQP + t0;
    u32x4 pre[11];
#pragma unroll
    for (int i = 0; i < 11; ++i) {
      const int r = row0 + i - 3;
      pre[i] = (i >= 3 || t0 > 0) ? *(const u32x4*)(P + (size_t)r * LD_OD + 2048 + ch) : (u32x4){0u, 0u, 0u, 0u};
    }
#pragma unroll
    for (int i = 0; i < 8; ++i) {
      u32x4 o;
#pragma unroll
      for (int q = 0; q < 4; ++q) {
        float a0 = bs[2 * q], a1 = bs[2 * q + 1];
#pragma unroll
        for (int k = 0; k < 4; ++k) { a0 += bflo(pre[i + k][q]) * w[k][2 * q]; a1 += bfhi(pre[i + k][q]) * w[k][2 * q + 1]; }
        o[q] = pk2(siluf_(a0), siluf_(a1));
      }
      *(u32x4*)(dbase + (size_t)(row0 + i) * dld) = o;
    }
  }
  for (int sq = r0; sq < 128; sq += NPAR) {
    const int row0 = T_PROMPT + 4 * sq;
    float pf[7][8];
#pragma unroll
    for (int i = 0; i < 3; ++i) {
      const f32x4 a = *(const f32x4*)(p.in[5] + ((size_t)sq * 3 + i) * 3072 + ch), b_ = *(const f32x4*)(p.in[5] + ((size_t)sq * 3 + i) * 3072 + ch + 4);
      pf[i][0] = a.x; pf[i][1] = a.y; pf[i][2] = a.z; pf[i][3] = a.w; pf[i][4] = b_.x; pf[i][5] = b_.y; pf[i][6] = b_.z; pf[i][7] = b_.w;
    }
#pragma unroll
    for (int i = 0; i < 4; ++i) {
      const u32x4 u = *(const u32x4*)(P + (size_t)(row0 + i) * LD_OD + 2048 + ch);
#pragma unroll
      for (int q = 0; q < 4; ++q) { pf[3 + i][2 * q] = bflo(u[q]); pf[3 + i][2 * q + 1] = bfhi(u[q]); }
    }
#pragma unroll
    for (int i = 0; i < 4; ++i) {
      u32x4 o;
#pragma unroll
      for (int q = 0; q < 4; ++q) {
        float a0 = bs[2 * q], a1 = bs[2 * q + 1];
#pragma unroll
        for (int k = 0; k < 4; ++k) { a0 += pf[i + k][2 * q] * w[k][2 * q]; a1 += pf[i + k][2 * q + 1] * w[k][2 * q + 1]; }
        o[q] = pk2(siluf_(a0), siluf_(a1));
      }
      *(u32x4*)(dbase + (size_t)(row0 + i) * dld) = o;
    }
  }
}

template <bool SO>
DI void scan_odd_job(const Params& p, char* lds, const int b, const int hp, const bool smp, const int tbeg, const int tend, const float* s_in, float* s_out, float* d_out) {
  const int tid = threadIdx.x & (HB - 1), c = tid & 63, w = tid >> 6, r32 = c & 31, h = c >> 5;
  const int grp = hp >> 2, hl = w >> 1, headw = 2 * hp + hl;
  const int row0 = (smp ? T_PROMPT + 4 * b : b * SEQP) + tbeg, ntok = tend - tbeg;
  const bf16_t* P = (const bf16_t*)(p.ws + OFF_P);
  bf16_t* O = (bf16_t*)(p.ws + OFF_O);
  const bf16_t* BC = (const bf16_t*)(p.ws + OFF_HN);
  float* CUM = (float*)(lds + M_CUM);
  float* DTL = (float*)(lds + M_DT);
  float* SSQ = (float*)(lds + M_SSQ);
  const int hd_l = 2 * hp + h;
  const float dtb = p.in[21][hd_l], aneg = -__expf(p.in[22][hd_l]);
  const float dsk = p.in[23][headw];
  f32x16 S[4];
  {
#pragma unroll
    for (int kt = 0; kt < 4; ++kt) zero16(S[kt]);
    if (!SO && s_in) {
      const float* sin = s_in + ((size_t)hl * 64 + 32 * (w & 1) + r32) * 128;
#pragma unroll
      for (int kt = 0; kt < 4; ++kt)
#pragma unroll
        for (int g = 0; g < 4; ++g) {
          const f32x4 v = *(const f32x4*)(sin + 32 * kt + 8 * g + 4 * h);
          S[kt][4 * g] = v.x; S[kt][4 * g + 1] = v.y; S[kt][4 * g + 2] = v.z; S[kt][4 * g + 3] = v.w;
        }
    }
  }
  float dsum = 0.f;
  unsigned rx[8], rb[8], rc[8], rz[8]; float rdt;
  auto load_raw = [&](int ch) {
#pragma unroll
    for (int i = 0; i < 8; ++i) {
      const int t = min(ch * 32 + 8 * w + i, ntok - 1);
      rx[i] = *(const unsigned*)(O + (size_t)(row0 + t) * 2048 + hp * 128 + 2 * c);
      rb[i] = *(const unsigned*)(BC + (size_t)(row0 + t) * 1024 + grp * 128 + 2 * c);
      if (!SO) {
        rc[i] = *(const unsigned*)(BC + (size_t)(row0 + t) * 1024 + 512 + grp * 128 + 2 * c);
        rz[i] = *(const unsigned*)(P + (size_t)(row0 + t) * LD_OD + hp * 128 + 2 * c);
      }
    }
    {
      const int t = min(ch * 32 + r32, ntok - 1);
      rdt = bflo((unsigned)P[(size_t)(row0 + t) * LD_OD + 5120 + hd_l]);
    }
  };
  const int nch = __builtin_amdgcn_readfirstlane((ntok + 31) >> 5);
  load_raw(0);
  for (int ch = 0; ch < nch; ++ch) {
    const int t0 = ch * 32;
    {
      const float xdt = rdt + dtb;
      float dt = xdt > 20.f ? xdt : __logf(1.f + __expf(xdt));
      dt = (t0 + r32 < ntok) ? dt : 0.f;
      float cs = dt * aneg;
#pragma unroll
      for (int d = 1; d < 32; d <<= 1) { const float o_ = __shfl_up(cs, d, 32); if (r32 >= d) cs += o_; }
      if (w == 0) { CUM[h * 32 + r32] = cs; DTL[h * 32 + r32] = dt; }
    }
    {
#pragma unroll
      for (int i = 0; i < 8; ++i) {
        if (!SO) {
          *(unsigned*)(lds + M_BM + (8 * w + i) * RS + 4 * c) = rb[i];
          *(unsigned*)(lds + M_CM + (8 * w + i) * RS + 4 * c) = rc[i];
          *(unsigned*)(lds + M_XS + (8 * w + i) * RS + 4 * c) = rx[i];
          *(unsigned*)(lds + M_Z + (8 * w + i) * RS + 4 * c) = rz[i];
        }
      }
      u32x4 b0, b1;
#pragma unroll
      for (int m = 0; m < 4; ++m) {
        b0[m] = (rb[2 * m] & 0xffffu) | (rb[2 * m + 1] << 16);
        b1[m] = (rb[2 * m] >> 16) | (rb[2 * m + 1] & 0xffff0000u);
      }
      *(u32x4*)(lds + M_BT + (2 * c) * TS + 16 * w) = b0;
      *(u32x4*)(lds + M_BT + (2 * c + 1) * TS + 16 * w) = b1;
    }
    __syncthreads();
    {
      const int hx = c >> 5;
      const float last = CUM[hx * 32 + 31];
      float vt[8][2], ve[8][2];
#pragma unroll
      for (int i = 0; i < 8; ++i) {
        const int ti = 8 * w + i;
        const float dt = DTL[hx * 32 + ti], cm = CUM[hx * 32 + ti];
        const float ee = __expf(last - cm);
        vt[i][0] = bflo(rx[i]) * dt; vt[i][1] = bfhi(rx[i]) * dt;
        ve[i][0] = vt[i][0] * ee; ve[i][1] = vt[i][1] * ee;
      }
#pragma unroll
      for (int e = 0; e < 2; ++e) {
        u32x4 pv, pe;
#pragma unroll
        for (int m = 0; m < 4; ++m) { pv[m] = pk2(vt[2 * m][e], vt[2 * m + 1][e]); pe[m] = pk2(ve[2 * m][e], ve[2 * m + 1][e]); }
        if (!SO) *(u32x4*)(lds + M_VT + (2 * c + e) * TS + 16 * w) = pv;
        *(u32x4*)(lds + M_VENDT + (2 * c + e) * TS + 16 * w) = pe;
      }
    }
    __syncthreads();
    load_raw(min(ch + 1, nch - 1));
    f32x16 o;
    const float lastw = CUM[hl * 32 + 31];
    dsum += lastw;
    if (!SO) {
      const char* BMr = lds + M_BM + r32 * RS;
      const char* CMr = lds + M_CM + r32 * RS;
      f32x16 sc; zero16(sc);
#pragma unroll
      for (int s = 0; s < 8; ++s) {
        const bf16x8 a = *(const bf16x8*)(BMr + s * 32 + h * 16);
        const bf16x8 bq = *(const bf16x8*)(CMr + s * 32 + h * 16);
        sc = MFMA32(a, bq, sc);
      }
      const float ci = CUM[hl * 32 + r32];
#pragma unroll
      for (int g = 0; g < 4; ++g) {
        const f32x4 cj = *(const f32x4*)(CUM + hl * 32 + 8 * g + 4 * h);
#pragma unroll
        for (int e = 0; e < 4; ++e) {
          const int j = 8 * g + 4 * h + e;
          const float cje = e == 0 ? cj.x : (e == 1 ? cj.y : (e == 2 ? cj.z : cj.w));
          sc[4 * g + e] = (j <= r32) ? sc[4 * g + e] * __expf(ci - cje) : 0.f;
        }
      }
      const bf16x8 scb0 = pack8<0>(sc), scb1 = pack8<1>(sc);
      zero16(o);
#pragma unroll
      for (int kt = 0; kt < 4; ++kt) {
        {
          const bf16x8 a = pack8<0>(S[kt]);
          const s16x4 lo = *(const s16x4*)(CMr + (32 * kt + 4 * h) * 2), hi = *(const s16x4*)(CMr + (32 * kt + 8 + 4 * h) * 2);
          o = MFMA32(a, cat8(lo, hi), o);
        }
        {
          const bf16x8 a = pack8<1>(S[kt]);
          const s16x4 lo = *(const s16x4*)(CMr + (32 * kt + 16 + 4 * h) * 2), hi = *(const s16x4*)(CMr + (32 * kt + 24 + 4 * h) * 2);
          o = MFMA32(a, cat8(lo, hi), o);
        }
      }
      const float ei = __expf(ci);
#pragma unroll
      for (int r = 0; r < 16; ++r) o[r] *= ei;
      const char* VTr = lds + M_VT + (32 * w + r32) * TS;
      {
        const s16x4 lo = *(const s16x4*)(VTr + (4 * h) * 2), hi = *(const s16x4*)(VTr + (8 + 4 * h) * 2);
        o = MFMA32(cat8(lo, hi), scb0, o);
      }
      {
        const s16x4 lo = *(const s16x4*)(VTr + (16 + 4 * h) * 2), hi = *(const s16x4*)(VTr + (24 + 4 * h) * 2);
        o = MFMA32(cat8(lo, hi), scb1, o);
      }
    }
    {
      const float el = __expf(lastw);
#pragma unroll
      for (int kt = 0; kt < 4; ++kt)
#pragma unroll
        for (int r = 0; r < 16; ++r) S[kt][r] *= el;
      const char* VEr = lds + M_VENDT + (32 * w + r32) * TS;
#pragma unroll
      for (int s = 0; s < 2; ++s) {
        const bf16x8 bq = *(const bf16x8*)(VEr + s * 32 + h * 16);
#pragma unroll
        for (int kt = 0; kt < 4; ++kt) {
          const bf16x8 a = *(const bf16x8*)(lds + M_BT + (32 * kt + r32) * TS + s * 32 + h * 16);
          S[kt] = MFMA32(a, bq, S[kt]);
        }
      }
    }
    if (!SO) {
      float y[16]; float ss = 0.f;
#pragma unroll
      for (int g = 0; g < 4; ++g) {
        const u32x2 xp = *(const u32x2*)(lds + M_XS + r32 * RS + (32 * w + 8 * g + 4 * h) * 2);
        const u32x2 zp = *(const u32x2*)(lds + M_Z + r32 * RS + (32 * w + 8 * g + 4 * h) * 2);
        y[4 * g] = (o[4 * g] + dsk * bflo(xp[0])) * bflo(zp[0]);
        y[4 * g + 1] = (o[4 * g + 1] + dsk * bfhi(xp[0])) * bfhi(zp[0]);
        y[4 * g + 2] = (o[4 * g + 2] + dsk * bflo(xp[1])) * bflo(zp[1]);
        y[4 * g + 3] = (o[4 * g + 3] + dsk * bfhi(xp[1])) * bfhi(zp[1]);
      }
#pragma unroll
      for (int r = 0; r < 16; ++r) ss += y[r] * y[r];
      ss += __shfl_xor(ss, 32);
      if (h == 0) SSQ[w * 32 + r32] = ss;
      if (t0 + r32 < ntok) {
        bf16_t* orow = O + (size_t)(row0 + t0 + r32) * 2048 + hp * 128 + 32 * w + 4 * h;
#pragma unroll
        for (int g = 0; g < 4; ++g) { u32x2 v; v[0] = pk2(y[4 * g], y[4 * g + 1]); v[1] = pk2(y[4 * g + 2], y[4 * g + 3]); *(u32x2*)(orow + 8 * g) = v; }
      }
    }
    __syncthreads();
    if (!SO && tid < 32 && t0 + tid < ntok) {
      float* q = (float*)(p.ws + OFF_SSQ);
      q[(size_t)(row0 + t0 + tid) * 16 + hp] = (SSQ[tid] + SSQ[32 + tid]) + (SSQ[64 + tid] + SSQ[96 + tid]);
    }
  }
  if (s_out) {
    float* so = s_out + ((size_t)hl * 64 + 32 * (w & 1) + r32) * 128;
#pragma unroll
    for (int kt = 0; kt < 4; ++kt)
#pragma unroll
      for (int g = 0; g < 4; ++g) {
        f32x4 v = {S[kt][4 * g], S[kt][4 * g + 1], S[kt][4 * g + 2], S[kt][4 * g + 3]};
        *(f32x4*)(so + 32 * kt + 8 * g + 4 * h) = v;
      }
  }
  if (SO && (w & 1) == 0 && c == 0) d_out[hl * 7] = dsum;
  __syncthreads();
}

DI void phase_scan_odd_a(const Params& p, char* lds, int bid, int G) {
  float* scr = (float*)(p.ws + OFF_MIX);
  const int half = threadIdx.x >> 8; lds += half * HALF_LDS;
  for (int jb = bid * 2; jb < 896 + 2048; jb += G * 2) {
    const int j = jb + half;
    if (j >= 896) {
      const int jj = j - 896, hp = jj & 15, b = jj >> 4;
      scan_odd_job<false>(p, lds, b, hp, true, 0, 4, p.in[4] + ((size_t)b * 32 + 2 * hp) * 8192, p.out + OUT_SSS + ((size_t)b * 32 + 2 * hp) * 8192, nullptr);
      continue;
    }
    const int hp = j & 15, b = (j >> 4) & 7, sc = j >> 7;
    float* U = scr + SCR_SS_U + ((((size_t)b * 16 + hp) * 7 + sc) * 2) * 8192;
    float* D = scr + SCR_SS_D + ((size_t)b * 32 + 2 * hp) * 7 + sc;
    scan_odd_job<true>(p, lds, b, hp, false, sc_beg(sc), sc_end(sc), nullptr, U, D);
  }
}
DI void phase_scan_odd_c(const Params& p, int bid, int G) {
  float* scr = (float*)(p.ws + OFF_MIX);
  for (int i = bid * NTHREADS + threadIdx.x; i < 128 * 2 * 2048; i += G * NTHREADS) {
    const int e4 = i & 2047, hd = (i >> 11) & 1, bhp = i >> 12;
    float* U = scr + SCR_SS_U + ((size_t)bhp * 7 * 2 + hd) * 8192 + 4 * e4;
    const float* D = scr + SCR_SS_D + ((size_t)(bhp >> 4) * 32 + 2 * (bhp & 15) + hd) * 7;
    f32x4 run = {0.f, 0.f, 0.f, 0.f};
#pragma unroll
    for (int sc = 0; sc < 7; ++sc) {
      const float d = __expf(D[sc]);
      const f32x4 u = *(const f32x4*)(U + (size_t)sc * 16384);
      run = run * d + u;
      *(f32x4*)(U + (size_t)sc * 16384) = run;
    }
  }
}
DI void phase_scan_odd_b(const Params& p, char* lds, int bid, int G) {
  float* scr = (float*)(p.ws + OFF_MIX);
  const int half = threadIdx.x >> 8; lds += half * HALF_LDS;
  for (int jb = bid * 2; jb < 1024; jb += G * 2) {
    const int j = jb + half;
    {
      const int hp = j & 15, b = (j >> 4) & 7, sc = j >> 7;
      const float* s_in = sc ? scr + SCR_SS_U + ((((size_t)b * 16 + hp) * 7 + sc - 1) * 2) * 8192 : nullptr;
      float* s_out = sc == NSC - 1 ? p.out + OUT_SSP + ((size_t)b * 32 + 2 * hp) * 8192 : nullptr;
      scan_odd_job<false>(p, lds, b, hp, false, sc_beg(sc), sc_end(sc), s_in, s_out, nullptr);
    }
  }
  const bf16_t* P = (const bf16_t*)(p.ws + OFF_P);
  for (int i = bid * NTHREADS + threadIdx.x; i < 136 * 3 * 3072; i += G * NTHREADS) {
    const int ch = i % 3072, r = i / 3072, j = r % 3, b = r / 3;
    if (b < 8) p.out[OUT_CVP + ((size_t)b * 3 + j) * 3072 + ch] = bflo((unsigned)P[(size_t)(b * SEQP + 2061 + j) * LD_OD + 2048 + ch]);
    else { const int bs = b - 8; p.out[OUT_CVS + ((size_t)bs * 3 + j) * 3072 + ch] = bflo((unsigned)P[(size_t)(T_PROMPT + 4 * bs + 1 + j) * LD_OD + 2048 + ch]); }
  }
}

#define XB_TMO      128
#define XB_XCNT(j)  (256  + 64 * (j))
#define XB_XSUB(j)  (1280 + 64 * (j))
#define XB_XGEN(j)  (2304 + 64 * (j))
#define XB_TOP      3328
#define XB_TOPGEN   3392
#define XCD_BAR_WORDS 3456
#define XB_SPIN_CAP (1u << 20)
#define LAS __attribute__((address_space(3)))
DI unsigned xb_ld(unsigned* p) { return __hip_atomic_load(p, __ATOMIC_RELAXED, __HIP_MEMORY_SCOPE_AGENT); }
DI unsigned xb_add(unsigned* p, unsigned v) { return __hip_atomic_fetch_add(p, v, __ATOMIC_RELAXED, __HIP_MEMORY_SCOPE_AGENT); }
DI unsigned xb_xcc_id() { return (unsigned)__builtin_amdgcn_s_getreg((3 << 11) | 20) & 0xFu; }
#define XB_SPIN(cond, bar) do { unsigned _sp = 0; while (cond) { __builtin_amdgcn_s_sleep(1); \
    if ((++_sp & 255u) == 0u) { if (xb_ld(&(bar)[XB_TMO])) break; if (_sp > XB_SPIN_CAP) { atomicAdd(&(bar)[XB_TMO], 1u); break; } } } } while (0)
struct XcdBarrier { unsigned* bar; unsigned x; volatile LAS unsigned* st; };
DI XcdBarrier xcd_barrier_post(unsigned* bar, volatile LAS unsigned* st) {
  XcdBarrier b; b.bar = bar; b.x = xb_xcc_id(); b.st = st;
  if (threadIdx.x == 0) (void)xb_add(&bar[XB_XCNT(b.x)], 1u);
  return b;
}
DI void xcd_barrier_complete(unsigned* bar, unsigned x, unsigned& nloc, unsigned& nx) {
  const unsigned G = gridDim.x * gridDim.y * gridDim.z;
  unsigned sum, cnt, mine, sp = 0u;
  for (;;) {
    sum = 0u; cnt = 0u; mine = 0u;
#pragma unroll
    for (unsigned j = 0; j < 16; ++j) { const unsigned c = xb_ld(&bar[XB_XCNT(j)]); sum += c; cnt += (c > 0u) ? 1u : 0u; mine = (j == x) ? c : mine; }
    if (sum == G) break;
    __builtin_amdgcn_s_sleep(1);
    if ((++sp & 255u) == 0u) { if (xb_ld(&bar[XB_TMO])) break; if (sp > XB_SPIN_CAP) { atomicAdd(&bar[XB_TMO], 1u); break; } }
  }
  nloc = mine > 0u ? mine : 1u; nx = cnt > 0u ? cnt : 1u;
}
DI void xcd_barrier(const XcdBarrier& b) {
  asm volatile("s_waitcnt vmcnt(0)" ::: "memory");
  __syncthreads();
  if (threadIdx.x == 0) {
    unsigned* bar = b.bar;
    __builtin_amdgcn_s_waitcnt(0);
    unsigned nloc = b.st[0], nx = b.st[1];
    if (nloc == 0u) { xcd_barrier_complete(bar, b.x, nloc, nx); b.st[0] = nloc; b.st[1] = nx; }
    const unsigned old = xb_add(&bar[XB_XSUB(b.x)], 1u);
    const unsigned gen = old / nloc;
    if (old + 1u == (gen + 1u) * nloc) {
      __builtin_amdgcn_fence(__ATOMIC_RELEASE, "agent");
      asm volatile("s_waitcnt vmcnt(0)" ::: "memory");
      const unsigned og = xb_add(&bar[XB_TOP], 1u);
      const unsigned tg = og / nx;
      if (og + 1u == (tg + 1u) * nx) xb_add(&bar[XB_TOPGEN], 1u);
      else XB_SPIN(xb_ld(&bar[XB_TOPGEN]) == tg, bar);
      __builtin_amdgcn_fence(__ATOMIC_ACQUIRE, "agent");
      xb_add(&bar[XB_XGEN(b.x)], 1u);
      asm volatile("s_waitcnt vmcnt(0)" ::: "memory");
    } else {
      XB_SPIN(xb_ld(&bar[XB_XGEN(b.x)]) == gen, bar);
      __builtin_amdgcn_fence(__ATOMIC_ACQUIRE, "agent");
      asm volatile("s_waitcnt vmcnt(0)" ::: "memory");
    }
  }
  __syncthreads();
}

constexpr int N_PHASES = 21;
#ifndef ONLY_PHASE
#define ONLY_PHASE -1
#endif
#define PHASE(k, body) do { if ((ONLY_PHASE < 0 || ONLY_PHASE == (k)) && ph_lo <= (k) && (k) <= ph_hi) { body; } if (ph_lo <= (k) && (k) < ph_hi) xcd_barrier(xb); } while (0)

__global__ void __launch_bounds__(NTHREADS, 2) fwd_mega(Params p, int ph_lo, int ph_hi) {
  extern __shared__ __attribute__((aligned(16))) char lds[];
  cg::grid_group grid = cg::this_grid();
  const int G = gridDim.x, bid = blockIdx.x;
  if (ph_lo > 1000) grid.sync();
  volatile LAS unsigned* xst = (volatile LAS unsigned*)(lds + 2 * HALF_LDS);
  if (threadIdx.x == 0) { xst[0] = 0u; xst[1] = 0u; }
  __syncthreads();
  XcdBarrier xb = xcd_barrier_post((unsigned*)(p.ws + OFF_BAR), xst);
  bf16_t* HN = (bf16_t*)(p.ws + OFF_HN);
  bf16_t* Pb = (bf16_t*)(p.ws + OFF_P);
  bf16_t* Ob = (bf16_t*)(p.ws + OFF_O);
  float* MIX = (float*)(p.ws + OFF_MIX);
  PHASE(0, phase_prep(p, lds, bid, G));
  PHASE(1, gemm_run(lds, HN, (const bf16_t*)(p.ws + OFF_WT_EVIN), LD_EV, 1024, EpiStoreBf16{Pb, LD_EV, (1u << 6) | (1u << 7) | (1u << 12) | (1u << 13), (1u << 2) | (1u << 3)}, bid, G));
  PHASE(2, phase_scan_even_a(p, lds, bid, G));
  PHASE(3, phase_scan_even_c(p, bid, G));
  PHASE(4, phase_scan_even_b(p, lds, bid, G));
  PHASE(5, gemm_n1024<false>(lds, Ob, (const bf16_t*)(p.ws + OFF_WT_EVOUT), 1024, EpiResNorm<false>{(bf16_t*)(p.ws + OFF_X), (bf16_t*)(p.ws + OFF_HN), p.in[9], p.in[10], nullptr, (float*)(p.ws + OFF_XB) + 0 * (SZ_XB_SET / 4), (unsigned*)(p.ws + OFF_CNT) + 0 * (SZ_CNT_SET / 4), (unsigned*)(p.ws + OFF_BAR) + 64}, (float*)Pb, bid, G));
  PHASE(6, phase_rowwise(p, p.in[9], p.in[10], false, (const float*)Pb, 4, M_MAIN, bid, G));
  PHASE(7, gemm_run(lds, HN, (const bf16_t*)(p.ws + OFF_WT_GU), 5632, 1024, EpiSwiglu{Pb, 2816}, bid, G));
  PHASE(8, gemm_n1024<false>(lds, Pb, (const bf16_t*)(p.ws + OFF_WT_DN), 2816, EpiResNorm<false>{(bf16_t*)(p.ws + OFF_X), (bf16_t*)(p.ws + OFF_HN), p.in[11], p.in[8] + 1024, nullptr, (float*)(p.ws + OFF_XB) + 2 * (SZ_XB_SET / 4), (unsigned*)(p.ws + OFF_CNT) + 2 * (SZ_CNT_SET / 4), (unsigned*)(p.ws + OFF_BAR) + 64}, (float*)Ob, bid, G));
  PHASE(9, phase_rowwise(p, p.in[11], p.in[8] + 1024, false, (const float*)Ob, 11, M_MAIN, bid, G));
  PHASE(10, gemm_run(lds, HN, (const bf16_t*)(p.ws + OFF_WT_ODIN), LD_OD, 1024, EpiStoreBf16{Pb, LD_OD, 0xffu, 0u}, bid, G));
  PHASE(11, phase_conv(p, bid, G));
  PHASE(12, phase_scan_odd_a(p, lds, bid, G));
  PHASE(13, phase_scan_odd_c(p, bid, G));
  PHASE(14, phase_scan_odd_b(p, lds, bid, G));
  PHASE(15, phase_groupnorm(p, bid, G));
  PHASE(16, gemm_n1024<false>(lds, Ob, (const bf16_t*)(p.ws + OFF_WT_ODOUT), 2048, EpiResNorm<false>{(bf16_t*)(p.ws + OFF_X), (bf16_t*)(p.ws + OFF_HN), p.in[9] + 1024, p.in[10] + 1024, nullptr, (float*)(p.ws + OFF_XB) + 4 * (SZ_XB_SET / 4), (unsigned*)(p.ws + OFF_CNT) + 4 * (SZ_CNT_SET / 4), (unsigned*)(p.ws + OFF_BAR) + 64}, (float*)Pb, bid, G));
  PHASE(17, phase_rowwise(p, p.in[9] + 1024, p.in[10] + 1024, false, (const float*)Pb, 8, M_MAIN, bid, G));
  PHASE(18, gemm_run(lds, HN, (const bf16_t*)(p.ws + OFF_WT_GU + SZ_WT_GU1), 5632, 1024, EpiSwiglu{Pb, 2816}, bid, G));
  PHASE(19, gemm_n1024<true>(lds, Pb, (const bf16_t*)(p.ws + OFF_WT_DN + SZ_WT_DN1), 2816, EpiResNorm<true>{(bf16_t*)(p.ws + OFF_X), (bf16_t*)(p.ws + OFF_HN), p.in[11] + 1024, nullptr, p.out + OUT_YP, (float*)(p.ws + OFF_XB) + 6 * (SZ_XB_SET / 4), (unsigned*)(p.ws + OFF_CNT) + 6 * (SZ_CNT_SET / 4), (unsigned*)(p.ws + OFF_BAR) + 64}, (float*)Ob, bid, G));
  PHASE(20, phase_rowwise(p, p.in[11] + 1024, nullptr, true, (const float*)Ob, 11, M_MAIN, bid, G));
}

extern "C" void kernel_launch(void* const* d_in, const int* in_sizes, int n_in, void* d_out, int out_size, void* d_ws, size_t ws_size, hipStream_t stream) {
  static int grid_blocks = 0;
  if (!grid_blocks) {
    int dev = 0, cus = 0, per_cu = 0;
    hipGetDevice(&dev);
    hipDeviceGetAttribute(&cus, hipDeviceAttributeMultiprocessorCount, dev);
    hipFuncSetAttribute((const void*)fwd_mega, hipFuncAttributeMaxDynamicSharedMemorySize, LDS_BYTES);
    hipOccupancyMaxActiveBlocksPerMultiprocessor(&per_cu, (const void*)fwd_mega, NTHREADS, LDS_BYTES);
    if (per_cu < 1) per_cu = 1;
    if (per_cu > 1) per_cu = 1;
    grid_blocks = cus * per_cu;
    if (ws_size < WS_END) fprintf(stderr, "kernel_launch: workspace too small: %zu < %zu\n", ws_size, (size_t)WS_END);
  }
  Params p{};
  for (int i = 0; i < 29; ++i) p.in[i] = (const float*)d_in[i];
  p.out = (float*)d_out;
  p.ws = (char*)d_ws;
  (void)hipMemsetAsync((char*)d_ws + OFF_BAR, 0, 16384 + 8 * SZ_CNT_SET, stream);
#if ONE_LAUNCH
  int lo = 0, hi = N_PHASES - 1;
  void* args[] = {&p, &lo, &hi};
  hipError_t e = hipLaunchCooperativeKernel((const void*)fwd_mega, dim3(grid_blocks), dim3(NTHREADS), args, LDS_BYTES, stream);
  if (e != hipSuccess) fprintf(stderr, "cooperative launch failed: %s (grid %d)\n", hipGetErrorString(e), grid_blocks);
#else
  for (int ph = 0; ph < N_PHASES; ++ph) {
    int lo = ph, hi = ph;
    void* args[] = {&p, &lo, &hi};
    hipError_t e = hipLaunchCooperativeKernel((const void*)fwd_mega, dim3(grid_blocks), dim3(NTHREADS), args, LDS_BYTES, stream);
    if (e != hipSuccess) fprintf(stderr, "launch failed: %s (grid %d)\n", hipGetErrorString(e), grid_blocks);
  }
#endif
}
```
